# Optimizing an MI355X kernel written in HIP

```python
import math
import jax, jax.numpy as jnp
from jax import lax
import numpy as np

D_MODEL = 1024
BATCH = 8
SEQ = 2048
DEPTH = 1
DEC_BATCH = 128
DEC_SEQ = 4
PAST_LEN = 16384
PAGE_SIZE = 128

D_MIX = 2 * D_MODEL
S5_WIDTH = D_MIX // 4
S5_GROUP = 16
S5_GROUPS = S5_WIDTH // S5_GROUP
S5_STATE = 64
SSD_WIDTH = D_MIX - S5_WIDTH
SSD_HEAD_DIM = 64
SSD_HEADS = SSD_WIDTH // SSD_HEAD_DIM
SSD_GROUPS = 4
SSD_STATE = 128
SSD_CONV = 4
SSD_CHUNK = 128
SSD_XBC = SSD_WIDTH + 2 * SSD_GROUPS * SSD_STATE
IN_WIDTH = S5_WIDTH + SSD_WIDTH + SSD_XBC + SSD_HEADS
D_FF = ((8 * D_MODEL // 3 + 255) // 256) * 256
EPS = 1e-6

kernel_name = "hymba_s5_ssd_macaron_step"


def rmsnorm(x, w):
    xf = x.astype(jnp.float32)
    xf = xf * lax.rsqrt(jnp.mean(xf * xf, axis=-1, keepdims=True) + EPS)
    return (xf * w.astype(jnp.float32)).astype(x.dtype)


def swiglu(h, w_gate, w_up, w_down):
    return (jax.nn.silu(h @ w_gate) * (h @ w_up)) @ w_down


def _cplx_combine(e1, e2):
    a1r, a1i, b1r, b1i = e1
    a2r, a2i, b2r, b2i = e2
    return (a2r * a1r - a2i * a1i, a2r * a1i + a2i * a1r,
            a2r * b1r - a2i * b1i + b2r, a2r * b1i + a2i * b1r + b2i)


def s5_scan(u, s_re0, s_im0, lam_re, lam_im, log_step, b_re, b_im, c_re, c_im, d_skip):
    f32 = jnp.float32
    lam_re, lam_im = lam_re.astype(f32), lam_im.astype(f32)
    step = jnp.exp(log_step.astype(f32))[:, None]
    mag = jnp.exp(lam_re * step)
    ang = lam_im * step
    abar_re, abar_im = mag * jnp.cos(ang), mag * jnp.sin(ang)
    den = lam_re * lam_re + lam_im * lam_im
    nre, nim = abar_re - 1.0, abar_im
    coef_re = (nre * lam_re + nim * lam_im) / den
    coef_im = (nim * lam_re - nre * lam_im) / den
    b_re, b_im = b_re.astype(f32), b_im.astype(f32)
    bbar_re = coef_re[..., None] * b_re - coef_im[..., None] * b_im
    bbar_im = coef_re[..., None] * b_im + coef_im[..., None] * b_re
    bu_re = jnp.einsum('blgh,gph->lbgp', u, bbar_re)
    bu_im = jnp.einsum('blgh,gph->lbgp', u, bbar_im)
    s_re0, s_im0 = s_re0.astype(f32), s_im0.astype(f32)
    bu_re = bu_re.at[0].add(abar_re * s_re0 - abar_im * s_im0)
    bu_im = bu_im.at[0].add(abar_re * s_im0 + abar_im * s_re0)
    l = u.shape[1]
    a_re = jnp.broadcast_to(abar_re[None, None], (l, 1) + abar_re.shape)
    a_im = jnp.broadcast_to(abar_im[None, None], (l, 1) + abar_im.shape)
    _, _, x_re, x_im = lax.associative_scan(_cplx_combine, (a_re, a_im, bu_re, bu_im), axis=0)
    y = (jnp.einsum('lbgp,ghp->blgh', x_re, c_re.astype(f32))
         - jnp.einsum('lbgp,ghp->blgh', x_im, c_im.astype(f32))
         + d_skip.astype(f32) * u)
    return y, x_re[-1], x_im[-1]


def ssd_chunked(x, dt, a, bmat, cmat, h0):
    b, l, nh, p = x.shape
    g, n = bmat.shape[2], bmat.shape[3]
    r = nh // g
    cs = math.gcd(l, SSD_CHUNK)
    nc = l // cs
    xd = (x * dt[..., None]).reshape(b, nc, cs, g, r, p)
    la = (dt * a).reshape(b, nc, cs, g, r)
    bm = bmat.reshape(b, nc, cs, g, n)
    cm = cmat.reshape(b, nc, cs, g, n)
    acum = jnp.cumsum(la, axis=2)
    diff = acum[:, :, :, None] - acum[:, :, None, :]
    mask = jnp.tril(jnp.ones((cs, cs), dtype=bool))[None, None, :, :, None, None]
    decay = jnp.exp(jnp.where(mask, diff, -jnp.inf))
    cb = jnp.einsum('bclgn,bcsgn->bclsg', cm, bm)
    y_diag = jnp.einsum('bclsg,bclsgr,bcsgrp->bclgrp', cb, decay, xd)
    dstate = jnp.exp(acum[:, :, -1:] - acum)
    states = jnp.einsum('bclgn,bclgr,bclgrp->bcgrpn', bm, dstate, xd)
    chunk_decay = jnp.exp(acum[:, :, -1])

    def step(hc, inp):
        st, dec = inp
        return hc * dec[..., None, None] + st, hc

    h_init = h0.astype(jnp.float32).reshape(b, g, r, p, n)
    h_fin, h_enter = lax.scan(step, h_init, (jnp.moveaxis(states, 1, 0), jnp.moveaxis(chunk_decay, 1, 0)))
    h_enter = jnp.moveaxis(h_enter, 0, 1)
    y_off = jnp.einsum('bclgn,bcgrpn,bclgr->bclgrp', cm, h_enter, jnp.exp(acum))
    y = (y_diag + y_off).reshape(b, l, nh, p)
    return y, h_fin.reshape(b, nh, p, n)


def mixer(h, s5_re0, s5_im0, ssd0, conv0, w_in, s5_lambda_re, s5_lambda_im, s5_log_step,
          s5_b_re, s5_b_im, s5_c_re, s5_c_im, s5_d, s5_w_glu, s5_b_glu,
          ssd_conv_w, ssd_conv_b, ssd_dt_bias, ssd_a_log, ssd_d, ssd_norm, w_out):
    f32 = jnp.float32
    b, l, _ = h.shape
    proj = (h @ w_in).astype(f32)
    u, z, xbc, dt_raw = jnp.split(
        proj, [S5_WIDTH, S5_WIDTH + SSD_WIDTH, S5_WIDTH + SSD_WIDTH + SSD_XBC], axis=-1)
    y5, s5_re1, s5_im1 = s5_scan(u.reshape(b, l, S5_GROUPS, S5_GROUP), s5_re0, s5_im0,
                                 s5_lambda_re, s5_lambda_im, s5_log_step,
                                 s5_b_re, s5_b_im, s5_c_re, s5_c_im, s5_d)
    v = jax.nn.gelu(y5.reshape(b, l, S5_WIDTH))
    o5 = v * jax.nn.sigmoid(v @ s5_w_glu.astype(f32) + s5_b_glu.astype(f32))
    xbc_full = jnp.concatenate([conv0.astype(f32), xbc], axis=1)
    conv_w = ssd_conv_w.astype(f32)
    conv = ssd_conv_b.astype(f32) + sum(conv_w[k] * xbc_full[:, k:k + l] for k in range(SSD_CONV))
    conv1 = xbc_full[:, l:]
    xbc_c = jax.nn.silu(conv)
    xs, bm, cm = jnp.split(xbc_c, [SSD_WIDTH, SSD_WIDTH + SSD_GROUPS * SSD_STATE], axis=-1)
    dt = jax.nn.softplus(dt_raw + ssd_dt_bias.astype(f32))
    a = -jnp.exp(ssd_a_log.astype(f32))
    xh = xs.reshape(b, l, SSD_HEADS, SSD_HEAD_DIM)
    ys, ssd1 = ssd_chunked(xh, dt, a, bm.reshape(b, l, SSD_GROUPS, SSD_STATE),
                           cm.reshape(b, l, SSD_GROUPS, SSD_STATE), ssd0)
    ys = (ys + ssd_d.astype(f32)[:, None] * xh).reshape(b, l, SSD_WIDTH) * jax.nn.silu(z)
    yg = ys.reshape(b, l, SSD_GROUPS, SSD_WIDTH // SSD_GROUPS)
    yg = yg * lax.rsqrt(jnp.mean(yg * yg, axis=-1, keepdims=True) + EPS)
    o_ssd = yg.reshape(b, l, SSD_WIDTH) * ssd_norm.astype(f32)
    out = jnp.concatenate([o5, o_ssd], axis=-1).astype(h.dtype) @ w_out
    return out, s5_re1, s5_im1, ssd1, conv1


def setup_inputs(seed: int = 0) -> dict:
    key = jax.random.key(seed)
    ks = jax.random.split(key, 40)
    f32 = jnp.float32
    nrm = lambda k, shape, s: (jax.random.normal(k, shape, f32) * s)
    D, L = D_MODEL, DEPTH
    G, P, H = S5_GROUPS, S5_STATE, S5_GROUP
    dt0 = jnp.exp(jax.random.uniform(ks[27], (L, SSD_HEADS), f32, math.log(1e-3), math.log(1e-1)))
    return {
        "x_prompt": nrm(ks[0], (BATCH, SEQ, D), 1.0),
        "x_sample": nrm(ks[1], (DEC_BATCH, DEC_SEQ, D), 1.0),
        "state_s5_re": nrm(ks[2], (L, DEC_BATCH, G, P), 0.5),
        "state_s5_im": nrm(ks[3], (L, DEC_BATCH, G, P), 0.5),
        "state_ssd": nrm(ks[4], (L, DEC_BATCH, SSD_HEADS, SSD_HEAD_DIM, SSD_STATE), 0.1),
        "state_conv": nrm(ks[5], (L, DEC_BATCH, SSD_CONV - 1, SSD_XBC), 1.0),
        "ffn1_norm": 1.0 + nrm(ks[6], (L, D), 0.01),
        "ffn1_w_gate": nrm(ks[7], (L, D, D_FF), D ** -0.5),
        "ffn1_w_up": nrm(ks[8], (L, D, D_FF), D ** -0.5),
        "ffn1_w_down": nrm(ks[9], (L, D_FF, D), D_FF ** -0.5),
        "mix_norm": 1.0 + nrm(ks[10], (L, D), 0.01),
        "w_in": nrm(ks[11], (L, D, IN_WIDTH), D ** -0.5),
        "s5_lambda_re": -0.5 + nrm(ks[12], (L, G, P), 0.01),
        "s5_lambda_im": jnp.pi * jnp.arange(P, dtype=f32) + nrm(ks[13], (L, G, P), 0.01),
        "s5_log_step": jax.random.uniform(ks[14], (L, G), f32, math.log(1e-3), math.log(1e-1)),
        "s5_b_re": nrm(ks[15], (L, G, P, H), (2 * H) ** -0.5),
        "s5_b_im": nrm(ks[16], (L, G, P, H), (2 * H) ** -0.5),
        "s5_c_re": nrm(ks[17], (L, G, H, P), (2 * P) ** -0.5),
        "s5_c_im": nrm(ks[18], (L, G, H, P), (2 * P) ** -0.5),
        "s5_d": nrm(ks[19], (L, G, H), 1.0),
        "s5_w_glu": nrm(ks[20], (L, S5_WIDTH, S5_WIDTH), S5_WIDTH ** -0.5),
        "s5_b_glu": nrm(ks[21], (L, S5_WIDTH), 0.01),
        "ssd_conv_w": nrm(ks[22], (L, SSD_CONV, SSD_XBC), SSD_CONV ** -0.5),
        "ssd_conv_b": nrm(ks[23], (L, SSD_XBC), 0.01),
        "ssd_dt_bias": dt0 + jnp.log(-jnp.expm1(-dt0)),
        "ssd_a_log": jnp.log(jax.random.uniform(ks[24], (L, SSD_HEADS), f32, 1.0, 16.0)),
        "ssd_d": 1.0 + nrm(ks[25], (L, SSD_HEADS), 0.1),
        "ssd_norm": 1.0 + nrm(ks[26], (L, SSD_WIDTH), 0.01),
        "w_out": nrm(ks[28], (L, D_MIX, D), D_MIX ** -0.5),
        "ffn2_norm": 1.0 + nrm(ks[29], (L, D), 0.01),
        "ffn2_w_gate": nrm(ks[30], (L, D, D_FF), D ** -0.5),
        "ffn2_w_up": nrm(ks[31], (L, D, D_FF), D ** -0.5),
        "ffn2_w_down": nrm(ks[32], (L, D_FF, D), D_FF ** -0.5),
        "final_norm": 1.0 + nrm(ks[33], (D,), 0.01),
    }


def reference(x_prompt, x_sample, state_s5_re, state_s5_im, state_ssd, state_conv,
              ffn1_norm, ffn1_w_gate, ffn1_w_up, ffn1_w_down, mix_norm, w_in,
              s5_lambda_re, s5_lambda_im, s5_log_step, s5_b_re, s5_b_im, s5_c_re, s5_c_im,
              s5_d, s5_w_glu, s5_b_glu, ssd_conv_w, ssd_conv_b, ssd_dt_bias, ssd_a_log,
              ssd_d, ssd_norm, w_out, ffn2_norm, ffn2_w_gate, ffn2_w_up, ffn2_w_down, final_norm):
    f32 = jnp.float32
    xp, xs = x_prompt, x_sample
    p_states = (jnp.zeros((BATCH, S5_GROUPS, S5_STATE), f32),
                jnp.zeros((BATCH, S5_GROUPS, S5_STATE), f32),
                jnp.zeros((BATCH, SSD_HEADS, SSD_HEAD_DIM, SSD_STATE), f32),
                jnp.zeros((BATCH, SSD_CONV - 1, SSD_XBC), f32))
    new_p = ([], [], [], [])
    new_s = ([], [], [], [])
    for i in range(DEPTH):
        mix_params = (w_in[i], s5_lambda_re[i], s5_lambda_im[i], s5_log_step[i],
                      s5_b_re[i], s5_b_im[i], s5_c_re[i], s5_c_im[i], s5_d[i],
                      s5_w_glu[i], s5_b_glu[i], ssd_conv_w[i], ssd_conv_b[i],
                      ssd_dt_bias[i], ssd_a_log[i], ssd_d[i], ssd_norm[i], w_out[i])
        s_states = (state_s5_re[i], state_s5_im[i], state_ssd[i], state_conv[i])
        outs = []
        for x, st, acc in ((xp, p_states, new_p), (xs, s_states, new_s)):
            x = x + 0.5 * swiglu(rmsnorm(x, ffn1_norm[i]), ffn1_w_gate[i], ffn1_w_up[i], ffn1_w_down[i])
            m, s5r, s5i, ssd1, conv1 = mixer(rmsnorm(x, mix_norm[i]), *st, *mix_params)
            x = x + m.astype(x.dtype)
            x = x + 0.5 * swiglu(rmsnorm(x, ffn2_norm[i]), ffn2_w_gate[i], ffn2_w_up[i], ffn2_w_down[i])
            for lst, val in zip(acc, (s5r, s5i, ssd1, conv1)):
                lst.append(val)
            outs.append(x)
        xp, xs = outs
    y_prompt = rmsnorm(xp, final_norm)
    y_sample = rmsnorm(xs, final_norm)
    return (y_prompt, y_sample,
            jnp.stack(new_p[0]), jnp.stack(new_p[1]), jnp.stack(new_p[2]), jnp.stack(new_p[3]),
            jnp.stack(new_s[0]), jnp.stack(new_s[1]), jnp.stack(new_s[2]), jnp.stack(new_s[3]))
```

```cpp
#include <hip/hip_runtime.h>
#include <hip/hip_cooperative_groups.h>
#include <cstdio>
#include <cstdint>
namespace cg = cooperative_groups;

#define LAS __attribute__((address_space(3)))
typedef unsigned short bf16_t;
typedef short bf16x8 __attribute__((ext_vector_type(8)));
typedef float f32x4 __attribute__((ext_vector_type(4)));
typedef float f32x2 __attribute__((ext_vector_type(2)));
typedef unsigned u32x4 __attribute__((ext_vector_type(4)));
typedef unsigned u32x2 __attribute__((ext_vector_type(2)));

constexpr int D = 1024, FF = 2816, NIN = 4632, NINP = 4864, DMIX = 2048;
constexpr int MP = 16384, MS = 512, M = MP + MS, SEQ = 2048, NB = 8, NSB = 128;
constexpr int XBC = 2560, SSDW = 1536, NH = 24;
constexpr float EPS = 1e-6f;
constexpr size_t O_Y = 0, O_S5RP = 17301504, O_S5IP = 17317888, O_SSDP = 17334272, O_CONVP = 18907136,
                 O_S5RS = 18968576, O_S5IS = 19230720, O_SSDS = 19492864, O_CONVS = 44658688;
constexpr size_t WS_CTL = 0, WS_S5A = 4096, WS_BBAR = WS_S5A + 16384, WS_CMAT = WS_BBAR + 131072, WS_DTRAW = WS_CMAT + 131072,
                 WS_W1T = WS_DTRAW + (size_t)M * 24 * 4, WS_W1D = WS_W1T + (size_t)2 * FF * D * 2, WS_W2T = WS_W1D + (size_t)D * FF * 2,
                 WS_W2D = WS_W2T + (size_t)2 * FF * D * 2, WS_WIN = WS_W2D + (size_t)D * FF * 2, WS_WGLU = WS_WIN + (size_t)NINP * D * 2,
                 WS_WOUT = WS_WGLU + (size_t)512 * 512 * 2, WS_H = WS_WOUT + (size_t)D * DMIX * 2, WS_A = WS_H + (size_t)M * D * 2,
                 WS_XC = WS_A + (size_t)M * NINP * 2, WS_YS = WS_XC + (size_t)M * XBC * 2, WS_END = WS_YS + (size_t)M * SSDW * 2;
constexpr int LDS_BYTES = 158720;
constexpr int L_BCAST = 157696;

struct Params {
    const float* in[34];
    float* out;
    unsigned char* ws;
};

__device__ __forceinline__ unsigned pk2(float lo, float hi) { unsigned r; asm volatile("v_cvt_pk_bf16_f32 %0, %1, %2" : "=v"(r) : "v"(lo), "v"(hi)); return r; }
__device__ __forceinline__ float bflo(unsigned u) { return __uint_as_float(u << 16); }
__device__ __forceinline__ float bfhi(unsigned u) { return __uint_as_float(u & 0xffff0000u); }
__device__ __forceinline__ float bf2f(bf16_t v) { return __uint_as_float((unsigned)v << 16); }
__device__ __forceinline__ float wave_sum(float v) {
#pragma unroll
    for (int o = 1; o < 64; o <<= 1) v += __shfl_xor(v, o);
    return v;
}
__device__ __forceinline__ float silu_f(float x) { return x / (1.f + __expf(-x)); }
__device__ __forceinline__ float sigmoid_f(float x) { return 1.f / (1.f + __expf(-x)); }
__device__ __forceinline__ float softplus_f(float x) { return fmaxf(x, 0.f) + log1pf(__expf(-fabsf(x))); }
__device__ __forceinline__ float gelu_tanh(float y) { const float a = 0.7978845608028654f * (y + 0.044715f * y * y * y); const float t = 1.f - 2.f / (1.f + __expf(2.f * a)); return 0.5f * y * (1.f + t); }
#define LDS_WAIT() asm volatile("s_waitcnt lgkmcnt(0)" ::: "memory")

namespace pg8 {
constexpr int BM = 256, BK = 64, HALF = 128, HTB = HALF * BK * 2, STAGE_BYTES = 8 * HTB, NXCD = 8, WGM = 8;
__host__ __device__ __forceinline__ int lds_byte(int r, int c) { const int st = (r >> 4) * 2 + (c >> 5), rr = r & 15, cc = c & 31, ob = rr * 64 + cc * 2; return st * 1024 + (ob ^ (((ob >> 9) & 1) << 5)); }
__host__ __device__ __forceinline__ void stage_rc(int b, int& R, int& C) { const int st = b / 1024, sb = b % 1024, swz = sb ^ (((sb >> 9) & 1) << 5); R = (st >> 1) * 16 + swz / 64; C = (st & 1) * 32 + (swz % 64) / 2; }
struct Unit { int pm, pn; };
struct Gemm { const bf16_t* A; const bf16_t* Bt; int M, N, K; };
struct StaticOrder {
    int nM, nN, nwg, G, c;
    __host__ __device__ void init(int M_, int N_, int G_, int c_) { nM = M_ / BM; nN = N_ / BM; nwg = nM * nN; G = G_; c = c_; }
    __host__ __device__ bool next(int i, Unit& u) const {
        const long L = (long)i * G + c; if (L >= nwg) return false;
        int wgid = (int)L; { const int q = nwg / NXCD, r = nwg % NXCD, xcd = wgid % NXCD, off = wgid / NXCD; wgid = (xcd < r ? xcd * (q + 1) : r * (q + 1) + (xcd - r) * q) + off; }
        const int nig = WGM * nN, gid = wgid / nig, fm = gid * WGM, gsz = (nM - fm) < WGM ? (nM - fm) : WGM;
        u.pm = fm + ((wgid % nig) % gsz); u.pn = (wgid % nig) / gsz; return true;
    }
    __device__ __forceinline__ void a_ready(const Unit&) const {}
    __device__ __forceinline__ void done(const Unit&) const {}
};

template <class Epi, class Sched>
__device__ __forceinline__ void gemm_phase(LAS unsigned char* lds, const Gemm g, const Sched& S, const Epi& E) {
    const int tid = threadIdx.x, wid = __builtin_amdgcn_readfirstlane(tid >> 6), lane = tid & 63, wr = wid >> 2, wc = wid & 3, fr = lane & 15, fq = lane >> 4;
    const int K = g.K, nt = K / BK;
    unsigned voffA[2], voffB[2];
#pragma unroll
    for (int i = 0; i < 2; ++i) { int R, C; stage_rc(tid * 16 + i * 8192, R, C); voffA[i] = (unsigned)(R * K + C) * 2u; voffB[i] = (unsigned)(R * K + C) * 2u; }
    const size_t kstep = (size_t)(BK * 2);
    const size_t hstep = (size_t)HALF * K * 2;
    const size_t tstep = 2 * hstep;
    const unsigned ldsw = (unsigned)wid * 1024u;
    const int aoff = lds_byte(wr * 64 + fr, fq * 8), boff = lds_byte(wc * 32 + fr, fq * 8);
#define PG8_SA(b, h) (((b) * 2 + (h)) * HTB)
#define PG8_SB(b, h) ((4 + (b) * 2 + (h)) * HTB)
#define PG8_STAGE(bufoff, gbase, voff) do { _Pragma("unroll") for (int _i = 0; _i < 2; ++_i) \
        __builtin_amdgcn_global_load_lds((const unsigned*)((const char*)(gbase) + (voff)[_i]), (LAS unsigned*)(lds + (bufoff) + ldsw + _i * 8192), 16, 0, 0); } while (0)
#define PG8_LDA(dst, b, h) do { _Pragma("unroll") for (int m = 0; m < 4; ++m) _Pragma("unroll") for (int k = 0; k < 2; ++k) dst[m][k] = *(const LAS bf16x8*)(lds + PG8_SA(b, h) + aoff + m * 2048 + k * 1024); } while (0)
#define PG8_LDB(dst, b, h) do { _Pragma("unroll") for (int n = 0; n < 2; ++n) _Pragma("unroll") for (int k = 0; k < 2; ++k) dst[n][k] = *(const LAS bf16x8*)(lds + PG8_SB(b, h) + boff + n * 2048 + k * 1024); } while (0)
#define PG8_MMA(ai, bj, At, Bt) do { __builtin_amdgcn_s_setprio(1); _Pragma("unroll") for (int m = 0; m < 4; ++m) _Pragma("unroll") for (int n = 0; n < 2; ++n) _Pragma("unroll") for (int k = 0; k < 2; ++k) \
        acc[ai][bj][m][n] = __builtin_amdgcn_mfma_f32_16x16x32_bf16(Bt[n][k], At[m][k], acc[ai][bj][m][n], 0, 0, 0); __builtin_amdgcn_s_setprio(0); } while (0)
#define PG8_WAIT_V(n) asm volatile("s_waitcnt vmcnt(" #n ")" ::: "memory")
#define PG8_WAIT_L(n) asm volatile("s_waitcnt lgkmcnt(" #n ")" ::: "memory")
#define PG8_BAR __builtin_amdgcn_s_barrier()
#define PG8_SCHED __builtin_amdgcn_sched_barrier(0)
    Unit cur, nxt; int ui = 0;
    if (!S.next(0, cur)) return;
    f32x4 acc[2][2][4][2];
#pragma unroll
    for (int a = 0; a < 2; ++a)
#pragma unroll
        for (int b = 0; b < 2; ++b)
#pragma unroll
            for (int m = 0; m < 4; ++m)
#pragma unroll
                for (int n = 0; n < 2; ++n) acc[a][b][m][n] = (f32x4){0.f, 0.f, 0.f, 0.f};
    bf16x8 At[4][2], B0[2][2], B1[2][2];
    const char* cA = (const char*)g.A + (size_t)cur.pm * tstep; const char* cB = (const char*)g.Bt + (size_t)cur.pn * tstep;
    S.a_ready(cur);
    PG8_STAGE(PG8_SB(0, 0), cB, voffB); PG8_STAGE(PG8_SA(0, 0), cA, voffA); PG8_STAGE(PG8_SB(0, 1), cB + hstep, voffB); PG8_STAGE(PG8_SA(0, 1), cA + hstep, voffA);
    if (wr == 1) PG8_BAR;
    PG8_WAIT_V(4); PG8_BAR;
    PG8_STAGE(PG8_SB(1, 0), cB + kstep, voffB); PG8_STAGE(PG8_SA(1, 0), cA + kstep, voffA); PG8_STAGE(PG8_SB(1, 1), cB + hstep + kstep, voffB);
    PG8_WAIT_V(6); PG8_BAR;
    for (;;) {
        const bool has_next = S.next(ui + 1, nxt);
        const char* nA = has_next ? (const char*)g.A + (size_t)nxt.pm * tstep : cA; const char* nB = has_next ? (const char*)g.Bt + (size_t)nxt.pn * tstep : cB;
        for (int t = 0; t < nt; t += 2) {
            const bool last = (t == nt - 2);
            const char* a1 = cA + (size_t)(t + 1) * kstep;
            const char* a2 = last ? nA : cA + (size_t)(t + 2) * kstep; const char* b2 = last ? nB : cB + (size_t)(t + 2) * kstep;
            const char* a3 = a2 + kstep; const char* b3 = b2 + kstep;
            if (last && has_next) S.a_ready(nxt);
            PG8_LDB(B0, 0, 0); PG8_SCHED; PG8_LDA(At, 0, 0); PG8_STAGE(PG8_SA(1, 1), a1 + hstep, voffA);
            PG8_WAIT_L(8); PG8_BAR; PG8_WAIT_L(0); PG8_MMA(0, 0, At, B0); PG8_BAR; PG8_SCHED;
            PG8_LDB(B1, 0, 1); PG8_STAGE(PG8_SB(0, 0), b2, voffB);
            PG8_BAR; PG8_WAIT_L(0); PG8_MMA(0, 1, At, B1); PG8_BAR;
            PG8_LDA(At, 0, 1); PG8_STAGE(PG8_SA(0, 0), a2, voffA);
            PG8_BAR; PG8_WAIT_L(0); PG8_MMA(1, 0, At, B0); PG8_BAR; PG8_SCHED;
            PG8_STAGE(PG8_SB(0, 1), b2 + hstep, voffB);
            PG8_WAIT_V(6); PG8_BAR; PG8_MMA(1, 1, At, B1); PG8_BAR;
            PG8_LDB(B0, 1, 0); PG8_SCHED; PG8_LDA(At, 1, 0); PG8_STAGE(PG8_SA(0, 1), a2 + hstep, voffA);
            PG8_WAIT_L(8); PG8_BAR; PG8_WAIT_L(0); PG8_MMA(0, 0, At, B0); PG8_BAR; PG8_SCHED;
            PG8_LDB(B1, 1, 1); PG8_STAGE(PG8_SB(1, 0), b3, voffB);
            PG8_BAR; PG8_WAIT_L(0); PG8_MMA(0, 1, At, B1); PG8_BAR;
            PG8_LDA(At, 1, 1); PG8_STAGE(PG8_SA(1, 0), a3, voffA);
            PG8_BAR; PG8_WAIT_L(0); PG8_MMA(1, 0, At, B0); PG8_BAR; PG8_SCHED;
            PG8_STAGE(PG8_SB(1, 1), b3 + hstep, voffB);
            PG8_WAIT_V(6); PG8_BAR; PG8_MMA(1, 1, At, B1); PG8_BAR;
        }
        E(acc, cur, wr, wc, fr, fq); S.done(cur);
        if (!has_next) break;
#pragma unroll
        for (int a = 0; a < 2; ++a)
#pragma unroll
            for (int b = 0; b < 2; ++b)
#pragma unroll
                for (int m = 0; m < 4; ++m)
#pragma unroll
                    for (int n = 0; n < 2; ++n) acc[a][b][m][n] = (f32x4){0.f, 0.f, 0.f, 0.f};
        cur = nxt; cA = nA; cB = nB; ++ui;
    }
    PG8_WAIT_V(0);
    if (wr == 0) PG8_BAR;
    PG8_BAR;
#undef PG8_SA
#undef PG8_SB
#undef PG8_STAGE
#undef PG8_LDA
#undef PG8_LDB
#undef PG8_MMA
#undef PG8_WAIT_V
#undef PG8_WAIT_L
#undef PG8_BAR
#undef PG8_SCHED
}
}
using pg8::Unit;

struct EpiGateUp {
    bf16_t* act;
    __device__ __forceinline__ void operator()(const f32x4 (&acc)[2][2][4][2], const Unit& u, int wr, int wc, int fr, int fq) const {
#pragma unroll
        for (int ai = 0; ai < 2; ++ai)
#pragma unroll
            for (int m = 0; m < 4; ++m) {
                const int r = u.pm * 256 + ai * 128 + wr * 64 + m * 16 + fr;
#pragma unroll
                for (int bj = 0; bj < 2; ++bj) {
                    const int j = (u.pn * 256 + bj * 128 + wc * 32) / 2 + 4 * fq;
                    const f32x4 gt = acc[ai][bj][m][0], up = acc[ai][bj][m][1];
                    u32x2 o; o.x = pk2(silu_f(gt[0]) * up[0], silu_f(gt[1]) * up[1]); o.y = pk2(silu_f(gt[2]) * up[2], silu_f(gt[3]) * up[3]);
                    *(u32x2*)(act + (size_t)r * FF + j) = o;
                }
            }
    }
};
struct EpiResid {
    const float* rp; const float* rs; float* y; float scale;
    __device__ __forceinline__ void operator()(const f32x4 (&acc)[2][2][4][2], const Unit& u, int wr, int wc, int fr, int fq) const {
#pragma unroll
        for (int ai = 0; ai < 2; ++ai)
#pragma unroll
            for (int m = 0; m < 4; ++m) {
                const int r = u.pm * 256 + ai * 128 + wr * 64 + m * 16 + fr;
                const float* rrow = (r < MP) ? rp + (size_t)r * D : rs + (size_t)(r - MP) * D;
                float* yrow = y + (size_t)r * D;
#pragma unroll
                for (int bj = 0; bj < 2; ++bj)
#pragma unroll
                    for (int n = 0; n < 2; ++n) {
                        const int c = u.pn * 256 + bj * 128 + wc * 32 + n * 16 + 4 * fq;
                        const f32x4 rv = *(const f32x4*)(rrow + c);
                        *(f32x4*)(yrow + c) = rv + acc[ai][bj][m][n] * scale;
                    }
            }
    }
};
struct EpiProj {
    bf16_t* proj; float* dtraw;
    __device__ __forceinline__ void operator()(const f32x4 (&acc)[2][2][4][2], const Unit& u, int wr, int wc, int fr, int fq) const {
#pragma unroll
        for (int ai = 0; ai < 2; ++ai)
#pragma unroll
            for (int m = 0; m < 4; ++m) {
                const int r = u.pm * 256 + ai * 128 + wr * 64 + m * 16 + fr;
#pragma unroll
                for (int bj = 0; bj < 2; ++bj)
#pragma unroll
                    for (int n = 0; n < 2; ++n) {
                        const int c = u.pn * 256 + bj * 128 + wc * 32 + n * 16 + 4 * fq;
                        const f32x4 v = acc[ai][bj][m][n];
                        if (u.pn == 18) { if (c - 4608 < 24) *(f32x4*)(dtraw + (size_t)r * 24 + (c - 4608)) = v; }
                        else { u32x2 o; o.x = pk2(v[0], v[1]); o.y = pk2(v[2], v[3]); *(u32x2*)(proj + (size_t)r * NINP + c) = o; }
                    }
            }
    }
};
struct EpiGlu {
    const bf16_t* v; const float* bias; bf16_t* mix;
    __device__ __forceinline__ void operator()(const f32x4 (&acc)[2][2][4][2], const Unit& u, int wr, int wc, int fr, int fq) const {
#pragma unroll
        for (int ai = 0; ai < 2; ++ai)
#pragma unroll
            for (int m = 0; m < 4; ++m) {
                const int r = u.pm * 256 + ai * 128 + wr * 64 + m * 16 + fr;
#pragma unroll
                for (int bj = 0; bj < 2; ++bj)
#pragma unroll
                    for (int n = 0; n < 2; ++n) {
                        const int c = u.pn * 256 + bj * 128 + wc * 32 + n * 16 + 4 * fq;
                        const f32x4 a = acc[ai][bj][m][n]; const f32x4 bb = *(const f32x4*)(bias + c);
                        const u32x2 vv = *(const u32x2*)(v + (size_t)r * 512 + c);
                        u32x2 o; o.x = pk2(bflo(vv.x) * sigmoid_f(a[0] + bb[0]), bfhi(vv.x) * sigmoid_f(a[1] + bb[1]));
                        o.y = pk2(bflo(vv.y) * sigmoid_f(a[2] + bb[2]), bfhi(vv.y) * sigmoid_f(a[3] + bb[3]));
                        *(u32x2*)(mix + (size_t)r * DMIX + c) = o;
                    }
            }
    }
};

__device__ __forceinline__ void transpose_item(const float* W, int K, int N, bf16_t* WT, int mode, LAS float* scr, int item, int lane) {
    const int nblk = (N + 31) / 32, kb = item / nblk, nb = item % nblk, k0 = 64 * kb, n0 = 32 * nb;
    const int nn = n0 + (lane & 31);
#pragma unroll 8
    for (int i = 0; i < 32; ++i) { const int kk = 2 * i + (lane >> 5); scr[kk * 33 + (lane & 31)] = (nn < N) ? W[(size_t)(k0 + kk) * N + nn] : 0.f; }
    LDS_WAIT();
    const int c = lane & 7;
#pragma unroll
    for (int j = 0; j < 4; ++j) { const int n = (lane >> 3) + 8 * j; const LAS float* s = scr + (8 * c) * 33 + n;
        u32x4 o; o.x = pk2(s[0 * 33], s[1 * 33]); o.y = pk2(s[2 * 33], s[3 * 33]); o.z = pk2(s[4 * 33], s[5 * 33]); o.w = pk2(s[6 * 33], s[7 * 33]);
        const int jn = n0 + n;
        const int row = (mode == 0) ? jn : (((jn >> 4) << 5) + (jn & 15) + (mode == 2 ? 16 : 0));
        *(u32x4*)(WT + (size_t)row * K + k0 + 8 * c) = o; }
    LDS_WAIT();
}
__device__ __forceinline__ void rms_row_bf16(const float* xrow, const float* w, bf16_t* orow, int lane) {
    const f32x4* xr = (const f32x4*)xrow + lane; const f32x4* wr = (const f32x4*)w + lane;
    f32x4 v[4]; float s = 0.f;
#pragma unroll
    for (int j = 0; j < 4; ++j) { v[j] = xr[64 * j]; s += (v[j].x * v[j].x + v[j].y * v[j].y) + (v[j].z * v[j].z + v[j].w * v[j].w); }
    const float rstd = rsqrtf(wave_sum(s) * (1.f / D) + EPS);
    u32x2* o8 = (u32x2*)orow + lane;
#pragma unroll
    for (int j = 0; j < 4; ++j) { const f32x4 ww = wr[64 * j]; u32x2 o; o.x = pk2(v[j].x * rstd * ww.x, v[j].y * rstd * ww.y); o.y = pk2(v[j].z * rstd * ww.z, v[j].w * rstd * ww.w); o8[64 * j] = o; }
}
__device__ __forceinline__ void rms_phase(const float* srcp, const float* srcs, const float* w, bf16_t* dst, int gw, int ngw, int lane) {
    for (int m = gw; m < M; m += ngw) {
        const float* xrow = (m < MP) ? srcp + (size_t)m * D : srcs + (size_t)(m - MP) * D;
        rms_row_bf16(xrow, w, dst + (size_t)m * D, lane);
    }
}

__device__ __forceinline__ void unpack8(const u32x4 u, float (&f)[8]) { f[0] = bflo(u.x); f[1] = bfhi(u.x); f[2] = bflo(u.y); f[3] = bfhi(u.y); f[4] = bflo(u.z); f[5] = bfhi(u.z); f[6] = bflo(u.w); f[7] = bfhi(u.w); }
__device__ __forceinline__ void conv_phase(const Params& p, int gtid, int nthreads) {
    const bf16_t* proj = (const bf16_t*)(p.ws + WS_A); bf16_t* xc = (bf16_t*)(p.ws + WS_XC);
    const float* cw = p.in[22]; const float* cb = p.in[23]; const float* sconv = p.in[5];
    const int NT_P = (MP / 16) * 320, NT_S = NSB * 320;
    for (int task = gtid; task < NT_P + NT_S; task += nthreads) {
        const bool samp = task >= NT_P; const int tk = samp ? task - NT_P : task;
        const int cgp = tk % 320, rb = tk / 320, c0 = cgp * 8;
        const int m0 = samp ? MP + rb * 4 : rb * 16; const int nrow = samp ? 4 : 16;
        float w0[8], w1[8], w2[8], w3[8], bs[8], r0[8], r1[8], r2[8];
#pragma unroll
        for (int e = 0; e < 8; e += 4) { *(f32x4*)&w0[e] = *(const f32x4*)(cw + c0 + e); *(f32x4*)&w1[e] = *(const f32x4*)(cw + XBC + c0 + e); *(f32x4*)&w2[e] = *(const f32x4*)(cw + 2 * XBC + c0 + e);
            *(f32x4*)&w3[e] = *(const f32x4*)(cw + 3 * XBC + c0 + e); *(f32x4*)&bs[e] = *(const f32x4*)(cb + c0 + e); }
        if (samp) {
            const float* s = sconv + (size_t)rb * 3 * XBC + c0;
#pragma unroll
            for (int e = 0; e < 8; ++e) { r0[e] = s[e]; r1[e] = s[XBC + e]; r2[e] = s[2 * XBC + e]; }
        } else if ((m0 % SEQ) != 0) {
            unpack8(*(const u32x4*)(proj + (size_t)(m0 - 3) * NINP + 2048 + c0), r0); unpack8(*(const u32x4*)(proj + (size_t)(m0 - 2) * NINP + 2048 + c0), r1); unpack8(*(const u32x4*)(proj + (size_t)(m0 - 1) * NINP + 2048 + c0), r2);
        } else {
#pragma unroll
            for (int e = 0; e < 8; ++e) { r0[e] = 0.f; r1[e] = 0.f; r2[e] = 0.f; }
        }
        const bool lastblk = !samp && ((m0 % SEQ) == SEQ - 16);
        for (int i = 0; i < nrow; ++i) {
            float cur[8]; unpack8(*(const u32x4*)(proj + (size_t)(m0 + i) * NINP + 2048 + c0), cur);
            float o[8];
#pragma unroll
            for (int e = 0; e < 8; ++e) { const float cv = bs[e] + w0[e] * r0[e] + w1[e] * r1[e] + w2[e] * r2[e] + w3[e] * cur[e]; o[e] = silu_f(cv); r0[e] = r1[e]; r1[e] = r2[e]; r2[e] = cur[e]; }
            u32x4 ov; ov.x = pk2(o[0], o[1]); ov.y = pk2(o[2], o[3]); ov.z = pk2(o[4], o[5]); ov.w = pk2(o[6], o[7]);
            *(u32x4*)(xc + (size_t)(m0 + i) * XBC + c0) = ov;
            if (samp) { if (i >= 1) { float* d = p.out + O_CONVS + ((size_t)rb * 3 + (i - 1)) * XBC + c0; *(f32x4*)d = *(f32x4*)&cur[0]; *(f32x4*)(d + 4) = *(f32x4*)&cur[4]; } }
            else if (lastblk && i >= 13) { float* d = p.out + O_CONVP + ((size_t)(m0 / SEQ) * 3 + (i - 13)) * XBC + c0; *(f32x4*)d = *(f32x4*)&cur[0]; *(f32x4*)(d + 4) = *(f32x4*)&cur[4]; }
        }
    }
}

constexpr int LROW = 272;
constexpr int L_C = 0, L_B = 34816, L_BT = 69632, L_XT = 104448, L_XS = 121856, L_HT = 139264, L_AC = 156672, L_DT = 157184;
__device__ __forceinline__ float wave_incl_scan(float v, int lane) {
#pragma unroll
    for (int o = 1; o < 64; o <<= 1) { const float t = __shfl_up(v, o); if (lane >= o) v += t; }
    return v;
}
__device__ __forceinline__ void ssd_prompt_item(const Params& p, LAS unsigned char* lds, int b, int h) {
    const int tid = threadIdx.x, lane = tid & 63, w = __builtin_amdgcn_readfirstlane(tid >> 6), fr = lane & 15, fq = lane >> 4;
    const int g = h / 6;
    const bf16_t* xc = (const bf16_t*)(p.ws + WS_XC); const float* dtraw = (const float*)(p.ws + WS_DTRAW); bf16_t* ys = (bf16_t*)(p.ws + WS_YS);
    const float a_h = -__expf(p.in[25][h]), dtb = p.in[24][h], Dh = p.in[26][h];
    f32x4 hacc[4];
#pragma unroll
    for (int i = 0; i < 4; ++i) hacc[i] = (f32x4){0.f, 0.f, 0.f, 0.f};
    for (int i = tid; i < 64 * 17; i += 512) *(LAS u32x4*)(lds + L_HT + i * 16) = (u32x4){0u, 0u, 0u, 0u};
    const int rh = w & 1, pq = w >> 1, row = rh * 64 + lane;
    for (int c = 0; c < 16; ++c) {
        const int m0 = b * SEQ + c * 128;
        const float dt_lo = softplus_f(dtraw[(size_t)(m0 + lane) * 24 + h] + dtb), dt_hi = softplus_f(dtraw[(size_t)(m0 + 64 + lane) * 24 + h] + dtb);
        const float ac_lo = wave_incl_scan(dt_lo * a_h, lane); const float tot_lo = __shfl(ac_lo, 63);
        const float ac_hi = wave_incl_scan(dt_hi * a_h, lane) + tot_lo; const float alast = __shfl(ac_hi, 63);
        const float my_dt = rh ? dt_hi : dt_lo, my_ac = rh ? ac_hi : ac_lo;
        const float xscale = my_dt * __expf(alast - my_ac);
        if (w == 0) { *(LAS float*)(lds + L_AC + lane * 4) = ac_lo; *(LAS float*)(lds + L_AC + 256 + lane * 4) = ac_hi; *(LAS float*)(lds + L_DT + lane * 4) = dt_lo; *(LAS float*)(lds + L_DT + 256 + lane * 4) = dt_hi; }
        const bf16_t* grow = xc + (size_t)(m0 + row) * XBC;
#pragma unroll
        for (int j = 0; j < 4; ++j) {
            const int pc = pq * 4 + j;
            const u32x4 vc = *(const u32x4*)(grow + 2048 + g * 128 + pc * 8);
            const u32x4 vb = *(const u32x4*)(grow + 1536 + g * 128 + pc * 8);
            *(LAS u32x4*)(lds + L_C + row * LROW + pc * 16) = vc;
            *(LAS u32x4*)(lds + L_B + row * LROW + pc * 16) = vb;
            LAS bf16_t* bt = (LAS bf16_t*)(lds + L_BT + (pc * 8) * LROW + row * 2);
            bt[0 * 136] = (bf16_t)(vb.x & 0xffff); bt[1 * 136] = (bf16_t)(vb.x >> 16); bt[2 * 136] = (bf16_t)(vb.y & 0xffff); bt[3 * 136] = (bf16_t)(vb.y >> 16);
            bt[4 * 136] = (bf16_t)(vb.z & 0xffff); bt[5 * 136] = (bf16_t)(vb.z >> 16); bt[6 * 136] = (bf16_t)(vb.w & 0xffff); bt[7 * 136] = (bf16_t)(vb.w >> 16);
        }
#pragma unroll
        for (int j = 0; j < 2; ++j) {
            const int pc = pq * 2 + j;
            const u32x4 vx = *(const u32x4*)(grow + h * 64 + pc * 8);
            float xf[8]; unpack8(vx, xf);
            LAS bf16_t* xt = (LAS bf16_t*)(lds + L_XT + (pc * 8) * LROW + row * 2);
            LAS bf16_t* xs = (LAS bf16_t*)(lds + L_XS + (pc * 8) * LROW + row * 2);
            xt[0 * 136] = (bf16_t)(vx.x & 0xffff); xt[1 * 136] = (bf16_t)(vx.x >> 16); xt[2 * 136] = (bf16_t)(vx.y & 0xffff); xt[3 * 136] = (bf16_t)(vx.y >> 16);
            xt[4 * 136] = (bf16_t)(vx.z & 0xffff); xt[5 * 136] = (bf16_t)(vx.z >> 16); xt[6 * 136] = (bf16_t)(vx.w & 0xffff); xt[7 * 136] = (bf16_t)(vx.w >> 16);
#pragma unroll
            for (int e = 0; e < 8; e += 2) { const unsigned pp = pk2(xf[e] * xscale, xf[e + 1] * xscale); xs[e * 136] = (bf16_t)(pp & 0xffff); xs[(e + 1) * 136] = (bf16_t)(pp >> 16); }
        }
        __syncthreads();
        const int l = 16 * w + fr;
        bf16x8 cfrag[4];
#pragma unroll
        for (int ks = 0; ks < 4; ++ks) cfrag[ks] = *(const LAS bf16x8*)(lds + L_C + l * LROW + (ks * 32 + fq * 8) * 2);
        f32x4 yacc[4];
#pragma unroll
        for (int pb = 0; pb < 4; ++pb) {
            f32x4 a = (f32x4){0.f, 0.f, 0.f, 0.f};
#pragma unroll
            for (int ks = 0; ks < 4; ++ks) { const bf16x8 hf = *(const LAS bf16x8*)(lds + L_HT + (pb * 16 + fr) * LROW + (ks * 32 + fq * 8) * 2); a = __builtin_amdgcn_mfma_f32_16x16x32_bf16(hf, cfrag[ks], a, 0, 0, 0); }
            yacc[pb] = a;
        }
        const float al = *(const LAS float*)(lds + L_AC + l * 4);
        { const float el = __expf(al);
#pragma unroll
          for (int pb = 0; pb < 4; ++pb) yacc[pb] = yacc[pb] * el; }
        f32x4 cbt[8];
#pragma unroll
        for (int sb = 0; sb < 8; ++sb) {
            cbt[sb] = (f32x4){0.f, 0.f, 0.f, 0.f};
            if (sb <= w) {
                f32x4 a = (f32x4){0.f, 0.f, 0.f, 0.f};
#pragma unroll
                for (int ks = 0; ks < 4; ++ks) { const bf16x8 bf = *(const LAS bf16x8*)(lds + L_B + (sb * 16 + fr) * LROW + (ks * 32 + fq * 8) * 2); a = __builtin_amdgcn_mfma_f32_16x16x32_bf16(bf, cfrag[ks], a, 0, 0, 0); }
                cbt[sb] = a;
            }
        }
        __syncthreads();
        const int nks = (w >> 1) + 1;
#pragma unroll
        for (int sb = 0; sb < 8; ++sb) {
            if (sb < 2 * nks) {
                const int s0 = sb * 16 + 4 * fq;
                const f32x4 as = *(const LAS f32x4*)(lds + L_AC + s0 * 4), ds = *(const LAS f32x4*)(lds + L_DT + s0 * 4);
                float mv[4];
#pragma unroll
                for (int e = 0; e < 4; ++e) { const float v = cbt[sb][e] * __expf(al - as[e]) * ds[e]; mv[e] = (sb <= w && (s0 + e) <= l) ? v : 0.f; }
                u32x2 o; o.x = pk2(mv[0], mv[1]); o.y = pk2(mv[2], mv[3]);
                *(LAS u32x2*)(lds + L_B + l * LROW + s0 * 2) = o;
            }
        }
        LDS_WAIT();
#pragma unroll
        for (int ks = 0; ks < 4; ++ks) {
            if (ks < nks) {
                const bf16x8 mf = *(const LAS bf16x8*)(lds + L_B + l * LROW + (ks * 32 + fq * 8) * 2);
#pragma unroll
                for (int pb = 0; pb < 4; ++pb) { const bf16x8 xf = *(const LAS bf16x8*)(lds + L_XT + (pb * 16 + fr) * LROW + (ks * 32 + fq * 8) * 2); yacc[pb] = __builtin_amdgcn_mfma_f32_16x16x32_bf16(xf, mf, yacc[pb], 0, 0, 0); }
            }
        }
#pragma unroll
        for (int pb = 0; pb < 4; ++pb) {
            const int pcol = h * 64 + pb * 16 + 4 * fq;
            const u32x2 xv = *(const u32x2*)(xc + (size_t)(m0 + l) * XBC + pcol);
            u32x2 o; o.x = pk2(yacc[pb][0] + Dh * bflo(xv.x), yacc[pb][1] + Dh * bfhi(xv.x)); o.y = pk2(yacc[pb][2] + Dh * bflo(xv.y), yacc[pb][3] + Dh * bfhi(xv.y));
            *(u32x2*)(ys + (size_t)(m0 + l) * SSDW + pcol) = o;
        }
        { const float ea = __expf(alast);
#pragma unroll
          for (int pb = 0; pb < 4; ++pb) hacc[pb] = hacc[pb] * ea; }
#pragma unroll
        for (int ks = 0; ks < 4; ++ks) {
            const bf16x8 btf = *(const LAS bf16x8*)(lds + L_BT + (16 * w + fr) * LROW + (ks * 32 + fq * 8) * 2);
#pragma unroll
            for (int pb = 0; pb < 4; ++pb) { const bf16x8 xsf = *(const LAS bf16x8*)(lds + L_XS + (pb * 16 + fr) * LROW + (ks * 32 + fq * 8) * 2); hacc[pb] = __builtin_amdgcn_mfma_f32_16x16x32_bf16(btf, xsf, hacc[pb], 0, 0, 0); }
        }
#pragma unroll
        for (int pb = 0; pb < 4; ++pb) { u32x2 o; o.x = pk2(hacc[pb][0], hacc[pb][1]); o.y = pk2(hacc[pb][2], hacc[pb][3]); *(LAS u32x2*)(lds + L_HT + (pb * 16 + fr) * LROW + (16 * w + 4 * fq) * 2) = o; }
        __syncthreads();
    }
    float* so = p.out + O_SSDP + ((size_t)(b * NH + h) * 64) * 128;
#pragma unroll
    for (int pb = 0; pb < 4; ++pb) *(f32x4*)(so + (size_t)(pb * 16 + fr) * 128 + 16 * w + 4 * fq) = hacc[pb];
}

__device__ __forceinline__ void s5_wave_item(const Params& p, LAS unsigned char* wl, int g, int bidx, int m_start, int nrows, bool samp, int lane) {
    const int fr = lane & 15, fq = lane >> 4;
    const bf16_t* proj = (const bf16_t*)(p.ws + WS_A); bf16_t* vbuf = (bf16_t*)(p.ws + WS_H);
    const bf16_t* BBAR = (const bf16_t*)(p.ws + WS_BBAR); const bf16_t* CMAT = (const bf16_t*)(p.ws + WS_CMAT); const float* AB = (const float*)(p.ws + WS_S5A);
    const bf16x8 zf = (bf16x8){0, 0, 0, 0, 0, 0, 0, 0};
    bf16x8 bfrag[8], cfrag[4];
#pragma unroll
    for (int t = 0; t < 8; ++t) bfrag[t] = (fq < 2) ? *(const bf16x8*)(BBAR + ((size_t)(g * 128 + t * 16 + fr)) * 16 + fq * 8) : zf;
#pragma unroll
    for (int ks = 0; ks < 4; ++ks) cfrag[ks] = *(const bf16x8*)(CMAT + ((size_t)(g * 16 + fr)) * 128 + ks * 32 + fq * 8);
    const float ar = AB[g * 64 + lane], ai = AB[2048 + g * 64 + lane];
    const f32x4 d4 = *(const f32x4*)(p.in[19] + g * 16 + 4 * fq);
    LAS float* sBu = (LAS float*)wl; LAS bf16_t* sS = (LAS bf16_t*)(wl + 8448);
    float sr = 0.f, si = 0.f;
    for (int m0 = m_start; m0 < m_start + nrows; m0 += 16) {
        const bf16_t* urow = proj + (size_t)(m0 + fr) * NINP + g * 16;
        const bf16x8 uf = (fq < 2) ? *(const bf16x8*)(urow + fq * 8) : zf;
        const u32x2 u4 = *(const u32x2*)(urow + 4 * fq);
#pragma unroll
        for (int t = 0; t < 8; ++t) {
            f32x4 a = (f32x4){0.f, 0.f, 0.f, 0.f};
            a = __builtin_amdgcn_mfma_f32_16x16x32_bf16(bfrag[t], uf, a, 0, 0, 0);
            *(LAS f32x4*)(sBu + fr * 132 + t * 16 + 4 * fq) = a;
        }
        LDS_WAIT();
#pragma unroll
        for (int t = 0; t < 16; ++t) {
            if (samp && (t & 3) == 0) { const int bb = (m0 - MP + t) >> 2; sr = p.in[2][((size_t)bb * 32 + g) * 64 + lane]; si = p.in[3][((size_t)bb * 32 + g) * 64 + lane]; }
            const float br = sBu[t * 132 + lane], bi = sBu[t * 132 + 64 + lane];
            const float nr = ar * sr - ai * si + br, ni = ar * si + ai * sr + bi;
            sr = nr; si = ni;
            const unsigned pp = pk2(sr, si);
            sS[t * 136 + lane] = (bf16_t)(pp & 0xffff); sS[t * 136 + 64 + lane] = (bf16_t)(pp >> 16);
            if (samp && (t & 3) == 3) { const int bb = (m0 - MP + t) >> 2; p.out[O_S5RS + ((size_t)bb * 32 + g) * 64 + lane] = sr; p.out[O_S5IS + ((size_t)bb * 32 + g) * 64 + lane] = si; }
        }
        LDS_WAIT();
        f32x4 y = (f32x4){0.f, 0.f, 0.f, 0.f};
#pragma unroll
        for (int ks = 0; ks < 4; ++ks) { const bf16x8 sf = *(const LAS bf16x8*)(sS + fr * 136 + ks * 32 + fq * 8); y = __builtin_amdgcn_mfma_f32_16x16x32_bf16(cfrag[ks], sf, y, 0, 0, 0); }
        const float y0 = y[0] + d4[0] * bflo(u4.x), y1 = y[1] + d4[1] * bfhi(u4.x), y2 = y[2] + d4[2] * bflo(u4.y), y3 = y[3] + d4[3] * bfhi(u4.y);
        u32x2 o; o.x = pk2(gelu_tanh(y0), gelu_tanh(y1)); o.y = pk2(gelu_tanh(y2), gelu_tanh(y3));
        *(u32x2*)(vbuf + (size_t)(m0 + fr) * 512 + g * 16 + 4 * fq) = o;
        LDS_WAIT();
    }
    if (!samp) { p.out[O_S5RP + ((size_t)bidx * 32 + g) * 64 + lane] = sr; p.out[O_S5IP + ((size_t)bidx * 32 + g) * 64 + lane] = si; }
}

__device__ __forceinline__ void ssd_sample_item(const Params& p, int b, int h) {
    const int tid = threadIdx.x, g = h / 6, pp = tid >> 3, n0 = (tid & 7) * 16;
    const bf16_t* xc = (const bf16_t*)(p.ws + WS_XC); const float* dtraw = (const float*)(p.ws + WS_DTRAW); bf16_t* ys = (bf16_t*)(p.ws + WS_YS);
    const float a_h = -__expf(p.in[25][h]), dtb = p.in[24][h], Dh = p.in[26][h];
    const size_t so = ((size_t)(b * NH + h) * 64 + pp) * 128 + n0;
    const float* h0 = p.in[4] + so;
    float hv[16];
#pragma unroll
    for (int j = 0; j < 16; j += 4) *(f32x4*)&hv[j] = *(const f32x4*)(h0 + j);
#pragma unroll
    for (int t = 0; t < 4; ++t) {
        const int m = MP + b * 4 + t;
        const float dt = softplus_f(dtraw[(size_t)m * 24 + h] + dtb), dec = __expf(dt * a_h);
        const bf16_t* row = xc + (size_t)m * XBC;
        const float xv = bf2f(row[h * 64 + pp]), xd = xv * dt;
        float Bv[16], Cv[16];
        unpack8(*(const u32x4*)(row + 1536 + g * 128 + n0), *(float(*)[8])&Bv[0]); unpack8(*(const u32x4*)(row + 1536 + g * 128 + n0 + 8), *(float(*)[8])&Bv[8]);
        unpack8(*(const u32x4*)(row + 2048 + g * 128 + n0), *(float(*)[8])&Cv[0]); unpack8(*(const u32x4*)(row + 2048 + g * 128 + n0 + 8), *(float(*)[8])&Cv[8]);
        float acc = 0.f;
#pragma unroll
        for (int j = 0; j < 16; ++j) { hv[j] = hv[j] * dec + xd * Bv[j]; acc += hv[j] * Cv[j]; }
        acc += __shfl_xor(acc, 1); acc += __shfl_xor(acc, 2); acc += __shfl_xor(acc, 4);
        if ((tid & 7) == 0) ys[(size_t)m * SSDW + h * 64 + pp] = (bf16_t)(pk2(acc + Dh * xv, 0.f) & 0xffff);
    }
    float* ho = p.out + O_SSDS + so;
#pragma unroll
    for (int j = 0; j < 16; j += 4) *(f32x4*)(ho + j) = *(f32x4*)&hv[j];
}

__device__ __forceinline__ void gatenorm_phase(const Params& p, int gw, int ngw, int lane) {
    const bf16_t* proj = (const bf16_t*)(p.ws + WS_A); const bf16_t* ys = (const bf16_t*)(p.ws + WS_YS); bf16_t* mix = (bf16_t*)(p.ws + WS_XC);
    const float* nw = p.in[27];
    for (int task = gw; task < M * 4; task += ngw) {
        const int m = task >> 2, grp = task & 3, c0 = grp * 384 + lane * 8;
        float gv[8]; float ss = 0.f;
        if (lane < 48) {
            float yv[8], zv[8];
            unpack8(*(const u32x4*)(ys + (size_t)m * SSDW + c0), yv); unpack8(*(const u32x4*)(proj + (size_t)m * NINP + 512 + c0), zv);
#pragma unroll
            for (int e = 0; e < 8; ++e) { gv[e] = yv[e] * silu_f(zv[e]); ss += gv[e] * gv[e]; }
        }
        const float rstd = rsqrtf(wave_sum(ss) * (1.f / 384.f) + EPS);
        if (lane < 48) {
            const f32x4 n0 = *(const f32x4*)(nw + c0), n1 = *(const f32x4*)(nw + c0 + 4);
            u32x4 o; o.x = pk2(gv[0] * rstd * n0[0], gv[1] * rstd * n0[1]); o.y = pk2(gv[2] * rstd * n0[2], gv[3] * rstd * n0[3]);
            o.z = pk2(gv[4] * rstd * n1[0], gv[5] * rstd * n1[1]); o.w = pk2(gv[6] * rstd * n1[2], gv[7] * rstd * n1[3]);
            *(u32x4*)(mix + (size_t)m * DMIX + 512 + c0) = o;
        }
    }
}

__global__ void __launch_bounds__(512, 2) hymba_fwd(Params p) {
    extern __shared__ __attribute__((aligned(16))) unsigned char smem[];
    LAS unsigned char* lds = (LAS unsigned char*)smem;
    cg::grid_group grid = cg::this_grid();
    const int tid = threadIdx.x, lane = tid & 63, wave = __builtin_amdgcn_readfirstlane(tid >> 6);
    const int G = gridDim.x, bid = blockIdx.x;
    const int gw = bid * 8 + wave, ngw = G * 8, gtid = bid * 512 + tid, nthreads = G * 512;
    unsigned* ctl = (unsigned*)(p.ws + WS_CTL);
    bf16_t* W1T = (bf16_t*)(p.ws + WS_W1T); bf16_t* W1D = (bf16_t*)(p.ws + WS_W1D); bf16_t* W2T = (bf16_t*)(p.ws + WS_W2T); bf16_t* W2D = (bf16_t*)(p.ws + WS_W2D);
    bf16_t* WIN = (bf16_t*)(p.ws + WS_WIN); bf16_t* WGLU = (bf16_t*)(p.ws + WS_WGLU); bf16_t* WOUT = (bf16_t*)(p.ws + WS_WOUT);
    bf16_t* HB = (bf16_t*)(p.ws + WS_H); bf16_t* AB = (bf16_t*)(p.ws + WS_A); bf16_t* XC = (bf16_t*)(p.ws + WS_XC);
    float* yout = p.out + O_Y;
    pg8::StaticOrder S;

    {
        if (gtid == 0) { ctl[0] = 0u; }
        LAS float* scr = (LAS float*)(lds + wave * 8448);
        constexpr int I_GU = (D / 64) * (FF / 32), I_DN = (FF / 64) * (D / 32), I_IN = (D / 64) * ((NIN + 31) / 32), I_GL = (512 / 64) * (512 / 32), I_OUT = (DMIX / 64) * (D / 32);
        constexpr int NITEMS = 4 * I_GU + 2 * I_DN + I_IN + I_GL + I_OUT;
        for (int it = gw; it < NITEMS; it += ngw) {
            int r = it;
            if (r < I_GU) { transpose_item(p.in[7], D, FF, W1T, 1, scr, r, lane); continue; } r -= I_GU;
            if (r < I_GU) { transpose_item(p.in[8], D, FF, W1T, 2, scr, r, lane); continue; } r -= I_GU;
            if (r < I_DN) { transpose_item(p.in[9], FF, D, W1D, 0, scr, r, lane); continue; } r -= I_DN;
            if (r < I_GU) { transpose_item(p.in[30], D, FF, W2T, 1, scr, r, lane); continue; } r -= I_GU;
            if (r < I_GU) { transpose_item(p.in[31], D, FF, W2T, 2, scr, r, lane); continue; } r -= I_GU;
            if (r < I_DN) { transpose_item(p.in[32], FF, D, W2D, 0, scr, r, lane); continue; } r -= I_DN;
            if (r < I_IN) { transpose_item(p.in[11], D, NIN, WIN, 0, scr, r, lane); continue; } r -= I_IN;
            if (r < I_GL) { transpose_item(p.in[20], 512, 512, WGLU, 0, scr, r, lane); continue; } r -= I_GL;
            transpose_item(p.in[28], DMIX, D, WOUT, 0, scr, r, lane);
        }
        rms_phase(p.in[0], p.in[1], p.in[6], HB, gw, ngw, lane);
        if (gtid < 2048) {
            const int idx = gtid, g = idx >> 6, pp = idx & 63;
            const double lr = p.in[12][idx], li = p.in[13][idx], step = exp((double)p.in[14][g]);
            const double mag = exp(lr * step), ang = li * step;
            const double are = mag * cos(ang), aim = mag * sin(ang);
            const double den = lr * lr + li * li, nre = are - 1.0, nim = aim;
            const float cre = (float)((nre * lr + nim * li) / den), cim = (float)((nim * lr - nre * li) / den);
            float* ABf = (float*)(p.ws + WS_S5A); ABf[idx] = (float)are; ABf[2048 + idx] = (float)aim;
            bf16_t* BBAR = (bf16_t*)(p.ws + WS_BBAR); bf16_t* CMAT = (bf16_t*)(p.ws + WS_CMAT);
            const float* bre = p.in[15] + (size_t)idx * 16; const float* bim = p.in[16] + (size_t)idx * 16;
#pragma unroll
            for (int hh = 0; hh < 16; hh += 2) {
                const float r0 = cre * bre[hh] - cim * bim[hh], r1 = cre * bre[hh + 1] - cim * bim[hh + 1];
                const float i0 = cre * bim[hh] + cim * bre[hh], i1 = cre * bim[hh + 1] + cim * bre[hh + 1];
                *(unsigned*)(BBAR + ((size_t)(g * 128 + pp)) * 16 + hh) = pk2(r0, r1);
                *(unsigned*)(BBAR + ((size_t)(g * 128 + 64 + pp)) * 16 + hh) = pk2(i0, i1);
            }
#pragma unroll
            for (int hh = 0; hh < 16; ++hh) {
                const float cr = p.in[17][((size_t)g * 16 + hh) * 64 + pp], ci = p.in[18][((size_t)g * 16 + hh) * 64 + pp];
                const unsigned pk = pk2(cr, -ci);
                CMAT[((size_t)(g * 16 + hh)) * 128 + pp] = (bf16_t)(pk & 0xffff); CMAT[((size_t)(g * 16 + hh)) * 128 + 64 + pp] = (bf16_t)(pk >> 16);
            }
        }
    }
    grid.sync();
    { S.init(M, 2 * FF, G, bid); pg8::gemm_phase(lds, pg8::Gemm{HB, W1T, M, 2 * FF, D}, S, EpiGateUp{AB}); }
    grid.sync();
    { S.init(M, D, G, bid); pg8::gemm_phase(lds, pg8::Gemm{AB, W1D, M, D, FF}, S, EpiResid{p.in[0], p.in[1], yout, 0.5f}); }
    grid.sync();
    rms_phase(yout, yout + (size_t)MP * D, p.in[10], HB, gw, ngw, lane);
    grid.sync();
    { S.init(M, NINP, G, bid); pg8::gemm_phase(lds, pg8::Gemm{HB, WIN, M, NINP, D}, S, EpiProj{AB, (float*)(p.ws + WS_DTRAW)}); }
    grid.sync();
    conv_phase(p, gtid, nthreads);
    grid.sync();
    {
        volatile LAS int* bc = (volatile LAS int*)(lds + L_BCAST);
        constexpr int N_SSDP = NB * NH, N_S5P = 32, N_S5S = 128, N_SSDS = NSB * NH;
        for (;;) {
            __syncthreads();
            if (tid == 0) *bc = (int)atomicAdd(&ctl[0], 1u);
            __syncthreads();
            int it = *bc;
            if (it >= N_SSDP + N_S5P + N_S5S + N_SSDS) break;
            if (it < N_SSDP) { ssd_prompt_item(p, lds, it / NH, it % NH); continue; }
            it -= N_SSDP;
            if (it < N_S5P) { const int pair = it * 8 + wave; s5_wave_item(p, lds + wave * 12800, pair & 31, pair >> 5, (pair >> 5) * SEQ, SEQ, false, lane); continue; }
            it -= N_S5P;
            if (it < N_S5S) { const int idx = it * 8 + wave; s5_wave_item(p, lds + wave * 12800, idx & 31, 0, MP + (idx >> 5) * 16, 16, true, lane); continue; }
            it -= N_S5S;
            ssd_sample_item(p, it / NH, it % NH);
        }
    }
    grid.sync();
    { S.init(M, 512, G, bid); pg8::gemm_phase(lds, pg8::Gemm{HB, WGLU, M, 512, 512}, S, EpiGlu{HB, p.in[21], XC}); }
    gatenorm_phase(p, gw, ngw, lane);
    grid.sync();
    { S.init(M, D, G, bid); pg8::gemm_phase(lds, pg8::Gemm{XC, WOUT, M, D, DMIX}, S, EpiResid{yout, yout + (size_t)MP * D, yout, 1.0f}); }
    grid.sync();
    rms_phase(yout, yout + (size_t)MP * D, p.in[29], HB, gw, ngw, lane);
    grid.sync();
    { S.init(M, 2 * FF, G, bid); pg8::gemm_phase(lds, pg8::Gemm{HB, W2T, M, 2 * FF, D}, S, EpiGateUp{AB}); }
    grid.sync();
    { S.init(M, D, G, bid); pg8::gemm_phase(lds, pg8::Gemm{AB, W2D, M, D, FF}, S, EpiResid{yout, yout + (size_t)MP * D, yout, 0.5f}); }
    grid.sync();
    for (int m = gw; m < M; m += ngw) {
        f32x4* xr = (f32x4*)(yout + (size_t)m * D) + lane; const f32x4* wr = (const f32x4*)p.in[33] + lane;
        f32x4 v[4]; float s = 0.f;
#pragma unroll
        for (int j = 0; j < 4; ++j) { v[j] = xr[64 * j]; s += (v[j].x * v[j].x + v[j].y * v[j].y) + (v[j].z * v[j].z + v[j].w * v[j].w); }
        const float rstd = rsqrtf(wave_sum(s) * (1.f / D) + EPS);
#pragma unroll
        for (int j = 0; j < 4; ++j) xr[64 * j] = v[j] * rstd * wr[64 * j];
    }
}

extern "C" void kernel_launch(void* const* d_in, const int* in_sizes, int n_in, void* d_out, int out_size, void* d_ws, size_t ws_size, hipStream_t stream) {
    static int grid_blocks = 0;
    if (grid_blocks == 0) {
        if (n_in != 34 || ws_size < WS_END) { fprintf(stderr, "kernel_launch: unexpected n_in %d or ws_size %zu (< %zu)\n", n_in, ws_size, (size_t)WS_END); grid_blocks = -1; return; }
        int dev = 0, cus = 0, per_cu = 0;
        hipGetDevice(&dev);
        hipDeviceGetAttribute(&cus, hipDeviceAttributeMultiprocessorCount, dev);
        hipFuncSetAttribute((const void*)hymba_fwd, hipFuncAttributeMaxDynamicSharedMemorySize, LDS_BYTES);
        hipOccupancyMaxActiveBlocksPerMultiprocessor(&per_cu, (const void*)hymba_fwd, 512, LDS_BYTES);
        if (per_cu < 1) { fprintf(stderr, "kernel_launch: occupancy query says %d blocks/CU\n", per_cu); per_cu = 1; }
        grid_blocks = cus;
    }
    if (grid_blocks < 0) return;
    Params p{};
    for (int i = 0; i < 34; ++i) p.in[i] = (const float*)d_in[i];
    p.out = (float*)d_out; p.ws = (unsigned char*)d_ws;
    void* args[] = {&p};
    hipError_t e = hipLaunchCooperativeKernel((const void*)hymba_fwd, dim3(grid_blocks), dim3(512), args, LDS_BYTES, stream);
    if (e != hipSuccess) fprintf(stderr, "cooperative launch failed: %s (grid %d)\n", hipGetErrorString(e), grid_blocks);
}
```

```cpp
#include <hip/hip_runtime.h>
#include <hip/hip_cooperative_groups.h>
#include <cstdio>
#include <cstdint>
namespace cg = cooperative_groups;

#define LAS __attribute__((address_space(3)))
typedef unsigned short bf16_t;
typedef short bf16x8 __attribute__((ext_vector_type(8)));
typedef float f32x4 __attribute__((ext_vector_type(4)));
typedef float f32x2 __attribute__((ext_vector_type(2)));
typedef unsigned u32x4 __attribute__((ext_vector_type(4)));
typedef unsigned u32x2 __attribute__((ext_vector_type(2)));

constexpr int D = 1024, FF = 2816, NIN = 4632, NINP = 4864, DMIX = 2048;
constexpr int MP = 16384, MS = 512, M = MP + MS, SEQ = 2048, NB = 8, NSB = 128;
constexpr int XBC = 2560, SSDW = 1536, NH = 24;
constexpr float EPS = 1e-6f;
constexpr size_t O_Y = 0, O_S5RP = 17301504, O_S5IP = 17317888, O_SSDP = 17334272, O_CONVP = 18907136,
                 O_S5RS = 18968576, O_S5IS = 19230720, O_SSDS = 19492864, O_CONVS = 44658688;
constexpr size_t WS_CTL = 0, WS_BAR = 2048, WS_S5A = 16384, WS_BBAR = WS_S5A + 16384, WS_CMAT = WS_BBAR + 131072, WS_DTRAW = WS_CMAT + 131072,
                 WS_W1T = WS_DTRAW + (size_t)M * 24 * 4, WS_W1D = WS_W1T + (size_t)2 * FF * D * 2, WS_W2T = WS_W1D + (size_t)D * FF * 2,
                 WS_W2D = WS_W2T + (size_t)2 * FF * D * 2, WS_WIN = WS_W2D + (size_t)D * FF * 2, WS_WGLU = WS_WIN + (size_t)NINP * D * 2,
                 WS_WOUT = WS_WGLU + (size_t)512 * 512 * 2, WS_H = WS_WOUT + (size_t)D * DMIX * 2, WS_A = WS_H + (size_t)M * D * 2,
                 WS_XC = WS_A + (size_t)M * NINP * 2, WS_YS = WS_XC + (size_t)M * XBC * 2, WS_S5END = WS_YS + (size_t)M * SSDW * 2, WS_END = WS_S5END + (size_t)256 * 8 * 128 * 4;
constexpr size_t XC_BCN = 0, XC_XSN = (size_t)M * 1024 * 2, XC_XT = XC_XSN + (size_t)MS * SSDW * 2, H_BT = (size_t)M * 512 * 2;
constexpr int LDS_BYTES = 158720;
#define REP_P1 1
#define REP_P6 1
#define REP_P5 1
#define REP_P7 1
constexpr int L_BCAST = 158208, L_XBST = 158224;

struct Params {
    const float* in[34];
    float* out;
    unsigned char* ws;
    int use_cg; int pad;
};

__device__ __forceinline__ unsigned pk2(float lo, float hi) { unsigned r; asm volatile("v_cvt_pk_bf16_f32 %0, %1, %2" : "=v"(r) : "v"(lo), "v"(hi)); return r; }
__device__ __forceinline__ float bflo(unsigned u) { return __uint_as_float(u << 16); }
__device__ __forceinline__ float bfhi(unsigned u) { return __uint_as_float(u & 0xffff0000u); }
__device__ __forceinline__ float bf2f(bf16_t v) { return __uint_as_float((unsigned)v << 16); }
__device__ __forceinline__ float wave_sum(float v) {
#pragma unroll
    for (int o = 1; o < 64; o <<= 1) v += __shfl_xor(v, o);
    return v;
}
__device__ __forceinline__ float silu_f(float x) { return x / (1.f + __expf(-x)); }
__device__ __forceinline__ float sigmoid_f(float x) { return 1.f / (1.f + __expf(-x)); }
__device__ __forceinline__ float softplus_f(float x) { return fmaxf(x, 0.f) + log1pf(__expf(-fabsf(x))); }
__device__ __forceinline__ float gelu_tanh(float y) { const float a = 0.7978845608028654f * (y + 0.044715f * y * y * y); const float t = 1.f - 2.f / (1.f + __expf(2.f * a)); return 0.5f * y * (1.f + t); }
#define LDS_WAIT() asm volatile("s_waitcnt lgkmcnt(0)" ::: "memory")
#define LDS_BARRIER() do { asm volatile("s_waitcnt lgkmcnt(0)" ::: "memory"); __builtin_amdgcn_s_barrier(); asm volatile("" ::: "memory"); } while (0)

namespace pg8 {
constexpr int BM = 256, BK = 64, HALF = 128, HTB = HALF * BK * 2, STAGE_BYTES = 8 * HTB, NXCD = 8, WGM = 8;
__host__ __device__ __forceinline__ int lds_byte(int r, int c) { const int st = (r >> 4) * 2 + (c >> 5), rr = r & 15, cc = c & 31, ob = rr * 64 + cc * 2; return st * 1024 + (ob ^ (((ob >> 9) & 1) << 5)); }
__host__ __device__ __forceinline__ void stage_rc(int b, int& R, int& C) { const int st = b / 1024, sb = b % 1024, swz = sb ^ (((sb >> 9) & 1) << 5); R = (st >> 1) * 16 + swz / 64; C = (st & 1) * 32 + (swz % 64) / 2; }
struct Unit { int pm, pn, kofs; };
struct Gemm { const bf16_t* A; const bf16_t* Bt; int M, N, K, ld; };
struct StaticOrder {
    int nM, nN, nwg, G, c;
    __host__ __device__ void init(int M_, int N_, int G_, int c_) { nM = M_ / BM; nN = N_ / BM; nwg = nM * nN; G = G_; c = c_; }
    __host__ __device__ bool next(int i, Unit& u) const {
        const long L = (long)i * G + c; if (L >= nwg) return false;
        int wgid = (int)L; { const int q = nwg / NXCD, r = nwg % NXCD, xcd = wgid % NXCD, off = wgid / NXCD; wgid = (xcd < r ? xcd * (q + 1) : r * (q + 1) + (xcd - r) * q) + off; }
        const int nig = WGM * nN, gid = wgid / nig, fm = gid * WGM, gsz = (nM - fm) < WGM ? (nM - fm) : WGM;
        u.pm = fm + ((wgid % nig) % gsz); u.pn = (wgid % nig) / gsz; u.kofs = 0; return true;
    }
    __device__ __forceinline__ void a_ready(const Unit&) const {}
    __device__ __forceinline__ void done(const Unit&) const {}
};
struct SplitOrder {
    int nunits, G, c, kslice;
    __host__ __device__ bool next(int i, Unit& u) const { const int L = i * G + c; if (L >= nunits) return false; u.pm = L & 1; u.pn = (L >> 1) & 3; u.kofs = (L >> 3) * kslice; return true; }
    __device__ __forceinline__ void a_ready(const Unit&) const {}
    __device__ __forceinline__ void done(const Unit&) const {}
};

template <bool SP2, class Epi, class Sched>
__device__ __forceinline__ void gemm_phase(LAS unsigned char* lds, const Gemm g, const Sched& S, const Epi& E) {
    int tid = threadIdx.x; asm volatile("" : "+v"(tid));
    const int wid = __builtin_amdgcn_readfirstlane(tid >> 6), lane = tid & 63, wr = wid >> 2, wc = wid & 3, fr = lane & 15, fq = lane >> 4;
    const int K = g.K, nt = K / BK;
    int ldv = g.ld; asm volatile("" : "+s"(ldv));
    unsigned voffA[2], voffB[2];
#pragma unroll
    for (int i = 0; i < 2; ++i) { int R, C; stage_rc(tid * 16 + i * 8192, R, C); voffA[i] = (unsigned)(R * ldv + C) * 2u; voffB[i] = voffA[i]; }
    const size_t kstep = (size_t)(BK * 2);
    const size_t hstepA = (size_t)HALF * ldv * 2, hstepB = hstepA;
    const size_t tstepA = 2 * hstepA, tstepB = tstepA;
    const unsigned ldsw = (unsigned)wid * 1024u;
    const int aoff = lds_byte(wr * 64 + fr, fq * 8), boff = lds_byte(wc * 32 + fr, fq * 8);
#define PG8_SA(b, h) (((b) * 2 + (h)) * HTB)
#define PG8_SB(b, h) ((4 + (b) * 2 + (h)) * HTB)
#define PG8_STAGE(bufoff, gbase, voff) do { _Pragma("unroll") for (int _i = 0; _i < 2; ++_i) \
        __builtin_amdgcn_global_load_lds((const unsigned*)((const char*)(gbase) + (voff)[_i]), (LAS unsigned*)(lds + (bufoff) + ldsw + _i * 8192), 16, 0, 0); } while (0)
#define PG8_LDA(dst, b, h) do { _Pragma("unroll") for (int m = 0; m < 4; ++m) _Pragma("unroll") for (int k = 0; k < 2; ++k) dst[m][k] = *(const LAS bf16x8*)(lds + PG8_SA(b, h) + aoff + m * 2048 + k * 1024); } while (0)
#define PG8_LDB(dst, b, h) do { _Pragma("unroll") for (int n = 0; n < 2; ++n) _Pragma("unroll") for (int k = 0; k < 2; ++k) dst[n][k] = *(const LAS bf16x8*)(lds + PG8_SB(b, h) + boff + n * 2048 + k * 1024); } while (0)
#define PG8_MMA(ai, bj, At, Bt) do { __builtin_amdgcn_s_setprio(1); _Pragma("unroll") for (int m = 0; m < 4; ++m) _Pragma("unroll") for (int n = 0; n < 2; ++n) _Pragma("unroll") for (int k = 0; k < 2; ++k) \
        acc[ai][bj][m][n] = __builtin_amdgcn_mfma_f32_16x16x32_bf16(Bt[n][k], At[m][k], acc[ai][bj][m][n], 0, 0, 0); __builtin_amdgcn_s_setprio(0); } while (0)
#define PG8_WAIT_V(n) asm volatile("s_waitcnt vmcnt(" #n ")" ::: "memory")
#define PG8_WAIT_L(n) asm volatile("s_waitcnt lgkmcnt(" #n ")" ::: "memory")
#define PG8_BAR __builtin_amdgcn_s_barrier()
#define PG8_SCHED __builtin_amdgcn_sched_barrier(0)
    Unit cur, nxt; int ui = 0;
    if (!S.next(0, cur)) return;
    f32x4 acc[2][2][4][2];
#pragma unroll
    for (int a = 0; a < 2; ++a)
#pragma unroll
        for (int b = 0; b < 2; ++b)
#pragma unroll
            for (int m = 0; m < 4; ++m)
#pragma unroll
                for (int n = 0; n < 2; ++n) acc[a][b][m][n] = (f32x4){0.f, 0.f, 0.f, 0.f};
    bf16x8 At[4][2], B0[2][2], B1[2][2];
    const char* cA = (const char*)g.A + (size_t)cur.pm * tstepA + (size_t)cur.kofs * 2; const char* cB = (const char*)g.Bt + (size_t)cur.pn * tstepB + (size_t)cur.kofs * 2;
    S.a_ready(cur);
    if constexpr (SP2) {
        PG8_STAGE(PG8_SB(0, 0), cB, voffB); PG8_STAGE(PG8_SB(0, 1), cB + hstepB, voffB); PG8_STAGE(PG8_SA(0, 0), cA, voffA); PG8_STAGE(PG8_SA(0, 1), cA + hstepA, voffA);
        if (wr == 1) PG8_BAR;
        PG8_WAIT_V(2); PG8_BAR;
    } else {
        PG8_STAGE(PG8_SB(0, 0), cB, voffB); PG8_STAGE(PG8_SA(0, 0), cA, voffA); PG8_STAGE(PG8_SB(0, 1), cB + hstepB, voffB); PG8_STAGE(PG8_SA(0, 1), cA + hstepA, voffA);
        if (wr == 1) PG8_BAR;
        PG8_WAIT_V(4); PG8_BAR;
    }
    PG8_STAGE(PG8_SB(1, 0), cB + kstep, voffB); PG8_STAGE(PG8_SA(1, 0), cA + kstep, voffA); PG8_STAGE(PG8_SB(1, 1), cB + hstepB + kstep, voffB);
    PG8_WAIT_V(6); PG8_BAR;
    for (;;) {
        const bool has_next = S.next(ui + 1, nxt);
        const char* nA = has_next ? (const char*)g.A + (size_t)nxt.pm * tstepA + (size_t)nxt.kofs * 2 : cA; const char* nB = has_next ? (const char*)g.Bt + (size_t)nxt.pn * tstepB + (size_t)nxt.kofs * 2 : cB;
        for (int t = 0; t < nt; t += 2) {
            const bool last = (t == nt - 2);
            const char* a1 = cA + (size_t)(t + 1) * kstep;
            const char* a2 = last ? nA : cA + (size_t)(t + 2) * kstep; const char* b2 = last ? nB : cB + (size_t)(t + 2) * kstep;
            const char* a3 = a2 + kstep; const char* b3 = b2 + kstep;
            if (last && has_next) S.a_ready(nxt);
            if constexpr (SP2) {
            PG8_LDB(B0, 0, 0); PG8_LDB(B1, 0, 1); PG8_SCHED; PG8_LDA(At, 0, 0); PG8_STAGE(PG8_SA(1, 1), a1 + hstepA, voffA);
            PG8_WAIT_V(8); PG8_WAIT_L(0); PG8_BAR; PG8_MMA(0, 0, At, B0); PG8_MMA(0, 1, At, B1); PG8_BAR; PG8_SCHED;
            PG8_LDA(At, 0, 1); PG8_STAGE(PG8_SB(0, 0), b2, voffB); PG8_STAGE(PG8_SB(0, 1), b2 + hstepB, voffB); PG8_STAGE(PG8_SA(0, 0), a2, voffA);
            PG8_WAIT_V(8); PG8_WAIT_L(0); PG8_BAR; PG8_MMA(1, 0, At, B0); PG8_MMA(1, 1, At, B1); PG8_BAR; PG8_SCHED;
            PG8_LDB(B0, 1, 0); PG8_LDB(B1, 1, 1); PG8_SCHED; PG8_LDA(At, 1, 0); PG8_STAGE(PG8_SA(0, 1), a2 + hstepA, voffA);
            PG8_WAIT_V(8); PG8_WAIT_L(0); PG8_BAR; PG8_MMA(0, 0, At, B0); PG8_MMA(0, 1, At, B1); PG8_BAR; PG8_SCHED;
            PG8_LDA(At, 1, 1); PG8_STAGE(PG8_SB(1, 0), b3, voffB); PG8_STAGE(PG8_SB(1, 1), b3 + hstepB, voffB); PG8_STAGE(PG8_SA(1, 0), a3, voffA);
            PG8_WAIT_V(8); PG8_WAIT_L(0); PG8_BAR; PG8_MMA(1, 0, At, B0); PG8_MMA(1, 1, At, B1); PG8_BAR; PG8_SCHED;
            } else {
            PG8_LDB(B0, 0, 0); PG8_SCHED; PG8_LDA(At, 0, 0); PG8_STAGE(PG8_SA(1, 1), a1 + hstepA, voffA);
            PG8_WAIT_L(8); PG8_BAR; PG8_WAIT_L(0); PG8_MMA(0, 0, At, B0); PG8_BAR; PG8_SCHED;
            PG8_LDB(B1, 0, 1); PG8_STAGE(PG8_SB(0, 0), b2, voffB);
            PG8_BAR; PG8_WAIT_L(0); PG8_MMA(0, 1, At, B1); PG8_BAR;
            PG8_LDA(At, 0, 1); PG8_STAGE(PG8_SA(0, 0), a2, voffA);
            PG8_BAR; PG8_WAIT_L(0); PG8_MMA(1, 0, At, B0); PG8_BAR; PG8_SCHED;
            PG8_STAGE(PG8_SB(0, 1), b2 + hstepB, voffB);
            PG8_WAIT_V(6); PG8_BAR; PG8_MMA(1, 1, At, B1); PG8_BAR;
            PG8_LDB(B0, 1, 0); PG8_SCHED; PG8_LDA(At, 1, 0); PG8_STAGE(PG8_SA(0, 1), a2 + hstepA, voffA);
            PG8_WAIT_L(8); PG8_BAR; PG8_WAIT_L(0); PG8_MMA(0, 0, At, B0); PG8_BAR; PG8_SCHED;
            PG8_LDB(B1, 1, 1); PG8_STAGE(PG8_SB(1, 0), b3, voffB);
            PG8_BAR; PG8_WAIT_L(0); PG8_MMA(0, 1, At, B1); PG8_BAR;
            PG8_LDA(At, 1, 1); PG8_STAGE(PG8_SA(1, 0), a3, voffA);
            PG8_BAR; PG8_WAIT_L(0); PG8_MMA(1, 0, At, B0); PG8_BAR; PG8_SCHED;
            PG8_STAGE(PG8_SB(1, 1), b3 + hstepB, voffB);
            PG8_WAIT_V(6); PG8_BAR; PG8_MMA(1, 1, At, B1); PG8_BAR;
                    }
        }
        if constexpr (SP2) { if (wr == 0) PG8_BAR; }
        E(acc, cur, wr, wc, fr, fq); S.done(cur);
        if (!has_next) break;
#pragma unroll
        for (int a = 0; a < 2; ++a)
#pragma unroll
            for (int b = 0; b < 2; ++b)
#pragma unroll
                for (int m = 0; m < 4; ++m)
#pragma unroll
                    for (int n = 0; n < 2; ++n) acc[a][b][m][n] = (f32x4){0.f, 0.f, 0.f, 0.f};
        cur = nxt; cA = nA; cB = nB; ++ui;
        if constexpr (SP2) { if (wr == 1) PG8_BAR; }
    }
    PG8_WAIT_V(0);
    if constexpr (!SP2) { if (wr == 0) PG8_BAR; }
    PG8_BAR;
#undef PG8_SA
#undef PG8_SB
#undef PG8_STAGE
#undef PG8_LDA
#undef PG8_LDB
#undef PG8_MMA
#undef PG8_WAIT_V
#undef PG8_WAIT_L
#undef PG8_BAR
#undef PG8_SCHED
}
}
using pg8::Unit;

struct EpiGateUp {
    bf16_t* act;
    __device__ __forceinline__ void operator()(const f32x4 (&acc)[2][2][4][2], const Unit& u, int wr, int wc, int fr, int fq) const {
#pragma unroll
        for (int ai = 0; ai < 2; ++ai)
#pragma unroll
            for (int m = 0; m < 4; ++m) {
                const int r = u.pm * 256 + ai * 128 + wr * 64 + m * 16 + fr;
                const int j = u.pn * 128 + wc * 32 + 8 * fq;
                const f32x4 g0 = acc[ai][0][m][0], g1 = acc[ai][0][m][1], u0 = acc[ai][1][m][0], u1 = acc[ai][1][m][1];
                u32x4 o; o.x = pk2(silu_f(g0[0]) * u0[0], silu_f(g0[1]) * u0[1]); o.y = pk2(silu_f(g0[2]) * u0[2], silu_f(g0[3]) * u0[3]);
                o.z = pk2(silu_f(g1[0]) * u1[0], silu_f(g1[1]) * u1[1]); o.w = pk2(silu_f(g1[2]) * u1[2], silu_f(g1[3]) * u1[3]);
                *(u32x4*)(act + (size_t)r * FF + j) = o;
            }
    }
};
struct EpiResid {
    const float* rp; const float* rs; float* y; float scale;
    __device__ __forceinline__ void operator()(const f32x4 (&acc)[2][2][4][2], const Unit& u, int wr, int wc, int fr, int fq) const {
#pragma unroll
        for (int ai = 0; ai < 2; ++ai)
#pragma unroll
            for (int m = 0; m < 4; ++m) {
                const int r = u.pm * 256 + ai * 128 + wr * 64 + m * 16 + fr;
                const float* rrow = (r < MP) ? rp + (size_t)r * D : rs + (size_t)(r - MP) * D;
                float* yrow = y + (size_t)r * D;
#pragma unroll
                for (int bj = 0; bj < 2; ++bj)
#pragma unroll
                    for (int n = 0; n < 2; ++n) {
                        const int c = u.pn * 256 + bj * 128 + wc * 32 + n * 16 + 4 * fq;
                        const f32x4 rv = *(const f32x4*)(rrow + c);
                        *(f32x4*)(yrow + c) = rv + acc[ai][bj][m][n] * scale;
                    }
            }
    }
};
struct EpiAtomic {
    float* y; float scale;
    __device__ __forceinline__ void operator()(const f32x4 (&acc)[2][2][4][2], const Unit& u, int wr, int wc, int fr, int fq) const {
#pragma unroll
        for (int ai = 0; ai < 2; ++ai)
#pragma unroll
            for (int m = 0; m < 4; ++m) {
                float* yrow = y + (size_t)(u.pm * 256 + ai * 128 + wr * 64 + m * 16 + fr) * D;
#pragma unroll
                for (int bj = 0; bj < 2; ++bj)
#pragma unroll
                    for (int n = 0; n < 2; ++n) {
                        const int c = u.pn * 256 + bj * 128 + wc * 32 + n * 16 + 4 * fq;
#pragma unroll
                        for (int e = 0; e < 4; ++e) unsafeAtomicAdd(yrow + c + e, acc[ai][bj][m][n][e] * scale);
                    }
            }
    }
};
struct EpiProj {
    bf16_t* proj; float* dtraw;
    __device__ __forceinline__ void operator()(const f32x4 (&acc)[2][2][4][2], const Unit& u, int wr, int wc, int fr, int fq) const {
#pragma unroll
        for (int ai = 0; ai < 2; ++ai)
#pragma unroll
            for (int m = 0; m < 4; ++m) {
                const int r = u.pm * 256 + ai * 128 + wr * 64 + m * 16 + fr;
#pragma unroll
                for (int bj = 0; bj < 2; ++bj) {
                    const int c = u.pn * 256 + bj * 128 + wc * 32 + 8 * fq;
                    const f32x4 v0 = acc[ai][bj][m][0], v1 = acc[ai][bj][m][1];
                    if (u.pn == 18) { if (c - 4608 < 24) { *(f32x4*)(dtraw + (size_t)r * 24 + (c - 4608)) = v0; *(f32x4*)(dtraw + (size_t)r * 24 + (c - 4608) + 4) = v1; } }
                    else { u32x4 o; o.x = pk2(v0[0], v0[1]); o.y = pk2(v0[2], v0[3]); o.z = pk2(v1[0], v1[1]); o.w = pk2(v1[2], v1[3]); *(u32x4*)(proj + (size_t)r * NINP + c) = o; }
                }
            }
    }
};
struct EpiGlu {
    const bf16_t* v; const float* bias; bf16_t* mix;
    __device__ __forceinline__ void operator()(const f32x4 (&acc)[2][2][4][2], const Unit& u, int wr, int wc, int fr, int fq) const {
#pragma unroll
        for (int ai = 0; ai < 2; ++ai)
#pragma unroll
            for (int m = 0; m < 4; ++m) {
                const int r = u.pm * 256 + ai * 128 + wr * 64 + m * 16 + fr;
#pragma unroll
                for (int bj = 0; bj < 2; ++bj)
#pragma unroll
                    for (int n = 0; n < 2; ++n) {
                        const int c = u.pn * 256 + bj * 128 + wc * 32 + n * 16 + 4 * fq;
                        const f32x4 a = acc[ai][bj][m][n]; const f32x4 bb = *(const f32x4*)(bias + c);
                        const u32x2 vv = *(const u32x2*)(v + (size_t)r * 512 + c);
                        u32x2 o; o.x = pk2(bflo(vv.x) * sigmoid_f(a[0] + bb[0]), bfhi(vv.x) * sigmoid_f(a[1] + bb[1]));
                        o.y = pk2(bflo(vv.y) * sigmoid_f(a[2] + bb[2]), bfhi(vv.y) * sigmoid_f(a[3] + bb[3]));
                        *(u32x2*)(mix + (size_t)r * DMIX + c) = o;
                    }
            }
    }
};

__device__ __forceinline__ void transpose_item(const float* W, int K, int N, bf16_t* WT, int mode, LAS float* scr, int item, int lane) {
    const int nblk = (N + 63) / 64, kb = item / nblk, nb = item % nblk, k0 = 64 * kb, n0 = 64 * nb;
    const int c4 = lane & 15, rr = lane >> 4, nn = n0 + 4 * c4;
    f32x4 v[16];
#pragma unroll
    for (int i = 0; i < 16; ++i) v[i] = (nn < N) ? *(const f32x4*)(W + (size_t)(k0 + 4 * i + rr) * N + nn) : (f32x4){0.f, 0.f, 0.f, 0.f};
#pragma unroll
    for (int i = 0; i < 16; ++i) { LAS float* d = scr + (4 * i + rr) * 65 + 4 * c4; d[0] = v[i][0]; d[1] = v[i][1]; d[2] = v[i][2]; d[3] = v[i][3]; }
    LDS_WAIT();
    const int c = lane & 7, nrow = lane >> 3;
#pragma unroll
    for (int j = 0; j < 8; ++j) { const int n = nrow + 8 * j; const LAS float* s = scr + (8 * c) * 65 + n;
        u32x4 o; o.x = pk2(s[0 * 65], s[1 * 65]); o.y = pk2(s[2 * 65], s[3 * 65]); o.z = pk2(s[4 * 65], s[5 * 65]); o.w = pk2(s[6 * 65], s[7 * 65]);
        const int jn = n0 + n;
        const int ip = 16 * ((jn >> 2) & 1) + 4 * ((jn >> 3) & 3) + (jn & 3);
        const int row = (mode == 0) ? jn : (mode == 3) ? ((jn & ~31) + ip) : ((jn >> 7) * 256 + ((jn & 127) & ~31) + ip + (mode == 5 ? 128 : 0));
        *(u32x4*)(WT + (size_t)row * K + k0 + 8 * c) = o; }
    LDS_WAIT();
}
constexpr int I_GU = (D / 64) * (FF / 64), I_DN = (FF / 64) * (D / 64), I_IN = (D / 64) * ((NIN + 63) / 64), I_GL = (512 / 64) * (512 / 64), I_OUT = (DMIX / 64) * (D / 64);
constexpr int CV_W1T = 0, CV_W1D = 2 * I_GU, CV_WIN = CV_W1D + I_DN, CV_WGLU = CV_WIN + I_IN, CV_WOUT = CV_WGLU + I_GL, CV_W2T = CV_WOUT + I_OUT, CV_W2D = CV_W2T + 2 * I_GU, CV_END = CV_W2D + I_DN;
__device__ __forceinline__ void convert_items(const Params& p, LAS unsigned char* lds, int lo, int hi, int gw, int ngw, int wave, int lane_in) {
    int lane = lane_in; asm volatile("" : "+v"(lane));
    LAS float* scr = (LAS float*)(lds + wave * 16640);
    for (int it = lo + gw; it < hi; it += ngw) {
        int r = it;
        if (r < CV_W1D) { if (r < I_GU) transpose_item(p.in[7], D, FF, (bf16_t*)(p.ws + WS_W1T), 4, scr, r, lane); else transpose_item(p.in[8], D, FF, (bf16_t*)(p.ws + WS_W1T), 5, scr, r - I_GU, lane); continue; }
        if (r < CV_WIN) { transpose_item(p.in[9], FF, D, (bf16_t*)(p.ws + WS_W1D), 0, scr, r - CV_W1D, lane); continue; }
        if (r < CV_WGLU) { transpose_item(p.in[11], D, NIN, (bf16_t*)(p.ws + WS_WIN), 3, scr, r - CV_WIN, lane); continue; }
        if (r < CV_WOUT) { transpose_item(p.in[20], 512, 512, (bf16_t*)(p.ws + WS_WGLU), 0, scr, r - CV_WGLU, lane); continue; }
        if (r < CV_W2T) { transpose_item(p.in[28], DMIX, D, (bf16_t*)(p.ws + WS_WOUT), 0, scr, r - CV_WOUT, lane); continue; }
        if (r < CV_W2D) { r -= CV_W2T; if (r < I_GU) transpose_item(p.in[30], D, FF, (bf16_t*)(p.ws + WS_W2T), 4, scr, r, lane); else transpose_item(p.in[31], D, FF, (bf16_t*)(p.ws + WS_W2T), 5, scr, r - I_GU, lane); continue; }
        transpose_item(p.in[32], FF, D, (bf16_t*)(p.ws + WS_W2D), 0, scr, r - CV_W2D, lane);
    }
}

__device__ __forceinline__ void rms_phase(const float* srcp, const float* srcs, const float* w, bf16_t* dst, int gw, int ngw, int lane_in) {
    int lane = lane_in; asm volatile("" : "+v"(lane));
    for (int m = gw * 4; m < M; m += ngw * 4) {
        const float* xrow = (m < MP) ? srcp + (size_t)m * D : srcs + (size_t)(m - MP) * D;
        f32x4 v[4][4];
#pragma unroll
        for (int r = 0; r < 4; ++r)
#pragma unroll
            for (int j = 0; j < 4; ++j) v[r][j] = ((const f32x4*)(xrow + (size_t)r * D))[lane + 64 * j];
        f32x4 ww[4];
#pragma unroll
        for (int j = 0; j < 4; ++j) ww[j] = ((const f32x4*)w)[lane + 64 * j];
#pragma unroll
        for (int r = 0; r < 4; ++r) {
            float ss = 0.f;
#pragma unroll
            for (int j = 0; j < 4; ++j) ss += (v[r][j].x * v[r][j].x + v[r][j].y * v[r][j].y) + (v[r][j].z * v[r][j].z + v[r][j].w * v[r][j].w);
            const float rstd = rsqrtf(wave_sum(ss) * (1.f / D) + EPS);
            u32x2* o8 = (u32x2*)(dst + (size_t)(m + r) * D) + lane;
#pragma unroll
            for (int j = 0; j < 4; ++j) { u32x2 o; o.x = pk2(v[r][j].x * rstd * ww[j].x, v[r][j].y * rstd * ww[j].y); o.y = pk2(v[r][j].z * rstd * ww[j].z, v[r][j].w * rstd * ww[j].w); o8[64 * j] = o; }
        }
    }
}

__device__ __forceinline__ void unpack8(const u32x4 u, float (&f)[8]) { f[0] = bflo(u.x); f[1] = bfhi(u.x); f[2] = bflo(u.y); f[3] = bfhi(u.y); f[4] = bflo(u.z); f[5] = bfhi(u.z); f[6] = bflo(u.w); f[7] = bfhi(u.w); }
#define BF_ELEM(v, e) ((((e) & 1) ? ((v)[(e) >> 1] >> 16) : ((v)[(e) >> 1] & 0xffffu)))
__device__ __forceinline__ void conv_phase(const Params& p, int gtid, int nthreads) {
    const bf16_t* proj = (const bf16_t*)(p.ws + WS_A);
    bf16_t* BCN = (bf16_t*)(p.ws + WS_XC + XC_BCN); bf16_t* XSN = (bf16_t*)(p.ws + WS_XC + XC_XSN); bf16_t* XT = (bf16_t*)(p.ws + WS_XC + XC_XT); bf16_t* BT = (bf16_t*)(p.ws + WS_H + H_BT);
    const float* cw = p.in[22]; const float* cb = p.in[23]; const float* sconv = p.in[5];
    const int NT_P = (MP / 16) * 320, NT_S = NSB * 320;
    for (int task = gtid; task < NT_P; task += nthreads) {
        const int cgp = task % 320, rb = task / 320, c0 = cgp * 8, m0 = rb * 16;
        const bool first = (m0 % SEQ) == 0, lastblk = (m0 % SEQ) == SEQ - 16;
        u32x4 raw[19];
#pragma unroll
        for (int i = 0; i < 19; ++i) raw[i] = (i >= 3 || !first) ? *(const u32x4*)(proj + (size_t)(m0 - 3 + i) * NINP + 2048 + c0) : (u32x4){0u, 0u, 0u, 0u};
        float w0[8], w1[8], w2[8], w3[8], bs[8];
#pragma unroll
        for (int e = 0; e < 8; e += 4) { *(f32x4*)&w0[e] = *(const f32x4*)(cw + c0 + e); *(f32x4*)&w1[e] = *(const f32x4*)(cw + XBC + c0 + e); *(f32x4*)&w2[e] = *(const f32x4*)(cw + 2 * XBC + c0 + e);
            *(f32x4*)&w3[e] = *(const f32x4*)(cw + 3 * XBC + c0 + e); *(f32x4*)&bs[e] = *(const f32x4*)(cb + c0 + e); }
        float r0[8], r1[8], r2[8];
        unpack8(raw[0], r0); unpack8(raw[1], r1); unpack8(raw[2], r2);
        u32x4 ov[16];
#pragma unroll
        for (int i = 0; i < 16; ++i) {
            float cur[8]; unpack8(raw[i + 3], cur);
            float o[8];
#pragma unroll
            for (int e = 0; e < 8; ++e) { const float cv = bs[e] + w0[e] * r0[e] + w1[e] * r1[e] + w2[e] * r2[e] + w3[e] * cur[e]; o[e] = silu_f(cv); r0[e] = r1[e]; r1[e] = r2[e]; r2[e] = cur[e]; }
            ov[i].x = pk2(o[0], o[1]); ov[i].y = pk2(o[2], o[3]); ov[i].z = pk2(o[4], o[5]); ov[i].w = pk2(o[6], o[7]);
            if (i >= 13 && lastblk) { float* d = p.out + O_CONVP + ((size_t)(m0 / SEQ) * 3 + (i - 13)) * XBC + c0; *(f32x4*)d = (f32x4){cur[0], cur[1], cur[2], cur[3]}; *(f32x4*)(d + 4) = (f32x4){cur[4], cur[5], cur[6], cur[7]}; }
        }
        const int bb = m0 / SEQ, t0 = m0 % SEQ, cc = t0 >> 7, l0 = t0 & 127;
        if (c0 >= 1536) {
            const int cn = c0 - 1536;
#pragma unroll
            for (int i = 0; i < 16; ++i) *(u32x4*)(BCN + (size_t)(m0 + i) * 1024 + cn) = ov[i];
        }
        if (c0 < 2048) {
            bf16_t* tb = (c0 < 1536) ? XT + ((((size_t)(bb * 16 + cc) * NH + (c0 >> 6)) * 64 + (c0 & 63)) * 128 + l0)
                                     : BT + ((((size_t)(bb * 16 + cc) * 4 + ((c0 - 1536) >> 7)) * 128 + ((c0 - 1536) & 127)) * 128 + l0);
            const bool odd = (gtid & 1) != 0;
            bf16_t* t1 = odd ? tb - 8 * 128 + 8 : tb;
            bf16_t* t2 = odd ? tb + 8 : tb + 8 * 128;
#pragma unroll
            for (int e = 0; e < 8; ++e) {
                u32x4 q0, q1;
                q0.x = BF_ELEM(ov[0], e) | (BF_ELEM(ov[1], e) << 16); q0.y = BF_ELEM(ov[2], e) | (BF_ELEM(ov[3], e) << 16); q0.z = BF_ELEM(ov[4], e) | (BF_ELEM(ov[5], e) << 16); q0.w = BF_ELEM(ov[6], e) | (BF_ELEM(ov[7], e) << 16);
                q1.x = BF_ELEM(ov[8], e) | (BF_ELEM(ov[9], e) << 16); q1.y = BF_ELEM(ov[10], e) | (BF_ELEM(ov[11], e) << 16); q1.z = BF_ELEM(ov[12], e) | (BF_ELEM(ov[13], e) << 16); q1.w = BF_ELEM(ov[14], e) | (BF_ELEM(ov[15], e) << 16);
                const u32x4 snd = odd ? q0 : q1; u32x4 rcv;
                rcv.x = __shfl_xor(snd.x, 1); rcv.y = __shfl_xor(snd.y, 1); rcv.z = __shfl_xor(snd.z, 1); rcv.w = __shfl_xor(snd.w, 1);
                *(u32x4*)(t1 + (size_t)e * 128) = odd ? rcv : q0;
                *(u32x4*)(t2 + (size_t)e * 128) = odd ? q1 : rcv;
            }
        }
    }
    for (int task = gtid; task < NT_S; task += nthreads) {
        const int cgp = task % 320, b = task / 320, c0 = cgp * 8, m0 = MP + b * 4;
        u32x4 raw[4];
#pragma unroll
        for (int i = 0; i < 4; ++i) raw[i] = *(const u32x4*)(proj + (size_t)(m0 + i) * NINP + 2048 + c0);
        float w0[8], w1[8], w2[8], w3[8], bs[8], r0[8], r1[8], r2[8];
        const float* st = sconv + (size_t)b * 3 * XBC + c0;
#pragma unroll
        for (int e = 0; e < 8; e += 4) { *(f32x4*)&w0[e] = *(const f32x4*)(cw + c0 + e); *(f32x4*)&w1[e] = *(const f32x4*)(cw + XBC + c0 + e); *(f32x4*)&w2[e] = *(const f32x4*)(cw + 2 * XBC + c0 + e);
            *(f32x4*)&w3[e] = *(const f32x4*)(cw + 3 * XBC + c0 + e); *(f32x4*)&bs[e] = *(const f32x4*)(cb + c0 + e);
            *(f32x4*)&r0[e] = *(const f32x4*)(st + e); *(f32x4*)&r1[e] = *(const f32x4*)(st + XBC + e); *(f32x4*)&r2[e] = *(const f32x4*)(st + 2 * XBC + e); }
#pragma unroll
        for (int i = 0; i < 4; ++i) {
            float cur[8]; unpack8(raw[i], cur);
            float o[8];
#pragma unroll
            for (int e = 0; e < 8; ++e) { const float cv = bs[e] + w0[e] * r0[e] + w1[e] * r1[e] + w2[e] * r2[e] + w3[e] * cur[e]; o[e] = silu_f(cv); r0[e] = r1[e]; r1[e] = r2[e]; r2[e] = cur[e]; }
            u32x4 ov; ov.x = pk2(o[0], o[1]); ov.y = pk2(o[2], o[3]); ov.z = pk2(o[4], o[5]); ov.w = pk2(o[6], o[7]);
            if (c0 < 1536) *(u32x4*)(XSN + (size_t)(m0 + i - MP) * SSDW + c0) = ov;
            else *(u32x4*)(BCN + (size_t)(m0 + i) * 1024 + (c0 - 1536)) = ov;
            if (i >= 1) { float* d = p.out + O_CONVS + ((size_t)b * 3 + (i - 1)) * XBC + c0; *(f32x4*)d = (f32x4){cur[0], cur[1], cur[2], cur[3]}; *(f32x4*)(d + 4) = (f32x4){cur[4], cur[5], cur[6], cur[7]}; }
        }
    }
}

constexpr int LROW = 272;
constexpr int L_C = 0, L_B = 34816, L_BT = 69632, L_XT = 104448, L_XS = 121856, L_HT = 139264, L_AC = 156672, L_DT = 157184, L_G = 157696;
__device__ __forceinline__ float wave_incl_scan(float v, int lane) {
#pragma unroll
    for (int o = 1; o < 64; o <<= 1) { const float t = __shfl_up(v, o); if (lane >= o) v += t; }
    return v;
}
__device__ __forceinline__ void ssd_prompt_item(const Params& p, LAS unsigned char* lds, int b, int h) {
    int tid = threadIdx.x; asm volatile("" : "+v"(tid));
    const int lane = tid & 63, w = __builtin_amdgcn_readfirstlane(tid >> 6), fr = lane & 15, fq = lane >> 4;
    const int g = h / 6;
    const bf16_t* BCN = (const bf16_t*)(p.ws + WS_XC + XC_BCN); const bf16_t* XT = (const bf16_t*)(p.ws + WS_XC + XC_XT); const bf16_t* BT = (const bf16_t*)(p.ws + WS_H + H_BT);
    const float* dtraw = (const float*)(p.ws + WS_DTRAW); bf16_t* ys = (bf16_t*)(p.ws + WS_YS);
    const float a_h = -__expf(p.in[25][h]), dtb = p.in[24][h], Dh = p.in[26][h];
    f32x4 hacc[4];
#pragma unroll
    for (int i = 0; i < 4; ++i) hacc[i] = (f32x4){0.f, 0.f, 0.f, 0.f};
    for (int i = tid; i < 64 * 17; i += 512) *(LAS u32x4*)(lds + L_HT + i * 16) = (u32x4){0u, 0u, 0u, 0u};
    const int prow = tid >> 4, pc = tid & 15;
    u32x4 pvc[4], pvb[4], pvt[4], pvx[2]; float pdl, pdh;
#define SSD_FETCH(cc) do { const int _m0 = b * SEQ + (cc) * 128; \
        pdl = dtraw[(size_t)(_m0 + lane) * 24 + h]; pdh = dtraw[(size_t)(_m0 + 64 + lane) * 24 + h]; \
        const bf16_t* _bt = BT + (((size_t)(b * 16 + (cc)) * 4 + g) * 128) * 128; const bf16_t* _xt = XT + (((size_t)(b * 16 + (cc)) * NH + h) * 64) * 128; \
        _Pragma("unroll") for (int j = 0; j < 4; ++j) { const bf16_t* _gr = BCN + (size_t)(_m0 + prow + 32 * j) * 1024 + g * 128 + pc * 8; pvb[j] = *(const u32x4*)_gr; pvc[j] = *(const u32x4*)(_gr + 512); \
            pvt[j] = *(const u32x4*)(_bt + (size_t)(prow + 32 * j) * 128 + pc * 8); } \
        _Pragma("unroll") for (int j = 0; j < 2; ++j) pvx[j] = *(const u32x4*)(_xt + (size_t)(prow + 32 * j) * 128 + pc * 8); } while (0)
    SSD_FETCH(0);
    for (int c = 0; c < 16; ++c) {
        const int m0 = b * SEQ + c * 128;
        const float dt_lo = softplus_f(pdl + dtb), dt_hi = softplus_f(pdh + dtb);
        const float ac_lo = wave_incl_scan(dt_lo * a_h, lane); const float tot_lo = __shfl(ac_lo, 63);
        const float ac_hi = wave_incl_scan(dt_hi * a_h, lane) + tot_lo; const float alast = __shfl(ac_hi, 63);
        const float sc_lo = dt_lo * __expf(alast - ac_lo), sc_hi = dt_hi * __expf(alast - ac_hi);
        if (w == 0) { const float ae_lo = __shfl(ac_lo, (lane & 48) + 15), ae_hi = __shfl(ac_hi, (lane & 48) + 15);
            *(LAS float*)(lds + L_G + lane * 4) = dt_lo * __expf(ae_lo - ac_lo); *(LAS float*)(lds + L_G + 256 + lane * 4) = dt_hi * __expf(ae_hi - ac_hi);
            *(LAS float*)(lds + L_AC + lane * 4) = ac_lo; *(LAS float*)(lds + L_AC + 256 + lane * 4) = ac_hi; *(LAS float*)(lds + L_DT + lane * 4) = dt_lo; *(LAS float*)(lds + L_DT + 256 + lane * 4) = dt_hi; }
        float sc[8];
#pragma unroll
        for (int e = 0; e < 8; ++e) { const int src = (pc * 8 + e) & 63; const float vlo = __shfl(sc_lo, src), vhi = __shfl(sc_hi, src); sc[e] = (pc < 8) ? vlo : vhi; }
#pragma unroll
        for (int j = 0; j < 4; ++j) {
            const int r = prow + 32 * j;
            *(LAS u32x4*)(lds + L_C + r * LROW + pc * 16) = pvc[j];
            *(LAS u32x4*)(lds + L_B + r * LROW + pc * 16) = pvb[j];
            *(LAS u32x4*)(lds + L_BT + r * LROW + pc * 16) = pvt[j];
        }
#pragma unroll
        for (int j = 0; j < 2; ++j) {
            const int r = prow + 32 * j;
            float xf[8]; unpack8(pvx[j], xf);
            *(LAS u32x4*)(lds + L_XT + r * LROW + pc * 16) = pvx[j];
            u32x4 q; q.x = pk2(xf[0] * sc[0], xf[1] * sc[1]); q.y = pk2(xf[2] * sc[2], xf[3] * sc[3]); q.z = pk2(xf[4] * sc[4], xf[5] * sc[5]); q.w = pk2(xf[6] * sc[6], xf[7] * sc[7]);
            *(LAS u32x4*)(lds + L_XS + r * LROW + pc * 16) = q;
        }
        LDS_BARRIER();
        if (c < 15) SSD_FETCH(c + 1);
        const int l = 16 * w + fr;
        bf16x8 cfrag[4];
#pragma unroll
        for (int ks = 0; ks < 4; ++ks) cfrag[ks] = *(const LAS bf16x8*)(lds + L_C + l * LROW + (ks * 32 + fq * 8) * 2);
        f32x4 yacc[4];
#pragma unroll
        for (int pb = 0; pb < 4; ++pb) {
            f32x4 a = (f32x4){0.f, 0.f, 0.f, 0.f};
#pragma unroll
            for (int ks = 0; ks < 4; ++ks) { const bf16x8 hf = *(const LAS bf16x8*)(lds + L_HT + (pb * 16 + fr) * LROW + (ks * 32 + fq * 8) * 2); a = __builtin_amdgcn_mfma_f32_16x16x32_bf16(hf, cfrag[ks], a, 0, 0, 0); }
            yacc[pb] = a;
        }
        const float al = *(const LAS float*)(lds + L_AC + l * 4);
        { const float el = __expf(al);
#pragma unroll
          for (int pb = 0; pb < 4; ++pb) yacc[pb] = yacc[pb] * el; }
        f32x4 cbt[8];
#pragma unroll
        for (int sb = 0; sb < 8; ++sb) {
            cbt[sb] = (f32x4){0.f, 0.f, 0.f, 0.f};
            if (sb <= w) {
                f32x4 a = (f32x4){0.f, 0.f, 0.f, 0.f};
#pragma unroll
                for (int ks = 0; ks < 4; ++ks) { const bf16x8 bf = *(const LAS bf16x8*)(lds + L_B + (sb * 16 + fr) * LROW + (ks * 32 + fq * 8) * 2); a = __builtin_amdgcn_mfma_f32_16x16x32_bf16(bf, cfrag[ks], a, 0, 0, 0); }
                cbt[sb] = a;
            }
        }
        LDS_BARRIER();
        const int nks = (w >> 1) + 1;
#pragma unroll
        for (int sb = 0; sb < 8; ++sb) {
            if (sb < 2 * nks) {
                const int s0 = sb * 16 + 4 * fq;
                float mv[4];
                if (sb < w) {
                    const float f = __expf(al - *(const LAS float*)(lds + L_AC + (sb * 16 + 15) * 4));
                    const f32x4 gs = *(const LAS f32x4*)(lds + L_G + s0 * 4);
#pragma unroll
                    for (int e = 0; e < 4; ++e) mv[e] = cbt[sb][e] * f * gs[e];
                } else if (sb == w) {
                    const f32x4 as = *(const LAS f32x4*)(lds + L_AC + s0 * 4), ds = *(const LAS f32x4*)(lds + L_DT + s0 * 4);
#pragma unroll
                    for (int e = 0; e < 4; ++e) { const float v = cbt[sb][e] * __expf(al - as[e]) * ds[e]; mv[e] = ((s0 + e) <= l) ? v : 0.f; if (s0 + e == l) mv[e] += Dh; }
                } else {
#pragma unroll
                    for (int e = 0; e < 4; ++e) mv[e] = 0.f;
                }
                u32x2 o; o.x = pk2(mv[0], mv[1]); o.y = pk2(mv[2], mv[3]);
                *(LAS u32x2*)(lds + L_B + l * LROW + s0 * 2) = o;
            }
        }
        LDS_WAIT();
#pragma unroll
        for (int ks = 0; ks < 4; ++ks) {
            if (ks < nks) {
                const bf16x8 mf = *(const LAS bf16x8*)(lds + L_B + l * LROW + (ks * 32 + fq * 8) * 2);
#pragma unroll
                for (int pb = 0; pb < 4; ++pb) { const bf16x8 xf = *(const LAS bf16x8*)(lds + L_XT + (pb * 16 + fr) * LROW + (ks * 32 + fq * 8) * 2); yacc[pb] = __builtin_amdgcn_mfma_f32_16x16x32_bf16(xf, mf, yacc[pb], 0, 0, 0); }
            }
        }
#pragma unroll
        for (int pb = 0; pb < 4; ++pb) {
            const int pcol = h * 64 + pb * 16 + 4 * fq;
            u32x2 o; o.x = pk2(yacc[pb][0], yacc[pb][1]); o.y = pk2(yacc[pb][2], yacc[pb][3]);
            *(u32x2*)(ys + (size_t)(m0 + l) * SSDW + pcol) = o;
        }
        { const float ea = __expf(alast);
#pragma unroll
          for (int pb = 0; pb < 4; ++pb) hacc[pb] = hacc[pb] * ea; }
#pragma unroll
        for (int ks = 0; ks < 4; ++ks) {
            const bf16x8 btf = *(const LAS bf16x8*)(lds + L_BT + (16 * w + fr) * LROW + (ks * 32 + fq * 8) * 2);
#pragma unroll
            for (int pb = 0; pb < 4; ++pb) { const bf16x8 xsf = *(const LAS bf16x8*)(lds + L_XS + (pb * 16 + fr) * LROW + (ks * 32 + fq * 8) * 2); hacc[pb] = __builtin_amdgcn_mfma_f32_16x16x32_bf16(btf, xsf, hacc[pb], 0, 0, 0); }
        }
#pragma unroll
        for (int pb = 0; pb < 4; ++pb) { u32x2 o; o.x = pk2(hacc[pb][0], hacc[pb][1]); o.y = pk2(hacc[pb][2], hacc[pb][3]); *(LAS u32x2*)(lds + L_HT + (pb * 16 + fr) * LROW + (16 * w + 4 * fq) * 2) = o; }
        LDS_BARRIER();
    }
    float* so = p.out + O_SSDP + ((size_t)(b * NH + h) * 64) * 128;
#pragma unroll
    for (int pb = 0; pb < 4; ++pb) *(f32x4*)(so + (size_t)(pb * 16 + fr) * 128 + 16 * w + 4 * fq) = hacc[pb];
}

template <int MODE>
__device__ __forceinline__ void s5_wave_item(const Params& p, LAS unsigned char* wl, int g, int bidx, int seg, int m_start, int nrows, int lane_in) {
    int lane = lane_in; asm volatile("" : "+v"(lane));
    const int fr = lane & 15, fq = lane >> 4;
    const bf16_t* proj = (const bf16_t*)(p.ws + WS_A); bf16_t* vbuf = (bf16_t*)(p.ws + WS_H);
    const bf16_t* BBAR = (const bf16_t*)(p.ws + WS_BBAR); const bf16_t* CMAT = (const bf16_t*)(p.ws + WS_CMAT); const float* AB = (const float*)(p.ws + WS_S5A);
    float* S5E = (float*)(p.ws + WS_S5END);
    const bf16x8 zf = (bf16x8){0, 0, 0, 0, 0, 0, 0, 0};
    bf16x8 bfrag[8], cfrag[4];
#pragma unroll
    for (int t = 0; t < 8; ++t) bfrag[t] = (fq < 2) ? *(const bf16x8*)(BBAR + ((size_t)(g * 128 + t * 16 + fr)) * 16 + fq * 8) : zf;
    if (MODE != 1) {
#pragma unroll
        for (int ks = 0; ks < 4; ++ks) cfrag[ks] = *(const bf16x8*)(CMAT + ((size_t)(g * 16 + fr)) * 128 + ks * 32 + fq * 8);
    }
    const float ar = AB[g * 64 + lane], ai = AB[2048 + g * 64 + lane];
    const f32x4 d4 = *(const f32x4*)(p.in[19] + g * 16 + 4 * fq);
    LAS float* sBu = (LAS float*)wl; LAS bf16_t* sS = (LAS bf16_t*)(wl + 8448);
    float sr = 0.f, si = 0.f;
    if (MODE == 2 && seg > 0) {
        float pr = ar, pi = ai;
#pragma unroll
        for (int q = 0; q < 8; ++q) { const float nr = pr * pr - pi * pi, ni = 2.f * pr * pi; pr = nr; pi = ni; }
        for (int j = 0; j < seg; ++j) {
            const float* e = S5E + ((size_t)((bidx * 32 + g) * 8 + j)) * 128;
            const float er = e[lane], ei = e[64 + lane];
            const float nr = pr * sr - pi * si + er, ni = pr * si + pi * sr + ei; sr = nr; si = ni;
        }
    }
    bf16x8 uf_n; u32x2 u4_n;
    { const bf16_t* urow = proj + (size_t)(m_start + fr) * NINP + g * 16; uf_n = (fq < 2) ? *(const bf16x8*)(urow + fq * 8) : zf; u4_n = *(const u32x2*)(urow + 4 * fq); }
    for (int m0 = m_start; m0 < m_start + nrows; m0 += 16) {
        const bf16x8 uf = uf_n; const u32x2 u4 = u4_n;
        { const int mn = (m0 + 16 < m_start + nrows) ? m0 + 16 : m0; const bf16_t* urow = proj + (size_t)(mn + fr) * NINP + g * 16; uf_n = (fq < 2) ? *(const bf16x8*)(urow + fq * 8) : zf; u4_n = *(const u32x2*)(urow + 4 * fq); }
#pragma unroll
        for (int t = 0; t < 8; ++t) {
            f32x4 a = (f32x4){0.f, 0.f, 0.f, 0.f};
            a = __builtin_amdgcn_mfma_f32_16x16x32_bf16(bfrag[t], uf, a, 0, 0, 0);
            *(LAS f32x4*)(sBu + fr * 132 + t * 16 + 4 * fq) = a;
        }
        LDS_WAIT();
        {
            float br[16], bi[16]; unsigned pkv[16];
#pragma unroll
            for (int t = 0; t < 16; ++t) { br[t] = sBu[t * 132 + lane]; bi[t] = sBu[t * 132 + 64 + lane]; }
            float s0r[4], s0i[4];
            if (MODE == 0) {
#pragma unroll
                for (int q = 0; q < 4; ++q) { const int bb = ((m0 - MP) >> 2) + q; s0r[q] = p.in[2][((size_t)bb * 32 + g) * 64 + lane]; s0i[q] = p.in[3][((size_t)bb * 32 + g) * 64 + lane]; }
            }
#pragma unroll
            for (int t = 0; t < 16; ++t) {
                if (MODE == 0 && (t & 3) == 0) { sr = s0r[t >> 2]; si = s0i[t >> 2]; }
                const float nr = ar * sr - ai * si + br[t], ni = ar * si + ai * sr + bi[t];
                sr = nr; si = ni;
                if (MODE != 1) pkv[t] = pk2(sr, si);
                if (MODE == 0 && (t & 3) == 3) { const int bb = (m0 - MP + t) >> 2; p.out[O_S5RS + ((size_t)bb * 32 + g) * 64 + lane] = sr; p.out[O_S5IS + ((size_t)bb * 32 + g) * 64 + lane] = si; }
            }
            if (MODE != 1) {
#pragma unroll
                for (int t = 0; t < 16; ++t) { sS[t * 136 + lane] = (bf16_t)(pkv[t] & 0xffff); sS[t * 136 + 64 + lane] = (bf16_t)(pkv[t] >> 16); }
            }
        }
        LDS_WAIT();
        if (MODE != 1) {
            f32x4 y = (f32x4){0.f, 0.f, 0.f, 0.f};
#pragma unroll
            for (int ks = 0; ks < 4; ++ks) { const bf16x8 sf = *(const LAS bf16x8*)(sS + fr * 136 + ks * 32 + fq * 8); y = __builtin_amdgcn_mfma_f32_16x16x32_bf16(cfrag[ks], sf, y, 0, 0, 0); }
            const float y0 = y[0] + d4[0] * bflo(u4.x), y1 = y[1] + d4[1] * bfhi(u4.x), y2 = y[2] + d4[2] * bflo(u4.y), y3 = y[3] + d4[3] * bfhi(u4.y);
            u32x2 o; o.x = pk2(gelu_tanh(y0), gelu_tanh(y1)); o.y = pk2(gelu_tanh(y2), gelu_tanh(y3));
            *(u32x2*)(vbuf + (size_t)(m0 + fr) * 512 + g * 16 + 4 * fq) = o;
            LDS_WAIT();
        }
    }
    if (MODE == 1) { float* e = S5E + ((size_t)((bidx * 32 + g) * 8 + seg)) * 128; e[lane] = sr; e[64 + lane] = si; }
    if (MODE == 2 && seg == 7) { p.out[O_S5RP + ((size_t)bidx * 32 + g) * 64 + lane] = sr; p.out[O_S5IP + ((size_t)bidx * 32 + g) * 64 + lane] = si; }
}

#define SMP_LOAD(HS, BS, CS, DS, XS_, PS, pr_) do { const int _b = (pr_) / NH, _h = (pr_) % NH, _g = _h / 6; \
        PS[0] = p.in[25][_h]; PS[1] = p.in[24][_h]; PS[2] = p.in[26][_h]; \
        const float* _h0 = p.in[4] + ((size_t)(_b * NH + _h) * 64 + pp) * 128 + n0; \
        _Pragma("unroll") for (int j = 0; j < 4; ++j) HS[j] = *(const f32x4*)(_h0 + 4 * j); \
        _Pragma("unroll") for (int t = 0; t < 4; ++t) { const int _m = MP + _b * 4 + t; const bf16_t* _row = BCN + (size_t)_m * 1024 + _g * 128 + n0; \
            DS[t] = dtraw[(size_t)_m * 24 + _h]; XS_[t] = *(const unsigned*)(XSN + (size_t)(_m - MP) * SSDW + _h * 64 + (pp & ~1)); \
            BS[t][0] = *(const u32x4*)_row; BS[t][1] = *(const u32x4*)(_row + 8); CS[t][0] = *(const u32x4*)(_row + 512); CS[t][1] = *(const u32x4*)(_row + 520); } } while (0)
#define SMP_COMPUTE(HS, BS, CS, DS, XS_, PS, pr_) do { const int _b = (pr_) / NH, _h = (pr_) % NH; \
        const float a_h = -__expf(PS[0]), dtb = PS[1], Dh = PS[2]; \
        float hv[16]; \
        _Pragma("unroll") for (int j = 0; j < 4; ++j) { hv[4 * j] = HS[j][0]; hv[4 * j + 1] = HS[j][1]; hv[4 * j + 2] = HS[j][2]; hv[4 * j + 3] = HS[j][3]; } \
        _Pragma("unroll") for (int t = 0; t < 4; ++t) { const int _m = MP + _b * 4 + t; \
            const float dt = softplus_f(DS[t] + dtb), dec = __expf(dt * a_h); const float xv = (pp & 1) ? bfhi(XS_[t]) : bflo(XS_[t]), xd = xv * dt; \
            float acc = 0.f; \
            _Pragma("unroll") for (int hf = 0; hf < 2; ++hf) { float Bv[8], Cv[8]; unpack8(BS[t][hf], Bv); unpack8(CS[t][hf], Cv); \
                _Pragma("unroll") for (int j = 0; j < 8; ++j) { hv[8 * hf + j] = hv[8 * hf + j] * dec + xd * Bv[j]; acc += hv[8 * hf + j] * Cv[j]; } } \
            acc += __shfl_xor(acc, 1); acc += __shfl_xor(acc, 2); acc += __shfl_xor(acc, 4); \
            if ((tid & 7) == 0) ys[(size_t)_m * SSDW + _h * 64 + pp] = (bf16_t)(pk2(acc + Dh * xv, 0.f) & 0xffff); } \
        float* _ho = p.out + O_SSDS + ((size_t)(_b * NH + _h) * 64 + pp) * 128 + n0; \
        _Pragma("unroll") for (int j = 0; j < 16; j += 4) *(f32x4*)(_ho + j) = (f32x4){hv[j], hv[j + 1], hv[j + 2], hv[j + 3]}; } while (0)
constexpr int SMP_PAIRS = 6;
__device__ __forceinline__ void ssd_sample_item(const Params& p, int item) {
    int tid = threadIdx.x; asm volatile("" : "+v"(tid));
    const int pp = tid >> 3, n0 = (tid & 7) * 16;
    const bf16_t* BCN = (const bf16_t*)(p.ws + WS_XC + XC_BCN); const bf16_t* XSN = (const bf16_t*)(p.ws + WS_XC + XC_XSN); const float* dtraw = (const float*)(p.ws + WS_DTRAW); bf16_t* ys = (bf16_t*)(p.ws + WS_YS);
    f32x4 hA[4], hB[4]; u32x4 bA[4][2], cA[4][2], bB[4][2], cB[4][2]; float dA[4], dB[4], sA3[3], sB3[3]; unsigned xA[4], xB[4];
    const int pr0 = item * SMP_PAIRS;
    SMP_LOAD(hA, bA, cA, dA, xA, sA3, pr0);
#pragma unroll
    for (int k = 0; k < SMP_PAIRS; k += 2) {
        const int pr = pr0 + k;
        SMP_LOAD(hB, bB, cB, dB, xB, sB3, pr + 1);
        SMP_COMPUTE(hA, bA, cA, dA, xA, sA3, pr);
        if (k + 2 < SMP_PAIRS) SMP_LOAD(hA, bA, cA, dA, xA, sA3, pr + 2);
        SMP_COMPUTE(hB, bB, cB, dB, xB, sB3, pr + 1);
    }
}

__device__ __forceinline__ void gatenorm_phase(const Params& p, int gw, int ngw, int lane_in) {
    int lane = lane_in; asm volatile("" : "+v"(lane));
    const bf16_t* proj = (const bf16_t*)(p.ws + WS_A); const bf16_t* ys = (const bf16_t*)(p.ws + WS_YS); bf16_t* mix = (bf16_t*)(p.ws + WS_XC);
    const float* nw = p.in[27];
    for (int m = gw * 2; m < M; m += ngw * 2) {
        u32x4 yr[2][3], zr[2][3];
#pragma unroll
        for (int r = 0; r < 2; ++r)
#pragma unroll
            for (int j = 0; j < 3; ++j) { const int c0 = (lane + 64 * j) * 8; yr[r][j] = *(const u32x4*)(ys + (size_t)(m + r) * SSDW + c0); zr[r][j] = *(const u32x4*)(proj + (size_t)(m + r) * NINP + 512 + c0); }
#pragma unroll
        for (int r = 0; r < 2; ++r) {
            float gv[3][8]; float sg[4] = {0.f, 0.f, 0.f, 0.f};
#pragma unroll
            for (int j = 0; j < 3; ++j) {
                float yv[8], zv[8]; unpack8(yr[r][j], yv); unpack8(zr[r][j], zv);
                float ss = 0.f;
#pragma unroll
                for (int e = 0; e < 8; ++e) { gv[j][e] = yv[e] * silu_f(zv[e]); ss += gv[j][e] * gv[j][e]; }
                const int grp = (lane + 64 * j) / 48;
#pragma unroll
                for (int q = 0; q < 4; ++q) sg[q] += (grp == q) ? ss : 0.f;
            }
            float rs[4];
#pragma unroll
            for (int q = 0; q < 4; ++q) rs[q] = rsqrtf(wave_sum(sg[q]) * (1.f / 384.f) + EPS);
#pragma unroll
            for (int j = 0; j < 3; ++j) {
                const int c0 = (lane + 64 * j) * 8, grp = (lane + 64 * j) / 48;
                const float rstd = grp == 0 ? rs[0] : (grp == 1 ? rs[1] : (grp == 2 ? rs[2] : rs[3]));
                const f32x4 n0 = *(const f32x4*)(nw + c0), n1 = *(const f32x4*)(nw + c0 + 4);
                u32x4 o; o.x = pk2(gv[j][0] * rstd * n0[0], gv[j][1] * rstd * n0[1]); o.y = pk2(gv[j][2] * rstd * n0[2], gv[j][3] * rstd * n0[3]);
                o.z = pk2(gv[j][4] * rstd * n1[0], gv[j][5] * rstd * n1[1]); o.w = pk2(gv[j][6] * rstd * n1[2], gv[j][7] * rstd * n1[3]);
                *(u32x4*)(mix + (size_t)(m + r) * DMIX + 512 + c0) = o;
            }
        }
    }
}

#define XB_TMO      128
#define XB_XCNT(j)  (256  + 64 * (j))
#define XB_XSUB(j)  (1280 + 64 * (j))
#define XB_XGEN(j)  (2304 + 64 * (j))
#define XB_TOP      3328
#define XB_TOPGEN   3392
#define XCD_BAR_WORDS 3456
#define XB_SPIN_CAP (1u << 18)

__device__ __forceinline__ unsigned xb_ld(unsigned* p)              { return __hip_atomic_load(p, __ATOMIC_RELAXED, __HIP_MEMORY_SCOPE_AGENT); }
__device__ __forceinline__ unsigned xb_add(unsigned* p, unsigned v) { return __hip_atomic_fetch_add(p, v, __ATOMIC_RELAXED, __HIP_MEMORY_SCOPE_AGENT); }
__device__ __forceinline__ unsigned xb_xcc_id() { return (unsigned)__builtin_amdgcn_s_getreg((3 << 11) | 20) & 0xFu; }
#define XB_SPIN(cond, bar) do { unsigned _sp = 0; while (cond) { __builtin_amdgcn_s_sleep(1); \
    if ((++_sp & 255u) == 0u) { if (xb_ld(&(bar)[XB_TMO])) break; if (_sp > XB_SPIN_CAP) { atomicAdd(&(bar)[XB_TMO], 1u); break; } } } } while (0)

struct XcdBarrier {
    unsigned* bar; unsigned x;
    volatile LAS unsigned* st;
};

__device__ __forceinline__ XcdBarrier xcd_barrier_post(unsigned* bar, volatile LAS unsigned* st) {
    XcdBarrier b; b.bar = bar; b.x = xb_xcc_id(); b.st = st;
    if (threadIdx.x == 0) (void)xb_add(&bar[XB_XCNT(b.x)], 1u);
    return b;
}
__device__ __forceinline__ void xcd_barrier_complete(unsigned* bar, unsigned x, unsigned& nloc, unsigned& nx) {
    const unsigned G = gridDim.x * gridDim.y * gridDim.z;
    unsigned sum, cnt, mine, sp = 0u;
    for (;;) {
        sum = 0u; cnt = 0u; mine = 0u;
#pragma unroll
        for (unsigned j = 0; j < 16; ++j) { const unsigned c = xb_ld(&bar[XB_XCNT(j)]); sum += c; cnt += (c > 0u) ? 1u : 0u; mine = (j == x) ? c : mine; }
        if (sum == G) break;
        __builtin_amdgcn_s_sleep(1);
        if ((++sp & 255u) == 0u) { if (xb_ld(&bar[XB_TMO])) break; if (sp > XB_SPIN_CAP) { atomicAdd(&bar[XB_TMO], 1u); break; } }
    }
    nloc = mine > 0u ? mine : 1u; nx = cnt > 0u ? cnt : 1u;
}

__device__ __forceinline__ void xcd_barrier(const XcdBarrier& b) {
    asm volatile("s_waitcnt vmcnt(0)" ::: "memory");
    __syncthreads();
    if (threadIdx.x == 0) {
        unsigned* bar = b.bar;
        __builtin_amdgcn_s_waitcnt(0);
        unsigned nloc = b.st[0], nx = b.st[1];
        if (nloc == 0u) { xcd_barrier_complete(bar, b.x, nloc, nx); b.st[0] = nloc; b.st[1] = nx; }
        const unsigned old = xb_add(&bar[XB_XSUB(b.x)], 1u);
        const unsigned gen = old / nloc;
        if (old + 1u == (gen + 1u) * nloc) {
            __builtin_amdgcn_fence(__ATOMIC_RELEASE, "agent");
            asm volatile("s_waitcnt vmcnt(0)" ::: "memory");
            const unsigned og = xb_add(&bar[XB_TOP], 1u);
            const unsigned tg = og / nx;
            if (og + 1u == (tg + 1u) * nx) xb_add(&bar[XB_TOPGEN], 1u);
            else XB_SPIN(xb_ld(&bar[XB_TOPGEN]) == tg, bar);
            __builtin_amdgcn_fence(__ATOMIC_ACQUIRE, "agent");
            xb_add(&bar[XB_XGEN(b.x)], 1u);
            asm volatile("s_waitcnt vmcnt(0)" ::: "memory");
        } else {
            XB_SPIN(xb_ld(&bar[XB_XGEN(b.x)]) == gen, bar);
            __builtin_amdgcn_fence(__ATOMIC_ACQUIRE, "agent");
            asm volatile("s_waitcnt vmcnt(0)" ::: "memory");
        }
    }
    __syncthreads();
}

__device__ __forceinline__ void seam(const XcdBarrier& b0) { XcdBarrier b = b0; asm volatile("" : "+s"(b.bar)); asm volatile("" : "+s"(b.x)); xcd_barrier(b); }

__global__ void __launch_bounds__(512, 2) hymba_fwd(Params p) {
    extern __shared__ __attribute__((aligned(16))) unsigned char smem[];
    LAS unsigned char* lds = (LAS unsigned char*)smem;
    cg::grid_group grid = cg::this_grid();
    const int tid = threadIdx.x, lane = tid & 63, wave = __builtin_amdgcn_readfirstlane(tid >> 6);
    const int G = gridDim.x, bid = blockIdx.x;
    const int gw = bid * 8 + wave, ngw = G * 8, gtid = bid * 512 + tid, nthreads = G * 512;
    unsigned* ctl = (unsigned*)(p.ws + WS_CTL);
    volatile LAS unsigned* xst = (volatile LAS unsigned*)(lds + L_XBST);
    if (tid == 0) { xst[0] = 0u; xst[1] = 0u; }
    __syncthreads();
    const XcdBarrier xb = xcd_barrier_post((unsigned*)(p.ws + WS_BAR), xst);
    bf16_t* W1T = (bf16_t*)(p.ws + WS_W1T); bf16_t* W1D = (bf16_t*)(p.ws + WS_W1D); bf16_t* W2T = (bf16_t*)(p.ws + WS_W2T); bf16_t* W2D = (bf16_t*)(p.ws + WS_W2D);
    bf16_t* WIN = (bf16_t*)(p.ws + WS_WIN); bf16_t* WGLU = (bf16_t*)(p.ws + WS_WGLU); bf16_t* WOUT = (bf16_t*)(p.ws + WS_WOUT);
    bf16_t* HB = (bf16_t*)(p.ws + WS_H); bf16_t* AB = (bf16_t*)(p.ws + WS_A); bf16_t* XC = (bf16_t*)(p.ws + WS_XC);
    float* yout = p.out + O_Y;
    pg8::StaticOrder S;

    {
        convert_items(p, lds, CV_W1T, CV_W1D, gw, ngw, wave, lane);
        rms_phase(p.in[0], p.in[1], p.in[6], HB, gw, ngw, lane);
        for (int i = gtid; i < MS * D / 4; i += nthreads) ((f32x4*)(yout + (size_t)MP * D))[i] = ((const f32x4*)p.in[1])[i];
    }
    if (p.use_cg) grid.sync();
    seam(xb);
    for (int rep = 0; rep < REP_P1; ++rep) { S.init(M, 2 * FF, G, bid); pg8::gemm_phase<true>(lds, pg8::Gemm{HB, W1T, M, 2 * FF, D, D}, S, EpiGateUp{AB});
        { const int nfull = S.nwg % G; if (nfull > 0 && bid >= nfull) convert_items(p, lds, CV_W1D, CV_WIN, (bid - nfull) * 8 + wave, (G - nfull) * 8, wave, lane); else if (nfull == 0) convert_items(p, lds, CV_W1D, CV_WIN, gw, ngw, wave, lane); }
        if (gtid >= nthreads - 2048) {
            const int idx = gtid - (nthreads - 2048), g = idx >> 6, pp = idx & 63;
            const double lr = p.in[12][idx], li = p.in[13][idx], step = exp((double)p.in[14][g]);
            const double mag = exp(lr * step), ang = li * step;
            const double are = mag * cos(ang), aim = mag * sin(ang);
            const double den = lr * lr + li * li, nre = are - 1.0, nim = aim;
            const float cre = (float)((nre * lr + nim * li) / den), cim = (float)((nim * lr - nre * li) / den);
            float* ABf = (float*)(p.ws + WS_S5A); ABf[idx] = (float)are; ABf[2048 + idx] = (float)aim;
            bf16_t* BBAR = (bf16_t*)(p.ws + WS_BBAR); bf16_t* CMAT = (bf16_t*)(p.ws + WS_CMAT);
            const float* bre = p.in[15] + (size_t)idx * 16; const float* bim = p.in[16] + (size_t)idx * 16;
#pragma unroll
            for (int hh = 0; hh < 16; hh += 2) {
                const float r0 = cre * bre[hh] - cim * bim[hh], r1 = cre * bre[hh + 1] - cim * bim[hh + 1];
                const float i0 = cre * bim[hh] + cim * bre[hh], i1 = cre * bim[hh + 1] + cim * bre[hh + 1];
                *(unsigned*)(BBAR + ((size_t)(g * 128 + pp)) * 16 + hh) = pk2(r0, r1);
                *(unsigned*)(BBAR + ((size_t)(g * 128 + 64 + pp)) * 16 + hh) = pk2(i0, i1);
            }
#pragma unroll
            for (int hh = 0; hh < 16; ++hh) {
                const float cr = p.in[17][((size_t)g * 16 + hh) * 64 + pp], ci = p.in[18][((size_t)g * 16 + hh) * 64 + pp];
                const unsigned pk = pk2(cr, -ci);
                CMAT[((size_t)(g * 16 + hh)) * 128 + pp] = (bf16_t)(pk & 0xffff); CMAT[((size_t)(g * 16 + hh)) * 128 + 64 + pp] = (bf16_t)(pk >> 16);
            }
        }
        seam(xb); }
    { S.init(MP, D, G, bid); pg8::gemm_phase<true>(lds, pg8::Gemm{AB, W1D, MP, D, FF, FF}, S, EpiResid{p.in[0], p.in[1], yout, 0.5f});
      pg8::SplitOrder S2{8 * (FF / 256), G, bid, 256}; pg8::gemm_phase<false>(lds, pg8::Gemm{AB + (size_t)MP * FF, W1D, MS, D, 256, FF}, S2, EpiAtomic{yout + (size_t)MP * D, 0.5f}); }
    { const int nsp = 8 * (FF / 256); if (G > nsp) { if (bid >= nsp) convert_items(p, lds, CV_WIN, CV_WGLU, (bid - nsp) * 8 + wave, (G - nsp) * 8, wave, lane); } else convert_items(p, lds, CV_WIN, CV_WGLU, gw, ngw, wave, lane); }
    seam(xb);
    rms_phase(yout, yout + (size_t)MP * D, p.in[10], HB, gw, ngw, lane);
    seam(xb);
    { S.init(M, NINP, G, bid); pg8::gemm_phase<true>(lds, pg8::Gemm{HB, WIN, M, NINP, D, D}, S, EpiProj{AB, (float*)(p.ws + WS_DTRAW)}); }
    { const int nfull = S.nwg % G; if (nfull > 0 && bid >= nfull) convert_items(p, lds, CV_WGLU, CV_W2T, (bid - nfull) * 8 + wave, (G - nfull) * 8, wave, lane); else if (nfull == 0) convert_items(p, lds, CV_WGLU, CV_W2T, gw, ngw, wave, lane); }
    seam(xb);
    for (int rep = 0; rep < REP_P5; ++rep) {
        for (int wi = gw; wi < 256 * 7; wi += ngw) { const int pair = wi / 7, sg = wi % 7; s5_wave_item<1>(p, lds + wave * 12800, pair & 31, pair >> 5, sg, (pair >> 5) * SEQ + sg * 256, 256, lane); }
        conv_phase(p, gtid, nthreads); seam(xb); }
    for (int rep = 0; rep < REP_P6; ++rep) {
        volatile LAS int* bc = (volatile LAS int*)(lds + L_BCAST);
        constexpr int N_SSDP = NB * NH, N_S5P = 256, N_S5S = 128, N_SSDS = NSB * NH / SMP_PAIRS;
        for (;;) {
            __syncthreads();
            if (tid == 0) *bc = (int)atomicAdd(&ctl[rep * 64], 1u);
            __syncthreads();
            int it = *bc;
            if (it >= N_SSDP + N_S5P + N_S5S + N_SSDS) break;
            if (it < N_SSDP) { ssd_prompt_item(p, lds, it / NH, it % NH); continue; }
            it -= N_SSDP;
            if (it < N_SSDS) { ssd_sample_item(p, it); continue; }
            it -= N_SSDS;
            if (it < N_S5P) { const int pair = it; s5_wave_item<2>(p, lds + wave * 12800, pair & 31, pair >> 5, wave, (pair >> 5) * SEQ + wave * 256, 256, lane); continue; }
            it -= N_S5P;
            { const int idx = it * 8 + wave; s5_wave_item<0>(p, lds + wave * 12800, idx & 31, 0, 0, MP + (idx >> 5) * 16, 16, lane); }
        }
        seam(xb);
    }
    { S.init(M, 512, G, bid); pg8::gemm_phase<true>(lds, pg8::Gemm{HB, WGLU, M, 512, 512, 512}, S, EpiGlu{HB, p.in[21], XC}); }
    { const int nglu = S.nwg; if (G > nglu) { if (bid >= nglu) convert_items(p, lds, CV_W2T, CV_END, (bid - nglu) * 8 + wave, (G - nglu) * 8, wave, lane); } else convert_items(p, lds, CV_W2T, CV_END, gw, ngw, wave, lane); }
    for (int rep = 0; rep < REP_P7; ++rep) { gatenorm_phase(p, gw, ngw, lane); seam(xb); }
    { S.init(MP, D, G, bid); pg8::gemm_phase<true>(lds, pg8::Gemm{XC, WOUT, MP, D, DMIX, DMIX}, S, EpiResid{yout, yout + (size_t)MP * D, yout, 1.0f});
      pg8::SplitOrder S2{8 * (DMIX / 256), G, bid, 256}; pg8::gemm_phase<false>(lds, pg8::Gemm{XC + (size_t)MP * DMIX, WOUT, MS, D, 256, DMIX}, S2, EpiAtomic{yout + (size_t)MP * D, 1.0f}); }
    seam(xb);
    rms_phase(yout, yout + (size_t)MP * D, p.in[29], HB, gw, ngw, lane);
    seam(xb);
    { S.init(M, 2 * FF, G, bid); pg8::gemm_phase<true>(lds, pg8::Gemm{HB, W2T, M, 2 * FF, D, D}, S, EpiGateUp{AB}); }
    seam(xb);
    { S.init(MP, D, G, bid); pg8::gemm_phase<true>(lds, pg8::Gemm{AB, W2D, MP, D, FF, FF}, S, EpiResid{yout, yout + (size_t)MP * D, yout, 0.5f});
      pg8::SplitOrder S2{8 * (FF / 256), G, bid, 256}; pg8::gemm_phase<false>(lds, pg8::Gemm{AB + (size_t)MP * FF, W2D, MS, D, 256, FF}, S2, EpiAtomic{yout + (size_t)MP * D, 0.5f}); }
    seam(xb);
    { int lane_f = lane; asm volatile("" : "+v"(lane_f));
    for (int m = gw * 4; m < M; m += ngw * 4) {
        f32x4 v[4][4], ww[4];
#pragma unroll
        for (int r = 0; r < 4; ++r)
#pragma unroll
            for (int j = 0; j < 4; ++j) v[r][j] = ((const f32x4*)(yout + (size_t)(m + r) * D))[lane_f + 64 * j];
#pragma unroll
        for (int j = 0; j < 4; ++j) ww[j] = ((const f32x4*)p.in[33])[lane_f + 64 * j];
#pragma unroll
        for (int r = 0; r < 4; ++r) {
            float ss = 0.f;
#pragma unroll
            for (int j = 0; j < 4; ++j) ss += (v[r][j].x * v[r][j].x + v[r][j].y * v[r][j].y) + (v[r][j].z * v[r][j].z + v[r][j].w * v[r][j].w);
            const float rstd = rsqrtf(wave_sum(ss) * (1.f / D) + EPS);
#pragma unroll
            for (int j = 0; j < 4; ++j) ((f32x4*)(yout + (size_t)(m + r) * D))[lane_f + 64 * j] = v[r][j] * rstd * ww[j];
        }
    } }
}

extern "C" void kernel_launch(void* const* d_in, const int* in_sizes, int n_in, void* d_out, int out_size, void* d_ws, size_t ws_size, hipStream_t stream) {
    static int grid_blocks = 0;
    if (grid_blocks == 0) {
        if (n_in != 34 || ws_size < WS_END) { fprintf(stderr, "kernel_launch: unexpected n_in %d or ws_size %zu (< %zu)\n", n_in, ws_size, (size_t)WS_END); grid_blocks = -1; return; }
        int dev = 0, cus = 0, per_cu = 0;
        hipGetDevice(&dev);
        hipDeviceGetAttribute(&cus, hipDeviceAttributeMultiprocessorCount, dev);
        hipFuncSetAttribute((const void*)hymba_fwd, hipFuncAttributeMaxDynamicSharedMemorySize, LDS_BYTES);
        hipOccupancyMaxActiveBlocksPerMultiprocessor(&per_cu, (const void*)hymba_fwd, 512, LDS_BYTES);
        if (per_cu < 1) { fprintf(stderr, "kernel_launch: occupancy query says %d blocks/CU\n", per_cu); per_cu = 1; }
        grid_blocks = cus;
    }
    if (grid_blocks < 0) return;
    if (hipMemsetAsync((char*)d_ws + WS_CTL, 0, 16384, stream) != hipSuccess) { fprintf(stderr, "kernel_launch: memset failed\n"); return; }
    Params p{};
    for (int i = 0; i < 34; ++i) p.in[i] = (const float*)d_in[i];
    p.out = (float*)d_out; p.ws = (unsigned char*)d_ws;
    void* args[] = {&p};
    hipError_t e = hipLaunchCooperativeKernel((const void*)hymba_fwd, dim3(grid_blocks), dim3(512), args, LDS_BYTES, stream);
    if (e != hipSuccess) fprintf(stderr, "cooperative launch failed: %s (grid %d)\n", hipGetErrorString(e), grid_blocks);
}
```

```cpp
#include <hip/hip_runtime.h>
#include <hip/hip_cooperative_groups.h>
#include <cstdio>
#include <cstdint>
namespace cg = cooperative_groups;

#define LAS __attribute__((address_space(3)))
typedef unsigned short bf16_t;
typedef short bf16x8 __attribute__((ext_vector_type(8)));
typedef float f32x4 __attribute__((ext_vector_type(4)));
typedef float f32x2 __attribute__((ext_vector_type(2)));
typedef unsigned u32x4 __attribute__((ext_vector_type(4)));
typedef unsigned u32x2 __attribute__((ext_vector_type(2)));

constexpr int D = 1024, FF = 2816, NIN = 4632, NINP = 4864, DMIX = 2048;
constexpr int MP = 16384, MS = 512, M = MP + MS, SEQ = 2048, NB = 8, NSB = 128;
constexpr int XBC = 2560, SSDW = 1536, NH = 24;
constexpr float EPS = 1e-6f;
constexpr size_t O_Y = 0, O_S5RP = 17301504, O_S5IP = 17317888, O_SSDP = 17334272, O_CONVP = 18907136,
                 O_S5RS = 18968576, O_S5IS = 19230720, O_SSDS = 19492864, O_CONVS = 44658688;
constexpr size_t WS_CTL = 0, WS_BAR = 2048, WS_S5A = 16384, WS_BBAR = WS_S5A + 16384, WS_CMAT = WS_BBAR + 131072, WS_DTRAW = WS_CMAT + 131072,
                 WS_W1T = WS_DTRAW + (size_t)M * 24 * 4, WS_W1D = WS_W1T + (size_t)2 * FF * D * 2, WS_W2T = WS_W1D + (size_t)D * FF * 2,
                 WS_W2D = WS_W2T + (size_t)2 * FF * D * 2, WS_WIN = WS_W2D + (size_t)D * FF * 2, WS_WGLU = WS_WIN + (size_t)NINP * D * 2,
                 WS_WOUT = WS_WGLU + (size_t)512 * 512 * 2, WS_H = WS_WOUT + (size_t)D * DMIX * 2, WS_A = WS_H + (size_t)M * D * 2,
                 WS_XC = WS_A + (size_t)M * NINP * 2, WS_YS = WS_XC + (size_t)M * XBC * 2, WS_S5END = WS_YS + (size_t)M * SSDW * 2, WS_END = WS_S5END + (size_t)256 * 8 * 128 * 4;
constexpr size_t XC_BCN = 0, XC_XSN = (size_t)M * 1024 * 2, XC_XT = XC_XSN + (size_t)MS * SSDW * 2, H_BT = (size_t)M * 512 * 2;
constexpr int LDS_BYTES = 158720;
#define REP_P1 1
#define REP_P6 1
#define REP_P5 1
#define REP_P7 1
constexpr int L_BCAST = 158208, L_XBST = 158224;

struct Params {
    const float* in[34];
    float* out;
    unsigned char* ws;
    int use_cg; int pad;
};

__device__ __forceinline__ unsigned pk2(float lo, float hi) { unsigned r; asm volatile("v_cvt_pk_bf16_f32 %0, %1, %2" : "=v"(r) : "v"(lo), "v"(hi)); return r; }
__device__ __forceinline__ float bflo(unsigned u) { return __uint_as_float(u << 16); }
__device__ __forceinline__ float bfhi(unsigned u) { return __uint_as_float(u & 0xffff0000u); }
__device__ __forceinline__ float bf2f(bf16_t v) { return __uint_as_float((unsigned)v << 16); }
__device__ __forceinline__ float wave_sum(float v) {
#pragma unroll
    for (int o = 1; o < 64; o <<= 1) v += __shfl_xor(v, o);
    return v;
}
__device__ __forceinline__ float silu_f(float x) { return x / (1.f + __expf(-x)); }
__device__ __forceinline__ float sigmoid_f(float x) { return 1.f / (1.f + __expf(-x)); }
__device__ __forceinline__ float softplus_f(float x) { return fmaxf(x, 0.f) + log1pf(__expf(-fabsf(x))); }
__device__ __forceinline__ float gelu_tanh(float y) { const float a = 0.7978845608028654f * (y + 0.044715f * y * y * y); const float t = 1.f - 2.f / (1.f + __expf(2.f * a)); return 0.5f * y * (1.f + t); }
#define LDS_WAIT() asm volatile("s_waitcnt lgkmcnt(0)" ::: "memory")
#define LDS_BARRIER() do { asm volatile("s_waitcnt lgkmcnt(0)" ::: "memory"); __builtin_amdgcn_s_barrier(); asm volatile("" ::: "memory"); } while (0)

namespace pg8 {
constexpr int BM = 256, BK = 64, HALF = 128, HTB = HALF * BK * 2, STAGE_BYTES = 8 * HTB, NXCD = 8, WGM = 8;
__host__ __device__ __forceinline__ int lds_byte(int r, int c) { const int st = (r >> 4) * 2 + (c >> 5), rr = r & 15, cc = c & 31, ob = rr * 64 + cc * 2; return st * 1024 + (ob ^ (((ob >> 9) & 1) << 5)); }
__host__ __device__ __forceinline__ void stage_rc(int b, int& R, int& C) { const int st = b / 1024, sb = b % 1024, swz = sb ^ (((sb >> 9) & 1) << 5); R = (st >> 1) * 16 + swz / 64; C = (st & 1) * 32 + (swz % 64) / 2; }
struct Unit { int pm, pn, kofs; };
struct Gemm { const bf16_t* A; const bf16_t* Bt; int M, N, K, ld; };
struct StaticOrder {
    int nM, nN, nwg, G, c;
    __host__ __device__ void init(int M_, int N_, int G_, int c_) { nM = M_ / BM; nN = N_ / BM; nwg = nM * nN; G = G_; c = c_; }
    __host__ __device__ bool next(int i, Unit& u) const {
        const long L = (long)i * G + c; if (L >= nwg) return false;
        int wgid = (int)L; { const int q = nwg / NXCD, r = nwg % NXCD, xcd = wgid % NXCD, off = wgid / NXCD; wgid = (xcd < r ? xcd * (q + 1) : r * (q + 1) + (xcd - r) * q) + off; }
        const int nig = WGM * nN, gid = wgid / nig, fm = gid * WGM, gsz = (nM - fm) < WGM ? (nM - fm) : WGM;
        u.pm = fm + ((wgid % nig) % gsz); u.pn = (wgid % nig) / gsz; u.kofs = 0; return true;
    }
    __device__ __forceinline__ void a_ready(const Unit&) const {}
    __device__ __forceinline__ void done(const Unit&) const {}
};
struct SplitOrder {
    int nunits, G, c, kslice;
    __host__ __device__ bool next(int i, Unit& u) const { const int L = i * G + c; if (L >= nunits) return false; u.pm = L & 1; u.pn = (L >> 1) & 3; u.kofs = (L >> 3) * kslice; return true; }
    __device__ __forceinline__ void a_ready(const Unit&) const {}
    __device__ __forceinline__ void done(const Unit&) const {}
};

template <bool SP2, class Epi, class Sched>
__device__ __forceinline__ void gemm_phase(LAS unsigned char* lds, const Gemm g, const Sched& S, const Epi& E) {
    int tid = threadIdx.x; asm volatile("" : "+v"(tid));
    const int wid = __builtin_amdgcn_readfirstlane(tid >> 6), lane = tid & 63, wr = wid >> 2, wc = wid & 3, fr = lane & 15, fq = lane >> 4;
    const int K = g.K, nt = K / BK;
    int ldv = g.ld; asm volatile("" : "+s"(ldv));
    unsigned voffA[2], voffB[2];
#pragma unroll
    for (int i = 0; i < 2; ++i) { int R, C; stage_rc(tid * 16 + i * 8192, R, C); voffA[i] = (unsigned)(R * ldv + C) * 2u; voffB[i] = voffA[i]; }
    const size_t kstep = (size_t)(BK * 2);
    const size_t hstepA = (size_t)HALF * ldv * 2, hstepB = hstepA;
    const size_t tstepA = 2 * hstepA, tstepB = tstepA;
    const unsigned ldsw = (unsigned)wid * 1024u;
    const int aoff = lds_byte(wr * 64 + fr, fq * 8), boff = lds_byte(wc * 32 + fr, fq * 8);
#define PG8_SA(b, h) (((b) * 2 + (h)) * HTB)
#define PG8_SB(b, h) ((4 + (b) * 2 + (h)) * HTB)
#define PG8_STAGE(bufoff, gbase, voff) do { _Pragma("unroll") for (int _i = 0; _i < 2; ++_i) \
        __builtin_amdgcn_global_load_lds((const unsigned*)((const char*)(gbase) + (voff)[_i]), (LAS unsigned*)(lds + (bufoff) + ldsw + _i * 8192), 16, 0, 0); } while (0)
#define PG8_LDA(dst, b, h) do { _Pragma("unroll") for (int m = 0; m < 4; ++m) _Pragma("unroll") for (int k = 0; k < 2; ++k) dst[m][k] = *(const LAS bf16x8*)(lds + PG8_SA(b, h) + aoff + m * 2048 + k * 1024); } while (0)
#define PG8_LDB(dst, b, h) do { _Pragma("unroll") for (int n = 0; n < 2; ++n) _Pragma("unroll") for (int k = 0; k < 2; ++k) dst[n][k] = *(const LAS bf16x8*)(lds + PG8_SB(b, h) + boff + n * 2048 + k * 1024); } while (0)
#define PG8_MMA(ai, bj, At, Bt) do { __builtin_amdgcn_s_setprio(1); _Pragma("unroll") for (int m = 0; m < 4; ++m) _Pragma("unroll") for (int n = 0; n < 2; ++n) _Pragma("unroll") for (int k = 0; k < 2; ++k) \
        acc[ai][bj][m][n] = __builtin_amdgcn_mfma_f32_16x16x32_bf16(Bt[n][k], At[m][k], acc[ai][bj][m][n], 0, 0, 0); __builtin_amdgcn_s_setprio(0); } while (0)
#define PG8_WAIT_V(n) asm volatile("s_waitcnt vmcnt(" #n ")" ::: "memory")
#define PG8_WAIT_L(n) asm volatile("s_waitcnt lgkmcnt(" #n ")" ::: "memory")
#define PG8_BAR __builtin_amdgcn_s_barrier()
#define PG8_SCHED __builtin_amdgcn_sched_barrier(0)
    Unit cur, nxt; int ui = 0;
    if (!S.next(0, cur)) return;
    f32x4 acc[2][2][4][2];
#pragma unroll
    for (int a = 0; a < 2; ++a)
#pragma unroll
        for (int b = 0; b < 2; ++b)
#pragma unroll
            for (int m = 0; m < 4; ++m)
#pragma unroll
                for (int n = 0; n < 2; ++n) acc[a][b][m][n] = (f32x4){0.f, 0.f, 0.f, 0.f};
    bf16x8 At[4][2], B0[2][2], B1[2][2];
    const char* cA = (const char*)g.A + (size_t)cur.pm * tstepA + (size_t)cur.kofs * 2; const char* cB = (const char*)g.Bt + (size_t)cur.pn * tstepB + (size_t)cur.kofs * 2;
    S.a_ready(cur);
    if constexpr (SP2) {
        PG8_STAGE(PG8_SB(0, 0), cB, voffB); PG8_STAGE(PG8_SB(0, 1), cB + hstepB, voffB); PG8_STAGE(PG8_SA(0, 0), cA, voffA); PG8_STAGE(PG8_SA(0, 1), cA + hstepA, voffA);
        if (wr == 1) PG8_BAR;
        PG8_WAIT_V(2); PG8_BAR;
    } else {
        PG8_STAGE(PG8_SB(0, 0), cB, voffB); PG8_STAGE(PG8_SA(0, 0), cA, voffA); PG8_STAGE(PG8_SB(0, 1), cB + hstepB, voffB); PG8_STAGE(PG8_SA(0, 1), cA + hstepA, voffA);
        if (wr == 1) PG8_BAR;
        PG8_WAIT_V(4); PG8_BAR;
    }
    PG8_STAGE(PG8_SB(1, 0), cB + kstep, voffB); PG8_STAGE(PG8_SA(1, 0), cA + kstep, voffA); PG8_STAGE(PG8_SB(1, 1), cB + hstepB + kstep, voffB);
    PG8_WAIT_V(6); PG8_BAR;
    for (;;) {
        const bool has_next = S.next(ui + 1, nxt);
        const char* nA = has_next ? (const char*)g.A + (size_t)nxt.pm * tstepA + (size_t)nxt.kofs * 2 : cA; const char* nB = has_next ? (const char*)g.Bt + (size_t)nxt.pn * tstepB + (size_t)nxt.kofs * 2 : cB;
        for (int t = 0; t < nt; t += 2) {
            const bool last = (t == nt - 2);
            const char* a1 = cA + (size_t)(t + 1) * kstep;
            const char* a2 = last ? nA : cA + (size_t)(t + 2) * kstep; const char* b2 = last ? nB : cB + (size_t)(t + 2) * kstep;
            const char* a3 = a2 + kstep; const char* b3 = b2 + kstep;
            if (last && has_next) S.a_ready(nxt);
            if constexpr (SP2) {
            PG8_LDB(B0, 0, 0); PG8_LDB(B1, 0, 1); PG8_SCHED; PG8_LDA(At, 0, 0); PG8_STAGE(PG8_SA(1, 1), a1 + hstepA, voffA);
            PG8_WAIT_V(8); PG8_WAIT_L(0); PG8_BAR; PG8_MMA(0, 0, At, B0); PG8_MMA(0, 1, At, B1); PG8_BAR; PG8_SCHED;
            PG8_LDA(At, 0, 1); PG8_STAGE(PG8_SB(0, 0), b2, voffB); PG8_STAGE(PG8_SB(0, 1), b2 + hstepB, voffB); PG8_STAGE(PG8_SA(0, 0), a2, voffA);
            PG8_WAIT_V(8); PG8_WAIT_L(0); PG8_BAR; PG8_MMA(1, 0, At, B0); PG8_MMA(1, 1, At, B1); PG8_BAR; PG8_SCHED;
            PG8_LDB(B0, 1, 0); PG8_LDB(B1, 1, 1); PG8_SCHED; PG8_LDA(At, 1, 0); PG8_STAGE(PG8_SA(0, 1), a2 + hstepA, voffA);
            PG8_WAIT_V(8); PG8_WAIT_L(0); PG8_BAR; PG8_MMA(0, 0, At, B0); PG8_MMA(0, 1, At, B1); PG8_BAR; PG8_SCHED;
            PG8_LDA(At, 1, 1); PG8_STAGE(PG8_SB(1, 0), b3, voffB); PG8_STAGE(PG8_SB(1, 1), b3 + hstepB, voffB); PG8_STAGE(PG8_SA(1, 0), a3, voffA);
            PG8_WAIT_V(8); PG8_WAIT_L(0); PG8_BAR; PG8_MMA(1, 0, At, B0); PG8_MMA(1, 1, At, B1); PG8_BAR; PG8_SCHED;
            } else {
            PG8_LDB(B0, 0, 0); PG8_SCHED; PG8_LDA(At, 0, 0); PG8_STAGE(PG8_SA(1, 1), a1 + hstepA, voffA);
            PG8_WAIT_L(8); PG8_BAR; PG8_WAIT_L(0); PG8_MMA(0, 0, At, B0); PG8_BAR; PG8_SCHED;
            PG8_LDB(B1, 0, 1); PG8_STAGE(PG8_SB(0, 0), b2, voffB);
            PG8_BAR; PG8_WAIT_L(0); PG8_MMA(0, 1, At, B1); PG8_BAR;
            PG8_LDA(At, 0, 1); PG8_STAGE(PG8_SA(0, 0), a2, voffA);
            PG8_BAR; PG8_WAIT_L(0); PG8_MMA(1, 0, At, B0); PG8_BAR; PG8_SCHED;
            PG8_STAGE(PG8_SB(0, 1), b2 + hstepB, voffB);
            PG8_WAIT_V(6); PG8_BAR; PG8_MMA(1, 1, At, B1); PG8_BAR;
            PG8_LDB(B0, 1, 0); PG8_SCHED; PG8_LDA(At, 1, 0); PG8_STAGE(PG8_SA(0, 1), a2 + hstepA, voffA);
            PG8_WAIT_L(8); PG8_BAR; PG8_WAIT_L(0); PG8_MMA(0, 0, At, B0); PG8_BAR; PG8_SCHED;
            PG8_LDB(B1, 1, 1); PG8_STAGE(PG8_SB(1, 0), b3, voffB);
            PG8_BAR; PG8_WAIT_L(0); PG8_MMA(0, 1, At, B1); PG8_BAR;
            PG8_LDA(At, 1, 1); PG8_STAGE(PG8_SA(1, 0), a3, voffA);
            PG8_BAR; PG8_WAIT_L(0); PG8_MMA(1, 0, At, B0); PG8_BAR; PG8_SCHED;
            PG8_STAGE(PG8_SB(1, 1), b3 + hstepB, voffB);
            PG8_WAIT_V(6); PG8_BAR; PG8_MMA(1, 1, At, B1); PG8_BAR;
                    }
        }
        if constexpr (SP2) { if (wr == 0) PG8_BAR; }
        E(acc, cur, wr, wc, fr, fq); S.done(cur);
        if (!has_next) break;
#pragma unroll
        for (int a = 0; a < 2; ++a)
#pragma unroll
            for (int b = 0; b < 2; ++b)
#pragma unroll
                for (int m = 0; m < 4; ++m)
#pragma unroll
                    for (int n = 0; n < 2; ++n) acc[a][b][m][n] = (f32x4){0.f, 0.f, 0.f, 0.f};
        cur = nxt; cA = nA; cB = nB; ++ui;
        if constexpr (SP2) { if (wr == 1) PG8_BAR; }
    }
    PG8_WAIT_V(0);
    if constexpr (!SP2) { if (wr == 0) PG8_BAR; }
    PG8_BAR;
#undef PG8_SA
#undef PG8_SB
#undef PG8_STAGE
#undef PG8_LDA
#undef PG8_LDB
#undef PG8_MMA
#undef PG8_WAIT_V
#undef PG8_WAIT_L
#undef PG8_BAR
#undef PG8_SCHED
}
}
using pg8::Unit;

struct EpiGateUp {
    bf16_t* act;
    __device__ __forceinline__ void operator()(const f32x4 (&acc)[2][2][4][2], const Unit& u, int wr, int wc, int fr, int fq) const {
#pragma unroll
        for (int ai = 0; ai < 2; ++ai)
#pragma unroll
            for (int m = 0; m < 4; ++m) {
                const int r = u.pm * 256 + ai * 128 + wr * 64 + m * 16 + fr;
                const int j = u.pn * 128 + wc * 32 + 8 * fq;
                const f32x4 g0 = acc[ai][0][m][0], g1 = acc[ai][0][m][1], u0 = acc[ai][1][m][0], u1 = acc[ai][1][m][1];
                u32x4 o; o.x = pk2(silu_f(g0[0]) * u0[0], silu_f(g0[1]) * u0[1]); o.y = pk2(silu_f(g0[2]) * u0[2], silu_f(g0[3]) * u0[3]);
                o.z = pk2(silu_f(g1[0]) * u1[0], silu_f(g1[1]) * u1[1]); o.w = pk2(silu_f(g1[2]) * u1[2], silu_f(g1[3]) * u1[3]);
                *(u32x4*)(act + (size_t)r * FF + j) = o;
            }
    }
};
struct EpiResid {
    const float* rp; const float* rs; float* y; float scale;
    __device__ __forceinline__ void operator()(const f32x4 (&acc)[2][2][4][2], const Unit& u, int wr, int wc, int fr, int fq) const {
#pragma unroll
        for (int ai = 0; ai < 2; ++ai)
#pragma unroll
            for (int m = 0; m < 4; ++m) {
                const int r = u.pm * 256 + ai * 128 + wr * 64 + m * 16 + fr;
                const float* rrow = (r < MP) ? rp + (size_t)r * D : rs + (size_t)(r - MP) * D;
                float* yrow = y + (size_t)r * D;
#pragma unroll
                for (int bj = 0; bj < 2; ++bj)
#pragma unroll
                    for (int n = 0; n < 2; ++n) {
                        const int c = u.pn * 256 + bj * 128 + wc * 32 + n * 16 + 4 * fq;
                        const f32x4 rv = *(const f32x4*)(rrow + c);
                        *(f32x4*)(yrow + c) = rv + acc[ai][bj][m][n] * scale;
                    }
            }
    }
};
struct EpiPart {
    float* part; float scale;
    __device__ __forceinline__ void operator()(const f32x4 (&acc)[2][2][4][2], const Unit& u, int wr, int wc, int fr, int fq) const {
        float* pb = part + (size_t)(u.kofs >> 8) * MS * D;
#pragma unroll
        for (int ai = 0; ai < 2; ++ai)
#pragma unroll
            for (int m = 0; m < 4; ++m) {
                float* yrow = pb + (size_t)(u.pm * 256 + ai * 128 + wr * 64 + m * 16 + fr) * D;
#pragma unroll
                for (int bj = 0; bj < 2; ++bj)
#pragma unroll
                    for (int n = 0; n < 2; ++n) {
                        const int c = u.pn * 256 + bj * 128 + wc * 32 + n * 16 + 4 * fq;
                        *(f32x4*)(yrow + c) = acc[ai][bj][m][n] * scale;
                    }
            }
    }
};
struct EpiProj {
    bf16_t* proj; float* dtraw;
    __device__ __forceinline__ void operator()(const f32x4 (&acc)[2][2][4][2], const Unit& u, int wr, int wc, int fr, int fq) const {
#pragma unroll
        for (int ai = 0; ai < 2; ++ai)
#pragma unroll
            for (int m = 0; m < 4; ++m) {
                const int r = u.pm * 256 + ai * 128 + wr * 64 + m * 16 + fr;
#pragma unroll
                for (int bj = 0; bj < 2; ++bj) {
                    const int c = u.pn * 256 + bj * 128 + wc * 32 + 8 * fq;
                    const f32x4 v0 = acc[ai][bj][m][0], v1 = acc[ai][bj][m][1];
                    if (u.pn == 18) { if (c - 4608 < 24) { *(f32x4*)(dtraw + (size_t)r * 24 + (c - 4608)) = v0; *(f32x4*)(dtraw + (size_t)r * 24 + (c - 4608) + 4) = v1; } }
                    else { u32x4 o; o.x = pk2(v0[0], v0[1]); o.y = pk2(v0[2], v0[3]); o.z = pk2(v1[0], v1[1]); o.w = pk2(v1[2], v1[3]); *(u32x4*)(proj + (size_t)r * NINP + c) = o; }
                }
            }
    }
};
struct EpiGlu {
    const bf16_t* v; const float* bias; bf16_t* mix;
    __device__ __forceinline__ void operator()(const f32x4 (&acc)[2][2][4][2], const Unit& u, int wr, int wc, int fr, int fq) const {
#pragma unroll
        for (int ai = 0; ai < 2; ++ai)
#pragma unroll
            for (int m = 0; m < 4; ++m) {
                const int r = u.pm * 256 + ai * 128 + wr * 64 + m * 16 + fr;
#pragma unroll
                for (int bj = 0; bj < 2; ++bj)
#pragma unroll
                    for (int n = 0; n < 2; ++n) {
                        const int c = u.pn * 256 + bj * 128 + wc * 32 + n * 16 + 4 * fq;
                        const f32x4 a = acc[ai][bj][m][n]; const f32x4 bb = *(const f32x4*)(bias + c);
                        const u32x2 vv = *(const u32x2*)(v + (size_t)r * 512 + c);
                        u32x2 o; o.x = pk2(bflo(vv.x) * sigmoid_f(a[0] + bb[0]), bfhi(vv.x) * sigmoid_f(a[1] + bb[1]));
                        o.y = pk2(bflo(vv.y) * sigmoid_f(a[2] + bb[2]), bfhi(vv.y) * sigmoid_f(a[3] + bb[3]));
                        *(u32x2*)(mix + (size_t)r * DMIX + c) = o;
                    }
            }
    }
};

__device__ __forceinline__ void transpose_item(const float* W, int K, int N, bf16_t* WT, int mode, LAS float* scr, int item, int lane) {
    const int nblk = (N + 63) / 64, kb = item / nblk, nb = item % nblk, k0 = 64 * kb, n0 = 64 * nb;
    const int c4 = lane & 15, rr = lane >> 4, nn = n0 + 4 * c4;
    f32x4 v[16];
#pragma unroll
    for (int i = 0; i < 16; ++i) v[i] = (nn < N) ? *(const f32x4*)(W + (size_t)(k0 + 4 * i + rr) * N + nn) : (f32x4){0.f, 0.f, 0.f, 0.f};
#pragma unroll
    for (int i = 0; i < 16; ++i) { LAS float* d = scr + (4 * i + rr) * 65 + 4 * c4; d[0] = v[i][0]; d[1] = v[i][1]; d[2] = v[i][2]; d[3] = v[i][3]; }
    LDS_WAIT();
    const int c = lane & 7, nrow = lane >> 3;
#pragma unroll
    for (int j = 0; j < 8; ++j) { const int n = nrow + 8 * j; const LAS float* s = scr + (8 * c) * 65 + n;
        u32x4 o; o.x = pk2(s[0 * 65], s[1 * 65]); o.y = pk2(s[2 * 65], s[3 * 65]); o.z = pk2(s[4 * 65], s[5 * 65]); o.w = pk2(s[6 * 65], s[7 * 65]);
        const int jn = n0 + n;
        const int ip = 16 * ((jn >> 2) & 1) + 4 * ((jn >> 3) & 3) + (jn & 3);
        const int row = (mode == 0) ? jn : (mode == 3) ? ((jn & ~31) + ip) : ((jn >> 7) * 256 + ((jn & 127) & ~31) + ip + (mode == 5 ? 128 : 0));
        *(u32x4*)(WT + (size_t)row * K + k0 + 8 * c) = o; }
    LDS_WAIT();
}
constexpr int I_GU = (D / 64) * (FF / 64), I_DN = (FF / 64) * (D / 64), I_IN = (D / 64) * ((NIN + 63) / 64), I_GL = (512 / 64) * (512 / 64), I_OUT = (DMIX / 64) * (D / 64);
constexpr int CV_W1T = 0, CV_W1D = 2 * I_GU, CV_WIN = CV_W1D + I_DN, CV_WGLU = CV_WIN + I_IN, CV_WOUT = CV_WGLU + I_GL, CV_W2T = CV_WOUT + I_OUT, CV_W2D = CV_W2T + 2 * I_GU, CV_END = CV_W2D + I_DN;
__device__ __forceinline__ void convert_items(const Params& p, LAS unsigned char* lds, int lo, int hi, int gw, int ngw, int wave, int lane_in) {
    int lane = lane_in; asm volatile("" : "+v"(lane));
    LAS float* scr = (LAS float*)(lds + wave * 16640);
    for (int it = lo + gw; it < hi; it += ngw) {
        int r = it;
        if (r < CV_W1D) { if (r < I_GU) transpose_item(p.in[7], D, FF, (bf16_t*)(p.ws + WS_W1T), 4, scr, r, lane); else transpose_item(p.in[8], D, FF, (bf16_t*)(p.ws + WS_W1T), 5, scr, r - I_GU, lane); continue; }
        if (r < CV_WIN) { transpose_item(p.in[9], FF, D, (bf16_t*)(p.ws + WS_W1D), 0, scr, r - CV_W1D, lane); continue; }
        if (r < CV_WGLU) { transpose_item(p.in[11], D, NIN, (bf16_t*)(p.ws + WS_WIN), 3, scr, r - CV_WIN, lane); continue; }
        if (r < CV_WOUT) { transpose_item(p.in[20], 512, 512, (bf16_t*)(p.ws + WS_WGLU), 0, scr, r - CV_WGLU, lane); continue; }
        if (r < CV_W2T) { transpose_item(p.in[28], DMIX, D, (bf16_t*)(p.ws + WS_WOUT), 0, scr, r - CV_WOUT, lane); continue; }
        if (r < CV_W2D) { r -= CV_W2T; if (r < I_GU) transpose_item(p.in[30], D, FF, (bf16_t*)(p.ws + WS_W2T), 4, scr, r, lane); else transpose_item(p.in[31], D, FF, (bf16_t*)(p.ws + WS_W2T), 5, scr, r - I_GU, lane); continue; }
        transpose_item(p.in[32], FF, D, (bf16_t*)(p.ws + WS_W2D), 0, scr, r - CV_W2D, lane);
    }
}

__device__ __forceinline__ void rms_phase(const float* srcp, const float* srcs, const float* w, bf16_t* dst, int gw, int ngw, int lane_in, const float* part = nullptr, int nsl = 0, float* wb = nullptr) {
    int lane = lane_in; asm volatile("" : "+v"(lane));
    for (int m = gw * 4; m < M; m += ngw * 4) {
        const float* xrow = (m < MP) ? srcp + (size_t)m * D : srcs + (size_t)(m - MP) * D;
        f32x4 v[4][4];
#pragma unroll
        for (int r = 0; r < 4; ++r)
#pragma unroll
            for (int j = 0; j < 4; ++j) v[r][j] = ((const f32x4*)(xrow + (size_t)r * D))[lane + 64 * j];
        if (nsl > 0 && m >= MP) {
            for (int sl = 0; sl < nsl; ++sl) {
#pragma unroll
                for (int r = 0; r < 4; ++r)
#pragma unroll
                    for (int j = 0; j < 4; ++j) v[r][j] += ((const f32x4*)(part + ((size_t)sl * MS + (m + r - MP)) * D))[lane + 64 * j];
            }
#pragma unroll
            for (int r = 0; r < 4; ++r)
#pragma unroll
                for (int j = 0; j < 4; ++j) ((f32x4*)(wb + (size_t)(m + r - MP) * D))[lane + 64 * j] = v[r][j];
        }
        f32x4 ww[4];
#pragma unroll
        for (int j = 0; j < 4; ++j) ww[j] = ((const f32x4*)w)[lane + 64 * j];
#pragma unroll
        for (int r = 0; r < 4; ++r) {
            float ss = 0.f;
#pragma unroll
            for (int j = 0; j < 4; ++j) ss += (v[r][j].x * v[r][j].x + v[r][j].y * v[r][j].y) + (v[r][j].z * v[r][j].z + v[r][j].w * v[r][j].w);
            const float rstd = rsqrtf(wave_sum(ss) * (1.f / D) + EPS);
            u32x2* o8 = (u32x2*)(dst + (size_t)(m + r) * D) + lane;
#pragma unroll
            for (int j = 0; j < 4; ++j) { u32x2 o; o.x = pk2(v[r][j].x * rstd * ww[j].x, v[r][j].y * rstd * ww[j].y); o.y = pk2(v[r][j].z * rstd * ww[j].z, v[r][j].w * rstd * ww[j].w); o8[64 * j] = o; }
        }
    }
}

__device__ __forceinline__ void unpack8(const u32x4 u, float (&f)[8]) { f[0] = bflo(u.x); f[1] = bfhi(u.x); f[2] = bflo(u.y); f[3] = bfhi(u.y); f[4] = bflo(u.z); f[5] = bfhi(u.z); f[6] = bflo(u.w); f[7] = bfhi(u.w); }
#define BF_ELEM(v, e) ((((e) & 1) ? ((v)[(e) >> 1] >> 16) : ((v)[(e) >> 1] & 0xffffu)))
__device__ __forceinline__ void conv_phase(const Params& p, int gtid, int nthreads) {
    const bf16_t* proj = (const bf16_t*)(p.ws + WS_A);
    bf16_t* BCN = (bf16_t*)(p.ws + WS_XC + XC_BCN); bf16_t* XSN = (bf16_t*)(p.ws + WS_XC + XC_XSN); bf16_t* XT = (bf16_t*)(p.ws + WS_XC + XC_XT); bf16_t* BT = (bf16_t*)(p.ws + WS_H + H_BT);
    const float* cw = p.in[22]; const float* cb = p.in[23]; const float* sconv = p.in[5];
    const int NT_P = (MP / 16) * 320, NT_S = NSB * 320;
    for (int task = gtid; task < NT_P; task += nthreads) {
        const int cgp = task % 320, rb = task / 320, c0 = cgp * 8, m0 = rb * 16;
        const bool first = (m0 % SEQ) == 0, lastblk = (m0 % SEQ) == SEQ - 16;
        u32x4 raw[19];
#pragma unroll
        for (int i = 0; i < 19; ++i) raw[i] = (i >= 3 || !first) ? *(const u32x4*)(proj + (size_t)(m0 - 3 + i) * NINP + 2048 + c0) : (u32x4){0u, 0u, 0u, 0u};
        float w0[8], w1[8], w2[8], w3[8], bs[8];
#pragma unroll
        for (int e = 0; e < 8; e += 4) { *(f32x4*)&w0[e] = *(const f32x4*)(cw + c0 + e); *(f32x4*)&w1[e] = *(const f32x4*)(cw + XBC + c0 + e); *(f32x4*)&w2[e] = *(const f32x4*)(cw + 2 * XBC + c0 + e);
            *(f32x4*)&w3[e] = *(const f32x4*)(cw + 3 * XBC + c0 + e); *(f32x4*)&bs[e] = *(const f32x4*)(cb + c0 + e); }
        float r0[8], r1[8], r2[8];
        unpack8(raw[0], r0); unpack8(raw[1], r1); unpack8(raw[2], r2);
        u32x4 ov[16];
#pragma unroll
        for (int i = 0; i < 16; ++i) {
            float cur[8]; unpack8(raw[i + 3], cur);
            float o[8];
#pragma unroll
            for (int e = 0; e < 8; ++e) { const float cv = bs[e] + w0[e] * r0[e] + w1[e] * r1[e] + w2[e] * r2[e] + w3[e] * cur[e]; o[e] = silu_f(cv); r0[e] = r1[e]; r1[e] = r2[e]; r2[e] = cur[e]; }
            ov[i].x = pk2(o[0], o[1]); ov[i].y = pk2(o[2], o[3]); ov[i].z = pk2(o[4], o[5]); ov[i].w = pk2(o[6], o[7]);
            if (i >= 13 && lastblk) { float* d = p.out + O_CONVP + ((size_t)(m0 / SEQ) * 3 + (i - 13)) * XBC + c0; *(f32x4*)d = (f32x4){cur[0], cur[1], cur[2], cur[3]}; *(f32x4*)(d + 4) = (f32x4){cur[4], cur[5], cur[6], cur[7]}; }
        }
        const int bb = m0 / SEQ, t0 = m0 % SEQ, cc = t0 >> 7, l0 = t0 & 127;
        if (c0 >= 1536) {
            const int cn = c0 - 1536;
#pragma unroll
            for (int i = 0; i < 16; ++i) *(u32x4*)(BCN + (size_t)(m0 + i) * 1024 + cn) = ov[i];
        }
        if (c0 < 2048) {
            bf16_t* tb = (c0 < 1536) ? XT + ((((size_t)(bb * 16 + cc) * NH + (c0 >> 6)) * 64 + (c0 & 63)) * 128 + l0)
                                     : BT + ((((size_t)(bb * 16 + cc) * 4 + ((c0 - 1536) >> 7)) * 128 + ((c0 - 1536) & 127)) * 128 + l0);
            const bool odd = (gtid & 1) != 0;
            bf16_t* t1 = odd ? tb - 8 * 128 + 8 : tb;
            bf16_t* t2 = odd ? tb + 8 : tb + 8 * 128;
#pragma unroll
            for (int e = 0; e < 8; ++e) {
                u32x4 q0, q1;
                q0.x = BF_ELEM(ov[0], e) | (BF_ELEM(ov[1], e) << 16); q0.y = BF_ELEM(ov[2], e) | (BF_ELEM(ov[3], e) << 16); q0.z = BF_ELEM(ov[4], e) | (BF_ELEM(ov[5], e) << 16); q0.w = BF_ELEM(ov[6], e) | (BF_ELEM(ov[7], e) << 16);
                q1.x = BF_ELEM(ov[8], e) | (BF_ELEM(ov[9], e) << 16); q1.y = BF_ELEM(ov[10], e) | (BF_ELEM(ov[11], e) << 16); q1.z = BF_ELEM(ov[12], e) | (BF_ELEM(ov[13], e) << 16); q1.w = BF_ELEM(ov[14], e) | (BF_ELEM(ov[15], e) << 16);
                const u32x4 snd = odd ? q0 : q1; u32x4 rcv;
                rcv.x = __shfl_xor(snd.x, 1); rcv.y = __shfl_xor(snd.y, 1); rcv.z = __shfl_xor(snd.z, 1); rcv.w = __shfl_xor(snd.w, 1);
                *(u32x4*)(t1 + (size_t)e * 128) = odd ? rcv : q0;
                *(u32x4*)(t2 + (size_t)e * 128) = odd ? q1 : rcv;
            }
        }
    }
    for (int task = gtid; task < NT_S; task += nthreads) {
        const int cgp = task % 320, b = task / 320, c0 = cgp * 8, m0 = MP + b * 4;
        u32x4 raw[4];
#pragma unroll
        for (int i = 0; i < 4; ++i) raw[i] = *(const u32x4*)(proj + (size_t)(m0 + i) * NINP + 2048 + c0);
        float w0[8], w1[8], w2[8], w3[8], bs[8], r0[8], r1[8], r2[8];
        const float* st = sconv + (size_t)b * 3 * XBC + c0;
#pragma unroll
        for (int e = 0; e < 8; e += 4) { *(f32x4*)&w0[e] = *(const f32x4*)(cw + c0 + e); *(f32x4*)&w1[e] = *(const f32x4*)(cw + XBC + c0 + e); *(f32x4*)&w2[e] = *(const f32x4*)(cw + 2 * XBC + c0 + e);
            *(f32x4*)&w3[e] = *(const f32x4*)(cw + 3 * XBC + c0 + e); *(f32x4*)&bs[e] = *(const f32x4*)(cb + c0 + e);
            *(f32x4*)&r0[e] = *(const f32x4*)(st + e); *(f32x4*)&r1[e] = *(const f32x4*)(st + XBC + e); *(f32x4*)&r2[e] = *(const f32x4*)(st + 2 * XBC + e); }
#pragma unroll
        for (int i = 0; i < 4; ++i) {
            float cur[8]; unpack8(raw[i], cur);
            float o[8];
#pragma unroll
            for (int e = 0; e < 8; ++e) { const float cv = bs[e] + w0[e] * r0[e] + w1[e] * r1[e] + w2[e] * r2[e] + w3[e] * cur[e]; o[e] = silu_f(cv); r0[e] = r1[e]; r1[e] = r2[e]; r2[e] = cur[e]; }
            u32x4 ov; ov.x = pk2(o[0], o[1]); ov.y = pk2(o[2], o[3]); ov.z = pk2(o[4], o[5]); ov.w = pk2(o[6], o[7]);
            if (c0 < 1536) *(u32x4*)(XSN + (size_t)(m0 + i - MP) * SSDW + c0) = ov;
            else *(u32x4*)(BCN + (size_t)(m0 + i) * 1024 + (c0 - 1536)) = ov;
            if (i >= 1) { float* d = p.out + O_CONVS + ((size_t)b * 3 + (i - 1)) * XBC + c0; *(f32x4*)d = (f32x4){cur[0], cur[1], cur[2], cur[3]}; *(f32x4*)(d + 4) = (f32x4){cur[4], cur[5], cur[6], cur[7]}; }
        }
    }
}

constexpr int LROW = 272;
constexpr int L_C = 0, L_B = 34816, L_BT = 69632, L_XT = 104448, L_XS = 121856, L_HT = 139264, L_AC = 156672, L_DT = 157184, L_G = 157696;
__device__ __forceinline__ float wave_incl_scan(float v, int lane) {
#pragma unroll
    for (int o = 1; o < 64; o <<= 1) { const float t = __shfl_up(v, o); if (lane >= o) v += t; }
    return v;
}
__device__ __forceinline__ void ssd_prompt_item(const Params& p, LAS unsigned char* lds, int b, int h) {
    int tid = threadIdx.x; asm volatile("" : "+v"(tid));
    const int lane = tid & 63, w = __builtin_amdgcn_readfirstlane(tid >> 6), fr = lane & 15, fq = lane >> 4;
    const int g = h / 6;
    const bf16_t* BCN = (const bf16_t*)(p.ws + WS_XC + XC_BCN); const bf16_t* XT = (const bf16_t*)(p.ws + WS_XC + XC_XT); const bf16_t* BT = (const bf16_t*)(p.ws + WS_H + H_BT);
    const float* dtraw = (const float*)(p.ws + WS_DTRAW); bf16_t* ys = (bf16_t*)(p.ws + WS_YS);
    const float a_h = -__expf(p.in[25][h]), dtb = p.in[24][h], Dh = p.in[26][h];
    f32x4 hacc[4];
#pragma unroll
    for (int i = 0; i < 4; ++i) hacc[i] = (f32x4){0.f, 0.f, 0.f, 0.f};
    for (int i = tid; i < 64 * 17; i += 512) *(LAS u32x4*)(lds + L_HT + i * 16) = (u32x4){0u, 0u, 0u, 0u};
    const int prow = tid >> 4, pc = tid & 15;
    u32x4 pvc[4], pvb[4], pvt[4], pvx[2]; float pdl, pdh;
#define SSD_FETCH(cc) do { const int _m0 = b * SEQ + (cc) * 128; \
        pdl = dtraw[(size_t)(_m0 + lane) * 24 + h]; pdh = dtraw[(size_t)(_m0 + 64 + lane) * 24 + h]; \
        const bf16_t* _bt = BT + (((size_t)(b * 16 + (cc)) * 4 + g) * 128) * 128; const bf16_t* _xt = XT + (((size_t)(b * 16 + (cc)) * NH + h) * 64) * 128; \
        _Pragma("unroll") for (int j = 0; j < 4; ++j) { const bf16_t* _gr = BCN + (size_t)(_m0 + prow + 32 * j) * 1024 + g * 128 + pc * 8; pvb[j] = *(const u32x4*)_gr; pvc[j] = *(const u32x4*)(_gr + 512); \
            pvt[j] = *(const u32x4*)(_bt + (size_t)(prow + 32 * j) * 128 + pc * 8); } \
        _Pragma("unroll") for (int j = 0; j < 2; ++j) pvx[j] = *(const u32x4*)(_xt + (size_t)(prow + 32 * j) * 128 + pc * 8); } while (0)
    SSD_FETCH(0);
    for (int c = 0; c < 16; ++c) {
        const int m0 = b * SEQ + c * 128;
        const float dt_lo = softplus_f(pdl + dtb), dt_hi = softplus_f(pdh + dtb);
        const float ac_lo = wave_incl_scan(dt_lo * a_h, lane); const float tot_lo = __shfl(ac_lo, 63);
        const float ac_hi = wave_incl_scan(dt_hi * a_h, lane) + tot_lo; const float alast = __shfl(ac_hi, 63);
        const float sc_lo = dt_lo * __expf(alast - ac_lo), sc_hi = dt_hi * __expf(alast - ac_hi);
        if (w == 0) { const float ae_lo = __shfl(ac_lo, (lane & 48) + 15), ae_hi = __shfl(ac_hi, (lane & 48) + 15);
            *(LAS float*)(lds + L_G + lane * 4) = dt_lo * __expf(ae_lo - ac_lo); *(LAS float*)(lds + L_G + 256 + lane * 4) = dt_hi * __expf(ae_hi - ac_hi);
            *(LAS float*)(lds + L_AC + lane * 4) = ac_lo; *(LAS float*)(lds + L_AC + 256 + lane * 4) = ac_hi; *(LAS float*)(lds + L_DT + lane * 4) = dt_lo; *(LAS float*)(lds + L_DT + 256 + lane * 4) = dt_hi; }
        float sc[8];
#pragma unroll
        for (int e = 0; e < 8; ++e) { const int src = (pc * 8 + e) & 63; const float vlo = __shfl(sc_lo, src), vhi = __shfl(sc_hi, src); sc[e] = (pc < 8) ? vlo : vhi; }
#pragma unroll
        for (int j = 0; j < 4; ++j) {
            const int r = prow + 32 * j;
            *(LAS u32x4*)(lds + L_C + r * LROW + pc * 16) = pvc[j];
            *(LAS u32x4*)(lds + L_B + r * LROW + pc * 16) = pvb[j];
            *(LAS u32x4*)(lds + L_BT + r * LROW + pc * 16) = pvt[j];
        }
#pragma unroll
        for (int j = 0; j < 2; ++j) {
            const int r = prow + 32 * j;
            float xf[8]; unpack8(pvx[j], xf);
            *(LAS u32x4*)(lds + L_XT + r * LROW + pc * 16) = pvx[j];
            u32x4 q; q.x = pk2(xf[0] * sc[0], xf[1] * sc[1]); q.y = pk2(xf[2] * sc[2], xf[3] * sc[3]); q.z = pk2(xf[4] * sc[4], xf[5] * sc[5]); q.w = pk2(xf[6] * sc[6], xf[7] * sc[7]);
            *(LAS u32x4*)(lds + L_XS + r * LROW + pc * 16) = q;
        }
        LDS_BARRIER();
        if (c < 15) SSD_FETCH(c + 1);
        const int l = 16 * w + fr;
        bf16x8 cfrag[4];
#pragma unroll
        for (int ks = 0; ks < 4; ++ks) cfrag[ks] = *(const LAS bf16x8*)(lds + L_C + l * LROW + (ks * 32 + fq * 8) * 2);
        f32x4 yacc[4];
#pragma unroll
        for (int pb = 0; pb < 4; ++pb) {
            f32x4 a = (f32x4){0.f, 0.f, 0.f, 0.f};
#pragma unroll
            for (int ks = 0; ks < 4; ++ks) { const bf16x8 hf = *(const LAS bf16x8*)(lds + L_HT + (pb * 16 + fr) * LROW + (ks * 32 + fq * 8) * 2); a = __builtin_amdgcn_mfma_f32_16x16x32_bf16(hf, cfrag[ks], a, 0, 0, 0); }
            yacc[pb] = a;
        }
        const float al = *(const LAS float*)(lds + L_AC + l * 4);
        { const float el = __expf(al);
#pragma unroll
          for (int pb = 0; pb < 4; ++pb) yacc[pb] = yacc[pb] * el; }
        f32x4 cbt[8];
#pragma unroll
        for (int sb = 0; sb < 8; ++sb) {
            cbt[sb] = (f32x4){0.f, 0.f, 0.f, 0.f};
            if (sb <= w) {
                f32x4 a = (f32x4){0.f, 0.f, 0.f, 0.f};
#pragma unroll
                for (int ks = 0; ks < 4; ++ks) { const bf16x8 bf = *(const LAS bf16x8*)(lds + L_B + (sb * 16 + fr) * LROW + (ks * 32 + fq * 8) * 2); a = __builtin_amdgcn_mfma_f32_16x16x32_bf16(bf, cfrag[ks], a, 0, 0, 0); }
                cbt[sb] = a;
            }
        }
        LDS_BARRIER();
        const int nks = (w >> 1) + 1;
#pragma unroll
        for (int sb = 0; sb < 8; ++sb) {
            if (sb < 2 * nks) {
                const int s0 = sb * 16 + 4 * fq;
                float mv[4];
                if (sb < w) {
                    const float f = __expf(al - *(const LAS float*)(lds + L_AC + (sb * 16 + 15) * 4));
                    const f32x4 gs = *(const LAS f32x4*)(lds + L_G + s0 * 4);
#pragma unroll
                    for (int e = 0; e < 4; ++e) mv[e] = cbt[sb][e] * f * gs[e];
                } else if (sb == w) {
                    const f32x4 as = *(const LAS f32x4*)(lds + L_AC + s0 * 4), ds = *(const LAS f32x4*)(lds + L_DT + s0 * 4);
#pragma unroll
                    for (int e = 0; e < 4; ++e) { const float v = cbt[sb][e] * __expf(al - as[e]) * ds[e]; mv[e] = ((s0 + e) <= l) ? v : 0.f; if (s0 + e == l) mv[e] += Dh; }
                } else {
#pragma unroll
                    for (int e = 0; e < 4; ++e) mv[e] = 0.f;
                }
                u32x2 o; o.x = pk2(mv[0], mv[1]); o.y = pk2(mv[2], mv[3]);
                *(LAS u32x2*)(lds + L_B + l * LROW + s0 * 2) = o;
            }
        }
        LDS_WAIT();
#pragma unroll
        for (int ks = 0; ks < 4; ++ks) {
            if (ks < nks) {
                const bf16x8 mf = *(const LAS bf16x8*)(lds + L_B + l * LROW + (ks * 32 + fq * 8) * 2);
#pragma unroll
                for (int pb = 0; pb < 4; ++pb) { const bf16x8 xf = *(const LAS bf16x8*)(lds + L_XT + (pb * 16 + fr) * LROW + (ks * 32 + fq * 8) * 2); yacc[pb] = __builtin_amdgcn_mfma_f32_16x16x32_bf16(xf, mf, yacc[pb], 0, 0, 0); }
            }
        }
#pragma unroll
        for (int pb = 0; pb < 4; ++pb) {
            const int pcol = h * 64 + pb * 16 + 4 * fq;
            u32x2 o; o.x = pk2(yacc[pb][0], yacc[pb][1]); o.y = pk2(yacc[pb][2], yacc[pb][3]);
            *(u32x2*)(ys + (size_t)(m0 + l) * SSDW + pcol) = o;
        }
        { const float ea = __expf(alast);
#pragma unroll
          for (int pb = 0; pb < 4; ++pb) hacc[pb] = hacc[pb] * ea; }
#pragma unroll
        for (int ks = 0; ks < 4; ++ks) {
            const bf16x8 btf = *(const LAS bf16x8*)(lds + L_BT + (16 * w + fr) * LROW + (ks * 32 + fq * 8) * 2);
#pragma unroll
            for (int pb = 0; pb < 4; ++pb) { const bf16x8 xsf = *(const LAS bf16x8*)(lds + L_XS + (pb * 16 + fr) * LROW + (ks * 32 + fq * 8) * 2); hacc[pb] = __builtin_amdgcn_mfma_f32_16x16x32_bf16(btf, xsf, hacc[pb], 0, 0, 0); }
        }
#pragma unroll
        for (int pb = 0; pb < 4; ++pb) { u32x2 o; o.x = pk2(hacc[pb][0], hacc[pb][1]); o.y = pk2(hacc[pb][2], hacc[pb][3]); *(LAS u32x2*)(lds + L_HT + (pb * 16 + fr) * LROW + (16 * w + 4 * fq) * 2) = o; }
        LDS_BARRIER();
    }
    float* so = p.out + O_SSDP + ((size_t)(b * NH + h) * 64) * 128;
#pragma unroll
    for (int pb = 0; pb < 4; ++pb) *(f32x4*)(so + (size_t)(pb * 16 + fr) * 128 + 16 * w + 4 * fq) = hacc[pb];
}

template <int MODE>
__device__ __forceinline__ void s5_wave_item(const Params& p, LAS unsigned char* wl, int g, int bidx, int seg, int m_start, int nrows, int lane_in) {
    int lane = lane_in; asm volatile("" : "+v"(lane));
    const int fr = lane & 15, fq = lane >> 4;
    const bf16_t* proj = (const bf16_t*)(p.ws + WS_A); bf16_t* vbuf = (bf16_t*)(p.ws + WS_H);
    const bf16_t* BBAR = (const bf16_t*)(p.ws + WS_BBAR); const bf16_t* CMAT = (const bf16_t*)(p.ws + WS_CMAT); const float* AB = (const float*)(p.ws + WS_S5A);
    float* S5E = (float*)(p.ws + WS_S5END);
    const bf16x8 zf = (bf16x8){0, 0, 0, 0, 0, 0, 0, 0};
    bf16x8 bfrag[8], cfrag[4];
#pragma unroll
    for (int t = 0; t < 8; ++t) bfrag[t] = (fq < 2) ? *(const bf16x8*)(BBAR + ((size_t)(g * 128 + t * 16 + fr)) * 16 + fq * 8) : zf;
    if (MODE != 1) {
#pragma unroll
        for (int ks = 0; ks < 4; ++ks) cfrag[ks] = *(const bf16x8*)(CMAT + ((size_t)(g * 16 + fr)) * 128 + ks * 32 + fq * 8);
    }
    const float ar = AB[g * 64 + lane], ai = AB[2048 + g * 64 + lane];
    const f32x4 d4 = *(const f32x4*)(p.in[19] + g * 16 + 4 * fq);
    LAS float* sBu = (LAS float*)wl; LAS bf16_t* sS = (LAS bf16_t*)(wl + 8448);
    float sr = 0.f, si = 0.f;
    if (MODE == 2 && seg > 0) {
        float pr = ar, pi = ai;
#pragma unroll
        for (int q = 0; q < 8; ++q) { const float nr = pr * pr - pi * pi, ni = 2.f * pr * pi; pr = nr; pi = ni; }
        for (int j = 0; j < seg; ++j) {
            const float* e = S5E + ((size_t)((bidx * 32 + g) * 8 + j)) * 128;
            const float er = e[lane], ei = e[64 + lane];
            const float nr = pr * sr - pi * si + er, ni = pr * si + pi * sr + ei; sr = nr; si = ni;
        }
    }
    bf16x8 uf_n; u32x2 u4_n;
    { const bf16_t* urow = proj + (size_t)(m_start + fr) * NINP + g * 16; uf_n = (fq < 2) ? *(const bf16x8*)(urow + fq * 8) : zf; u4_n = *(const u32x2*)(urow + 4 * fq); }
    for (int m0 = m_start; m0 < m_start + nrows; m0 += 16) {
        const bf16x8 uf = uf_n; const u32x2 u4 = u4_n;
        { const int mn = (m0 + 16 < m_start + nrows) ? m0 + 16 : m0; const bf16_t* urow = proj + (size_t)(mn + fr) * NINP + g * 16; uf_n = (fq < 2) ? *(const bf16x8*)(urow + fq * 8) : zf; u4_n = *(const u32x2*)(urow + 4 * fq); }
#pragma unroll
        for (int t = 0; t < 8; ++t) {
            f32x4 a = (f32x4){0.f, 0.f, 0.f, 0.f};
            a = __builtin_amdgcn_mfma_f32_16x16x32_bf16(bfrag[t], uf, a, 0, 0, 0);
            *(LAS f32x4*)(sBu + fr * 132 + t * 16 + 4 * fq) = a;
        }
        LDS_WAIT();
        {
            float br[16], bi[16]; unsigned pkv[16];
#pragma unroll
            for (int t = 0; t < 16; ++t) { br[t] = sBu[t * 132 + lane]; bi[t] = sBu[t * 132 + 64 + lane]; }
            float s0r[4], s0i[4];
            if (MODE == 0) {
#pragma unroll
                for (int q = 0; q < 4; ++q) { const int bb = ((m0 - MP) >> 2) + q; s0r[q] = p.in[2][((size_t)bb * 32 + g) * 64 + lane]; s0i[q] = p.in[3][((size_t)bb * 32 + g) * 64 + lane]; }
            }
#pragma unroll
            for (int t = 0; t < 16; ++t) {
                if (MODE == 0 && (t & 3) == 0) { sr = s0r[t >> 2]; si = s0i[t >> 2]; }
                const float nr = ar * sr - ai * si + br[t], ni = ar * si + ai * sr + bi[t];
                sr = nr; si = ni;
                if (MODE != 1) pkv[t] = pk2(sr, si);
                if (MODE == 0 && (t & 3) == 3) { const int bb = (m0 - MP + t) >> 2; p.out[O_S5RS + ((size_t)bb * 32 + g) * 64 + lane] = sr; p.out[O_S5IS + ((size_t)bb * 32 + g) * 64 + lane] = si; }
            }
            if (MODE != 1) {
#pragma unroll
                for (int t = 0; t < 16; ++t) { sS[t * 136 + lane] = (bf16_t)(pkv[t] & 0xffff); sS[t * 136 + 64 + lane] = (bf16_t)(pkv[t] >> 16); }
            }
        }
        LDS_WAIT();
        if (MODE != 1) {
            f32x4 y = (f32x4){0.f, 0.f, 0.f, 0.f};
#pragma unroll
            for (int ks = 0; ks < 4; ++ks) { const bf16x8 sf = *(const LAS bf16x8*)(sS + fr * 136 + ks * 32 + fq * 8); y = __builtin_amdgcn_mfma_f32_16x16x32_bf16(cfrag[ks], sf, y, 0, 0, 0); }
            const float y0 = y[0] + d4[0] * bflo(u4.x), y1 = y[1] + d4[1] * bfhi(u4.x), y2 = y[2] + d4[2] * bflo(u4.y), y3 = y[3] + d4[3] * bfhi(u4.y);
            u32x2 o; o.x = pk2(gelu_tanh(y0), gelu_tanh(y1)); o.y = pk2(gelu_tanh(y2), gelu_tanh(y3));
            *(u32x2*)(vbuf + (size_t)(m0 + fr) * 512 + g * 16 + 4 * fq) = o;
            LDS_WAIT();
        }
    }
    if (MODE == 1) { float* e = S5E + ((size_t)((bidx * 32 + g) * 8 + seg)) * 128; e[lane] = sr; e[64 + lane] = si; }
    if (MODE == 2 && seg == 7) { p.out[O_S5RP + ((size_t)bidx * 32 + g) * 64 + lane] = sr; p.out[O_S5IP + ((size_t)bidx * 32 + g) * 64 + lane] = si; }
}

#define SMP_LOAD(HS, BS, CS, DS, XS_, PS, pr_) do { const int _b = (pr_) / NH, _h = (pr_) % NH, _g = _h / 6; \
        PS[0] = p.in[25][_h]; PS[1] = p.in[24][_h]; PS[2] = p.in[26][_h]; \
        const float* _h0 = p.in[4] + ((size_t)(_b * NH + _h) * 64 + pp) * 128 + n0; \
        _Pragma("unroll") for (int j = 0; j < 4; ++j) HS[j] = *(const f32x4*)(_h0 + 4 * j); \
        _Pragma("unroll") for (int t = 0; t < 4; ++t) { const int _m = MP + _b * 4 + t; const bf16_t* _row = BCN + (size_t)_m * 1024 + _g * 128 + n0; \
            DS[t] = dtraw[(size_t)_m * 24 + _h]; XS_[t] = *(const unsigned*)(XSN + (size_t)(_m - MP) * SSDW + _h * 64 + (pp & ~1)); \
            BS[t][0] = *(const u32x4*)_row; BS[t][1] = *(const u32x4*)(_row + 8); CS[t][0] = *(const u32x4*)(_row + 512); CS[t][1] = *(const u32x4*)(_row + 520); } } while (0)
#define SMP_COMPUTE(HS, BS, CS, DS, XS_, PS, pr_) do { const int _b = (pr_) / NH, _h = (pr_) % NH; \
        const float a_h = -__expf(PS[0]), dtb = PS[1], Dh = PS[2]; \
        float hv[16]; \
        _Pragma("unroll") for (int j = 0; j < 4; ++j) { hv[4 * j] = HS[j][0]; hv[4 * j + 1] = HS[j][1]; hv[4 * j + 2] = HS[j][2]; hv[4 * j + 3] = HS[j][3]; } \
        _Pragma("unroll") for (int t = 0; t < 4; ++t) { const int _m = MP + _b * 4 + t; \
            const float dt = softplus_f(DS[t] + dtb), dec = __expf(dt * a_h); const float xv = (pp & 1) ? bfhi(XS_[t]) : bflo(XS_[t]), xd = xv * dt; \
            float acc = 0.f; \
            _Pragma("unroll") for (int hf = 0; hf < 2; ++hf) { float Bv[8], Cv[8]; unpack8(BS[t][hf], Bv); unpack8(CS[t][hf], Cv); \
                _Pragma("unroll") for (int j = 0; j < 8; ++j) { hv[8 * hf + j] = hv[8 * hf + j] * dec + xd * Bv[j]; acc += hv[8 * hf + j] * Cv[j]; } } \
            acc += __shfl_xor(acc, 1); acc += __shfl_xor(acc, 2); acc += __shfl_xor(acc, 4); \
            if ((tid & 7) == 0) ys[(size_t)_m * SSDW + _h * 64 + pp] = (bf16_t)(pk2(acc + Dh * xv, 0.f) & 0xffff); } \
        float* _ho = p.out + O_SSDS + ((size_t)(_b * NH + _h) * 64 + pp) * 128 + n0; \
        _Pragma("unroll") for (int j = 0; j < 16; j += 4) *(f32x4*)(_ho + j) = (f32x4){hv[j], hv[j + 1], hv[j + 2], hv[j + 3]}; } while (0)
constexpr int SMP_PAIRS = 6;
__device__ __forceinline__ void ssd_sample_item(const Params& p, int item) {
    int tid = threadIdx.x; asm volatile("" : "+v"(tid));
    const int pp = tid >> 3, n0 = (tid & 7) * 16;
    const bf16_t* BCN = (const bf16_t*)(p.ws + WS_XC + XC_BCN); const bf16_t* XSN = (const bf16_t*)(p.ws + WS_XC + XC_XSN); const float* dtraw = (const float*)(p.ws + WS_DTRAW); bf16_t* ys = (bf16_t*)(p.ws + WS_YS);
    f32x4 hA[4], hB[4]; u32x4 bA[4][2], cA[4][2], bB[4][2], cB[4][2]; float dA[4], dB[4], sA3[3], sB3[3]; unsigned xA[4], xB[4];
    const int pr0 = item * SMP_PAIRS;
    SMP_LOAD(hA, bA, cA, dA, xA, sA3, pr0);
#pragma unroll
    for (int k = 0; k < SMP_PAIRS; k += 2) {
        const int pr = pr0 + k;
        SMP_LOAD(hB, bB, cB, dB, xB, sB3, pr + 1);
        SMP_COMPUTE(hA, bA, cA, dA, xA, sA3, pr);
        if (k + 2 < SMP_PAIRS) SMP_LOAD(hA, bA, cA, dA, xA, sA3, pr + 2);
        SMP_COMPUTE(hB, bB, cB, dB, xB, sB3, pr + 1);
    }
}

__device__ __forceinline__ void gatenorm_phase(const Params& p, int gw, int ngw, int lane_in) {
    int lane = lane_in; asm volatile("" : "+v"(lane));
    const bf16_t* proj = (const bf16_t*)(p.ws + WS_A); const bf16_t* ys = (const bf16_t*)(p.ws + WS_YS); bf16_t* mix = (bf16_t*)(p.ws + WS_XC);
    const float* nw = p.in[27];
    for (int m = gw * 2; m < M; m += ngw * 2) {
        u32x4 yr[2][3], zr[2][3];
#pragma unroll
        for (int r = 0; r < 2; ++r)
#pragma unroll
            for (int j = 0; j < 3; ++j) { const int c0 = (lane + 64 * j) * 8; yr[r][j] = *(const u32x4*)(ys + (size_t)(m + r) * SSDW + c0); zr[r][j] = *(const u32x4*)(proj + (size_t)(m + r) * NINP + 512 + c0); }
#pragma unroll
        for (int r = 0; r < 2; ++r) {
            float gv[3][8]; float sg[4] = {0.f, 0.f, 0.f, 0.f};
#pragma unroll
            for (int j = 0; j < 3; ++j) {
                float yv[8], zv[8]; unpack8(yr[r][j], yv); unpack8(zr[r][j], zv);
                float ss = 0.f;
#pragma unroll
                for (int e = 0; e < 8; ++e) { gv[j][e] = yv[e] * silu_f(zv[e]); ss += gv[j][e] * gv[j][e]; }
                const int grp = (lane + 64 * j) / 48;
#pragma unroll
                for (int q = 0; q < 4; ++q) sg[q] += (grp == q) ? ss : 0.f;
            }
            float rs[4];
#pragma unroll
            for (int q = 0; q < 4; ++q) rs[q] = rsqrtf(wave_sum(sg[q]) * (1.f / 384.f) + EPS);
#pragma unroll
            for (int j = 0; j < 3; ++j) {
                const int c0 = (lane + 64 * j) * 8, grp = (lane + 64 * j) / 48;
                const float rstd = grp == 0 ? rs[0] : (grp == 1 ? rs[1] : (grp == 2 ? rs[2] : rs[3]));
                const f32x4 n0 = *(const f32x4*)(nw + c0), n1 = *(const f32x4*)(nw + c0 + 4);
                u32x4 o; o.x = pk2(gv[j][0] * rstd * n0[0], gv[j][1] * rstd * n0[1]); o.y = pk2(gv[j][2] * rstd * n0[2], gv[j][3] * rstd * n0[3]);
                o.z = pk2(gv[j][4] * rstd * n1[0], gv[j][5] * rstd * n1[1]); o.w = pk2(gv[j][6] * rstd * n1[2], gv[j][7] * rstd * n1[3]);
                *(u32x4*)(mix + (size_t)(m + r) * DMIX + 512 + c0) = o;
            }
        }
    }
}

#define XB_TMO      128
#define XB_XCNT(j)  (256  + 64 * (j))
#define XB_XSUB(j)  (1280 + 64 * (j))
#define XB_XGEN(j)  (2304 + 64 * (j))
#define XB_TOP      3328
#define XB_TOPGEN   3392
#define XCD_BAR_WORDS 3456
#define XB_SPIN_CAP (1u << 18)

__device__ __forceinline__ unsigned xb_ld(unsigned* p)              { return __hip_atomic_load(p, __ATOMIC_RELAXED, __HIP_MEMORY_SCOPE_AGENT); }
__device__ __forceinline__ unsigned xb_add(unsigned* p, unsigned v) { return __hip_atomic_fetch_add(p, v, __ATOMIC_RELAXED, __HIP_MEMORY_SCOPE_AGENT); }
__device__ __forceinline__ unsigned xb_xcc_id() { return (unsigned)__builtin_amdgcn_s_getreg((3 << 11) | 20) & 0xFu; }
#define XB_SPIN(cond, bar) do { unsigned _sp = 0; while (cond) { __builtin_amdgcn_s_sleep(1); \
    if ((++_sp & 255u) == 0u) { if (xb_ld(&(bar)[XB_TMO])) break; if (_sp > XB_SPIN_CAP) { atomicAdd(&(bar)[XB_TMO], 1u); break; } } } } while (0)

struct XcdBarrier {
    unsigned* bar; unsigned x;
    volatile LAS unsigned* st;
};

__device__ __forceinline__ XcdBarrier xcd_barrier_post(unsigned* bar, volatile LAS unsigned* st) {
    XcdBarrier b; b.bar = bar; b.x = xb_xcc_id(); b.st = st;
    if (threadIdx.x == 0) (void)xb_add(&bar[XB_XCNT(b.x)], 1u);
    return b;
}
__device__ __forceinline__ void xcd_barrier_complete(unsigned* bar, unsigned x, unsigned& nloc, unsigned& nx) {
    const unsigned G = gridDim.x * gridDim.y * gridDim.z;
    unsigned sum, cnt, mine, sp = 0u;
    for (;;) {
        sum = 0u; cnt = 0u; mine = 0u;
#pragma unroll
        for (unsigned j = 0; j < 16; ++j) { const unsigned c = xb_ld(&bar[XB_XCNT(j)]); sum += c; cnt += (c > 0u) ? 1u : 0u; mine = (j == x) ? c : mine; }
        if (sum == G) break;
        __builtin_amdgcn_s_sleep(1);
        if ((++sp & 255u) == 0u) { if (xb_ld(&bar[XB_TMO])) break; if (sp > XB_SPIN_CAP) { atomicAdd(&bar[XB_TMO], 1u); break; } }
    }
    nloc = mine > 0u ? mine : 1u; nx = cnt > 0u ? cnt : 1u;
}

__device__ __forceinline__ void xcd_barrier(const XcdBarrier& b) {
    asm volatile("s_waitcnt vmcnt(0)" ::: "memory");
    __syncthreads();
    if (threadIdx.x == 0) {
        unsigned* bar = b.bar;
        __builtin_amdgcn_s_waitcnt(0);
        unsigned nloc = b.st[0], nx = b.st[1];
        if (nloc == 0u) { xcd_barrier_complete(bar, b.x, nloc, nx); b.st[0] = nloc; b.st[1] = nx; }
        const unsigned old = xb_add(&bar[XB_XSUB(b.x)], 1u);
        const unsigned gen = old / nloc;
        if (old + 1u == (gen + 1u) * nloc) {
            __builtin_amdgcn_fence(__ATOMIC_RELEASE, "agent");
            asm volatile("s_waitcnt vmcnt(0)" ::: "memory");
            const unsigned og = xb_add(&bar[XB_TOP], 1u);
            const unsigned tg = og / nx;
            if (og + 1u == (tg + 1u) * nx) xb_add(&bar[XB_TOPGEN], 1u);
            else XB_SPIN(xb_ld(&bar[XB_TOPGEN]) == tg, bar);
            __builtin_amdgcn_fence(__ATOMIC_ACQUIRE, "agent");
            xb_add(&bar[XB_XGEN(b.x)], 1u);
            asm volatile("s_waitcnt vmcnt(0)" ::: "memory");
        } else {
            XB_SPIN(xb_ld(&bar[XB_XGEN(b.x)]) == gen, bar);
            __builtin_amdgcn_fence(__ATOMIC_ACQUIRE, "agent");
            asm volatile("s_waitcnt vmcnt(0)" ::: "memory");
        }
    }
    __syncthreads();
}

__device__ __forceinline__ void seam(const XcdBarrier& b0) { XcdBarrier b = b0; asm volatile("" : "+s"(b.bar)); asm volatile("" : "+s"(b.x)); xcd_barrier(b); }

__global__ void __launch_bounds__(512, 2) hymba_fwd(Params p) {
    extern __shared__ __attribute__((aligned(16))) unsigned char smem[];
    LAS unsigned char* lds = (LAS unsigned char*)smem;
    cg::grid_group grid = cg::this_grid();
    const int tid = threadIdx.x, lane = tid & 63, wave = __builtin_amdgcn_readfirstlane(tid >> 6);
    const int G = gridDim.x, bid = blockIdx.x;
    const int gw = bid * 8 + wave, ngw = G * 8, gtid = bid * 512 + tid, nthreads = G * 512;
    unsigned* ctl = (unsigned*)(p.ws + WS_CTL);
    volatile LAS unsigned* xst = (volatile LAS unsigned*)(lds + L_XBST);
    if (tid == 0) { xst[0] = 0u; xst[1] = 0u; }
    __syncthreads();
    const XcdBarrier xb = xcd_barrier_post((unsigned*)(p.ws + WS_BAR), xst);
    bf16_t* W1T = (bf16_t*)(p.ws + WS_W1T); bf16_t* W1D = (bf16_t*)(p.ws + WS_W1D); bf16_t* W2T = (bf16_t*)(p.ws + WS_W2T); bf16_t* W2D = (bf16_t*)(p.ws + WS_W2D);
    bf16_t* WIN = (bf16_t*)(p.ws + WS_WIN); bf16_t* WGLU = (bf16_t*)(p.ws + WS_WGLU); bf16_t* WOUT = (bf16_t*)(p.ws + WS_WOUT);
    bf16_t* HB = (bf16_t*)(p.ws + WS_H); bf16_t* AB = (bf16_t*)(p.ws + WS_A); bf16_t* XC = (bf16_t*)(p.ws + WS_XC);
    float* yout = p.out + O_Y;
    pg8::StaticOrder S;

    {
        convert_items(p, lds, CV_W1T, CV_W1D, gw, ngw, wave, lane);
        rms_phase(p.in[0], p.in[1], p.in[6], HB, gw, ngw, lane);
        for (int i = gtid; i < MS * D / 4; i += nthreads) ((f32x4*)(yout + (size_t)MP * D))[i] = ((const f32x4*)p.in[1])[i];
    }
    if (p.use_cg) grid.sync();
    seam(xb);
    for (int rep = 0; rep < REP_P1; ++rep) { S.init(M, 2 * FF, G, bid); pg8::gemm_phase<true>(lds, pg8::Gemm{HB, W1T, M, 2 * FF, D, D}, S, EpiGateUp{AB});
        { const int nfull = S.nwg % G; if (nfull > 0 && bid >= nfull) convert_items(p, lds, CV_W1D, CV_WIN, (bid - nfull) * 8 + wave, (G - nfull) * 8, wave, lane); else if (nfull == 0) convert_items(p, lds, CV_W1D, CV_WIN, gw, ngw, wave, lane); }
        if (gtid >= nthreads - 2048) {
            const int idx = gtid - (nthreads - 2048), g = idx >> 6, pp = idx & 63;
            const double lr = p.in[12][idx], li = p.in[13][idx], step = exp((double)p.in[14][g]);
            const double mag = exp(lr * step), ang = li * step;
            const double are = mag * cos(ang), aim = mag * sin(ang);
            const double den = lr * lr + li * li, nre = are - 1.0, nim = aim;
            const float cre = (float)((nre * lr + nim * li) / den), cim = (float)((nim * lr - nre * li) / den);
            float* ABf = (float*)(p.ws + WS_S5A); ABf[idx] = (float)are; ABf[2048 + idx] = (float)aim;
            bf16_t* BBAR = (bf16_t*)(p.ws + WS_BBAR); bf16_t* CMAT = (bf16_t*)(p.ws + WS_CMAT);
            const float* bre = p.in[15] + (size_t)idx * 16; const float* bim = p.in[16] + (size_t)idx * 16;
#pragma unroll
            for (int hh = 0; hh < 16; hh += 2) {
                const float r0 = cre * bre[hh] - cim * bim[hh], r1 = cre * bre[hh + 1] - cim * bim[hh + 1];
                const float i0 = cre * bim[hh] + cim * bre[hh], i1 = cre * bim[hh + 1] + cim * bre[hh + 1];
                *(unsigned*)(BBAR + ((size_t)(g * 128 + pp)) * 16 + hh) = pk2(r0, r1);
                *(unsigned*)(BBAR + ((size_t)(g * 128 + 64 + pp)) * 16 + hh) = pk2(i0, i1);
            }
#pragma unroll
            for (int hh = 0; hh < 16; ++hh) {
                const float cr = p.in[17][((size_t)g * 16 + hh) * 64 + pp], ci = p.in[18][((size_t)g * 16 + hh) * 64 + pp];
                const unsigned pk = pk2(cr, -ci);
                CMAT[((size_t)(g * 16 + hh)) * 128 + pp] = (bf16_t)(pk & 0xffff); CMAT[((size_t)(g * 16 + hh)) * 128 + 64 + pp] = (bf16_t)(pk >> 16);
            }
        }
        seam(xb); }
    { S.init(MP, D, G, bid); pg8::gemm_phase<true>(lds, pg8::Gemm{AB, W1D, MP, D, FF, FF}, S, EpiResid{p.in[0], p.in[1], yout, 0.5f});
      pg8::SplitOrder S2{8 * (FF / 256), G, bid, 256}; pg8::gemm_phase<false>(lds, pg8::Gemm{AB + (size_t)MP * FF, W1D, MS, D, 256, FF}, S2, EpiPart{(float*)(p.ws + WS_YS), 0.5f}); }
    { const int nsp = 8 * (FF / 256); if (G > nsp) { if (bid >= nsp) convert_items(p, lds, CV_WIN, CV_WGLU, (bid - nsp) * 8 + wave, (G - nsp) * 8, wave, lane); } else convert_items(p, lds, CV_WIN, CV_WGLU, gw, ngw, wave, lane); }
    seam(xb);
    rms_phase(yout, yout + (size_t)MP * D, p.in[10], HB, gw, ngw, lane, (const float*)(p.ws + WS_YS), FF / 256, yout + (size_t)MP * D);
    seam(xb);
    { S.init(M, NINP, G, bid); pg8::gemm_phase<true>(lds, pg8::Gemm{HB, WIN, M, NINP, D, D}, S, EpiProj{AB, (float*)(p.ws + WS_DTRAW)}); }
    { const int nfull = S.nwg % G; if (nfull > 0 && bid >= nfull) convert_items(p, lds, CV_WGLU, CV_W2T, (bid - nfull) * 8 + wave, (G - nfull) * 8, wave, lane); else if (nfull == 0) convert_items(p, lds, CV_WGLU, CV_W2T, gw, ngw, wave, lane); }
    seam(xb);
    for (int rep = 0; rep < REP_P5; ++rep) {
        for (int wi = gw; wi < 256 * 7; wi += ngw) { const int pair = wi / 7, sg = wi % 7; s5_wave_item<1>(p, lds + wave * 12800, pair & 31, pair >> 5, sg, (pair >> 5) * SEQ + sg * 256, 256, lane); }
        conv_phase(p, gtid, nthreads); seam(xb); }
    for (int rep = 0; rep < REP_P6; ++rep) {
        volatile LAS int* bc = (volatile LAS int*)(lds + L_BCAST);
        constexpr int N_SSDP = NB * NH, N_S5P = 256, N_S5S = 128, N_SSDS = NSB * NH / SMP_PAIRS;
        for (;;) {
            __syncthreads();
            if (tid == 0) *bc = (int)atomicAdd(&ctl[rep * 64], 1u);
            __syncthreads();
            int it = *bc;
            if (it >= N_SSDP + N_S5P + N_S5S + N_SSDS) break;
            if (it < N_SSDP) { ssd_prompt_item(p, lds, it / NH, it % NH); continue; }
            it -= N_SSDP;
            if (it < N_SSDS) { ssd_sample_item(p, it); continue; }
            it -= N_SSDS;
            if (it < N_S5P) { const int pair = it; s5_wave_item<2>(p, lds + wave * 12800, pair & 31, pair >> 5, wave, (pair >> 5) * SEQ + wave * 256, 256, lane); continue; }
            it -= N_S5P;
            { const int idx = it * 8 + wave; s5_wave_item<0>(p, lds + wave * 12800, idx & 31, 0, 0, MP + (idx >> 5) * 16, 16, lane); }
        }
        seam(xb);
    }
    { S.init(M, 512, G, bid); pg8::gemm_phase<true>(lds, pg8::Gemm{HB, WGLU, M, 512, 512, 512}, S, EpiGlu{HB, p.in[21], XC}); }
    { const int nglu = S.nwg; if (G > nglu) { if (bid >= nglu) convert_items(p, lds, CV_W2T, CV_END, (bid - nglu) * 8 + wave, (G - nglu) * 8, wave, lane); } else convert_items(p, lds, CV_W2T, CV_END, gw, ngw, wave, lane); }
    for (int rep = 0; rep < REP_P7; ++rep) { gatenorm_phase(p, gw, ngw, lane); seam(xb); }
    { S.init(MP, D, G, bid); pg8::gemm_phase<true>(lds, pg8::Gemm{XC, WOUT, MP, D, DMIX, DMIX}, S, EpiResid{yout, yout + (size_t)MP * D, yout, 1.0f});
      pg8::SplitOrder S2{8 * (DMIX / 256), G, bid, 256}; pg8::gemm_phase<false>(lds, pg8::Gemm{XC + (size_t)MP * DMIX, WOUT, MS, D, 256, DMIX}, S2, EpiPart{(float*)(p.ws + WS_YS), 1.0f}); }
    seam(xb);
    rms_phase(yout, yout + (size_t)MP * D, p.in[29], HB, gw, ngw, lane, (const float*)(p.ws + WS_YS), DMIX / 256, yout + (size_t)MP * D);
    seam(xb);
    { S.init(M, 2 * FF, G, bid); pg8::gemm_phase<true>(lds, pg8::Gemm{HB, W2T, M, 2 * FF, D, D}, S, EpiGateUp{AB}); }
    seam(xb);
    { S.init(MP, D, G, bid); pg8::gemm_phase<true>(lds, pg8::Gemm{AB, W2D, MP, D, FF, FF}, S, EpiResid{yout, yout + (size_t)MP * D, yout, 0.5f});
      pg8::SplitOrder S2{8 * (FF / 256), G, bid, 256}; pg8::gemm_phase<false>(lds, pg8::Gemm{AB + (size_t)MP * FF, W2D, MS, D, 256, FF}, S2, EpiPart{(float*)(p.ws + WS_YS), 0.5f}); }
    seam(xb);
    { int lane_f = lane; asm volatile("" : "+v"(lane_f));
    for (int m = gw * 4; m < M; m += ngw * 4) {
        f32x4 v[4][4], ww[4];
#pragma unroll
        for (int r = 0; r < 4; ++r)
#pragma unroll
            for (int j = 0; j < 4; ++j) v[r][j] = ((const f32x4*)(yout + (size_t)(m + r) * D))[lane_f + 64 * j];
        if (m >= MP) {
            const float* part = (const float*)(p.ws + WS_YS);
            for (int sl = 0; sl < FF / 256; ++sl) {
#pragma unroll
                for (int r = 0; r < 4; ++r)
#pragma unroll
                    for (int j = 0; j < 4; ++j) v[r][j] += ((const f32x4*)(part + ((size_t)sl * MS + (m + r - MP)) * D))[lane_f + 64 * j];
            }
        }
#pragma unroll
        for (int j = 0; j < 4; ++j) ww[j] = ((const f32x4*)p.in[33])[lane_f + 64 * j];
#pragma unroll
        for (int r = 0; r < 4; ++r) {
            float ss = 0.f;
#pragma unroll
            for (int j = 0; j < 4; ++j) ss += (v[r][j].x * v[r][j].x + v[r][j].y * v[r][j].y) + (v[r][j].z * v[r][j].z + v[r][j].w * v[r][j].w);
            const float rstd = rsqrtf(wave_sum(ss) * (1.f / D) + EPS);
#pragma unroll
            for (int j = 0; j < 4; ++j) ((f32x4*)(yout + (size_t)(m + r) * D))[lane_f + 64 * j] = v[r][j] * rstd * ww[j];
        }
    } }
}

extern "C" void kernel_launch(void* const* d_in, const int* in_sizes, int n_in, void* d_out, int out_size, void* d_ws, size_t ws_size, hipStream_t stream) {
    static int grid_blocks = 0;
    if (grid_blocks == 0) {
        if (n_in != 34 || ws_size < WS_END) { fprintf(stderr, "kernel_launch: unexpected n_in %d or ws_size %zu (< %zu)\n", n_in, ws_size, (size_t)WS_END); grid_blocks = -1; return; }
        int dev = 0, cus = 0, per_cu = 0;
        hipGetDevice(&dev);
        hipDeviceGetAttribute(&cus, hipDeviceAttributeMultiprocessorCount, dev);
        hipFuncSetAttribute((const void*)hymba_fwd, hipFuncAttributeMaxDynamicSharedMemorySize, LDS_BYTES);
        hipOccupancyMaxActiveBlocksPerMultiprocessor(&per_cu, (const void*)hymba_fwd, 512, LDS_BYTES);
        if (per_cu < 1) { fprintf(stderr, "kernel_launch: occupancy query says %d blocks/CU\n", per_cu); per_cu = 1; }
        grid_blocks = cus;
    }
    if (grid_blocks < 0) return;
    if (hipMemsetAsync((char*)d_ws + WS_CTL, 0, 16384, stream) != hipSuccess) { fprintf(stderr, "kernel_launch: memset failed\n"); return; }
    Params p{};
    for (int i = 0; i < 34; ++i) p.in[i] = (const float*)d_in[i];
    p.out = (float*)d_out; p.ws = (unsigned char*)d_ws;
    void* args[] = {&p};
    hipError_t e = hipLaunchCooperativeKernel((const void*)hymba_fwd, dim3(grid_blocks), dim3(512), args, LDS_BYTES, stream);
    if (e != hipSuccess) fprintf(stderr, "cooperative launch failed: %s (grid %d)\n", hipGetErrorString(e), grid_blocks);
}
```

```cpp
#include <hip/hip_runtime.h>
#include <hip/hip_cooperative_groups.h>
#include <cstdio>
#include <cstdint>
namespace cg = cooperative_groups;

#define LAS __attribute__((address_space(3)))
typedef unsigned short bf16_t;
typedef short bf16x8 __attribute__((ext_vector_type(8)));
typedef float f32x4 __attribute__((ext_vector_type(4)));
typedef float f32x2 __attribute__((ext_vector_type(2)));
typedef unsigned u32x4 __attribute__((ext_vector_type(4)));
typedef unsigned u32x2 __attribute__((ext_vector_type(2)));

constexpr int D = 1024, FF = 2816, NIN = 4632, NINP = 4864, DMIX = 2048;
constexpr int MP = 16384, MS = 512, M = MP + MS, SEQ = 2048, NB = 8, NSB = 128;
constexpr int XBC = 2560, SSDW = 1536, NH = 24;
constexpr float EPS = 1e-6f;
constexpr size_t O_Y = 0, O_S5RP = 17301504, O_S5IP = 17317888, O_SSDP = 17334272, O_CONVP = 18907136,
                 O_S5RS = 18968576, O_S5IS = 19230720, O_SSDS = 19492864, O_CONVS = 44658688;
constexpr size_t WS_CTL = 0, WS_BAR = 2048, WS_S5A = 16384, WS_BBAR = WS_S5A + 16384, WS_CMAT = WS_BBAR + 131072, WS_DTRAW = WS_CMAT + 131072,
                 WS_W1T = WS_DTRAW + (size_t)M * 24 * 4, WS_W1D = WS_W1T + (size_t)2 * FF * D * 2, WS_W2T = WS_W1D + (size_t)D * FF * 2,
                 WS_W2D = WS_W2T + (size_t)2 * FF * D * 2, WS_WIN = WS_W2D + (size_t)D * FF * 2, WS_WGLU = WS_WIN + (size_t)NINP * D * 2,
                 WS_WOUT = WS_WGLU + (size_t)512 * 512 * 2, WS_H = WS_WOUT + (size_t)D * DMIX * 2, WS_A = WS_H + (size_t)M * D * 2,
                 WS_XC = WS_A + (size_t)M * NINP * 2, WS_YS = WS_XC + (size_t)M * XBC * 2, WS_S5END = WS_YS + (size_t)M * SSDW * 2, WS_END = WS_S5END + (size_t)256 * 8 * 128 * 4;
constexpr size_t XC_BCN = 0, XC_XSN = (size_t)M * 1024 * 2, XC_XT = XC_XSN + (size_t)MS * SSDW * 2, H_BT = (size_t)M * 512 * 2;
constexpr int LDS_BYTES = 158720;
#define REP_P1 1
#define REP_P6 1
#define REP_P5 1
#define REP_P7 1
constexpr int L_BCAST = 158208, L_XBST = 158224;

struct Params {
    const float* in[34];
    float* out;
    unsigned char* ws;
    int use_cg; int pad;
};

__device__ __forceinline__ unsigned pk2(float lo, float hi) { unsigned r; asm volatile("v_cvt_pk_bf16_f32 %0, %1, %2" : "=v"(r) : "v"(lo), "v"(hi)); return r; }
__device__ __forceinline__ float bflo(unsigned u) { return __uint_as_float(u << 16); }
__device__ __forceinline__ float bfhi(unsigned u) { return __uint_as_float(u & 0xffff0000u); }
__device__ __forceinline__ float bf2f(bf16_t v) { return __uint_as_float((unsigned)v << 16); }
__device__ __forceinline__ float wave_sum(float v) {
#pragma unroll
    for (int o = 1; o < 64; o <<= 1) v += __shfl_xor(v, o);
    return v;
}
__device__ __forceinline__ float silu_f(float x) { return x / (1.f + __expf(-x)); }
__device__ __forceinline__ float sigmoid_f(float x) { return 1.f / (1.f + __expf(-x)); }
__device__ __forceinline__ float softplus_f(float x) { return fmaxf(x, 0.f) + log1pf(__expf(-fabsf(x))); }
__device__ __forceinline__ float gelu_tanh(float y) { const float a = 0.7978845608028654f * (y + 0.044715f * y * y * y); const float t = 1.f - 2.f / (1.f + __expf(2.f * a)); return 0.5f * y * (1.f + t); }
#define LDS_WAIT() asm volatile("s_waitcnt lgkmcnt(0)" ::: "memory")
#define LDS_BARRIER() do { asm volatile("s_waitcnt lgkmcnt(0)" ::: "memory"); __builtin_amdgcn_s_barrier(); asm volatile("" ::: "memory"); } while (0)

namespace pg8 {
constexpr int BM = 256, BK = 64, HALF = 128, HTB = HALF * BK * 2, STAGE_BYTES = 8 * HTB, NXCD = 8, WGM = 8;
__host__ __device__ __forceinline__ int lds_byte(int r, int c) { const int st = (r >> 4) * 2 + (c >> 5), rr = r & 15, cc = c & 31, ob = rr * 64 + cc * 2; return st * 1024 + (ob ^ (((ob >> 9) & 1) << 5)); }
__host__ __device__ __forceinline__ void stage_rc(int b, int& R, int& C) { const int st = b / 1024, sb = b % 1024, swz = sb ^ (((sb >> 9) & 1) << 5); R = (st >> 1) * 16 + swz / 64; C = (st & 1) * 32 + (swz % 64) / 2; }
struct Unit { int pm, pn, kofs; };
struct Gemm { const bf16_t* A; const bf16_t* Bt; int M, N, K, ld; };
struct StaticOrder {
    int nM, nN, nwg, G, c;
    __host__ __device__ void init(int M_, int N_, int G_, int c_) { nM = M_ / BM; nN = N_ / BM; nwg = nM * nN; G = G_; c = c_; }
    __host__ __device__ bool next(int i, Unit& u) const {
        const long L = (long)i * G + c; if (L >= nwg) return false;
        int wgid = (int)L; { const int q = nwg / NXCD, r = nwg % NXCD, xcd = wgid % NXCD, off = wgid / NXCD; wgid = (xcd < r ? xcd * (q + 1) : r * (q + 1) + (xcd - r) * q) + off; }
        const int nig = WGM * nN, gid = wgid / nig, fm = gid * WGM, gsz = (nM - fm) < WGM ? (nM - fm) : WGM;
        u.pm = fm + ((wgid % nig) % gsz); u.pn = (wgid % nig) / gsz; u.kofs = 0; return true;
    }
    __device__ __forceinline__ void a_ready(const Unit&) const {}
    __device__ __forceinline__ void done(const Unit&) const {}
};
struct SplitOrder {
    int nunits, G, c, kslice;
    __host__ __device__ bool next(int i, Unit& u) const { const int L = i * G + c; if (L >= nunits) return false; u.pm = L & 1; u.pn = (L >> 1) & 3; u.kofs = (L >> 3) * kslice; return true; }
    __device__ __forceinline__ void a_ready(const Unit&) const {}
    __device__ __forceinline__ void done(const Unit&) const {}
};

template <bool SP2, class Epi, class Sched>
__device__ __forceinline__ void gemm_phase(LAS unsigned char* lds, const Gemm g, const Sched& S, const Epi& E) {
    int tid = threadIdx.x; asm volatile("" : "+v"(tid));
    const int wid = __builtin_amdgcn_readfirstlane(tid >> 6), lane = tid & 63, wr = wid >> 2, wc = wid & 3, fr = lane & 15, fq = lane >> 4;
    const int K = g.K, nt = K / BK;
    int ldv = g.ld; asm volatile("" : "+s"(ldv));
    unsigned voffA[2], voffB[2];
#pragma unroll
    for (int i = 0; i < 2; ++i) { int R, C; stage_rc(tid * 16 + i * 8192, R, C); voffA[i] = (unsigned)(R * ldv + C) * 2u; voffB[i] = voffA[i]; }
    const size_t kstep = (size_t)(BK * 2);
    const size_t hstepA = (size_t)HALF * ldv * 2, hstepB = hstepA;
    const size_t tstepA = 2 * hstepA, tstepB = tstepA;
    const unsigned ldsw = (unsigned)wid * 1024u;
    const int aoff = lds_byte(wr * 64 + fr, fq * 8), boff = lds_byte(wc * 32 + fr, fq * 8);
#define PG8_SA(b, h) (((b) * 2 + (h)) * HTB)
#define PG8_SB(b, h) ((4 + (b) * 2 + (h)) * HTB)
#define PG8_STAGE(bufoff, gbase, voff) do { _Pragma("unroll") for (int _i = 0; _i < 2; ++_i) \
        __builtin_amdgcn_global_load_lds((const unsigned*)((const char*)(gbase) + (voff)[_i]), (LAS unsigned*)(lds + (bufoff) + ldsw + _i * 8192), 16, 0, 0); } while (0)
#define PG8_LDA(dst, b, h) do { _Pragma("unroll") for (int m = 0; m < 4; ++m) _Pragma("unroll") for (int k = 0; k < 2; ++k) dst[m][k] = *(const LAS bf16x8*)(lds + PG8_SA(b, h) + aoff + m * 2048 + k * 1024); } while (0)
#define PG8_LDB(dst, b, h) do { _Pragma("unroll") for (int n = 0; n < 2; ++n) _Pragma("unroll") for (int k = 0; k < 2; ++k) dst[n][k] = *(const LAS bf16x8*)(lds + PG8_SB(b, h) + boff + n * 2048 + k * 1024); } while (0)
#define PG8_MMA(ai, bj, At, Bt) do { __builtin_amdgcn_s_setprio(1); _Pragma("unroll") for (int m = 0; m < 4; ++m) _Pragma("unroll") for (int n = 0; n < 2; ++n) _Pragma("unroll") for (int k = 0; k < 2; ++k) \
        acc[ai][bj][m][n] = __builtin_amdgcn_mfma_f32_16x16x32_bf16(Bt[n][k], At[m][k], acc[ai][bj][m][n], 0, 0, 0); __builtin_amdgcn_s_setprio(0); } while (0)
#define PG8_WAIT_V(n) asm volatile("s_waitcnt vmcnt(" #n ")" ::: "memory")
#define PG8_WAIT_L(n) asm volatile("s_waitcnt lgkmcnt(" #n ")" ::: "memory")
#define PG8_BAR __builtin_amdgcn_s_barrier()
#define PG8_SCHED __builtin_amdgcn_sched_barrier(0)
    Unit cur, nxt; int ui = 0;
    if (!S.next(0, cur)) return;
    f32x4 acc[2][2][4][2];
#pragma unroll
    for (int a = 0; a < 2; ++a)
#pragma unroll
        for (int b = 0; b < 2; ++b)
#pragma unroll
            for (int m = 0; m < 4; ++m)
#pragma unroll
                for (int n = 0; n < 2; ++n) acc[a][b][m][n] = (f32x4){0.f, 0.f, 0.f, 0.f};
    bf16x8 At[4][2], B0[2][2], B1[2][2];
    const char* cA = (const char*)g.A + (size_t)cur.pm * tstepA + (size_t)cur.kofs * 2; const char* cB = (const char*)g.Bt + (size_t)cur.pn * tstepB + (size_t)cur.kofs * 2;
    S.a_ready(cur);
    if constexpr (SP2) {
        PG8_STAGE(PG8_SB(0, 0), cB, voffB); PG8_STAGE(PG8_SB(0, 1), cB + hstepB, voffB); PG8_STAGE(PG8_SA(0, 0), cA, voffA); PG8_STAGE(PG8_SA(0, 1), cA + hstepA, voffA);
        if (wr == 1) PG8_BAR;
        PG8_WAIT_V(2); PG8_BAR;
    } else {
        PG8_STAGE(PG8_SB(0, 0), cB, voffB); PG8_STAGE(PG8_SA(0, 0), cA, voffA); PG8_STAGE(PG8_SB(0, 1), cB + hstepB, voffB); PG8_STAGE(PG8_SA(0, 1), cA + hstepA, voffA);
        if (wr == 1) PG8_BAR;
        PG8_WAIT_V(4); PG8_BAR;
    }
    PG8_STAGE(PG8_SB(1, 0), cB + kstep, voffB); PG8_STAGE(PG8_SA(1, 0), cA + kstep, voffA); PG8_STAGE(PG8_SB(1, 1), cB + hstepB + kstep, voffB);
    PG8_WAIT_V(6); PG8_BAR;
    for (;;) {
        const bool has_next = S.next(ui + 1, nxt);
        const char* nA = has_next ? (const char*)g.A + (size_t)nxt.pm * tstepA + (size_t)nxt.kofs * 2 : cA; const char* nB = has_next ? (const char*)g.Bt + (size_t)nxt.pn * tstepB + (size_t)nxt.kofs * 2 : cB;
        for (int t = 0; t < nt; t += 2) {
            const bool last = (t == nt - 2);
            const char* a1 = cA + (size_t)(t + 1) * kstep;
            const char* a2 = last ? nA : cA + (size_t)(t + 2) * kstep; const char* b2 = last ? nB : cB + (size_t)(t + 2) * kstep;
            const char* a3 = a2 + kstep; const char* b3 = b2 + kstep;
            if (last && has_next) S.a_ready(nxt);
            if constexpr (SP2) {
            PG8_LDB(B0, 0, 0); PG8_LDB(B1, 0, 1); PG8_SCHED; PG8_LDA(At, 0, 0); PG8_STAGE(PG8_SA(1, 1), a1 + hstepA, voffA);
            PG8_WAIT_V(8); PG8_WAIT_L(0); PG8_BAR; PG8_MMA(0, 0, At, B0); PG8_MMA(0, 1, At, B1); PG8_BAR; PG8_SCHED;
            PG8_LDA(At, 0, 1); PG8_STAGE(PG8_SB(0, 0), b2, voffB); PG8_STAGE(PG8_SB(0, 1), b2 + hstepB, voffB); PG8_STAGE(PG8_SA(0, 0), a2, voffA);
            PG8_WAIT_V(8); PG8_WAIT_L(0); PG8_BAR; PG8_MMA(1, 0, At, B0); PG8_MMA(1, 1, At, B1); PG8_BAR; PG8_SCHED;
            PG8_LDB(B0, 1, 0); PG8_LDB(B1, 1, 1); PG8_SCHED; PG8_LDA(At, 1, 0); PG8_STAGE(PG8_SA(0, 1), a2 + hstepA, voffA);
            PG8_WAIT_V(8); PG8_WAIT_L(0); PG8_BAR; PG8_MMA(0, 0, At, B0); PG8_MMA(0, 1, At, B1); PG8_BAR; PG8_SCHED;
            PG8_LDA(At, 1, 1); PG8_STAGE(PG8_SB(1, 0), b3, voffB); PG8_STAGE(PG8_SB(1, 1), b3 + hstepB, voffB); PG8_STAGE(PG8_SA(1, 0), a3, voffA);
            PG8_WAIT_V(8); PG8_WAIT_L(0); PG8_BAR; PG8_MMA(1, 0, At, B0); PG8_MMA(1, 1, At, B1); PG8_BAR; PG8_SCHED;
            } else {
            PG8_LDB(B0, 0, 0); PG8_SCHED; PG8_LDA(At, 0, 0); PG8_STAGE(PG8_SA(1, 1), a1 + hstepA, voffA);
            PG8_WAIT_L(8); PG8_BAR; PG8_WAIT_L(0); PG8_MMA(0, 0, At, B0); PG8_BAR; PG8_SCHED;
            PG8_LDB(B1, 0, 1); PG8_STAGE(PG8_SB(0, 0), b2, voffB);
            PG8_BAR; PG8_WAIT_L(0); PG8_MMA(0, 1, At, B1); PG8_BAR;
            PG8_LDA(At, 0, 1); PG8_STAGE(PG8_SA(0, 0), a2, voffA);
            PG8_BAR; PG8_WAIT_L(0); PG8_MMA(1, 0, At, B0); PG8_BAR; PG8_SCHED;
            PG8_STAGE(PG8_SB(0, 1), b2 + hstepB, voffB);
            PG8_WAIT_V(6); PG8_BAR; PG8_MMA(1, 1, At, B1); PG8_BAR;
            PG8_LDB(B0, 1, 0); PG8_SCHED; PG8_LDA(At, 1, 0); PG8_STAGE(PG8_SA(0, 1), a2 + hstepA, voffA);
            PG8_WAIT_L(8); PG8_BAR; PG8_WAIT_L(0); PG8_MMA(0, 0, At, B0); PG8_BAR; PG8_SCHED;
            PG8_LDB(B1, 1, 1); PG8_STAGE(PG8_SB(1, 0), b3, voffB);
            PG8_BAR; PG8_WAIT_L(0); PG8_MMA(0, 1, At, B1); PG8_BAR;
            PG8_LDA(At, 1, 1); PG8_STAGE(PG8_SA(1, 0), a3, voffA);
            PG8_BAR; PG8_WAIT_L(0); PG8_MMA(1, 0, At, B0); PG8_BAR; PG8_SCHED;
            PG8_STAGE(PG8_SB(1, 1), b3 + hstepB, voffB);
            PG8_WAIT_V(6); PG8_BAR; PG8_MMA(1, 1, At, B1); PG8_BAR;
                    }
        }
        if constexpr (SP2) { if (wr == 0) PG8_BAR; }
        E(acc, cur, wr, wc, fr, fq); S.done(cur);
        if (!has_next) break;
#pragma unroll
        for (int a = 0; a < 2; ++a)
#pragma unroll
            for (int b = 0; b < 2; ++b)
#pragma unroll
                for (int m = 0; m < 4; ++m)
#pragma unroll
                    for (int n = 0; n < 2; ++n) acc[a][b][m][n] = (f32x4){0.f, 0.f, 0.f, 0.f};
        cur = nxt; cA = nA; cB = nB; ++ui;
        if constexpr (SP2) { if (wr == 1) PG8_BAR; }
    }
    PG8_WAIT_V(0);
    if constexpr (!SP2) { if (wr == 0) PG8_BAR; }
    PG8_BAR;
#undef PG8_SA
#undef PG8_SB
#undef PG8_STAGE
#undef PG8_LDA
#undef PG8_LDB
#undef PG8_MMA
#undef PG8_WAIT_V
#undef PG8_WAIT_L
#undef PG8_BAR
#undef PG8_SCHED
}
}
using pg8::Unit;

struct EpiGateUp {
    bf16_t* act;
    __device__ __forceinline__ void operator()(const f32x4 (&acc)[2][2][4][2], const Unit& u, int wr, int wc, int fr, int fq) const {
#pragma unroll
        for (int ai = 0; ai < 2; ++ai)
#pragma unroll
            for (int m = 0; m < 4; ++m) {
                const int r = u.pm * 256 + ai * 128 + wr * 64 + m * 16 + fr;
                const int j = u.pn * 128 + wc * 32 + 8 * fq;
                const f32x4 g0 = acc[ai][0][m][0], g1 = acc[ai][0][m][1], u0 = acc[ai][1][m][0], u1 = acc[ai][1][m][1];
                u32x4 o; o.x = pk2(silu_f(g0[0]) * u0[0], silu_f(g0[1]) * u0[1]); o.y = pk2(silu_f(g0[2]) * u0[2], silu_f(g0[3]) * u0[3]);
                o.z = pk2(silu_f(g1[0]) * u1[0], silu_f(g1[1]) * u1[1]); o.w = pk2(silu_f(g1[2]) * u1[2], silu_f(g1[3]) * u1[3]);
                *(u32x4*)(act + (size_t)r * FF + j) = o;
            }
    }
};
struct EpiResid {
    const float* rp; const float* rs; float* y; float scale;
    __device__ __forceinline__ void operator()(const f32x4 (&acc)[2][2][4][2], const Unit& u, int wr, int wc, int fr, int fq) const {
#pragma unroll
        for (int ai = 0; ai < 2; ++ai)
#pragma unroll
            for (int m = 0; m < 4; ++m) {
                const int r = u.pm * 256 + ai * 128 + wr * 64 + m * 16 + fr;
                const float* rrow = (r < MP) ? rp + (size_t)r * D : rs + (size_t)(r - MP) * D;
                float* yrow = y + (size_t)r * D;
#pragma unroll
                for (int bj = 0; bj < 2; ++bj)
#pragma unroll
                    for (int n = 0; n < 2; ++n) {
                        const int c = u.pn * 256 + bj * 128 + wc * 32 + n * 16 + 4 * fq;
                        const f32x4 rv = *(const f32x4*)(rrow + c);
                        *(f32x4*)(yrow + c) = rv + acc[ai][bj][m][n] * scale;
                    }
            }
    }
};
struct EpiPart {
    float* part; float scale;
    __device__ __forceinline__ void operator()(const f32x4 (&acc)[2][2][4][2], const Unit& u, int wr, int wc, int fr, int fq) const {
        float* pb = part + (size_t)(u.kofs >> 8) * MS * D;
#pragma unroll
        for (int ai = 0; ai < 2; ++ai)
#pragma unroll
            for (int m = 0; m < 4; ++m) {
                float* yrow = pb + (size_t)(u.pm * 256 + ai * 128 + wr * 64 + m * 16 + fr) * D;
#pragma unroll
                for (int bj = 0; bj < 2; ++bj)
#pragma unroll
                    for (int n = 0; n < 2; ++n) {
                        const int c = u.pn * 256 + bj * 128 + wc * 32 + n * 16 + 4 * fq;
                        *(f32x4*)(yrow + c) = acc[ai][bj][m][n] * scale;
                    }
            }
    }
};
struct EpiProj {
    bf16_t* proj; float* dtraw;
    __device__ __forceinline__ void operator()(const f32x4 (&acc)[2][2][4][2], const Unit& u, int wr, int wc, int fr, int fq) const {
#pragma unroll
        for (int ai = 0; ai < 2; ++ai)
#pragma unroll
            for (int m = 0; m < 4; ++m) {
                const int r = u.pm * 256 + ai * 128 + wr * 64 + m * 16 + fr;
#pragma unroll
                for (int bj = 0; bj < 2; ++bj) {
                    const int c = u.pn * 256 + bj * 128 + wc * 32 + 8 * fq;
                    const f32x4 v0 = acc[ai][bj][m][0], v1 = acc[ai][bj][m][1];
                    if (u.pn == 18) { if (c - 4608 < 24) { *(f32x4*)(dtraw + (size_t)r * 24 + (c - 4608)) = v0; *(f32x4*)(dtraw + (size_t)r * 24 + (c - 4608) + 4) = v1; } }
                    else { u32x4 o; o.x = pk2(v0[0], v0[1]); o.y = pk2(v0[2], v0[3]); o.z = pk2(v1[0], v1[1]); o.w = pk2(v1[2], v1[3]); *(u32x4*)(proj + (size_t)r * NINP + c) = o; }
                }
            }
    }
};
struct EpiGlu {
    const bf16_t* v; const float* bias; bf16_t* mix;
    __device__ __forceinline__ void operator()(const f32x4 (&acc)[2][2][4][2], const Unit& u, int wr, int wc, int fr, int fq) const {
#pragma unroll
        for (int ai = 0; ai < 2; ++ai)
#pragma unroll
            for (int m = 0; m < 4; ++m) {
                const int r = u.pm * 256 + ai * 128 + wr * 64 + m * 16 + fr;
#pragma unroll
                for (int bj = 0; bj < 2; ++bj)
#pragma unroll
                    for (int n = 0; n < 2; ++n) {
                        const int c = u.pn * 256 + bj * 128 + wc * 32 + n * 16 + 4 * fq;
                        const f32x4 a = acc[ai][bj][m][n]; const f32x4 bb = *(const f32x4*)(bias + c);
                        const u32x2 vv = *(const u32x2*)(v + (size_t)r * 512 + c);
                        u32x2 o; o.x = pk2(bflo(vv.x) * sigmoid_f(a[0] + bb[0]), bfhi(vv.x) * sigmoid_f(a[1] + bb[1]));
                        o.y = pk2(bflo(vv.y) * sigmoid_f(a[2] + bb[2]), bfhi(vv.y) * sigmoid_f(a[3] + bb[3]));
                        *(u32x2*)(mix + (size_t)r * DMIX + c) = o;
                    }
            }
    }
};

__device__ __forceinline__ void transpose_item(const float* W, int K, int N, bf16_t* WT, int mode, LAS float* scr, int item, int lane) {
    const int nblk = (N + 63) / 64, kb = item / nblk, nb = item % nblk, k0 = 64 * kb, n0 = 64 * nb;
    const int c4 = lane & 15, rr = lane >> 4, nn = n0 + 4 * c4;
    f32x4 v[16];
#pragma unroll
    for (int i = 0; i < 16; ++i) v[i] = (nn < N) ? *(const f32x4*)(W + (size_t)(k0 + 4 * i + rr) * N + nn) : (f32x4){0.f, 0.f, 0.f, 0.f};
#pragma unroll
    for (int i = 0; i < 16; ++i) { LAS float* d = scr + (4 * i + rr) * 65 + 4 * c4; d[0] = v[i][0]; d[1] = v[i][1]; d[2] = v[i][2]; d[3] = v[i][3]; }
    LDS_WAIT();
    const int c = lane & 7, nrow = lane >> 3;
#pragma unroll
    for (int j = 0; j < 8; ++j) { const int n = nrow + 8 * j; const LAS float* s = scr + (8 * c) * 65 + n;
        u32x4 o; o.x = pk2(s[0 * 65], s[1 * 65]); o.y = pk2(s[2 * 65], s[3 * 65]); o.z = pk2(s[4 * 65], s[5 * 65]); o.w = pk2(s[6 * 65], s[7 * 65]);
        const int jn = n0 + n;
        const int ip = 16 * ((jn >> 2) & 1) + 4 * ((jn >> 3) & 3) + (jn & 3);
        const int row = (mode == 0) ? jn : (mode == 3) ? ((jn & ~31) + ip) : ((jn >> 7) * 256 + ((jn & 127) & ~31) + ip + (mode == 5 ? 128 : 0));
        *(u32x4*)(WT + (size_t)row * K + k0 + 8 * c) = o; }
    LDS_WAIT();
}
constexpr int I_GU = (D / 64) * (FF / 64), I_DN = (FF / 64) * (D / 64), I_IN = (D / 64) * ((NIN + 63) / 64), I_GL = (512 / 64) * (512 / 64), I_OUT = (DMIX / 64) * (D / 64);
constexpr int CV_W1T = 0, CV_W1D = 2 * I_GU, CV_WIN = CV_W1D + I_DN, CV_WGLU = CV_WIN + I_IN, CV_WOUT = CV_WGLU + I_GL, CV_W2T = CV_WOUT + I_OUT, CV_W2D = CV_W2T + 2 * I_GU, CV_END = CV_W2D + I_DN;
__device__ __forceinline__ void convert_items(const Params& p, LAS unsigned char* lds, int lo, int hi, int gw, int ngw, int wave, int lane_in) {
    int lane = lane_in; asm volatile("" : "+v"(lane));
    LAS float* scr = (LAS float*)(lds + wave * 16640);
    for (int it = lo + gw; it < hi; it += ngw) {
        int r = it;
        if (r < CV_W1D) { if (r < I_GU) transpose_item(p.in[7], D, FF, (bf16_t*)(p.ws + WS_W1T), 4, scr, r, lane); else transpose_item(p.in[8], D, FF, (bf16_t*)(p.ws + WS_W1T), 5, scr, r - I_GU, lane); continue; }
        if (r < CV_WIN) { transpose_item(p.in[9], FF, D, (bf16_t*)(p.ws + WS_W1D), 0, scr, r - CV_W1D, lane); continue; }
        if (r < CV_WGLU) { transpose_item(p.in[11], D, NIN, (bf16_t*)(p.ws + WS_WIN), 3, scr, r - CV_WIN, lane); continue; }
        if (r < CV_WOUT) { transpose_item(p.in[20], 512, 512, (bf16_t*)(p.ws + WS_WGLU), 0, scr, r - CV_WGLU, lane); continue; }
        if (r < CV_W2T) { transpose_item(p.in[28], DMIX, D, (bf16_t*)(p.ws + WS_WOUT), 0, scr, r - CV_WOUT, lane); continue; }
        if (r < CV_W2D) { r -= CV_W2T; if (r < I_GU) transpose_item(p.in[30], D, FF, (bf16_t*)(p.ws + WS_W2T), 4, scr, r, lane); else transpose_item(p.in[31], D, FF, (bf16_t*)(p.ws + WS_W2T), 5, scr, r - I_GU, lane); continue; }
        transpose_item(p.in[32], FF, D, (bf16_t*)(p.ws + WS_W2D), 0, scr, r - CV_W2D, lane);
    }
}

__device__ __forceinline__ void sum_sample_row(const float* base, const float* part, int nsl, int ms, int lane, f32x4 (&v)[4]) {
#pragma unroll
    for (int j = 0; j < 4; ++j) v[j] = ((const f32x4*)(base + (size_t)ms * D))[lane + 64 * j];
    for (int s0 = 0; s0 < nsl; s0 += 4) {
        f32x4 t[4][4];
#pragma unroll
        for (int q = 0; q < 4; ++q) { const int sl = (s0 + q < nsl) ? s0 + q : nsl - 1;
#pragma unroll
            for (int j = 0; j < 4; ++j) t[q][j] = ((const f32x4*)(part + ((size_t)sl * MS + ms) * D))[lane + 64 * j]; }
#pragma unroll
        for (int q = 0; q < 4; ++q) { const float wq = (s0 + q < nsl) ? 1.f : 0.f;
#pragma unroll
            for (int j = 0; j < 4; ++j) v[j] += t[q][j] * wq; }
    }
}
__device__ __forceinline__ void rms_phase(const float* srcp, const float* srcs, const float* w, bf16_t* dst, int gw, int ngw, int lane_in, const float* part = nullptr, int nsl = 0, float* wb = nullptr) {
    int lane = lane_in; asm volatile("" : "+v"(lane));
    const int mend = (nsl > 0) ? MP : M;
    for (int m = gw * 4; m < mend; m += ngw * 4) {
        const float* xrow = (m < MP) ? srcp + (size_t)m * D : srcs + (size_t)(m - MP) * D;
        f32x4 v[4][4];
#pragma unroll
        for (int r = 0; r < 4; ++r)
#pragma unroll
            for (int j = 0; j < 4; ++j) v[r][j] = ((const f32x4*)(xrow + (size_t)r * D))[lane + 64 * j];
        f32x4 ww[4];
#pragma unroll
        for (int j = 0; j < 4; ++j) ww[j] = ((const f32x4*)w)[lane + 64 * j];
#pragma unroll
        for (int r = 0; r < 4; ++r) {
            float ss = 0.f;
#pragma unroll
            for (int j = 0; j < 4; ++j) ss += (v[r][j].x * v[r][j].x + v[r][j].y * v[r][j].y) + (v[r][j].z * v[r][j].z + v[r][j].w * v[r][j].w);
            const float rstd = rsqrtf(wave_sum(ss) * (1.f / D) + EPS);
            u32x2* o8 = (u32x2*)(dst + (size_t)(m + r) * D) + lane;
#pragma unroll
            for (int j = 0; j < 4; ++j) { u32x2 o; o.x = pk2(v[r][j].x * rstd * ww[j].x, v[r][j].y * rstd * ww[j].y); o.y = pk2(v[r][j].z * rstd * ww[j].z, v[r][j].w * rstd * ww[j].w); o8[64 * j] = o; }
        }
    }
    if (nsl > 0) {
        for (int ms = ngw - 1 - gw; ms < MS; ms += ngw) {
            f32x4 v[4]; sum_sample_row(srcs, part, nsl, ms, lane, v);
            float ss = 0.f;
#pragma unroll
            for (int j = 0; j < 4; ++j) { ((f32x4*)(wb + (size_t)ms * D))[lane + 64 * j] = v[j]; ss += (v[j].x * v[j].x + v[j].y * v[j].y) + (v[j].z * v[j].z + v[j].w * v[j].w); }
            const float rstd = rsqrtf(wave_sum(ss) * (1.f / D) + EPS);
            u32x2* o8 = (u32x2*)(dst + (size_t)(MP + ms) * D) + lane;
#pragma unroll
            for (int j = 0; j < 4; ++j) { const f32x4 ww = ((const f32x4*)w)[lane + 64 * j]; u32x2 o; o.x = pk2(v[j].x * rstd * ww.x, v[j].y * rstd * ww.y); o.y = pk2(v[j].z * rstd * ww.z, v[j].w * rstd * ww.w); o8[64 * j] = o; }
        }
    }
}

__device__ __forceinline__ void unpack8(const u32x4 u, float (&f)[8]) { f[0] = bflo(u.x); f[1] = bfhi(u.x); f[2] = bflo(u.y); f[3] = bfhi(u.y); f[4] = bflo(u.z); f[5] = bfhi(u.z); f[6] = bflo(u.w); f[7] = bfhi(u.w); }
#define BF_ELEM(v, e) ((((e) & 1) ? ((v)[(e) >> 1] >> 16) : ((v)[(e) >> 1] & 0xffffu)))
__device__ __forceinline__ void conv_phase(const Params& p, int gtid, int nthreads) {
    const bf16_t* proj = (const bf16_t*)(p.ws + WS_A);
    bf16_t* BCN = (bf16_t*)(p.ws + WS_XC + XC_BCN); bf16_t* XSN = (bf16_t*)(p.ws + WS_XC + XC_XSN); bf16_t* XT = (bf16_t*)(p.ws + WS_XC + XC_XT); bf16_t* BT = (bf16_t*)(p.ws + WS_H + H_BT);
    const float* cw = p.in[22]; const float* cb = p.in[23]; const float* sconv = p.in[5];
    const int NT_P = (MP / 16) * 320, NT_S = NSB * 320;
    for (int task = gtid; task < NT_P; task += nthreads) {
        const int cgp = task % 320, rb = task / 320, c0 = cgp * 8, m0 = rb * 16;
        const bool first = (m0 % SEQ) == 0, lastblk = (m0 % SEQ) == SEQ - 16;
        u32x4 raw[19];
#pragma unroll
        for (int i = 0; i < 19; ++i) raw[i] = (i >= 3 || !first) ? *(const u32x4*)(proj + (size_t)(m0 - 3 + i) * NINP + 2048 + c0) : (u32x4){0u, 0u, 0u, 0u};
        float w0[8], w1[8], w2[8], w3[8], bs[8];
#pragma unroll
        for (int e = 0; e < 8; e += 4) { *(f32x4*)&w0[e] = *(const f32x4*)(cw + c0 + e); *(f32x4*)&w1[e] = *(const f32x4*)(cw + XBC + c0 + e); *(f32x4*)&w2[e] = *(const f32x4*)(cw + 2 * XBC + c0 + e);
            *(f32x4*)&w3[e] = *(const f32x4*)(cw + 3 * XBC + c0 + e); *(f32x4*)&bs[e] = *(const f32x4*)(cb + c0 + e); }
        float r0[8], r1[8], r2[8];
        unpack8(raw[0], r0); unpack8(raw[1], r1); unpack8(raw[2], r2);
        u32x4 ov[16];
#pragma unroll
        for (int i = 0; i < 16; ++i) {
            float cur[8]; unpack8(raw[i + 3], cur);
            float o[8];
#pragma unroll
            for (int e = 0; e < 8; ++e) { const float cv = bs[e] + w0[e] * r0[e] + w1[e] * r1[e] + w2[e] * r2[e] + w3[e] * cur[e]; o[e] = silu_f(cv); r0[e] = r1[e]; r1[e] = r2[e]; r2[e] = cur[e]; }
            ov[i].x = pk2(o[0], o[1]); ov[i].y = pk2(o[2], o[3]); ov[i].z = pk2(o[4], o[5]); ov[i].w = pk2(o[6], o[7]);
            if (i >= 13 && lastblk) { float* d = p.out + O_CONVP + ((size_t)(m0 / SEQ) * 3 + (i - 13)) * XBC + c0; *(f32x4*)d = (f32x4){cur[0], cur[1], cur[2], cur[3]}; *(f32x4*)(d + 4) = (f32x4){cur[4], cur[5], cur[6], cur[7]}; }
        }
        const int bb = m0 / SEQ, t0 = m0 % SEQ, cc = t0 >> 7, l0 = t0 & 127;
        if (c0 >= 1536) {
            const int cn = c0 - 1536;
#pragma unroll
            for (int i = 0; i < 16; ++i) *(u32x4*)(BCN + (size_t)(m0 + i) * 1024 + cn) = ov[i];
        }
        if (c0 < 2048) {
            bf16_t* tb = (c0 < 1536) ? XT + ((((size_t)(bb * 16 + cc) * NH + (c0 >> 6)) * 64 + (c0 & 63)) * 128 + l0)
                                     : BT + ((((size_t)(bb * 16 + cc) * 4 + ((c0 - 1536) >> 7)) * 128 + ((c0 - 1536) & 127)) * 128 + l0);
            const bool odd = (gtid & 1) != 0;
            bf16_t* t1 = odd ? tb - 8 * 128 + 8 : tb;
            bf16_t* t2 = odd ? tb + 8 : tb + 8 * 128;
#pragma unroll
            for (int e = 0; e < 8; ++e) {
                u32x4 q0, q1;
                q0.x = BF_ELEM(ov[0], e) | (BF_ELEM(ov[1], e) << 16); q0.y = BF_ELEM(ov[2], e) | (BF_ELEM(ov[3], e) << 16); q0.z = BF_ELEM(ov[4], e) | (BF_ELEM(ov[5], e) << 16); q0.w = BF_ELEM(ov[6], e) | (BF_ELEM(ov[7], e) << 16);
                q1.x = BF_ELEM(ov[8], e) | (BF_ELEM(ov[9], e) << 16); q1.y = BF_ELEM(ov[10], e) | (BF_ELEM(ov[11], e) << 16); q1.z = BF_ELEM(ov[12], e) | (BF_ELEM(ov[13], e) << 16); q1.w = BF_ELEM(ov[14], e) | (BF_ELEM(ov[15], e) << 16);
                const u32x4 snd = odd ? q0 : q1; u32x4 rcv;
                rcv.x = __shfl_xor(snd.x, 1); rcv.y = __shfl_xor(snd.y, 1); rcv.z = __shfl_xor(snd.z, 1); rcv.w = __shfl_xor(snd.w, 1);
                *(u32x4*)(t1 + (size_t)e * 128) = odd ? rcv : q0;
                *(u32x4*)(t2 + (size_t)e * 128) = odd ? q1 : rcv;
            }
        }
    }
    for (int task = gtid; task < NT_S; task += nthreads) {
        const int cgp = task % 320, b = task / 320, c0 = cgp * 8, m0 = MP + b * 4;
        u32x4 raw[4];
#pragma unroll
        for (int i = 0; i < 4; ++i) raw[i] = *(const u32x4*)(proj + (size_t)(m0 + i) * NINP + 2048 + c0);
        float w0[8], w1[8], w2[8], w3[8], bs[8], r0[8], r1[8], r2[8];
        const float* st = sconv + (size_t)b * 3 * XBC + c0;
#pragma unroll
        for (int e = 0; e < 8; e += 4) { *(f32x4*)&w0[e] = *(const f32x4*)(cw + c0 + e); *(f32x4*)&w1[e] = *(const f32x4*)(cw + XBC + c0 + e); *(f32x4*)&w2[e] = *(const f32x4*)(cw + 2 * XBC + c0 + e);
            *(f32x4*)&w3[e] = *(const f32x4*)(cw + 3 * XBC + c0 + e); *(f32x4*)&bs[e] = *(const f32x4*)(cb + c0 + e);
            *(f32x4*)&r0[e] = *(const f32x4*)(st + e); *(f32x4*)&r1[e] = *(const f32x4*)(st + XBC + e); *(f32x4*)&r2[e] = *(const f32x4*)(st + 2 * XBC + e); }
#pragma unroll
        for (int i = 0; i < 4; ++i) {
            float cur[8]; unpack8(raw[i], cur);
            float o[8];
#pragma unroll
            for (int e = 0; e < 8; ++e) { const float cv = bs[e] + w0[e] * r0[e] + w1[e] * r1[e] + w2[e] * r2[e] + w3[e] * cur[e]; o[e] = silu_f(cv); r0[e] = r1[e]; r1[e] = r2[e]; r2[e] = cur[e]; }
            u32x4 ov; ov.x = pk2(o[0], o[1]); ov.y = pk2(o[2], o[3]); ov.z = pk2(o[4], o[5]); ov.w = pk2(o[6], o[7]);
            if (c0 < 1536) *(u32x4*)(XSN + (size_t)(m0 + i - MP) * SSDW + c0) = ov;
            else *(u32x4*)(BCN + (size_t)(m0 + i) * 1024 + (c0 - 1536)) = ov;
            if (i >= 1) { float* d = p.out + O_CONVS + ((size_t)b * 3 + (i - 1)) * XBC + c0; *(f32x4*)d = (f32x4){cur[0], cur[1], cur[2], cur[3]}; *(f32x4*)(d + 4) = (f32x4){cur[4], cur[5], cur[6], cur[7]}; }
        }
    }
}

constexpr int LROW = 272;
constexpr int L_C = 0, L_B = 34816, L_BT = 69632, L_XT = 104448, L_XS = 121856, L_HT = 139264, L_AC = 156672, L_DT = 157184, L_G = 157696;
__device__ __forceinline__ float wave_incl_scan(float v, int lane) {
#pragma unroll
    for (int o = 1; o < 64; o <<= 1) { const float t = __shfl_up(v, o); if (lane >= o) v += t; }
    return v;
}
__device__ __forceinline__ void ssd_prompt_item(const Params& p, LAS unsigned char* lds, int b, int h) {
    int tid = threadIdx.x; asm volatile("" : "+v"(tid));
    const int lane = tid & 63, w = __builtin_amdgcn_readfirstlane(tid >> 6), fr = lane & 15, fq = lane >> 4;
    const int g = h / 6;
    const bf16_t* BCN = (const bf16_t*)(p.ws + WS_XC + XC_BCN); const bf16_t* XT = (const bf16_t*)(p.ws + WS_XC + XC_XT); const bf16_t* BT = (const bf16_t*)(p.ws + WS_H + H_BT);
    const float* dtraw = (const float*)(p.ws + WS_DTRAW); bf16_t* ys = (bf16_t*)(p.ws + WS_YS);
    const float a_h = -__expf(p.in[25][h]), dtb = p.in[24][h], Dh = p.in[26][h];
    f32x4 hacc[4];
#pragma unroll
    for (int i = 0; i < 4; ++i) hacc[i] = (f32x4){0.f, 0.f, 0.f, 0.f};
    for (int i = tid; i < 64 * 17; i += 512) *(LAS u32x4*)(lds + L_HT + i * 16) = (u32x4){0u, 0u, 0u, 0u};
    const int prow = tid >> 4, pc = tid & 15;
    u32x4 pvc[4], pvb[4], pvt[4], pvx[2]; float pdl, pdh;
#define SSD_FETCH(cc) do { const int _m0 = b * SEQ + (cc) * 128; \
        pdl = dtraw[(size_t)(_m0 + lane) * 24 + h]; pdh = dtraw[(size_t)(_m0 + 64 + lane) * 24 + h]; \
        const bf16_t* _bt = BT + (((size_t)(b * 16 + (cc)) * 4 + g) * 128) * 128; const bf16_t* _xt = XT + (((size_t)(b * 16 + (cc)) * NH + h) * 64) * 128; \
        _Pragma("unroll") for (int j = 0; j < 4; ++j) { const bf16_t* _gr = BCN + (size_t)(_m0 + prow + 32 * j) * 1024 + g * 128 + pc * 8; pvb[j] = *(const u32x4*)_gr; pvc[j] = *(const u32x4*)(_gr + 512); \
            pvt[j] = *(const u32x4*)(_bt + (size_t)(prow + 32 * j) * 128 + pc * 8); } \
        _Pragma("unroll") for (int j = 0; j < 2; ++j) pvx[j] = *(const u32x4*)(_xt + (size_t)(prow + 32 * j) * 128 + pc * 8); } while (0)
    SSD_FETCH(0);
    for (int c = 0; c < 16; ++c) {
        const int m0 = b * SEQ + c * 128;
        const float dt_lo = softplus_f(pdl + dtb), dt_hi = softplus_f(pdh + dtb);
        const float ac_lo = wave_incl_scan(dt_lo * a_h, lane); const float tot_lo = __shfl(ac_lo, 63);
        const float ac_hi = wave_incl_scan(dt_hi * a_h, lane) + tot_lo; const float alast = __shfl(ac_hi, 63);
        const float sc_lo = dt_lo * __expf(alast - ac_lo), sc_hi = dt_hi * __expf(alast - ac_hi);
        if (w == 0) { const float ae_lo = __shfl(ac_lo, (lane & 48) + 15), ae_hi = __shfl(ac_hi, (lane & 48) + 15);
            *(LAS float*)(lds + L_G + lane * 4) = dt_lo * __expf(ae_lo - ac_lo); *(LAS float*)(lds + L_G + 256 + lane * 4) = dt_hi * __expf(ae_hi - ac_hi);
            *(LAS float*)(lds + L_AC + lane * 4) = ac_lo; *(LAS float*)(lds + L_AC + 256 + lane * 4) = ac_hi; *(LAS float*)(lds + L_DT + lane * 4) = dt_lo; *(LAS float*)(lds + L_DT + 256 + lane * 4) = dt_hi; }
        float sc[8];
#pragma unroll
        for (int e = 0; e < 8; ++e) { const int src = (pc * 8 + e) & 63; const float vlo = __shfl(sc_lo, src), vhi = __shfl(sc_hi, src); sc[e] = (pc < 8) ? vlo : vhi; }
#pragma unroll
        for (int j = 0; j < 4; ++j) {
            const int r = prow + 32 * j;
            *(LAS u32x4*)(lds + L_C + r * LROW + pc * 16) = pvc[j];
            *(LAS u32x4*)(lds + L_B + r * LROW + pc * 16) = pvb[j];
            *(LAS u32x4*)(lds + L_BT + r * LROW + pc * 16) = pvt[j];
        }
#pragma unroll
        for (int j = 0; j < 2; ++j) {
            const int r = prow + 32 * j;
            float xf[8]; unpack8(pvx[j], xf);
            *(LAS u32x4*)(lds + L_XT + r * LROW + pc * 16) = pvx[j];
            u32x4 q; q.x = pk2(xf[0] * sc[0], xf[1] * sc[1]); q.y = pk2(xf[2] * sc[2], xf[3] * sc[3]); q.z = pk2(xf[4] * sc[4], xf[5] * sc[5]); q.w = pk2(xf[6] * sc[6], xf[7] * sc[7]);
            *(LAS u32x4*)(lds + L_XS + r * LROW + pc * 16) = q;
        }
        LDS_BARRIER();
        if (c < 15) SSD_FETCH(c + 1);
        const int l = 16 * w + fr;
        bf16x8 cfrag[4];
#pragma unroll
        for (int ks = 0; ks < 4; ++ks) cfrag[ks] = *(const LAS bf16x8*)(lds + L_C + l * LROW + (ks * 32 + fq * 8) * 2);
        f32x4 yacc[4];
#pragma unroll
        for (int pb = 0; pb < 4; ++pb) {
            f32x4 a = (f32x4){0.f, 0.f, 0.f, 0.f};
#pragma unroll
            for (int ks = 0; ks < 4; ++ks) { const bf16x8 hf = *(const LAS bf16x8*)(lds + L_HT + (pb * 16 + fr) * LROW + (ks * 32 + fq * 8) * 2); a = __builtin_amdgcn_mfma_f32_16x16x32_bf16(hf, cfrag[ks], a, 0, 0, 0); }
            yacc[pb] = a;
        }
        const float al = *(const LAS float*)(lds + L_AC + l * 4);
        { const float el = __expf(al);
#pragma unroll
          for (int pb = 0; pb < 4; ++pb) yacc[pb] = yacc[pb] * el; }
        f32x4 cbt[8];
#pragma unroll
        for (int sb = 0; sb < 8; ++sb) {
            cbt[sb] = (f32x4){0.f, 0.f, 0.f, 0.f};
            if (sb <= w) {
                f32x4 a = (f32x4){0.f, 0.f, 0.f, 0.f};
#pragma unroll
                for (int ks = 0; ks < 4; ++ks) { const bf16x8 bf = *(const LAS bf16x8*)(lds + L_B + (sb * 16 + fr) * LROW + (ks * 32 + fq * 8) * 2); a = __builtin_amdgcn_mfma_f32_16x16x32_bf16(bf, cfrag[ks], a, 0, 0, 0); }
                cbt[sb] = a;
            }
        }
        LDS_BARRIER();
        const int nks = (w >> 1) + 1;
#pragma unroll
        for (int sb = 0; sb < 8; ++sb) {
            if (sb < 2 * nks) {
                const int s0 = sb * 16 + 4 * fq;
                float mv[4];
                if (sb < w) {
                    const float f = __expf(al - *(const LAS float*)(lds + L_AC + (sb * 16 + 15) * 4));
                    const f32x4 gs = *(const LAS f32x4*)(lds + L_G + s0 * 4);
#pragma unroll
                    for (int e = 0; e < 4; ++e) mv[e] = cbt[sb][e] * f * gs[e];
                } else if (sb == w) {
                    const f32x4 as = *(const LAS f32x4*)(lds + L_AC + s0 * 4), ds = *(const LAS f32x4*)(lds + L_DT + s0 * 4);
#pragma unroll
                    for (int e = 0; e < 4; ++e) { const float v = cbt[sb][e] * __expf(al - as[e]) * ds[e]; mv[e] = ((s0 + e) <= l) ? v : 0.f; if (s0 + e == l) mv[e] += Dh; }
                } else {
#pragma unroll
                    for (int e = 0; e < 4; ++e) mv[e] = 0.f;
                }
                u32x2 o; o.x = pk2(mv[0], mv[1]); o.y = pk2(mv[2], mv[3]);
                *(LAS u32x2*)(lds + L_B + l * LROW + s0 * 2) = o;
            }
        }
        LDS_WAIT();
#pragma unroll
        for (int ks = 0; ks < 4; ++ks) {
            if (ks < nks) {
                const bf16x8 mf = *(const LAS bf16x8*)(lds + L_B + l * LROW + (ks * 32 + fq * 8) * 2);
#pragma unroll
                for (int pb = 0; pb < 4; ++pb) { const bf16x8 xf = *(const LAS bf16x8*)(lds + L_XT + (pb * 16 + fr) * LROW + (ks * 32 + fq * 8) * 2); yacc[pb] = __builtin_amdgcn_mfma_f32_16x16x32_bf16(xf, mf, yacc[pb], 0, 0, 0); }
            }
        }
#pragma unroll
        for (int pb = 0; pb < 4; ++pb) {
            const int pcol = h * 64 + pb * 16 + 4 * fq;
            u32x2 o; o.x = pk2(yacc[pb][0], yacc[pb][1]); o.y = pk2(yacc[pb][2], yacc[pb][3]);
            *(u32x2*)(ys + (size_t)(m0 + l) * SSDW + pcol) = o;
        }
        { const float ea = __expf(alast);
#pragma unroll
          for (int pb = 0; pb < 4; ++pb) hacc[pb] = hacc[pb] * ea; }
#pragma unroll
        for (int ks = 0; ks < 4; ++ks) {
            const bf16x8 btf = *(const LAS bf16x8*)(lds + L_BT + (16 * w + fr) * LROW + (ks * 32 + fq * 8) * 2);
#pragma unroll
            for (int pb = 0; pb < 4; ++pb) { const bf16x8 xsf = *(const LAS bf16x8*)(lds + L_XS + (pb * 16 + fr) * LROW + (ks * 32 + fq * 8) * 2); hacc[pb] = __builtin_amdgcn_mfma_f32_16x16x32_bf16(btf, xsf, hacc[pb], 0, 0, 0); }
        }
#pragma unroll
        for (int pb = 0; pb < 4; ++pb) { u32x2 o; o.x = pk2(hacc[pb][0], hacc[pb][1]); o.y = pk2(hacc[pb][2], hacc[pb][3]); *(LAS u32x2*)(lds + L_HT + (pb * 16 + fr) * LROW + (16 * w + 4 * fq) * 2) = o; }
        LDS_BARRIER();
    }
    float* so = p.out + O_SSDP + ((size_t)(b * NH + h) * 64) * 128;
#pragma unroll
    for (int pb = 0; pb < 4; ++pb) *(f32x4*)(so + (size_t)(pb * 16 + fr) * 128 + 16 * w + 4 * fq) = hacc[pb];
}

template <int MODE>
__device__ __forceinline__ void s5_wave_item(const Params& p, LAS unsigned char* wl, int g, int bidx, int seg, int m_start, int nrows, int lane_in) {
    int lane = lane_in; asm volatile("" : "+v"(lane));
    const int fr = lane & 15, fq = lane >> 4;
    const bf16_t* proj = (const bf16_t*)(p.ws + WS_A); bf16_t* vbuf = (bf16_t*)(p.ws + WS_H);
    const bf16_t* BBAR = (const bf16_t*)(p.ws + WS_BBAR); const bf16_t* CMAT = (const bf16_t*)(p.ws + WS_CMAT); const float* AB = (const float*)(p.ws + WS_S5A);
    float* S5E = (float*)(p.ws + WS_S5END);
    const bf16x8 zf = (bf16x8){0, 0, 0, 0, 0, 0, 0, 0};
    bf16x8 bfrag[8], cfrag[4];
#pragma unroll
    for (int t = 0; t < 8; ++t) bfrag[t] = (fq < 2) ? *(const bf16x8*)(BBAR + ((size_t)(g * 128 + t * 16 + fr)) * 16 + fq * 8) : zf;
    if (MODE != 1) {
#pragma unroll
        for (int ks = 0; ks < 4; ++ks) cfrag[ks] = *(const bf16x8*)(CMAT + ((size_t)(g * 16 + fr)) * 128 + ks * 32 + fq * 8);
    }
    const float ar = AB[g * 64 + lane], ai = AB[2048 + g * 64 + lane];
    const f32x4 d4 = *(const f32x4*)(p.in[19] + g * 16 + 4 * fq);
    LAS float* sBu = (LAS float*)wl; LAS bf16_t* sS = (LAS bf16_t*)(wl + 8448);
    float sr = 0.f, si = 0.f;
    if (MODE == 2 && seg > 0) {
        float pr = ar, pi = ai;
#pragma unroll
        for (int q = 0; q < 8; ++q) { const float nr = pr * pr - pi * pi, ni = 2.f * pr * pi; pr = nr; pi = ni; }
        for (int j = 0; j < seg; ++j) {
            const float* e = S5E + ((size_t)((bidx * 32 + g) * 8 + j)) * 128;
            const float er = e[lane], ei = e[64 + lane];
            const float nr = pr * sr - pi * si + er, ni = pr * si + pi * sr + ei; sr = nr; si = ni;
        }
    }
    bf16x8 uf_n; u32x2 u4_n;
    { const bf16_t* urow = proj + (size_t)(m_start + fr) * NINP + g * 16; uf_n = (fq < 2) ? *(const bf16x8*)(urow + fq * 8) : zf; u4_n = *(const u32x2*)(urow + 4 * fq); }
    for (int m0 = m_start; m0 < m_start + nrows; m0 += 16) {
        const bf16x8 uf = uf_n; const u32x2 u4 = u4_n;
        { const int mn = (m0 + 16 < m_start + nrows) ? m0 + 16 : m0; const bf16_t* urow = proj + (size_t)(mn + fr) * NINP + g * 16; uf_n = (fq < 2) ? *(const bf16x8*)(urow + fq * 8) : zf; u4_n = *(const u32x2*)(urow + 4 * fq); }
#pragma unroll
        for (int t = 0; t < 8; ++t) {
            f32x4 a = (f32x4){0.f, 0.f, 0.f, 0.f};
            a = __builtin_amdgcn_mfma_f32_16x16x32_bf16(bfrag[t], uf, a, 0, 0, 0);
            *(LAS f32x4*)(sBu + fr * 132 + t * 16 + 4 * fq) = a;
        }
        LDS_WAIT();
        {
            float br[16], bi[16]; unsigned pkv[16];
#pragma unroll
            for (int t = 0; t < 16; ++t) { br[t] = sBu[t * 132 + lane]; bi[t] = sBu[t * 132 + 64 + lane]; }
            float s0r[4], s0i[4];
            if (MODE == 0) {
#pragma unroll
                for (int q = 0; q < 4; ++q) { const int bb = ((m0 - MP) >> 2) + q; s0r[q] = p.in[2][((size_t)bb * 32 + g) * 64 + lane]; s0i[q] = p.in[3][((size_t)bb * 32 + g) * 64 + lane]; }
            }
#pragma unroll
            for (int t = 0; t < 16; ++t) {
                if (MODE == 0 && (t & 3) == 0) { sr = s0r[t >> 2]; si = s0i[t >> 2]; }
                const float nr = ar * sr - ai * si + br[t], ni = ar * si + ai * sr + bi[t];
                sr = nr; si = ni;
                if (MODE != 1) pkv[t] = pk2(sr, si);
                if (MODE == 0 && (t & 3) == 3) { const int bb = (m0 - MP + t) >> 2; p.out[O_S5RS + ((size_t)bb * 32 + g) * 64 + lane] = sr; p.out[O_S5IS + ((size_t)bb * 32 + g) * 64 + lane] = si; }
            }
            if (MODE != 1) {
#pragma unroll
                for (int t = 0; t < 16; ++t) { sS[t * 136 + lane] = (bf16_t)(pkv[t] & 0xffff); sS[t * 136 + 64 + lane] = (bf16_t)(pkv[t] >> 16); }
            }
        }
        LDS_WAIT();
        if (MODE != 1) {
            f32x4 y = (f32x4){0.f, 0.f, 0.f, 0.f};
#pragma unroll
            for (int ks = 0; ks < 4; ++ks) { const bf16x8 sf = *(const LAS bf16x8*)(sS + fr * 136 + ks * 32 + fq * 8); y = __builtin_amdgcn_mfma_f32_16x16x32_bf16(cfrag[ks], sf, y, 0, 0, 0); }
            const float y0 = y[0] + d4[0] * bflo(u4.x), y1 = y[1] + d4[1] * bfhi(u4.x), y2 = y[2] + d4[2] * bflo(u4.y), y3 = y[3] + d4[3] * bfhi(u4.y);
            u32x2 o; o.x = pk2(gelu_tanh(y0), gelu_tanh(y1)); o.y = pk2(gelu_tanh(y2), gelu_tanh(y3));
            *(u32x2*)(vbuf + (size_t)(m0 + fr) * 512 + g * 16 + 4 * fq) = o;
            LDS_WAIT();
        }
    }
    if (MODE == 1) { float* e = S5E + ((size_t)((bidx * 32 + g) * 8 + seg)) * 128; e[lane] = sr; e[64 + lane] = si; }
    if (MODE == 2 && seg == 7) { p.out[O_S5RP + ((size_t)bidx * 32 + g) * 64 + lane] = sr; p.out[O_S5IP + ((size_t)bidx * 32 + g) * 64 + lane] = si; }
}

#define SMP_LOAD(HS, BS, CS, DS, XS_, PS, pr_) do { const int _b = (pr_) / NH, _h = (pr_) % NH, _g = _h / 6; \
        PS[0] = p.in[25][_h]; PS[1] = p.in[24][_h]; PS[2] = p.in[26][_h]; \
        const float* _h0 = p.in[4] + ((size_t)(_b * NH + _h) * 64 + pp) * 128 + n0; \
        _Pragma("unroll") for (int j = 0; j < 4; ++j) HS[j] = *(const f32x4*)(_h0 + 4 * j); \
        _Pragma("unroll") for (int t = 0; t < 4; ++t) { const int _m = MP + _b * 4 + t; const bf16_t* _row = BCN + (size_t)_m * 1024 + _g * 128 + n0; \
            DS[t] = dtraw[(size_t)_m * 24 + _h]; XS_[t] = *(const unsigned*)(XSN + (size_t)(_m - MP) * SSDW + _h * 64 + (pp & ~1)); \
            BS[t][0] = *(const u32x4*)_row; BS[t][1] = *(const u32x4*)(_row + 8); CS[t][0] = *(const u32x4*)(_row + 512); CS[t][1] = *(const u32x4*)(_row + 520); } } while (0)
#define SMP_COMPUTE(HS, BS, CS, DS, XS_, PS, pr_) do { const int _b = (pr_) / NH, _h = (pr_) % NH; \
        const float a_h = -__expf(PS[0]), dtb = PS[1], Dh = PS[2]; \
        float hv[16]; \
        _Pragma("unroll") for (int j = 0; j < 4; ++j) { hv[4 * j] = HS[j][0]; hv[4 * j + 1] = HS[j][1]; hv[4 * j + 2] = HS[j][2]; hv[4 * j + 3] = HS[j][3]; } \
        _Pragma("unroll") for (int t = 0; t < 4; ++t) { const int _m = MP + _b * 4 + t; \
            const float dt = softplus_f(DS[t] + dtb), dec = __expf(dt * a_h); const float xv = (pp & 1) ? bfhi(XS_[t]) : bflo(XS_[t]), xd = xv * dt; \
            float acc = 0.f; \
            _Pragma("unroll") for (int hf = 0; hf < 2; ++hf) { float Bv[8], Cv[8]; unpack8(BS[t][hf], Bv); unpack8(CS[t][hf], Cv); \
                _Pragma("unroll") for (int j = 0; j < 8; ++j) { hv[8 * hf + j] = hv[8 * hf + j] * dec + xd * Bv[j]; acc += hv[8 * hf + j] * Cv[j]; } } \
            acc += __shfl_xor(acc, 1); acc += __shfl_xor(acc, 2); acc += __shfl_xor(acc, 4); \
            if ((tid & 7) == 0) ys[(size_t)_m * SSDW + _h * 64 + pp] = (bf16_t)(pk2(acc + Dh * xv, 0.f) & 0xffff); } \
        float* _ho = p.out + O_SSDS + ((size_t)(_b * NH + _h) * 64 + pp) * 128 + n0; \
        _Pragma("unroll") for (int j = 0; j < 16; j += 4) *(f32x4*)(_ho + j) = (f32x4){hv[j], hv[j + 1], hv[j + 2], hv[j + 3]}; } while (0)
constexpr int SMP_PAIRS = 6;
__device__ __forceinline__ void ssd_sample_item(const Params& p, int item) {
    int tid = threadIdx.x; asm volatile("" : "+v"(tid));
    const int pp = tid >> 3, n0 = (tid & 7) * 16;
    const bf16_t* BCN = (const bf16_t*)(p.ws + WS_XC + XC_BCN); const bf16_t* XSN = (const bf16_t*)(p.ws + WS_XC + XC_XSN); const float* dtraw = (const float*)(p.ws + WS_DTRAW); bf16_t* ys = (bf16_t*)(p.ws + WS_YS);
    f32x4 hA[4], hB[4]; u32x4 bA[4][2], cA[4][2], bB[4][2], cB[4][2]; float dA[4], dB[4], sA3[3], sB3[3]; unsigned xA[4], xB[4];
    const int pr0 = item * SMP_PAIRS;
    SMP_LOAD(hA, bA, cA, dA, xA, sA3, pr0);
#pragma unroll
    for (int k = 0; k < SMP_PAIRS; k += 2) {
        const int pr = pr0 + k;
        SMP_LOAD(hB, bB, cB, dB, xB, sB3, pr + 1);
        SMP_COMPUTE(hA, bA, cA, dA, xA, sA3, pr);
        if (k + 2 < SMP_PAIRS) SMP_LOAD(hA, bA, cA, dA, xA, sA3, pr + 2);
        SMP_COMPUTE(hB, bB, cB, dB, xB, sB3, pr + 1);
    }
}

__device__ __forceinline__ void gatenorm_phase(const Params& p, int gw, int ngw, int lane_in) {
    int lane = lane_in; asm volatile("" : "+v"(lane));
    const bf16_t* proj = (const bf16_t*)(p.ws + WS_A); const bf16_t* ys = (const bf16_t*)(p.ws + WS_YS); bf16_t* mix = (bf16_t*)(p.ws + WS_XC);
    const float* nw = p.in[27];
    for (int m = gw * 2; m < M; m += ngw * 2) {
        u32x4 yr[2][3], zr[2][3];
#pragma unroll
        for (int r = 0; r < 2; ++r)
#pragma unroll
            for (int j = 0; j < 3; ++j) { const int c0 = (lane + 64 * j) * 8; yr[r][j] = *(const u32x4*)(ys + (size_t)(m + r) * SSDW + c0); zr[r][j] = *(const u32x4*)(proj + (size_t)(m + r) * NINP + 512 + c0); }
#pragma unroll
        for (int r = 0; r < 2; ++r) {
            float gv[3][8]; float sg[4] = {0.f, 0.f, 0.f, 0.f};
#pragma unroll
            for (int j = 0; j < 3; ++j) {
                float yv[8], zv[8]; unpack8(yr[r][j], yv); unpack8(zr[r][j], zv);
                float ss = 0.f;
#pragma unroll
                for (int e = 0; e < 8; ++e) { gv[j][e] = yv[e] * silu_f(zv[e]); ss += gv[j][e] * gv[j][e]; }
                const int grp = (lane + 64 * j) / 48;
#pragma unroll
                for (int q = 0; q < 4; ++q) sg[q] += (grp == q) ? ss : 0.f;
            }
            float rs[4];
#pragma unroll
            for (int q = 0; q < 4; ++q) rs[q] = rsqrtf(wave_sum(sg[q]) * (1.f / 384.f) + EPS);
#pragma unroll
            for (int j = 0; j < 3; ++j) {
                const int c0 = (lane + 64 * j) * 8, grp = (lane + 64 * j) / 48;
                const float rstd = grp == 0 ? rs[0] : (grp == 1 ? rs[1] : (grp == 2 ? rs[2] : rs[3]));
                const f32x4 n0 = *(const f32x4*)(nw + c0), n1 = *(const f32x4*)(nw + c0 + 4);
                u32x4 o; o.x = pk2(gv[j][0] * rstd * n0[0], gv[j][1] * rstd * n0[1]); o.y = pk2(gv[j][2] * rstd * n0[2], gv[j][3] * rstd * n0[3]);
                o.z = pk2(gv[j][4] * rstd * n1[0], gv[j][5] * rstd * n1[1]); o.w = pk2(gv[j][6] * rstd * n1[2], gv[j][7] * rstd * n1[3]);
                *(u32x4*)(mix + (size_t)(m + r) * DMIX + 512 + c0) = o;
            }
        }
    }
}

#define XB_TMO      128
#define XB_XCNT(j)  (256  + 64 * (j))
#define XB_XSUB(j)  (1280 + 64 * (j))
#define XB_XGEN(j)  (2304 + 64 * (j))
#define XB_TOP      3328
#define XB_TOPGEN   3392
#define XCD_BAR_WORDS 3456
#define XB_SPIN_CAP (1u << 18)

__device__ __forceinline__ unsigned xb_ld(unsigned* p)              { return __hip_atomic_load(p, __ATOMIC_RELAXED, __HIP_MEMORY_SCOPE_AGENT); }
__device__ __forceinline__ unsigned xb_add(unsigned* p, unsigned v) { return __hip_atomic_fetch_add(p, v, __ATOMIC_RELAXED, __HIP_MEMORY_SCOPE_AGENT); }
__device__ __forceinline__ unsigned xb_xcc_id() { return (unsigned)__builtin_amdgcn_s_getreg((3 << 11) | 20) & 0xFu; }
#define XB_SPIN(cond, bar) do { unsigned _sp = 0; while (cond) { __builtin_amdgcn_s_sleep(1); \
    if ((++_sp & 255u) == 0u) { if (xb_ld(&(bar)[XB_TMO])) break; if (_sp > XB_SPIN_CAP) { atomicAdd(&(bar)[XB_TMO], 1u); break; } } } } while (0)

struct XcdBarrier {
    unsigned* bar; unsigned x;
    volatile LAS unsigned* st;
};

__device__ __forceinline__ XcdBarrier xcd_barrier_post(unsigned* bar, volatile LAS unsigned* st) {
    XcdBarrier b; b.bar = bar; b.x = xb_xcc_id(); b.st = st;
    if (threadIdx.x == 0) (void)xb_add(&bar[XB_XCNT(b.x)], 1u);
    return b;
}
__device__ __forceinline__ void xcd_barrier_complete(unsigned* bar, unsigned x, unsigned& nloc, unsigned& nx) {
    const unsigned G = gridDim.x * gridDim.y * gridDim.z;
    unsigned sum, cnt, mine, sp = 0u;
    for (;;) {
        sum = 0u; cnt = 0u; mine = 0u;
#pragma unroll
        for (unsigned j = 0; j < 16; ++j) { const unsigned c = xb_ld(&bar[XB_XCNT(j)]); sum += c; cnt += (c > 0u) ? 1u : 0u; mine = (j == x) ? c : mine; }
        if (sum == G) break;
        __builtin_amdgcn_s_sleep(1);
        if ((++sp & 255u) == 0u) { if (xb_ld(&bar[XB_TMO])) break; if (sp > XB_SPIN_CAP) { atomicAdd(&bar[XB_TMO], 1u); break; } }
    }
    nloc = mine > 0u ? mine : 1u; nx = cnt > 0u ? cnt : 1u;
}

__device__ __forceinline__ void xcd_barrier(const XcdBarrier& b) {
    asm volatile("s_waitcnt vmcnt(0)" ::: "memory");
    __syncthreads();
    if (threadIdx.x == 0) {
        unsigned* bar = b.bar;
        __builtin_amdgcn_s_waitcnt(0);
        unsigned nloc = b.st[0], nx = b.st[1];
        if (nloc == 0u) { xcd_barrier_complete(bar, b.x, nloc, nx); b.st[0] = nloc; b.st[1] = nx; }
        const unsigned old = xb_add(&bar[XB_XSUB(b.x)], 1u);
        const unsigned gen = old / nloc;
        if (old + 1u == (gen + 1u) * nloc) {
            __builtin_amdgcn_fence(__ATOMIC_RELEASE, "agent");
            asm volatile("s_waitcnt vmcnt(0)" ::: "memory");
            const unsigned og = xb_add(&bar[XB_TOP], 1u);
            const unsigned tg = og / nx;
            if (og + 1u == (tg + 1u) * nx) xb_add(&bar[XB_TOPGEN], 1u);
            else XB_SPIN(xb_ld(&bar[XB_TOPGEN]) == tg, bar);
            __builtin_amdgcn_fence(__ATOMIC_ACQUIRE, "agent");
            xb_add(&bar[XB_XGEN(b.x)], 1u);
            asm volatile("s_waitcnt vmcnt(0)" ::: "memory");
        } else {
            XB_SPIN(xb_ld(&bar[XB_XGEN(b.x)]) == gen, bar);
            __builtin_amdgcn_fence(__ATOMIC_ACQUIRE, "agent");
            asm volatile("s_waitcnt vmcnt(0)" ::: "memory");
        }
    }
    __syncthreads();
}

__device__ __forceinline__ void seam(const XcdBarrier& b0) { XcdBarrier b = b0; asm volatile("" : "+s"(b.bar)); asm volatile("" : "+s"(b.x)); xcd_barrier(b); }

__global__ void __launch_bounds__(512, 2) hymba_fwd(Params p) {
    extern __shared__ __attribute__((aligned(16))) unsigned char smem[];
    LAS unsigned char* lds = (LAS unsigned char*)smem;
    cg::grid_group grid = cg::this_grid();
    const int tid = threadIdx.x, lane = tid & 63, wave = __builtin_amdgcn_readfirstlane(tid >> 6);
    const int G = gridDim.x, bid = blockIdx.x;
    const int gw = bid * 8 + wave, ngw = G * 8, gtid = bid * 512 + tid, nthreads = G * 512;
    unsigned* ctl = (unsigned*)(p.ws + WS_CTL);
    volatile LAS unsigned* xst = (volatile LAS unsigned*)(lds + L_XBST);
    if (tid == 0) { xst[0] = 0u; xst[1] = 0u; }
    __syncthreads();
    const XcdBarrier xb = xcd_barrier_post((unsigned*)(p.ws + WS_BAR), xst);
    bf16_t* W1T = (bf16_t*)(p.ws + WS_W1T); bf16_t* W1D = (bf16_t*)(p.ws + WS_W1D); bf16_t* W2T = (bf16_t*)(p.ws + WS_W2T); bf16_t* W2D = (bf16_t*)(p.ws + WS_W2D);
    bf16_t* WIN = (bf16_t*)(p.ws + WS_WIN); bf16_t* WGLU = (bf16_t*)(p.ws + WS_WGLU); bf16_t* WOUT = (bf16_t*)(p.ws + WS_WOUT);
    bf16_t* HB = (bf16_t*)(p.ws + WS_H); bf16_t* AB = (bf16_t*)(p.ws + WS_A); bf16_t* XC = (bf16_t*)(p.ws + WS_XC);
    float* yout = p.out + O_Y;
    pg8::StaticOrder S;

    {
        convert_items(p, lds, CV_W1T, CV_W1D, gw, ngw, wave, lane);
        rms_phase(p.in[0], p.in[1], p.in[6], HB, gw, ngw, lane);
        for (int i = gtid; i < MS * D / 4; i += nthreads) ((f32x4*)(yout + (size_t)MP * D))[i] = ((const f32x4*)p.in[1])[i];
    }
    if (p.use_cg) grid.sync();
    seam(xb);
    for (int rep = 0; rep < REP_P1; ++rep) { S.init(M, 2 * FF, G, bid); pg8::gemm_phase<true>(lds, pg8::Gemm{HB, W1T, M, 2 * FF, D, D}, S, EpiGateUp{AB});
        { const int nfull = S.nwg % G; if (nfull > 0 && bid >= nfull) convert_items(p, lds, CV_W1D, CV_WIN, (bid - nfull) * 8 + wave, (G - nfull) * 8, wave, lane); else if (nfull == 0) convert_items(p, lds, CV_W1D, CV_WIN, gw, ngw, wave, lane); }
        if (gtid >= nthreads - 2048) {
            const int idx = gtid - (nthreads - 2048), g = idx >> 6, pp = idx & 63;
            const double lr = p.in[12][idx], li = p.in[13][idx], step = exp((double)p.in[14][g]);
            const double mag = exp(lr * step), ang = li * step;
            const double are = mag * cos(ang), aim = mag * sin(ang);
            const double den = lr * lr + li * li, nre = are - 1.0, nim = aim;
            const float cre = (float)((nre * lr + nim * li) / den), cim = (float)((nim * lr - nre * li) / den);
            float* ABf = (float*)(p.ws + WS_S5A); ABf[idx] = (float)are; ABf[2048 + idx] = (float)aim;
            bf16_t* BBAR = (bf16_t*)(p.ws + WS_BBAR); bf16_t* CMAT = (bf16_t*)(p.ws + WS_CMAT);
            const float* bre = p.in[15] + (size_t)idx * 16; const float* bim = p.in[16] + (size_t)idx * 16;
#pragma unroll
            for (int hh = 0; hh < 16; hh += 2) {
                const float r0 = cre * bre[hh] - cim * bim[hh], r1 = cre * bre[hh + 1] - cim * bim[hh + 1];
                const float i0 = cre * bim[hh] + cim * bre[hh], i1 = cre * bim[hh + 1] + cim * bre[hh + 1];
                *(unsigned*)(BBAR + ((size_t)(g * 128 + pp)) * 16 + hh) = pk2(r0, r1);
                *(unsigned*)(BBAR + ((size_t)(g * 128 + 64 + pp)) * 16 + hh) = pk2(i0, i1);
            }
#pragma unroll
            for (int hh = 0; hh < 16; ++hh) {
                const float cr = p.in[17][((size_t)g * 16 + hh) * 64 + pp], ci = p.in[18][((size_t)g * 16 + hh) * 64 + pp];
                const unsigned pk = pk2(cr, -ci);
                CMAT[((size_t)(g * 16 + hh)) * 128 + pp] = (bf16_t)(pk & 0xffff); CMAT[((size_t)(g * 16 + hh)) * 128 + 64 + pp] = (bf16_t)(pk >> 16);
            }
        }
        seam(xb); }
    { S.init(MP, D, G, bid); pg8::gemm_phase<true>(lds, pg8::Gemm{AB, W1D, MP, D, FF, FF}, S, EpiResid{p.in[0], p.in[1], yout, 0.5f});
      pg8::SplitOrder S2{8 * (FF / 256), G, bid, 256}; pg8::gemm_phase<false>(lds, pg8::Gemm{AB + (size_t)MP * FF, W1D, MS, D, 256, FF}, S2, EpiPart{(float*)(p.ws + WS_YS), 0.5f}); }
    { const int nsp = 8 * (FF / 256); if (G > nsp) { if (bid >= nsp) convert_items(p, lds, CV_WIN, CV_WGLU, (bid - nsp) * 8 + wave, (G - nsp) * 8, wave, lane); } else convert_items(p, lds, CV_WIN, CV_WGLU, gw, ngw, wave, lane); }
    seam(xb);
    rms_phase(yout, yout + (size_t)MP * D, p.in[10], HB, gw, ngw, lane, (const float*)(p.ws + WS_YS), FF / 256, yout + (size_t)MP * D);
    seam(xb);
    { S.init(M, NINP, G, bid); pg8::gemm_phase<true>(lds, pg8::Gemm{HB, WIN, M, NINP, D, D}, S, EpiProj{AB, (float*)(p.ws + WS_DTRAW)}); }
    { const int nfull = S.nwg % G; if (nfull > 0 && bid >= nfull) convert_items(p, lds, CV_WGLU, CV_W2T, (bid - nfull) * 8 + wave, (G - nfull) * 8, wave, lane); else if (nfull == 0) convert_items(p, lds, CV_WGLU, CV_W2T, gw, ngw, wave, lane); }
    seam(xb);
    for (int rep = 0; rep < REP_P5; ++rep) {
        for (int wi = gw; wi < 256 * 7; wi += ngw) { const int pair = wi / 7, sg = wi % 7; s5_wave_item<1>(p, lds + wave * 12800, pair & 31, pair >> 5, sg, (pair >> 5) * SEQ + sg * 256, 256, lane); }
        conv_phase(p, gtid, nthreads); seam(xb); }
    for (int rep = 0; rep < REP_P6; ++rep) {
        volatile LAS int* bc = (volatile LAS int*)(lds + L_BCAST);
        constexpr int N_SSDP = NB * NH, N_S5P = 256, N_S5S = 128, N_SSDS = NSB * NH / SMP_PAIRS;
        for (;;) {
            __syncthreads();
            if (tid == 0) *bc = (int)atomicAdd(&ctl[rep * 64], 1u);
            __syncthreads();
            int it = *bc;
            if (it >= N_SSDP + N_S5P + N_S5S + N_SSDS) break;
            if (it < N_SSDP) { ssd_prompt_item(p, lds, it / NH, it % NH); continue; }
            it -= N_SSDP;
            if (it < N_SSDS) { ssd_sample_item(p, it); continue; }
            it -= N_SSDS;
            if (it < N_S5P) { const int pair = it; s5_wave_item<2>(p, lds + wave * 12800, pair & 31, pair >> 5, wave, (pair >> 5) * SEQ + wave * 256, 256, lane); continue; }
            it -= N_S5P;
            { const int idx = it * 8 + wave; s5_wave_item<0>(p, lds + wave * 12800, idx & 31, 0, 0, MP + (idx >> 5) * 16, 16, lane); }
        }
        seam(xb);
    }
    { S.init(M, 512, G, bid); pg8::gemm_phase<true>(lds, pg8::Gemm{HB, WGLU, M, 512, 512, 512}, S, EpiGlu{HB, p.in[21], XC}); }
    { const int nglu = S.nwg; if (G > nglu) { if (bid >= nglu) convert_items(p, lds, CV_W2T, CV_END, (bid - nglu) * 8 + wave, (G - nglu) * 8, wave, lane); } else convert_items(p, lds, CV_W2T, CV_END, gw, ngw, wave, lane); }
    for (int rep = 0; rep < REP_P7; ++rep) { gatenorm_phase(p, gw, ngw, lane); seam(xb); }
    { S.init(MP, D, G, bid); pg8::gemm_phase<true>(lds, pg8::Gemm{XC, WOUT, MP, D, DMIX, DMIX}, S, EpiResid{yout, yout + (size_t)MP * D, yout, 1.0f});
      pg8::SplitOrder S2{8 * (DMIX / 256), G, bid, 256}; pg8::gemm_phase<false>(lds, pg8::Gemm{XC + (size_t)MP * DMIX, WOUT, MS, D, 256, DMIX}, S2, EpiPart{(float*)(p.ws + WS_YS), 1.0f}); }
    seam(xb);
    rms_phase(yout, yout + (size_t)MP * D, p.in[29], HB, gw, ngw, lane, (const float*)(p.ws + WS_YS), DMIX / 256, yout + (size_t)MP * D);
    seam(xb);
    { S.init(M, 2 * FF, G, bid); pg8::gemm_phase<true>(lds, pg8::Gemm{HB, W2T, M, 2 * FF, D, D}, S, EpiGateUp{AB}); }
    seam(xb);
    { S.init(MP, D, G, bid); pg8::gemm_phase<true>(lds, pg8::Gemm{AB, W2D, MP, D, FF, FF}, S, EpiResid{yout, yout + (size_t)MP * D, yout, 0.5f});
      pg8::SplitOrder S2{8 * (FF / 256), G, bid, 256}; pg8::gemm_phase<false>(lds, pg8::Gemm{AB + (size_t)MP * FF, W2D, MS, D, 256, FF}, S2, EpiPart{(float*)(p.ws + WS_YS), 0.5f}); }
    seam(xb);
    { int lane_f = lane; asm volatile("" : "+v"(lane_f));
    for (int m = gw * 4; m < MP; m += ngw * 4) {
        f32x4 v[4][4], ww[4];
#pragma unroll
        for (int r = 0; r < 4; ++r)
#pragma unroll
            for (int j = 0; j < 4; ++j) v[r][j] = ((const f32x4*)(yout + (size_t)(m + r) * D))[lane_f + 64 * j];
#pragma unroll
        for (int j = 0; j < 4; ++j) ww[j] = ((const f32x4*)p.in[33])[lane_f + 64 * j];
#pragma unroll
        for (int r = 0; r < 4; ++r) {
            float ss = 0.f;
#pragma unroll
            for (int j = 0; j < 4; ++j) ss += (v[r][j].x * v[r][j].x + v[r][j].y * v[r][j].y) + (v[r][j].z * v[r][j].z + v[r][j].w * v[r][j].w);
            const float rstd = rsqrtf(wave_sum(ss) * (1.f / D) + EPS);
#pragma unroll
            for (int j = 0; j < 4; ++j) ((f32x4*)(yout + (size_t)(m + r) * D))[lane_f + 64 * j] = v[r][j] * rstd * ww[j];
        }
    }
    for (int ms = ngw - 1 - gw; ms < MS; ms += ngw) {
        f32x4 v[4]; sum_sample_row(yout + (size_t)MP * D, (const float*)(p.ws + WS_YS), FF / 256, ms, lane_f, v);
        float ss = 0.f;
#pragma unroll
        for (int j = 0; j < 4; ++j) ss += (v[j].x * v[j].x + v[j].y * v[j].y) + (v[j].z * v[j].z + v[j].w * v[j].w);
        const float rstd = rsqrtf(wave_sum(ss) * (1.f / D) + EPS);
#pragma unroll
        for (int j = 0; j < 4; ++j) ((f32x4*)(yout + (size_t)(MP + ms) * D))[lane_f + 64 * j] = v[j] * rstd * ((const f32x4*)p.in[33])[lane_f + 64 * j];
    } }
}

extern "C" void kernel_launch(void* const* d_in, const int* in_sizes, int n_in, void* d_out, int out_size, void* d_ws, size_t ws_size, hipStream_t stream) {
    static int grid_blocks = 0;
    if (grid_blocks == 0) {
        if (n_in != 34 || ws_size < WS_END) { fprintf(stderr, "kernel_launch: unexpected n_in %d or ws_size %zu (< %zu)\n", n_in, ws_size, (size_t)WS_END); grid_blocks = -1; return; }
        int dev = 0, cus = 0, per_cu = 0;
        hipGetDevice(&dev);
        hipDeviceGetAttribute(&cus, hipDeviceAttributeMultiprocessorCount, dev);
        hipFuncSetAttribute((const void*)hymba_fwd, hipFuncAttributeMaxDynamicSharedMemorySize, LDS_BYTES);
        hipOccupancyMaxActiveBlocksPerMultiprocessor(&per_cu, (const void*)hymba_fwd, 512, LDS_BYTES);
        if (per_cu < 1) { fprintf(stderr, "kernel_launch: occupancy query says %d blocks/CU\n", per_cu); per_cu = 1; }
        grid_blocks = cus;
    }
    if (grid_blocks < 0) return;
    if (hipMemsetAsync((char*)d_ws + WS_CTL, 0, 16384, stream) != hipSuccess) { fprintf(stderr, "kernel_launch: memset failed\n"); return; }
    Params p{};
    for (int i = 0; i < 34; ++i) p.in[i] = (const float*)d_in[i];
    p.out = (float*)d_out; p.ws = (unsigned char*)d_ws;
    void* args[] = {&p};
    hipError_t e = hipLaunchCooperativeKernel((const void*)hymba_fwd, dim3(grid_blocks), dim3(512), args, LDS_BYTES, stream);
    if (e != hipSuccess) fprintf(stderr, "cooperative launch failed: %s (grid %d)\n", hipGetErrorString(e), grid_blocks);
}
```

```cpp
#include <hip/hip_runtime.h>
#include <hip/hip_cooperative_groups.h>
#include <cstdio>
#include <cstdint>
namespace cg = cooperative_groups;

#define LAS __attribute__((address_space(3)))
typedef unsigned short bf16_t;
typedef short bf16x8 __attribute__((ext_vector_type(8)));
typedef float f32x4 __attribute__((ext_vector_type(4)));
typedef float f32x2 __attribute__((ext_vector_type(2)));
typedef unsigned u32x4 __attribute__((ext_vector_type(4)));
typedef unsigned u32x2 __attribute__((ext_vector_type(2)));

constexpr int D = 1024, FF = 2816, NIN = 4632, NINP = 4864, DMIX = 2048;
constexpr int MP = 16384, MS = 512, M = MP + MS, SEQ = 2048, NB = 8, NSB = 128;
constexpr int XBC = 2560, SSDW = 1536, NH = 24;
constexpr float EPS = 1e-6f;
constexpr size_t O_Y = 0, O_S5RP = 17301504, O_S5IP = 17317888, O_SSDP = 17334272, O_CONVP = 18907136,
                 O_S5RS = 18968576, O_S5IS = 19230720, O_SSDS = 19492864, O_CONVS = 44658688;
constexpr size_t WS_CTL = 0, WS_BAR = 2048, WS_S5A = 16384, WS_BBAR = WS_S5A + 16384, WS_CMAT = WS_BBAR + 131072, WS_DTRAW = WS_CMAT + 131072,
                 WS_W1T = WS_DTRAW + (size_t)M * 24 * 4, WS_W1D = WS_W1T + (size_t)2 * FF * D * 2, WS_W2T = WS_W1D + (size_t)D * FF * 2,
                 WS_W2D = WS_W2T + (size_t)2 * FF * D * 2, WS_WIN = WS_W2D + (size_t)D * FF * 2, WS_WGLU = WS_WIN + (size_t)NINP * D * 2,
                 WS_WOUT = WS_WGLU + (size_t)512 * 512 * 2, WS_H = WS_WOUT + (size_t)D * DMIX * 2, WS_A = WS_H + (size_t)M * D * 2,
                 WS_XC = WS_A + (size_t)M * NINP * 2, WS_YS = WS_XC + (size_t)M * XBC * 2, WS_S5END = WS_YS + (size_t)M * SSDW * 2, WS_END = WS_S5END + (size_t)256 * 8 * 128 * 4;
constexpr size_t XC_BCN = 0, XC_XSN = (size_t)M * 1024 * 2, XC_XT = XC_XSN + (size_t)MS * SSDW * 2, H_BT = (size_t)M * 512 * 2;
constexpr int LDS_BYTES = 158720;
#define REP_P1 1
#define REP_P6 1
#define REP_P5 1
#define REP_P7 1
constexpr int L_BCAST = 158208, L_XBST = 158224;

struct Params {
    const float* in[34];
    float* out;
    unsigned char* ws;
    int use_cg; int pad;
};

__device__ __forceinline__ unsigned pk2(float lo, float hi) { unsigned r; asm volatile("v_cvt_pk_bf16_f32 %0, %1, %2" : "=v"(r) : "v"(lo), "v"(hi)); return r; }
__device__ __forceinline__ float bflo(unsigned u) { return __uint_as_float(u << 16); }
__device__ __forceinline__ float bfhi(unsigned u) { return __uint_as_float(u & 0xffff0000u); }
__device__ __forceinline__ float bf2f(bf16_t v) { return __uint_as_float((unsigned)v << 16); }
__device__ __forceinline__ float wave_sum(float v) {
#pragma unroll
    for (int o = 1; o < 64; o <<= 1) v += __shfl_xor(v, o);
    return v;
}
__device__ __forceinline__ float silu_f(float x) { return x * __builtin_amdgcn_rcpf(1.f + __expf(-x)); }
__device__ __forceinline__ float sigmoid_f(float x) { return __builtin_amdgcn_rcpf(1.f + __expf(-x)); }
__device__ __forceinline__ float softplus_f(float x) { return fmaxf(x, 0.f) + log1pf(__expf(-fabsf(x))); }
__device__ __forceinline__ float gelu_tanh(float y) { const float a = 0.7978845608028654f * (y + 0.044715f * y * y * y); const float t = 1.f - 2.f * __builtin_amdgcn_rcpf(1.f + __expf(2.f * a)); return 0.5f * y * (1.f + t); }
#define LDS_WAIT() asm volatile("s_waitcnt lgkmcnt(0)" ::: "memory")
#define LDS_BARRIER() do { asm volatile("s_waitcnt lgkmcnt(0)" ::: "memory"); __builtin_amdgcn_s_barrier(); asm volatile("" ::: "memory"); } while (0)

namespace pg8 {
constexpr int BM = 256, BK = 64, HALF = 128, HTB = HALF * BK * 2, STAGE_BYTES = 8 * HTB, NXCD = 8, WGM = 8;
__host__ __device__ __forceinline__ int lds_byte(int r, int c) { const int st = (r >> 4) * 2 + (c >> 5), rr = r & 15, cc = c & 31, ob = rr * 64 + cc * 2; return st * 1024 + (ob ^ (((ob >> 9) & 1) << 5)); }
__host__ __device__ __forceinline__ void stage_rc(int b, int& R, int& C) { const int st = b / 1024, sb = b % 1024, swz = sb ^ (((sb >> 9) & 1) << 5); R = (st >> 1) * 16 + swz / 64; C = (st & 1) * 32 + (swz % 64) / 2; }
struct Unit { int pm, pn, kofs; };
struct Gemm { const bf16_t* A; const bf16_t* Bt; int M, N, K, ld; };
struct StaticOrder {
    int nM, nN, nwg, G, c;
    __host__ __device__ void init(int M_, int N_, int G_, int c_) { nM = M_ / BM; nN = N_ / BM; nwg = nM * nN; G = G_; c = c_; }
    __host__ __device__ bool next(int i, Unit& u) const {
        const long L = (long)i * G + c; if (L >= nwg) return false;
        int wgid = (int)L; { const int q = nwg / NXCD, r = nwg % NXCD, xcd = wgid % NXCD, off = wgid / NXCD; wgid = (xcd < r ? xcd * (q + 1) : r * (q + 1) + (xcd - r) * q) + off; }
        const int nig = WGM * nN, gid = wgid / nig, fm = gid * WGM, gsz = (nM - fm) < WGM ? (nM - fm) : WGM;
        u.pm = fm + ((wgid % nig) % gsz); u.pn = (wgid % nig) / gsz; u.kofs = 0; return true;
    }
    __device__ __forceinline__ void a_ready(const Unit&) const {}
    __device__ __forceinline__ void done(const Unit&) const {}
};
struct SplitOrder {
    int nunits, G, c, kslice;
    __host__ __device__ bool next(int i, Unit& u) const { const int L = i * G + c; if (L >= nunits) return false; u.pm = L & 1; u.pn = (L >> 1) & 3; u.kofs = (L >> 3) * kslice; return true; }
    __device__ __forceinline__ void a_ready(const Unit&) const {}
    __device__ __forceinline__ void done(const Unit&) const {}
};

template <bool SP2, class Epi, class Sched>
__device__ __forceinline__ void gemm_phase(LAS unsigned char* lds, const Gemm g, const Sched& S, const Epi& E) {
    int tid = threadIdx.x; asm volatile("" : "+v"(tid));
    const int wid = __builtin_amdgcn_readfirstlane(tid >> 6), lane = tid & 63, wr = wid >> 2, wc = wid & 3, fr = lane & 15, fq = lane >> 4;
    const int K = g.K, nt = K / BK;
    int ldv = g.ld; asm volatile("" : "+s"(ldv));
    unsigned voffA[2], voffB[2];
#pragma unroll
    for (int i = 0; i < 2; ++i) { int R, C; stage_rc(tid * 16 + i * 8192, R, C); voffA[i] = (unsigned)(R * ldv + C) * 2u; voffB[i] = voffA[i]; }
    const size_t kstep = (size_t)(BK * 2);
    const size_t hstepA = (size_t)HALF * ldv * 2, hstepB = hstepA;
    const size_t tstepA = 2 * hstepA, tstepB = tstepA;
    const unsigned ldsw = (unsigned)wid * 1024u;
    const int aoff = lds_byte(wr * 64 + fr, fq * 8), boff = lds_byte(wc * 32 + fr, fq * 8);
#define PG8_SA(b, h) (((b) * 2 + (h)) * HTB)
#define PG8_SB(b, h) ((4 + (b) * 2 + (h)) * HTB)
#define PG8_STAGE(bufoff, gbase, voff) do { _Pragma("unroll") for (int _i = 0; _i < 2; ++_i) \
        __builtin_amdgcn_global_load_lds((const unsigned*)((const char*)(gbase) + (voff)[_i]), (LAS unsigned*)(lds + (bufoff) + ldsw + _i * 8192), 16, 0, 0); } while (0)
#define PG8_LDA(dst, b, h) do { _Pragma("unroll") for (int m = 0; m < 4; ++m) _Pragma("unroll") for (int k = 0; k < 2; ++k) dst[m][k] = *(const LAS bf16x8*)(lds + PG8_SA(b, h) + aoff + m * 2048 + k * 1024); } while (0)
#define PG8_LDB(dst, b, h) do { _Pragma("unroll") for (int n = 0; n < 2; ++n) _Pragma("unroll") for (int k = 0; k < 2; ++k) dst[n][k] = *(const LAS bf16x8*)(lds + PG8_SB(b, h) + boff + n * 2048 + k * 1024); } while (0)
#define PG8_MMA(ai, bj, At, Bt) do { __builtin_amdgcn_s_setprio(1); _Pragma("unroll") for (int m = 0; m < 4; ++m) _Pragma("unroll") for (int n = 0; n < 2; ++n) _Pragma("unroll") for (int k = 0; k < 2; ++k) \
        acc[ai][bj][m][n] = __builtin_amdgcn_mfma_f32_16x16x32_bf16(Bt[n][k], At[m][k], acc[ai][bj][m][n], 0, 0, 0); __builtin_amdgcn_s_setprio(0); } while (0)
#define PG8_WAIT_V(n) asm volatile("s_waitcnt vmcnt(" #n ")" ::: "memory")
#define PG8_WAIT_L(n) asm volatile("s_waitcnt lgkmcnt(" #n ")" ::: "memory")
#define PG8_BAR __builtin_amdgcn_s_barrier()
#define PG8_SCHED __builtin_amdgcn_sched_barrier(0)
    Unit cur, nxt; int ui = 0;
    if (!S.next(0, cur)) return;
    f32x4 acc[2][2][4][2];
#pragma unroll
    for (int a = 0; a < 2; ++a)
#pragma unroll
        for (int b = 0; b < 2; ++b)
#pragma unroll
            for (int m = 0; m < 4; ++m)
#pragma unroll
                for (int n = 0; n < 2; ++n) acc[a][b][m][n] = (f32x4){0.f, 0.f, 0.f, 0.f};
    bf16x8 At[4][2], B0[2][2], B1[2][2];
    const char* cA = (const char*)g.A + (size_t)cur.pm * tstepA + (size_t)cur.kofs * 2; const char* cB = (const char*)g.Bt + (size_t)cur.pn * tstepB + (size_t)cur.kofs * 2;
    S.a_ready(cur);
    if constexpr (SP2) {
        PG8_STAGE(PG8_SB(0, 0), cB, voffB); PG8_STAGE(PG8_SB(0, 1), cB + hstepB, voffB); PG8_STAGE(PG8_SA(0, 0), cA, voffA); PG8_STAGE(PG8_SA(0, 1), cA + hstepA, voffA);
        if (wr == 1) PG8_BAR;
        PG8_WAIT_V(2); PG8_BAR;
    } else {
        PG8_STAGE(PG8_SB(0, 0), cB, voffB); PG8_STAGE(PG8_SA(0, 0), cA, voffA); PG8_STAGE(PG8_SB(0, 1), cB + hstepB, voffB); PG8_STAGE(PG8_SA(0, 1), cA + hstepA, voffA);
        if (wr == 1) PG8_BAR;
        PG8_WAIT_V(4); PG8_BAR;
    }
    PG8_STAGE(PG8_SB(1, 0), cB + kstep, voffB); PG8_STAGE(PG8_SA(1, 0), cA + kstep, voffA); PG8_STAGE(PG8_SB(1, 1), cB + hstepB + kstep, voffB);
    PG8_WAIT_V(6); PG8_BAR;
    for (;;) {
        const bool has_next = S.next(ui + 1, nxt);
        const char* nA = has_next ? (const char*)g.A + (size_t)nxt.pm * tstepA + (size_t)nxt.kofs * 2 : cA; const char* nB = has_next ? (const char*)g.Bt + (size_t)nxt.pn * tstepB + (size_t)nxt.kofs * 2 : cB;
        for (int t = 0; t < nt; t += 2) {
            const bool last = (t == nt - 2);
            const char* a1 = cA + (size_t)(t + 1) * kstep;
            const char* a2 = last ? nA : cA + (size_t)(t + 2) * kstep; const char* b2 = last ? nB : cB + (size_t)(t + 2) * kstep;
            const char* a3 = a2 + kstep; const char* b3 = b2 + kstep;
            if (last && has_next) S.a_ready(nxt);
            if constexpr (SP2) {
            PG8_LDB(B0, 0, 0); PG8_LDB(B1, 0, 1); PG8_SCHED; PG8_LDA(At, 0, 0); PG8_STAGE(PG8_SA(1, 1), a1 + hstepA, voffA);
            PG8_WAIT_V(8); PG8_WAIT_L(0); PG8_BAR; PG8_MMA(0, 0, At, B0); PG8_MMA(0, 1, At, B1); PG8_BAR; PG8_SCHED;
            PG8_LDA(At, 0, 1); PG8_STAGE(PG8_SB(0, 0), b2, voffB); PG8_STAGE(PG8_SB(0, 1), b2 + hstepB, voffB); PG8_STAGE(PG8_SA(0, 0), a2, voffA);
            PG8_WAIT_V(8); PG8_WAIT_L(0); PG8_BAR; PG8_MMA(1, 0, At, B0); PG8_MMA(1, 1, At, B1); PG8_BAR; PG8_SCHED;
            PG8_LDB(B0, 1, 0); PG8_LDB(B1, 1, 1); PG8_SCHED; PG8_LDA(At, 1, 0); PG8_STAGE(PG8_SA(0, 1), a2 + hstepA, voffA);
            PG8_WAIT_V(8); PG8_WAIT_L(0); PG8_BAR; PG8_MMA(0, 0, At, B0); PG8_MMA(0, 1, At, B1); PG8_BAR; PG8_SCHED;
            PG8_LDA(At, 1, 1); PG8_STAGE(PG8_SB(1, 0), b3, voffB); PG8_STAGE(PG8_SB(1, 1), b3 + hstepB, voffB); PG8_STAGE(PG8_SA(1, 0), a3, voffA);
            PG8_WAIT_V(8); PG8_WAIT_L(0); PG8_BAR; PG8_MMA(1, 0, At, B0); PG8_MMA(1, 1, At, B1); PG8_BAR; PG8_SCHED;
            } else {
            PG8_LDB(B0, 0, 0); PG8_SCHED; PG8_LDA(At, 0, 0); PG8_STAGE(PG8_SA(1, 1), a1 + hstepA, voffA);
            PG8_WAIT_L(8); PG8_BAR; PG8_WAIT_L(0); PG8_MMA(0, 0, At, B0); PG8_BAR; PG8_SCHED;
            PG8_LDB(B1, 0, 1); PG8_STAGE(PG8_SB(0, 0), b2, voffB);
            PG8_BAR; PG8_WAIT_L(0); PG8_MMA(0, 1, At, B1); PG8_BAR;
            PG8_LDA(At, 0, 1); PG8_STAGE(PG8_SA(0, 0), a2, voffA);
            PG8_BAR; PG8_WAIT_L(0); PG8_MMA(1, 0, At, B0); PG8_BAR; PG8_SCHED;
            PG8_STAGE(PG8_SB(0, 1), b2 + hstepB, voffB);
            PG8_WAIT_V(6); PG8_BAR; PG8_MMA(1, 1, At, B1); PG8_BAR;
            PG8_LDB(B0, 1, 0); PG8_SCHED; PG8_LDA(At, 1, 0); PG8_STAGE(PG8_SA(0, 1), a2 + hstepA, voffA);
            PG8_WAIT_L(8); PG8_BAR; PG8_WAIT_L(0); PG8_MMA(0, 0, At, B0); PG8_BAR; PG8_SCHED;
            PG8_LDB(B1, 1, 1); PG8_STAGE(PG8_SB(1, 0), b3, voffB);
            PG8_BAR; PG8_WAIT_L(0); PG8_MMA(0, 1, At, B1); PG8_BAR;
            PG8_LDA(At, 1, 1); PG8_STAGE(PG8_SA(1, 0), a3, voffA);
            PG8_BAR; PG8_WAIT_L(0); PG8_MMA(1, 0, At, B0); PG8_BAR; PG8_SCHED;
            PG8_STAGE(PG8_SB(1, 1), b3 + hstepB, voffB);
            PG8_WAIT_V(6); PG8_BAR; PG8_MMA(1, 1, At, B1); PG8_BAR;
                    }
        }
        if constexpr (SP2) { if (wr == 0) PG8_BAR; }
        E(acc, cur, wr, wc, fr, fq); S.done(cur);
        if (!has_next) break;
#pragma unroll
        for (int a = 0; a < 2; ++a)
#pragma unroll
            for (int b = 0; b < 2; ++b)
#pragma unroll
                for (int m = 0; m < 4; ++m)
#pragma unroll
                    for (int n = 0; n < 2; ++n) acc[a][b][m][n] = (f32x4){0.f, 0.f, 0.f, 0.f};
        cur = nxt; cA = nA; cB = nB; ++ui;
        if constexpr (SP2) { if (wr == 1) PG8_BAR; }
    }
    PG8_WAIT_V(0);
    if constexpr (!SP2) { if (wr == 0) PG8_BAR; }
    PG8_BAR;
#undef PG8_SA
#undef PG8_SB
#undef PG8_STAGE
#undef PG8_LDA
#undef PG8_LDB
#undef PG8_MMA
#undef PG8_WAIT_V
#undef PG8_WAIT_L
#undef PG8_BAR
#undef PG8_SCHED
}
}
using pg8::Unit;

struct EpiGateUp {
    bf16_t* act;
    __device__ __forceinline__ void operator()(const f32x4 (&acc)[2][2][4][2], const Unit& u, int wr, int wc, int fr, int fq) const {
#pragma unroll
        for (int ai = 0; ai < 2; ++ai)
#pragma unroll
            for (int m = 0; m < 4; ++m) {
                const int r = u.pm * 256 + ai * 128 + wr * 64 + m * 16 + fr;
                const int j = u.pn * 128 + wc * 32 + 8 * fq;
                const f32x4 g0 = acc[ai][0][m][0], g1 = acc[ai][0][m][1], u0 = acc[ai][1][m][0], u1 = acc[ai][1][m][1];
                u32x4 o; o.x = pk2(silu_f(g0[0]) * u0[0], silu_f(g0[1]) * u0[1]); o.y = pk2(silu_f(g0[2]) * u0[2], silu_f(g0[3]) * u0[3]);
                o.z = pk2(silu_f(g1[0]) * u1[0], silu_f(g1[1]) * u1[1]); o.w = pk2(silu_f(g1[2]) * u1[2], silu_f(g1[3]) * u1[3]);
                *(u32x4*)(act + (size_t)r * FF + j) = o;
            }
    }
};
struct EpiResid {
    const float* rp; const float* rs; float* y; float scale;
    __device__ __forceinline__ void operator()(const f32x4 (&acc)[2][2][4][2], const Unit& u, int wr, int wc, int fr, int fq) const {
#pragma unroll
        for (int ai = 0; ai < 2; ++ai)
#pragma unroll
            for (int m = 0; m < 4; ++m) {
                const int r = u.pm * 256 + ai * 128 + wr * 64 + m * 16 + fr;
                const float* rrow = (r < MP) ? rp + (size_t)r * D : rs + (size_t)(r - MP) * D;
                float* yrow = y + (size_t)r * D;
#pragma unroll
                for (int bj = 0; bj < 2; ++bj)
#pragma unroll
                    for (int n = 0; n < 2; ++n) {
                        const int c = u.pn * 256 + bj * 128 + wc * 32 + n * 16 + 4 * fq;
                        const f32x4 rv = *(const f32x4*)(rrow + c);
                        *(f32x4*)(yrow + c) = rv + acc[ai][bj][m][n] * scale;
                    }
            }
    }
};
struct EpiPart {
    float* part; float scale;
    __device__ __forceinline__ void operator()(const f32x4 (&acc)[2][2][4][2], const Unit& u, int wr, int wc, int fr, int fq) const {
        float* pb = part + (size_t)(u.kofs >> 8) * MS * D;
#pragma unroll
        for (int ai = 0; ai < 2; ++ai)
#pragma unroll
            for (int m = 0; m < 4; ++m) {
                float* yrow = pb + (size_t)(u.pm * 256 + ai * 128 + wr * 64 + m * 16 + fr) * D;
#pragma unroll
                for (int bj = 0; bj < 2; ++bj)
#pragma unroll
                    for (int n = 0; n < 2; ++n) {
                        const int c = u.pn * 256 + bj * 128 + wc * 32 + n * 16 + 4 * fq;
                        *(f32x4*)(yrow + c) = acc[ai][bj][m][n] * scale;
                    }
            }
    }
};
struct EpiProj {
    bf16_t* proj; float* dtraw;
    __device__ __forceinline__ void operator()(const f32x4 (&acc)[2][2][4][2], const Unit& u, int wr, int wc, int fr, int fq) const {
#pragma unroll
        for (int ai = 0; ai < 2; ++ai)
#pragma unroll
            for (int m = 0; m < 4; ++m) {
                const int r = u.pm * 256 + ai * 128 + wr * 64 + m * 16 + fr;
#pragma unroll
                for (int bj = 0; bj < 2; ++bj) {
                    const int c = u.pn * 256 + bj * 128 + wc * 32 + 8 * fq;
                    const f32x4 v0 = acc[ai][bj][m][0], v1 = acc[ai][bj][m][1];
                    if (u.pn == 18) { if (c - 4608 < 24) { *(f32x4*)(dtraw + (size_t)r * 24 + (c - 4608)) = v0; *(f32x4*)(dtraw + (size_t)r * 24 + (c - 4608) + 4) = v1; } }
                    else { u32x4 o; o.x = pk2(v0[0], v0[1]); o.y = pk2(v0[2], v0[3]); o.z = pk2(v1[0], v1[1]); o.w = pk2(v1[2], v1[3]); *(u32x4*)(proj + (size_t)r * NINP + c) = o; }
                }
            }
    }
};
struct EpiGlu {
    const bf16_t* v; const float* bias; bf16_t* mix;
    __device__ __forceinline__ void operator()(const f32x4 (&acc)[2][2][4][2], const Unit& u, int wr, int wc, int fr, int fq) const {
#pragma unroll
        for (int ai = 0; ai < 2; ++ai)
#pragma unroll
            for (int m = 0; m < 4; ++m) {
                const int r = u.pm * 256 + ai * 128 + wr * 64 + m * 16 + fr;
#pragma unroll
                for (int bj = 0; bj < 2; ++bj)
#pragma unroll
                    for (int n = 0; n < 2; ++n) {
                        const int c = u.pn * 256 + bj * 128 + wc * 32 + n * 16 + 4 * fq;
                        const f32x4 a = acc[ai][bj][m][n]; const f32x4 bb = *(const f32x4*)(bias + c);
                        const u32x2 vv = *(const u32x2*)(v + (size_t)r * 512 + c);
                        u32x2 o; o.x = pk2(bflo(vv.x) * sigmoid_f(a[0] + bb[0]), bfhi(vv.x) * sigmoid_f(a[1] + bb[1]));
                        o.y = pk2(bflo(vv.y) * sigmoid_f(a[2] + bb[2]), bfhi(vv.y) * sigmoid_f(a[3] + bb[3]));
                        *(u32x2*)(mix + (size_t)r * DMIX + c) = o;
                    }
            }
    }
};

__device__ __forceinline__ void transpose_item(const float* W, int K, int N, bf16_t* WT, int mode, LAS float* scr, int item, int lane) {
    const int nblk = (N + 63) / 64, kb = item / nblk, nb = item % nblk, k0 = 64 * kb, n0 = 64 * nb;
    const int c4 = lane & 15, rr = lane >> 4, nn = n0 + 4 * c4;
    f32x4 v[16];
#pragma unroll
    for (int i = 0; i < 16; ++i) v[i] = (nn < N) ? *(const f32x4*)(W + (size_t)(k0 + 4 * i + rr) * N + nn) : (f32x4){0.f, 0.f, 0.f, 0.f};
#pragma unroll
    for (int i = 0; i < 16; ++i) { LAS float* d = scr + (4 * i + rr) * 65 + 4 * c4; d[0] = v[i][0]; d[1] = v[i][1]; d[2] = v[i][2]; d[3] = v[i][3]; }
    LDS_WAIT();
    const int c = lane & 7, nrow = lane >> 3;
#pragma unroll
    for (int j = 0; j < 8; ++j) { const int n = nrow + 8 * j; const LAS float* s = scr + (8 * c) * 65 + n;
        u32x4 o; o.x = pk2(s[0 * 65], s[1 * 65]); o.y = pk2(s[2 * 65], s[3 * 65]); o.z = pk2(s[4 * 65], s[5 * 65]); o.w = pk2(s[6 * 65], s[7 * 65]);
        const int jn = n0 + n;
        const int ip = 16 * ((jn >> 2) & 1) + 4 * ((jn >> 3) & 3) + (jn & 3);
        const int row = (mode == 0) ? jn : (mode == 3) ? ((jn & ~31) + ip) : ((jn >> 7) * 256 + ((jn & 127) & ~31) + ip + (mode == 5 ? 128 : 0));
        *(u32x4*)(WT + (size_t)row * K + k0 + 8 * c) = o; }
    LDS_WAIT();
}
constexpr int I_GU = (D / 64) * (FF / 64), I_DN = (FF / 64) * (D / 64), I_IN = (D / 64) * ((NIN + 63) / 64), I_GL = (512 / 64) * (512 / 64), I_OUT = (DMIX / 64) * (D / 64);
constexpr int CV_W1T = 0, CV_W1D = 2 * I_GU, CV_WIN = CV_W1D + I_DN, CV_WGLU = CV_WIN + I_IN, CV_WOUT = CV_WGLU + I_GL, CV_W2T = CV_WOUT + I_OUT, CV_W2D = CV_W2T + 2 * I_GU, CV_END = CV_W2D + I_DN;
__device__ __forceinline__ void convert_items(const Params& p, LAS unsigned char* lds, int lo, int hi, int gw, int ngw, int wave, int lane_in) {
    int lane = lane_in; asm volatile("" : "+v"(lane));
    LAS float* scr = (LAS float*)(lds + wave * 16640);
    for (int it = lo + gw; it < hi; it += ngw) {
        int r = it;
        if (r < CV_W1D) { if (r < I_GU) transpose_item(p.in[7], D, FF, (bf16_t*)(p.ws + WS_W1T), 4, scr, r, lane); else transpose_item(p.in[8], D, FF, (bf16_t*)(p.ws + WS_W1T), 5, scr, r - I_GU, lane); continue; }
        if (r < CV_WIN) { transpose_item(p.in[9], FF, D, (bf16_t*)(p.ws + WS_W1D), 0, scr, r - CV_W1D, lane); continue; }
        if (r < CV_WGLU) { transpose_item(p.in[11], D, NIN, (bf16_t*)(p.ws + WS_WIN), 3, scr, r - CV_WIN, lane); continue; }
        if (r < CV_WOUT) { transpose_item(p.in[20], 512, 512, (bf16_t*)(p.ws + WS_WGLU), 0, scr, r - CV_WGLU, lane); continue; }
        if (r < CV_W2T) { transpose_item(p.in[28], DMIX, D, (bf16_t*)(p.ws + WS_WOUT), 0, scr, r - CV_WOUT, lane); continue; }
        if (r < CV_W2D) { r -= CV_W2T; if (r < I_GU) transpose_item(p.in[30], D, FF, (bf16_t*)(p.ws + WS_W2T), 4, scr, r, lane); else transpose_item(p.in[31], D, FF, (bf16_t*)(p.ws + WS_W2T), 5, scr, r - I_GU, lane); continue; }
        transpose_item(p.in[32], FF, D, (bf16_t*)(p.ws + WS_W2D), 0, scr, r - CV_W2D, lane);
    }
}

__device__ __forceinline__ void sum_sample_row(const float* base, const float* part, int nsl, int ms, int lane, f32x4 (&v)[4]) {
#pragma unroll
    for (int j = 0; j < 4; ++j) v[j] = ((const f32x4*)(base + (size_t)ms * D))[lane + 64 * j];
    for (int s0 = 0; s0 < nsl; s0 += 4) {
        f32x4 t[4][4];
#pragma unroll
        for (int q = 0; q < 4; ++q) { const int sl = (s0 + q < nsl) ? s0 + q : nsl - 1;
#pragma unroll
            for (int j = 0; j < 4; ++j) t[q][j] = ((const f32x4*)(part + ((size_t)sl * MS + ms) * D))[lane + 64 * j]; }
#pragma unroll
        for (int q = 0; q < 4; ++q) { const float wq = (s0 + q < nsl) ? 1.f : 0.f;
#pragma unroll
            for (int j = 0; j < 4; ++j) v[j] += t[q][j] * wq; }
    }
}
__device__ __forceinline__ void rms_phase(const float* srcp, const float* srcs, const float* w, bf16_t* dst, int gw, int ngw, int lane_in, const float* part = nullptr, int nsl = 0, float* wb = nullptr) {
    int lane = lane_in; asm volatile("" : "+v"(lane));
    const int mend = (nsl > 0) ? MP : M;
    for (int m = gw * 4; m < mend; m += ngw * 4) {
        const float* xrow = (m < MP) ? srcp + (size_t)m * D : srcs + (size_t)(m - MP) * D;
        f32x4 v[4][4];
#pragma unroll
        for (int r = 0; r < 4; ++r)
#pragma unroll
            for (int j = 0; j < 4; ++j) v[r][j] = ((const f32x4*)(xrow + (size_t)r * D))[lane + 64 * j];
        f32x4 ww[4];
#pragma unroll
        for (int j = 0; j < 4; ++j) ww[j] = ((const f32x4*)w)[lane + 64 * j];
#pragma unroll
        for (int r = 0; r < 4; ++r) {
            float ss = 0.f;
#pragma unroll
            for (int j = 0; j < 4; ++j) ss += (v[r][j].x * v[r][j].x + v[r][j].y * v[r][j].y) + (v[r][j].z * v[r][j].z + v[r][j].w * v[r][j].w);
            const float rstd = rsqrtf(wave_sum(ss) * (1.f / D) + EPS);
            u32x2* o8 = (u32x2*)(dst + (size_t)(m + r) * D) + lane;
#pragma unroll
            for (int j = 0; j < 4; ++j) { u32x2 o; o.x = pk2(v[r][j].x * rstd * ww[j].x, v[r][j].y * rstd * ww[j].y); o.y = pk2(v[r][j].z * rstd * ww[j].z, v[r][j].w * rstd * ww[j].w); o8[64 * j] = o; }
        }
    }
    if (nsl > 0) {
        for (int ms = ngw - 1 - gw; ms < MS; ms += ngw) {
            f32x4 v[4]; sum_sample_row(srcs, part, nsl, ms, lane, v);
            float ss = 0.f;
#pragma unroll
            for (int j = 0; j < 4; ++j) { ((f32x4*)(wb + (size_t)ms * D))[lane + 64 * j] = v[j]; ss += (v[j].x * v[j].x + v[j].y * v[j].y) + (v[j].z * v[j].z + v[j].w * v[j].w); }
            const float rstd = rsqrtf(wave_sum(ss) * (1.f / D) + EPS);
            u32x2* o8 = (u32x2*)(dst + (size_t)(MP + ms) * D) + lane;
#pragma unroll
            for (int j = 0; j < 4; ++j) { const f32x4 ww = ((const f32x4*)w)[lane + 64 * j]; u32x2 o; o.x = pk2(v[j].x * rstd * ww.x, v[j].y * rstd * ww.y); o.y = pk2(v[j].z * rstd * ww.z, v[j].w * rstd * ww.w); o8[64 * j] = o; }
        }
    }
}

__device__ __forceinline__ void unpack8(const u32x4 u, float (&f)[8]) { f[0] = bflo(u.x); f[1] = bfhi(u.x); f[2] = bflo(u.y); f[3] = bfhi(u.y); f[4] = bflo(u.z); f[5] = bfhi(u.z); f[6] = bflo(u.w); f[7] = bfhi(u.w); }
#define BF_ELEM(v, e) ((((e) & 1) ? ((v)[(e) >> 1] >> 16) : ((v)[(e) >> 1] & 0xffffu)))
__device__ __forceinline__ void conv_phase(const Params& p, int gtid, int nthreads) {
    const bf16_t* proj = (const bf16_t*)(p.ws + WS_A);
    bf16_t* BCN = (bf16_t*)(p.ws + WS_XC + XC_BCN); bf16_t* XSN = (bf16_t*)(p.ws + WS_XC + XC_XSN); bf16_t* XT = (bf16_t*)(p.ws + WS_XC + XC_XT); bf16_t* BT = (bf16_t*)(p.ws + WS_H + H_BT);
    const float* cw = p.in[22]; const float* cb = p.in[23]; const float* sconv = p.in[5];
    const int NT_P = (MP / 16) * 320, NT_S = NSB * 320;
    for (int task = gtid; task < NT_P; task += nthreads) {
        const int cgp = task % 320, rb = task / 320, c0 = cgp * 8, m0 = rb * 16;
        const bool first = (m0 % SEQ) == 0, lastblk = (m0 % SEQ) == SEQ - 16;
        u32x4 raw[19];
#pragma unroll
        for (int i = 0; i < 19; ++i) raw[i] = (i >= 3 || !first) ? *(const u32x4*)(proj + (size_t)(m0 - 3 + i) * NINP + 2048 + c0) : (u32x4){0u, 0u, 0u, 0u};
        float w0[8], w1[8], w2[8], w3[8], bs[8];
#pragma unroll
        for (int e = 0; e < 8; e += 4) { *(f32x4*)&w0[e] = *(const f32x4*)(cw + c0 + e); *(f32x4*)&w1[e] = *(const f32x4*)(cw + XBC + c0 + e); *(f32x4*)&w2[e] = *(const f32x4*)(cw + 2 * XBC + c0 + e);
            *(f32x4*)&w3[e] = *(const f32x4*)(cw + 3 * XBC + c0 + e); *(f32x4*)&bs[e] = *(const f32x4*)(cb + c0 + e); }
        float r0[8], r1[8], r2[8];
        unpack8(raw[0], r0); unpack8(raw[1], r1); unpack8(raw[2], r2);
        u32x4 ov[16];
#pragma unroll
        for (int i = 0; i < 16; ++i) {
            float cur[8]; unpack8(raw[i + 3], cur);
            float o[8];
#pragma unroll
            for (int e = 0; e < 8; ++e) { const float cv = bs[e] + w0[e] * r0[e] + w1[e] * r1[e] + w2[e] * r2[e] + w3[e] * cur[e]; o[e] = silu_f(cv); r0[e] = r1[e]; r1[e] = r2[e]; r2[e] = cur[e]; }
            ov[i].x = pk2(o[0], o[1]); ov[i].y = pk2(o[2], o[3]); ov[i].z = pk2(o[4], o[5]); ov[i].w = pk2(o[6], o[7]);
            if (i >= 13 && lastblk) { float* d = p.out + O_CONVP + ((size_t)(m0 / SEQ) * 3 + (i - 13)) * XBC + c0; *(f32x4*)d = (f32x4){cur[0], cur[1], cur[2], cur[3]}; *(f32x4*)(d + 4) = (f32x4){cur[4], cur[5], cur[6], cur[7]}; }
        }
        const int bb = m0 / SEQ, t0 = m0 % SEQ, cc = t0 >> 7, l0 = t0 & 127;
        if (c0 >= 1536) {
            const int cn = c0 - 1536;
#pragma unroll
            for (int i = 0; i < 16; ++i) *(u32x4*)(BCN + (size_t)(m0 + i) * 1024 + cn) = ov[i];
        }
        if (c0 < 2048) {
            bf16_t* tb = (c0 < 1536) ? XT + ((((size_t)(bb * 16 + cc) * NH + (c0 >> 6)) * 64 + (c0 & 63)) * 128 + l0)
                                     : BT + ((((size_t)(bb * 16 + cc) * 4 + ((c0 - 1536) >> 7)) * 128 + ((c0 - 1536) & 127)) * 128 + l0);
            const bool odd = (gtid & 1) != 0;
            bf16_t* t1 = odd ? tb - 8 * 128 + 8 : tb;
            bf16_t* t2 = odd ? tb + 8 : tb + 8 * 128;
#pragma unroll
            for (int e = 0; e < 8; ++e) {
                u32x4 q0, q1;
                q0.x = BF_ELEM(ov[0], e) | (BF_ELEM(ov[1], e) << 16); q0.y = BF_ELEM(ov[2], e) | (BF_ELEM(ov[3], e) << 16); q0.z = BF_ELEM(ov[4], e) | (BF_ELEM(ov[5], e) << 16); q0.w = BF_ELEM(ov[6], e) | (BF_ELEM(ov[7], e) << 16);
                q1.x = BF_ELEM(ov[8], e) | (BF_ELEM(ov[9], e) << 16); q1.y = BF_ELEM(ov[10], e) | (BF_ELEM(ov[11], e) << 16); q1.z = BF_ELEM(ov[12], e) | (BF_ELEM(ov[13], e) << 16); q1.w = BF_ELEM(ov[14], e) | (BF_ELEM(ov[15], e) << 16);
                const u32x4 snd = odd ? q0 : q1; u32x4 rcv;
                rcv.x = __shfl_xor(snd.x, 1); rcv.y = __shfl_xor(snd.y, 1); rcv.z = __shfl_xor(snd.z, 1); rcv.w = __shfl_xor(snd.w, 1);
                *(u32x4*)(t1 + (size_t)e * 128) = odd ? rcv : q0;
                *(u32x4*)(t2 + (size_t)e * 128) = odd ? q1 : rcv;
            }
        }
    }
    for (int task = gtid; task < NT_S; task += nthreads) {
        const int cgp = task % 320, b = task / 320, c0 = cgp * 8, m0 = MP + b * 4;
        u32x4 raw[4];
#pragma unroll
        for (int i = 0; i < 4; ++i) raw[i] = *(const u32x4*)(proj + (size_t)(m0 + i) * NINP + 2048 + c0);
        float w0[8], w1[8], w2[8], w3[8], bs[8], r0[8], r1[8], r2[8];
        const float* st = sconv + (size_t)b * 3 * XBC + c0;
#pragma unroll
        for (int e = 0; e < 8; e += 4) { *(f32x4*)&w0[e] = *(const f32x4*)(cw + c0 + e); *(f32x4*)&w1[e] = *(const f32x4*)(cw + XBC + c0 + e); *(f32x4*)&w2[e] = *(const f32x4*)(cw + 2 * XBC + c0 + e);
            *(f32x4*)&w3[e] = *(const f32x4*)(cw + 3 * XBC + c0 + e); *(f32x4*)&bs[e] = *(const f32x4*)(cb + c0 + e);
            *(f32x4*)&r0[e] = *(const f32x4*)(st + e); *(f32x4*)&r1[e] = *(const f32x4*)(st + XBC + e); *(f32x4*)&r2[e] = *(const f32x4*)(st + 2 * XBC + e); }
#pragma unroll
        for (int i = 0; i < 4; ++i) {
            float cur[8]; unpack8(raw[i], cur);
            float o[8];
#pragma unroll
            for (int e = 0; e < 8; ++e) { const float cv = bs[e] + w0[e] * r0[e] + w1[e] * r1[e] + w2[e] * r2[e] + w3[e] * cur[e]; o[e] = silu_f(cv); r0[e] = r1[e]; r1[e] = r2[e]; r2[e] = cur[e]; }
            u32x4 ov; ov.x = pk2(o[0], o[1]); ov.y = pk2(o[2], o[3]); ov.z = pk2(o[4], o[5]); ov.w = pk2(o[6], o[7]);
            if (c0 < 1536) *(u32x4*)(XSN + (size_t)(m0 + i - MP) * SSDW + c0) = ov;
            else *(u32x4*)(BCN + (size_t)(m0 + i) * 1024 + (c0 - 1536)) = ov;
            if (i >= 1) { float* d = p.out + O_CONVS + ((size_t)b * 3 + (i - 1)) * XBC + c0; *(f32x4*)d = (f32x4){cur[0], cur[1], cur[2], cur[3]}; *(f32x4*)(d + 4) = (f32x4){cur[4], cur[5], cur[6], cur[7]}; }
        }
    }
}

constexpr int LROW = 272;
constexpr int L_C = 0, L_B = 34816, L_BT = 69632, L_XT = 104448, L_XS = 121856, L_HT = 139264, L_AC = 156672, L_DT = 157184, L_G = 157696;
__device__ __forceinline__ float wave_incl_scan(float v, int lane) {
#pragma unroll
    for (int o = 1; o < 64; o <<= 1) { const float t = __shfl_up(v, o); if (lane >= o) v += t; }
    return v;
}
__device__ __forceinline__ void ssd_prompt_item(const Params& p, LAS unsigned char* lds, int b, int h) {
    int tid = threadIdx.x; asm volatile("" : "+v"(tid));
    const int lane = tid & 63, w = __builtin_amdgcn_readfirstlane(tid >> 6), fr = lane & 15, fq = lane >> 4;
    const int g = h / 6;
    const bf16_t* BCN = (const bf16_t*)(p.ws + WS_XC + XC_BCN); const bf16_t* XT = (const bf16_t*)(p.ws + WS_XC + XC_XT); const bf16_t* BT = (const bf16_t*)(p.ws + WS_H + H_BT);
    const float* dtraw = (const float*)(p.ws + WS_DTRAW); bf16_t* ys = (bf16_t*)(p.ws + WS_YS);
    const float a_h = -__expf(p.in[25][h]), dtb = p.in[24][h], Dh = p.in[26][h];
    f32x4 hacc[4];
#pragma unroll
    for (int i = 0; i < 4; ++i) hacc[i] = (f32x4){0.f, 0.f, 0.f, 0.f};
    for (int i = tid; i < 64 * 17; i += 512) *(LAS u32x4*)(lds + L_HT + i * 16) = (u32x4){0u, 0u, 0u, 0u};
    const int prow = tid >> 4, pc = tid & 15;
    u32x4 pvc[4], pvb[4], pvt[4], pvx[2]; float pdl, pdh;
#define SSD_FETCH(cc) do { const int _m0 = b * SEQ + (cc) * 128; \
        pdl = dtraw[(size_t)(_m0 + lane) * 24 + h]; pdh = dtraw[(size_t)(_m0 + 64 + lane) * 24 + h]; \
        const bf16_t* _bt = BT + (((size_t)(b * 16 + (cc)) * 4 + g) * 128) * 128; const bf16_t* _xt = XT + (((size_t)(b * 16 + (cc)) * NH + h) * 64) * 128; \
        _Pragma("unroll") for (int j = 0; j < 4; ++j) { const bf16_t* _gr = BCN + (size_t)(_m0 + prow + 32 * j) * 1024 + g * 128 + pc * 8; pvb[j] = *(const u32x4*)_gr; pvc[j] = *(const u32x4*)(_gr + 512); \
            pvt[j] = *(const u32x4*)(_bt + (size_t)(prow + 32 * j) * 128 + pc * 8); } \
        _Pragma("unroll") for (int j = 0; j < 2; ++j) pvx[j] = *(const u32x4*)(_xt + (size_t)(prow + 32 * j) * 128 + pc * 8); } while (0)
    SSD_FETCH(0);
    for (int c = 0; c < 16; ++c) {
        const int m0 = b * SEQ + c * 128;
        const float dt_lo = softplus_f(pdl + dtb), dt_hi = softplus_f(pdh + dtb);
        const float ac_lo = wave_incl_scan(dt_lo * a_h, lane); const float tot_lo = __shfl(ac_lo, 63);
        const float ac_hi = wave_incl_scan(dt_hi * a_h, lane) + tot_lo; const float alast = __shfl(ac_hi, 63);
        const float sc_lo = dt_lo * __expf(alast - ac_lo), sc_hi = dt_hi * __expf(alast - ac_hi);
        if (w == 0) { const float ae_lo = __shfl(ac_lo, (lane & 48) + 15), ae_hi = __shfl(ac_hi, (lane & 48) + 15);
            *(LAS float*)(lds + L_G + lane * 4) = dt_lo * __expf(ae_lo - ac_lo); *(LAS float*)(lds + L_G + 256 + lane * 4) = dt_hi * __expf(ae_hi - ac_hi);
            *(LAS float*)(lds + L_AC + lane * 4) = ac_lo; *(LAS float*)(lds + L_AC + 256 + lane * 4) = ac_hi; *(LAS float*)(lds + L_DT + lane * 4) = dt_lo; *(LAS float*)(lds + L_DT + 256 + lane * 4) = dt_hi; }
        float sc[8];
#pragma unroll
        for (int e = 0; e < 8; ++e) { const int src = (pc * 8 + e) & 63; const float vlo = __shfl(sc_lo, src), vhi = __shfl(sc_hi, src); sc[e] = (pc < 8) ? vlo : vhi; }
#pragma unroll
        for (int j = 0; j < 4; ++j) {
            const int r = prow + 32 * j;
            *(LAS u32x4*)(lds + L_C + r * LROW + pc * 16) = pvc[j];
            *(LAS u32x4*)(lds + L_B + r * LROW + pc * 16) = pvb[j];
            *(LAS u32x4*)(lds + L_BT + r * LROW + pc * 16) = pvt[j];
        }
#pragma unroll
        for (int j = 0; j < 2; ++j) {
            const int r = prow + 32 * j;
            float xf[8]; unpack8(pvx[j], xf);
            *(LAS u32x4*)(lds + L_XT + r * LROW + pc * 16) = pvx[j];
            u32x4 q; q.x = pk2(xf[0] * sc[0], xf[1] * sc[1]); q.y = pk2(xf[2] * sc[2], xf[3] * sc[3]); q.z = pk2(xf[4] * sc[4], xf[5] * sc[5]); q.w = pk2(xf[6] * sc[6], xf[7] * sc[7]);
            *(LAS u32x4*)(lds + L_XS + r * LROW + pc * 16) = q;
        }
        LDS_BARRIER();
        if (c < 15) SSD_FETCH(c + 1);
        const int l = 16 * w + fr;
        bf16x8 cfrag[4];
#pragma unroll
        for (int ks = 0; ks < 4; ++ks) cfrag[ks] = *(const LAS bf16x8*)(lds + L_C + l * LROW + (ks * 32 + fq * 8) * 2);
        f32x4 yacc[4];
#pragma unroll
        for (int pb = 0; pb < 4; ++pb) {
            f32x4 a = (f32x4){0.f, 0.f, 0.f, 0.f};
#pragma unroll
            for (int ks = 0; ks < 4; ++ks) { const bf16x8 hf = *(const LAS bf16x8*)(lds + L_HT + (pb * 16 + fr) * LROW + (ks * 32 + fq * 8) * 2); a = __builtin_amdgcn_mfma_f32_16x16x32_bf16(hf, cfrag[ks], a, 0, 0, 0); }
            yacc[pb] = a;
        }
        const float al = *(const LAS float*)(lds + L_AC + l * 4);
        { const float el = __expf(al);
#pragma unroll
          for (int pb = 0; pb < 4; ++pb) yacc[pb] = yacc[pb] * el; }
        f32x4 cbt[8];
#pragma unroll
        for (int sb = 0; sb < 8; ++sb) {
            cbt[sb] = (f32x4){0.f, 0.f, 0.f, 0.f};
            if (sb <= w) {
                f32x4 a = (f32x4){0.f, 0.f, 0.f, 0.f};
#pragma unroll
                for (int ks = 0; ks < 4; ++ks) { const bf16x8 bf = *(const LAS bf16x8*)(lds + L_B + (sb * 16 + fr) * LROW + (ks * 32 + fq * 8) * 2); a = __builtin_amdgcn_mfma_f32_16x16x32_bf16(bf, cfrag[ks], a, 0, 0, 0); }
                cbt[sb] = a;
            }
        }
        LDS_BARRIER();
        const int nks = (w >> 1) + 1;
#pragma unroll
        for (int sb = 0; sb < 8; ++sb) {
            if (sb < 2 * nks) {
                const int s0 = sb * 16 + 4 * fq;
                float mv[4];
                if (sb < w) {
                    const float f = __expf(al - *(const LAS float*)(lds + L_AC + (sb * 16 + 15) * 4));
                    const f32x4 gs = *(const LAS f32x4*)(lds + L_G + s0 * 4);
#pragma unroll
                    for (int e = 0; e < 4; ++e) mv[e] = cbt[sb][e] * f * gs[e];
                } else if (sb == w) {
                    const f32x4 as = *(const LAS f32x4*)(lds + L_AC + s0 * 4), ds = *(const LAS f32x4*)(lds + L_DT + s0 * 4);
#pragma unroll
                    for (int e = 0; e < 4; ++e) { const float v = cbt[sb][e] * __expf(al - as[e]) * ds[e]; mv[e] = ((s0 + e) <= l) ? v : 0.f; if (s0 + e == l) mv[e] += Dh; }
                } else {
#pragma unroll
                    for (int e = 0; e < 4; ++e) mv[e] = 0.f;
                }
                u32x2 o; o.x = pk2(mv[0], mv[1]); o.y = pk2(mv[2], mv[3]);
                *(LAS u32x2*)(lds + L_B + l * LROW + s0 * 2) = o;
            }
        }
        LDS_WAIT();
#pragma unroll
        for (int ks = 0; ks < 4; ++ks) {
            if (ks < nks) {
                const bf16x8 mf = *(const LAS bf16x8*)(lds + L_B + l * LROW + (ks * 32 + fq * 8) * 2);
#pragma unroll
                for (int pb = 0; pb < 4; ++pb) { const bf16x8 xf = *(const LAS bf16x8*)(lds + L_XT + (pb * 16 + fr) * LROW + (ks * 32 + fq * 8) * 2); yacc[pb] = __builtin_amdgcn_mfma_f32_16x16x32_bf16(xf, mf, yacc[pb], 0, 0, 0); }
            }
        }
#pragma unroll
        for (int pb = 0; pb < 4; ++pb) {
            const int pcol = h * 64 + pb * 16 + 4 * fq;
            u32x2 o; o.x = pk2(yacc[pb][0], yacc[pb][1]); o.y = pk2(yacc[pb][2], yacc[pb][3]);
            *(u32x2*)(ys + (size_t)(m0 + l) * SSDW + pcol) = o;
        }
        { const float ea = __expf(alast);
#pragma unroll
          for (int pb = 0; pb < 4; ++pb) hacc[pb] = hacc[pb] * ea; }
#pragma unroll
        for (int ks = 0; ks < 4; ++ks) {
            const bf16x8 btf = *(const LAS bf16x8*)(lds + L_BT + (16 * w + fr) * LROW + (ks * 32 + fq * 8) * 2);
#pragma unroll
            for (int pb = 0; pb < 4; ++pb) { const bf16x8 xsf = *(const LAS bf16x8*)(lds + L_XS + (pb * 16 + fr) * LROW + (ks * 32 + fq * 8) * 2); hacc[pb] = __builtin_amdgcn_mfma_f32_16x16x32_bf16(btf, xsf, hacc[pb], 0, 0, 0); }
        }
#pragma unroll
        for (int pb = 0; pb < 4; ++pb) { u32x2 o; o.x = pk2(hacc[pb][0], hacc[pb][1]); o.y = pk2(hacc[pb][2], hacc[pb][3]); *(LAS u32x2*)(lds + L_HT + (pb * 16 + fr) * LROW + (16 * w + 4 * fq) * 2) = o; }
        LDS_BARRIER();
    }
    float* so = p.out + O_SSDP + ((size_t)(b * NH + h) * 64) * 128;
#pragma unroll
    for (int pb = 0; pb < 4; ++pb) *(f32x4*)(so + (size_t)(pb * 16 + fr) * 128 + 16 * w + 4 * fq) = hacc[pb];
}

template <int MODE>
__device__ __forceinline__ void s5_wave_item(const Params& p, LAS unsigned char* wl, int g, int bidx, int seg, int m_start, int nrows, int lane_in) {
    int lane = lane_in; asm volatile("" : "+v"(lane));
    const int fr = lane & 15, fq = lane >> 4;
    const bf16_t* proj = (const bf16_t*)(p.ws + WS_A); bf16_t* vbuf = (bf16_t*)(p.ws + WS_H);
    const bf16_t* BBAR = (const bf16_t*)(p.ws + WS_BBAR); const bf16_t* CMAT = (const bf16_t*)(p.ws + WS_CMAT); const float* AB = (const float*)(p.ws + WS_S5A);
    float* S5E = (float*)(p.ws + WS_S5END);
    const bf16x8 zf = (bf16x8){0, 0, 0, 0, 0, 0, 0, 0};
    bf16x8 bfrag[8], cfrag[4];
#pragma unroll
    for (int t = 0; t < 8; ++t) bfrag[t] = (fq < 2) ? *(const bf16x8*)(BBAR + ((size_t)(g * 128 + t * 16 + fr)) * 16 + fq * 8) : zf;
    if (MODE != 1) {
#pragma unroll
        for (int ks = 0; ks < 4; ++ks) cfrag[ks] = *(const bf16x8*)(CMAT + ((size_t)(g * 16 + fr)) * 128 + ks * 32 + fq * 8);
    }
    const float ar = AB[g * 64 + lane], ai = AB[2048 + g * 64 + lane];
    const f32x4 d4 = *(const f32x4*)(p.in[19] + g * 16 + 4 * fq);
    LAS float* sBu = (LAS float*)wl; LAS bf16_t* sS = (LAS bf16_t*)(wl + 8448);
    float sr = 0.f, si = 0.f;
    if (MODE == 2 && seg > 0) {
        float pr = ar, pi = ai;
#pragma unroll
        for (int q = 0; q < 8; ++q) { const float nr = pr * pr - pi * pi, ni = 2.f * pr * pi; pr = nr; pi = ni; }
        for (int j = 0; j < seg; ++j) {
            const float* e = S5E + ((size_t)((bidx * 32 + g) * 8 + j)) * 128;
            const float er = e[lane], ei = e[64 + lane];
            const float nr = pr * sr - pi * si + er, ni = pr * si + pi * sr + ei; sr = nr; si = ni;
        }
    }
    bf16x8 uf_n; u32x2 u4_n;
    { const bf16_t* urow = proj + (size_t)(m_start + fr) * NINP + g * 16; uf_n = (fq < 2) ? *(const bf16x8*)(urow + fq * 8) : zf; u4_n = *(const u32x2*)(urow + 4 * fq); }
    for (int m0 = m_start; m0 < m_start + nrows; m0 += 16) {
        const bf16x8 uf = uf_n; const u32x2 u4 = u4_n;
        { const int mn = (m0 + 16 < m_start + nrows) ? m0 + 16 : m0; const bf16_t* urow = proj + (size_t)(mn + fr) * NINP + g * 16; uf_n = (fq < 2) ? *(const bf16x8*)(urow + fq * 8) : zf; u4_n = *(const u32x2*)(urow + 4 * fq); }
#pragma unroll
        for (int t = 0; t < 8; ++t) {
            f32x4 a = (f32x4){0.f, 0.f, 0.f, 0.f};
            a = __builtin_amdgcn_mfma_f32_16x16x32_bf16(bfrag[t], uf, a, 0, 0, 0);
            *(LAS f32x4*)(sBu + fr * 132 + t * 16 + 4 * fq) = a;
        }
        LDS_WAIT();
        {
            float br[16], bi[16]; unsigned pkv[16];
#pragma unroll
            for (int t = 0; t < 16; ++t) { br[t] = sBu[t * 132 + lane]; bi[t] = sBu[t * 132 + 64 + lane]; }
            float s0r[4], s0i[4];
            if (MODE == 0) {
#pragma unroll
                for (int q = 0; q < 4; ++q) { const int bb = ((m0 - MP) >> 2) + q; s0r[q] = p.in[2][((size_t)bb * 32 + g) * 64 + lane]; s0i[q] = p.in[3][((size_t)bb * 32 + g) * 64 + lane]; }
            }
#pragma unroll
            for (int t = 0; t < 16; ++t) {
                if (MODE == 0 && (t & 3) == 0) { sr = s0r[t >> 2]; si = s0i[t >> 2]; }
                const float nr = ar * sr - ai * si + br[t], ni = ar * si + ai * sr + bi[t];
                sr = nr; si = ni;
                if (MODE != 1) pkv[t] = pk2(sr, si);
                if (MODE == 0 && (t & 3) == 3) { const int bb = (m0 - MP + t) >> 2; p.out[O_S5RS + ((size_t)bb * 32 + g) * 64 + lane] = sr; p.out[O_S5IS + ((size_t)bb * 32 + g) * 64 + lane] = si; }
            }
            if (MODE != 1) {
#pragma unroll
                for (int t = 0; t < 16; ++t) { sS[t * 136 + lane] = (bf16_t)(pkv[t] & 0xffff); sS[t * 136 + 64 + lane] = (bf16_t)(pkv[t] >> 16); }
            }
        }
        LDS_WAIT();
        if (MODE != 1) {
            f32x4 y = (f32x4){0.f, 0.f, 0.f, 0.f};
#pragma unroll
            for (int ks = 0; ks < 4; ++ks) { const bf16x8 sf = *(const LAS bf16x8*)(sS + fr * 136 + ks * 32 + fq * 8); y = __builtin_amdgcn_mfma_f32_16x16x32_bf16(cfrag[ks], sf, y, 0, 0, 0); }
            const float y0 = y[0] + d4[0] * bflo(u4.x), y1 = y[1] + d4[1] * bfhi(u4.x), y2 = y[2] + d4[2] * bflo(u4.y), y3 = y[3] + d4[3] * bfhi(u4.y);
            u32x2 o; o.x = pk2(gelu_tanh(y0), gelu_tanh(y1)); o.y = pk2(gelu_tanh(y2), gelu_tanh(y3));
            *(u32x2*)(vbuf + (size_t)(m0 + fr) * 512 + g * 16 + 4 * fq) = o;
            LDS_WAIT();
        }
    }
    if (MODE == 1) { float* e = S5E + ((size_t)((bidx * 32 + g) * 8 + seg)) * 128; e[lane] = sr; e[64 + lane] = si; }
    if (MODE == 2 && seg == 7) { p.out[O_S5RP + ((size_t)bidx * 32 + g) * 64 + lane] = sr; p.out[O_S5IP + ((size_t)bidx * 32 + g) * 64 + lane] = si; }
}

#define SMP_LOAD(HS, BS, CS, DS, XS_, PS, pr_) do { const int _b = (pr_) / NH, _h = (pr_) % NH, _g = _h / 6; \
        PS[0] = p.in[25][_h]; PS[1] = p.in[24][_h]; PS[2] = p.in[26][_h]; \
        const float* _h0 = p.in[4] + ((size_t)(_b * NH + _h) * 64 + pp) * 128 + n0; \
        _Pragma("unroll") for (int j = 0; j < 4; ++j) HS[j] = *(const f32x4*)(_h0 + 4 * j); \
        _Pragma("unroll") for (int t = 0; t < 4; ++t) { const int _m = MP + _b * 4 + t; const bf16_t* _row = BCN + (size_t)_m * 1024 + _g * 128 + n0; \
            DS[t] = dtraw[(size_t)_m * 24 + _h]; XS_[t] = *(const unsigned*)(XSN + (size_t)(_m - MP) * SSDW + _h * 64 + (pp & ~1)); \
            BS[t][0] = *(const u32x4*)_row; BS[t][1] = *(const u32x4*)(_row + 8); CS[t][0] = *(const u32x4*)(_row + 512); CS[t][1] = *(const u32x4*)(_row + 520); } } while (0)
#define SMP_COMPUTE(HS, BS, CS, DS, XS_, PS, pr_) do { const int _b = (pr_) / NH, _h = (pr_) % NH; \
        const float a_h = -__expf(PS[0]), dtb = PS[1], Dh = PS[2]; \
        float hv[16]; \
        _Pragma("unroll") for (int j = 0; j < 4; ++j) { hv[4 * j] = HS[j][0]; hv[4 * j + 1] = HS[j][1]; hv[4 * j + 2] = HS[j][2]; hv[4 * j + 3] = HS[j][3]; } \
        _Pragma("unroll") for (int t = 0; t < 4; ++t) { const int _m = MP + _b * 4 + t; \
            const float dt = softplus_f(DS[t] + dtb), dec = __expf(dt * a_h); const float xv = (pp & 1) ? bfhi(XS_[t]) : bflo(XS_[t]), xd = xv * dt; \
            float acc = 0.f; \
            _Pragma("unroll") for (int hf = 0; hf < 2; ++hf) { float Bv[8], Cv[8]; unpack8(BS[t][hf], Bv); unpack8(CS[t][hf], Cv); \
                _Pragma("unroll") for (int j = 0; j < 8; ++j) { hv[8 * hf + j] = hv[8 * hf + j] * dec + xd * Bv[j]; acc += hv[8 * hf + j] * Cv[j]; } } \
            acc += __shfl_xor(acc, 1); acc += __shfl_xor(acc, 2); acc += __shfl_xor(acc, 4); \
            if ((tid & 7) == 0) ys[(size_t)_m * SSDW + _h * 64 + pp] = (bf16_t)(pk2(acc + Dh * xv, 0.f) & 0xffff); } \
        float* _ho = p.out + O_SSDS + ((size_t)(_b * NH + _h) * 64 + pp) * 128 + n0; \
        _Pragma("unroll") for (int j = 0; j < 16; j += 4) *(f32x4*)(_ho + j) = (f32x4){hv[j], hv[j + 1], hv[j + 2], hv[j + 3]}; } while (0)
constexpr int SMP_PAIRS = 6;
__device__ __forceinline__ void ssd_sample_item(const Params& p, int item) {
    int tid = threadIdx.x; asm volatile("" : "+v"(tid));
    const int pp = tid >> 3, n0 = (tid & 7) * 16;
    const bf16_t* BCN = (const bf16_t*)(p.ws + WS_XC + XC_BCN); const bf16_t* XSN = (const bf16_t*)(p.ws + WS_XC + XC_XSN); const float* dtraw = (const float*)(p.ws + WS_DTRAW); bf16_t* ys = (bf16_t*)(p.ws + WS_YS);
    f32x4 hA[4], hB[4]; u32x4 bA[4][2], cA[4][2], bB[4][2], cB[4][2]; float dA[4], dB[4], sA3[3], sB3[3]; unsigned xA[4], xB[4];
    const int pr0 = item * SMP_PAIRS;
    SMP_LOAD(hA, bA, cA, dA, xA, sA3, pr0);
#pragma unroll
    for (int k = 0; k < SMP_PAIRS; k += 2) {
        const int pr = pr0 + k;
        SMP_LOAD(hB, bB, cB, dB, xB, sB3, pr + 1);
        SMP_COMPUTE(hA, bA, cA, dA, xA, sA3, pr);
        if (k + 2 < SMP_PAIRS) SMP_LOAD(hA, bA, cA, dA, xA, sA3, pr + 2);
        SMP_COMPUTE(hB, bB, cB, dB, xB, sB3, pr + 1);
    }
}

__device__ __forceinline__ void gatenorm_phase(const Params& p, int gw, int ngw, int lane_in) {
    int lane = lane_in; asm volatile("" : "+v"(lane));
    const bf16_t* proj = (const bf16_t*)(p.ws + WS_A); const bf16_t* ys = (const bf16_t*)(p.ws + WS_YS); bf16_t* mix = (bf16_t*)(p.ws + WS_XC);
    const float* nw = p.in[27];
    for (int m = gw * 2; m < M; m += ngw * 2) {
        u32x4 yr[2][3], zr[2][3];
#pragma unroll
        for (int r = 0; r < 2; ++r)
#pragma unroll
            for (int j = 0; j < 3; ++j) { const int c0 = (lane + 64 * j) * 8; yr[r][j] = *(const u32x4*)(ys + (size_t)(m + r) * SSDW + c0); zr[r][j] = *(const u32x4*)(proj + (size_t)(m + r) * NINP + 512 + c0); }
#pragma unroll
        for (int r = 0; r < 2; ++r) {
            float gv[3][8]; float sg[4] = {0.f, 0.f, 0.f, 0.f};
#pragma unroll
            for (int j = 0; j < 3; ++j) {
                float yv[8], zv[8]; unpack8(yr[r][j], yv); unpack8(zr[r][j], zv);
                float ss = 0.f;
#pragma unroll
                for (int e = 0; e < 8; ++e) { gv[j][e] = yv[e] * silu_f(zv[e]); ss += gv[j][e] * gv[j][e]; }
                const int grp = (lane + 64 * j) / 48;
#pragma unroll
                for (int q = 0; q < 4; ++q) sg[q] += (grp == q) ? ss : 0.f;
            }
            float rs[4];
#pragma unroll
            for (int q = 0; q < 4; ++q) rs[q] = rsqrtf(wave_sum(sg[q]) * (1.f / 384.f) + EPS);
#pragma unroll
            for (int j = 0; j < 3; ++j) {
                const int c0 = (lane + 64 * j) * 8, grp = (lane + 64 * j) / 48;
                const float rstd = grp == 0 ? rs[0] : (grp == 1 ? rs[1] : (grp == 2 ? rs[2] : rs[3]));
                const f32x4 n0 = *(const f32x4*)(nw + c0), n1 = *(const f32x4*)(nw + c0 + 4);
                u32x4 o; o.x = pk2(gv[j][0] * rstd * n0[0], gv[j][1] * rstd * n0[1]); o.y = pk2(gv[j][2] * rstd * n0[2], gv[j][3] * rstd * n0[3]);
                o.z = pk2(gv[j][4] * rstd * n1[0], gv[j][5] * rstd * n1[1]); o.w = pk2(gv[j][6] * rstd * n1[2], gv[j][7] * rstd * n1[3]);
                *(u32x4*)(mix + (size_t)(m + r) * DMIX + 512 + c0) = o;
            }
        }
    }
}

#define XB_TMO      128
#define XB_XCNT(j)  (256  + 64 * (j))
#define XB_XSUB(j)  (1280 + 64 * (j))
#define XB_XGEN(j)  (2304 + 64 * (j))
#define XB_TOP      3328
#define XB_TOPGEN   3392
#define XCD_BAR_WORDS 3456
#define XB_SPIN_CAP (1u << 18)

__device__ __forceinline__ unsigned xb_ld(unsigned* p)              { return __hip_atomic_load(p, __ATOMIC_RELAXED, __HIP_MEMORY_SCOPE_AGENT); }
__device__ __forceinline__ unsigned xb_add(unsigned* p, unsigned v) { return __hip_atomic_fetch_add(p, v, __ATOMIC_RELAXED, __HIP_MEMORY_SCOPE_AGENT); }
__device__ __forceinline__ unsigned xb_xcc_id() { return (unsigned)__builtin_amdgcn_s_getreg((3 << 11) | 20) & 0xFu; }
#define XB_SPIN(cond, bar) do { unsigned _sp = 0; while (cond) { __builtin_amdgcn_s_sleep(1); \
    if ((++_sp & 255u) == 0u) { if (xb_ld(&(bar)[XB_TMO])) break; if (_sp > XB_SPIN_CAP) { atomicAdd(&(bar)[XB_TMO], 1u); break; } } } } while (0)

struct XcdBarrier {
    unsigned* bar; unsigned x;
    volatile LAS unsigned* st;
};

__device__ __forceinline__ XcdBarrier xcd_barrier_post(unsigned* bar, volatile LAS unsigned* st) {
    XcdBarrier b; b.bar = bar; b.x = xb_xcc_id(); b.st = st;
    if (threadIdx.x == 0) (void)xb_add(&bar[XB_XCNT(b.x)], 1u);
    return b;
}
__device__ __forceinline__ void xcd_barrier_complete(unsigned* bar, unsigned x, unsigned& nloc, unsigned& nx) {
    const unsigned G = gridDim.x * gridDim.y * gridDim.z;
    unsigned sum, cnt, mine, sp = 0u;
    for (;;) {
        sum = 0u; cnt = 0u; mine = 0u;
#pragma unroll
        for (unsigned j = 0; j < 16; ++j) { const unsigned c = xb_ld(&bar[XB_XCNT(j)]); sum += c; cnt += (c > 0u) ? 1u : 0u; mine = (j == x) ? c : mine; }
        if (sum == G) break;
        __builtin_amdgcn_s_sleep(1);
        if ((++sp & 255u) == 0u) { if (xb_ld(&bar[XB_TMO])) break; if (sp > XB_SPIN_CAP) { atomicAdd(&bar[XB_TMO], 1u); break; } }
    }
    nloc = mine > 0u ? mine : 1u; nx = cnt > 0u ? cnt : 1u;
}

__device__ __forceinline__ void xcd_barrier(const XcdBarrier& b) {
    asm volatile("s_waitcnt vmcnt(0)" ::: "memory");
    __syncthreads();
    if (threadIdx.x == 0) {
        unsigned* bar = b.bar;
        __builtin_amdgcn_s_waitcnt(0);
        unsigned nloc = b.st[0], nx = b.st[1];
        if (nloc == 0u) { xcd_barrier_complete(bar, b.x, nloc, nx); b.st[0] = nloc; b.st[1] = nx; }
        const unsigned old = xb_add(&bar[XB_XSUB(b.x)], 1u);
        const unsigned gen = old / nloc;
        if (old + 1u == (gen + 1u) * nloc) {
            __builtin_amdgcn_fence(__ATOMIC_RELEASE, "agent");
            asm volatile("s_waitcnt vmcnt(0)" ::: "memory");
            const unsigned og = xb_add(&bar[XB_TOP], 1u);
            const unsigned tg = og / nx;
            if (og + 1u == (tg + 1u) * nx) xb_add(&bar[XB_TOPGEN], 1u);
            else XB_SPIN(xb_ld(&bar[XB_TOPGEN]) == tg, bar);
            __builtin_amdgcn_fence(__ATOMIC_ACQUIRE, "agent");
            xb_add(&bar[XB_XGEN(b.x)], 1u);
            asm volatile("s_waitcnt vmcnt(0)" ::: "memory");
        } else {
            XB_SPIN(xb_ld(&bar[XB_XGEN(b.x)]) == gen, bar);
            __builtin_amdgcn_fence(__ATOMIC_ACQUIRE, "agent");
            asm volatile("s_waitcnt vmcnt(0)" ::: "memory");
        }
    }
    __syncthreads();
}

__device__ __forceinline__ void seam(const XcdBarrier& b0) { XcdBarrier b = b0; asm volatile("" : "+s"(b.bar)); asm volatile("" : "+s"(b.x)); xcd_barrier(b); }

__global__ void __launch_bounds__(512, 2) hymba_fwd(Params p) {
    extern __shared__ __attribute__((aligned(16))) unsigned char smem[];
    LAS unsigned char* lds = (LAS unsigned char*)smem;
    cg::grid_group grid = cg::this_grid();
    const int tid = threadIdx.x, lane = tid & 63, wave = __builtin_amdgcn_readfirstlane(tid >> 6);
    const int G = gridDim.x, bid = blockIdx.x;
    const int gw = bid * 8 + wave, ngw = G * 8, gtid = bid * 512 + tid, nthreads = G * 512;
    unsigned* ctl = (unsigned*)(p.ws + WS_CTL);
    volatile LAS unsigned* xst = (volatile LAS unsigned*)(lds + L_XBST);
    if (tid == 0) { xst[0] = 0u; xst[1] = 0u; }
    __syncthreads();
    const XcdBarrier xb = xcd_barrier_post((unsigned*)(p.ws + WS_BAR), xst);
    bf16_t* W1T = (bf16_t*)(p.ws + WS_W1T); bf16_t* W1D = (bf16_t*)(p.ws + WS_W1D); bf16_t* W2T = (bf16_t*)(p.ws + WS_W2T); bf16_t* W2D = (bf16_t*)(p.ws + WS_W2D);
    bf16_t* WIN = (bf16_t*)(p.ws + WS_WIN); bf16_t* WGLU = (bf16_t*)(p.ws + WS_WGLU); bf16_t* WOUT = (bf16_t*)(p.ws + WS_WOUT);
    bf16_t* HB = (bf16_t*)(p.ws + WS_H); bf16_t* AB = (bf16_t*)(p.ws + WS_A); bf16_t* XC = (bf16_t*)(p.ws + WS_XC);
    float* yout = p.out + O_Y;
    pg8::StaticOrder S;

    {
        convert_items(p, lds, CV_W1T, CV_W1D, gw, ngw, wave, lane);
        rms_phase(p.in[0], p.in[1], p.in[6], HB, gw, ngw, lane);
        for (int i = gtid; i < MS * D / 4; i += nthreads) ((f32x4*)(yout + (size_t)MP * D))[i] = ((const f32x4*)p.in[1])[i];
    }
    if (p.use_cg) grid.sync();
    seam(xb);
    for (int rep = 0; rep < REP_P1; ++rep) { S.init(M, 2 * FF, G, bid); pg8::gemm_phase<true>(lds, pg8::Gemm{HB, W1T, M, 2 * FF, D, D}, S, EpiGateUp{AB});
        { const int nfull = S.nwg % G; if (nfull > 0 && bid >= nfull) convert_items(p, lds, CV_W1D, CV_WIN, (bid - nfull) * 8 + wave, (G - nfull) * 8, wave, lane); else if (nfull == 0) convert_items(p, lds, CV_W1D, CV_WIN, gw, ngw, wave, lane); }
        if (gtid >= nthreads - 2048) {
            const int idx = gtid - (nthreads - 2048), g = idx >> 6, pp = idx & 63;
            const double lr = p.in[12][idx], li = p.in[13][idx], step = exp((double)p.in[14][g]);
            const double mag = exp(lr * step), ang = li * step;
            const double are = mag * cos(ang), aim = mag * sin(ang);
            const double den = lr * lr + li * li, nre = are - 1.0, nim = aim;
            const float cre = (float)((nre * lr + nim * li) / den), cim = (float)((nim * lr - nre * li) / den);
            float* ABf = (float*)(p.ws + WS_S5A); ABf[idx] = (float)are; ABf[2048 + idx] = (float)aim;
            bf16_t* BBAR = (bf16_t*)(p.ws + WS_BBAR); bf16_t* CMAT = (bf16_t*)(p.ws + WS_CMAT);
            const float* bre = p.in[15] + (size_t)idx * 16; const float* bim = p.in[16] + (size_t)idx * 16;
#pragma unroll
            for (int hh = 0; hh < 16; hh += 2) {
                const float r0 = cre * bre[hh] - cim * bim[hh], r1 = cre * bre[hh + 1] - cim * bim[hh + 1];
                const float i0 = cre * bim[hh] + cim * bre[hh], i1 = cre * bim[hh + 1] + cim * bre[hh + 1];
                *(unsigned*)(BBAR + ((size_t)(g * 128 + pp)) * 16 + hh) = pk2(r0, r1);
                *(unsigned*)(BBAR + ((size_t)(g * 128 + 64 + pp)) * 16 + hh) = pk2(i0, i1);
            }
#pragma unroll
            for (int hh = 0; hh < 16; ++hh) {
                const float cr = p.in[17][((size_t)g * 16 + hh) * 64 + pp], ci = p.in[18][((size_t)g * 16 + hh) * 64 + pp];
                const unsigned pk = pk2(cr, -ci);
                CMAT[((size_t)(g * 16 + hh)) * 128 + pp] = (bf16_t)(pk & 0xffff); CMAT[((size_t)(g * 16 + hh)) * 128 + 64 + pp] = (bf16_t)(pk >> 16);
            }
        }
        seam(xb); }
    { S.init(MP, D, G, bid); pg8::gemm_phase<true>(lds, pg8::Gemm{AB, W1D, MP, D, FF, FF}, S, EpiResid{p.in[0], p.in[1], yout, 0.5f});
      pg8::SplitOrder S2{8 * (FF / 256), G, bid, 256}; pg8::gemm_phase<false>(lds, pg8::Gemm{AB + (size_t)MP * FF, W1D, MS, D, 256, FF}, S2, EpiPart{(float*)(p.ws + WS_YS), 0.5f}); }
    { const int nsp = 8 * (FF / 256); if (G > nsp) { if (bid >= nsp) convert_items(p, lds, CV_WIN, CV_WGLU, (bid - nsp) * 8 + wave, (G - nsp) * 8, wave, lane); } else convert_items(p, lds, CV_WIN, CV_WGLU, gw, ngw, wave, lane); }
    seam(xb);
    rms_phase(yout, yout + (size_t)MP * D, p.in[10], HB, gw, ngw, lane, (const float*)(p.ws + WS_YS), FF / 256, yout + (size_t)MP * D);
    seam(xb);
    { S.init(M, NINP, G, bid); pg8::gemm_phase<true>(lds, pg8::Gemm{HB, WIN, M, NINP, D, D}, S, EpiProj{AB, (float*)(p.ws + WS_DTRAW)}); }
    { const int nfull = S.nwg % G; if (nfull > 0 && bid >= nfull) convert_items(p, lds, CV_WGLU, CV_W2T, (bid - nfull) * 8 + wave, (G - nfull) * 8, wave, lane); else if (nfull == 0) convert_items(p, lds, CV_WGLU, CV_W2T, gw, ngw, wave, lane); }
    seam(xb);
    for (int rep = 0; rep < REP_P5; ++rep) {
        for (int wi = gw; wi < 256 * 7; wi += ngw) { const int pair = wi / 7, sg = wi % 7; s5_wave_item<1>(p, lds + wave * 12800, pair & 31, pair >> 5, sg, (pair >> 5) * SEQ + sg * 256, 256, lane); }
        conv_phase(p, gtid, nthreads); seam(xb); }
    for (int rep = 0; rep < REP_P6; ++rep) {
        volatile LAS int* bc = (volatile LAS int*)(lds + L_BCAST);
        constexpr int N_SSDP = NB * NH, N_S5P = 256, N_S5S = 128, N_SSDS = NSB * NH / SMP_PAIRS;
        for (;;) {
            __syncthreads();
            if (tid == 0) *bc = (int)atomicAdd(&ctl[rep * 64], 1u);
            __syncthreads();
            int it = *bc;
            if (it >= N_SSDP + N_S5P + N_S5S + N_SSDS) break;
            if (it < N_SSDP) { ssd_prompt_item(p, lds, it / NH, it % NH); continue; }
            it -= N_SSDP;
            if (it < N_SSDS) { ssd_sample_item(p, it); continue; }
            it -= N_SSDS;
            if (it < N_S5P) { const int pair = it; s5_wave_item<2>(p, lds + wave * 12800, pair & 31, pair >> 5, wave, (pair >> 5) * SEQ + wave * 256, 256, lane); continue; }
            it -= N_S5P;
            { const int idx = it * 8 + wave; s5_wave_item<0>(p, lds + wave * 12800, idx & 31, 0, 0, MP + (idx >> 5) * 16, 16, lane); }
        }
        seam(xb);
    }
    { S.init(M, 512, G, bid); pg8::gemm_phase<true>(lds, pg8::Gemm{HB, WGLU, M, 512, 512, 512}, S, EpiGlu{HB, p.in[21], XC}); }
    { const int nglu = S.nwg; if (G > nglu) { if (bid >= nglu) convert_items(p, lds, CV_W2T, CV_END, (bid - nglu) * 8 + wave, (G - nglu) * 8, wave, lane); } else convert_items(p, lds, CV_W2T, CV_END, gw, ngw, wave, lane); }
    for (int rep = 0; rep < REP_P7; ++rep) { gatenorm_phase(p, gw, ngw, lane); seam(xb); }
    { S.init(MP, D, G, bid); pg8::gemm_phase<true>(lds, pg8::Gemm{XC, WOUT, MP, D, DMIX, DMIX}, S, EpiResid{yout, yout + (size_t)MP * D, yout, 1.0f});
      pg8::SplitOrder S2{8 * (DMIX / 256), G, bid, 256}; pg8::gemm_phase<false>(lds, pg8::Gemm{XC + (size_t)MP * DMIX, WOUT, MS, D, 256, DMIX}, S2, EpiPart{(float*)(p.ws + WS_YS), 1.0f}); }
    seam(xb);
    rms_phase(yout, yout + (size_t)MP * D, p.in[29], HB, gw, ngw, lane, (const float*)(p.ws + WS_YS), DMIX / 256, yout + (size_t)MP * D);
    seam(xb);
    { S.init(M, 2 * FF, G, bid); pg8::gemm_phase<true>(lds, pg8::Gemm{HB, W2T, M, 2 * FF, D, D}, S, EpiGateUp{AB}); }
    seam(xb);
    { S.init(MP, D, G, bid); pg8::gemm_phase<true>(lds, pg8::Gemm{AB, W2D, MP, D, FF, FF}, S, EpiResid{yout, yout + (size_t)MP * D, yout, 0.5f});
      pg8::SplitOrder S2{8 * (FF / 256), G, bid, 256}; pg8::gemm_phase<false>(lds, pg8::Gemm{AB + (size_t)MP * FF, W2D, MS, D, 256, FF}, S2, EpiPart{(float*)(p.ws + WS_YS), 0.5f}); }
    seam(xb);
    { int lane_f = lane; asm volatile("" : "+v"(lane_f));
    for (int m = gw * 4; m < MP; m += ngw * 4) {
        f32x4 v[4][4], ww[4];
#pragma unroll
        for (int r = 0; r < 4; ++r)
#pragma unroll
            for (int j = 0; j < 4; ++j) v[r][j] = ((const f32x4*)(yout + (size_t)(m + r) * D))[lane_f + 64 * j];
#pragma unroll
        for (int j = 0; j < 4; ++j) ww[j] = ((const f32x4*)p.in[33])[lane_f + 64 * j];
#pragma unroll
        for (int r = 0; r < 4; ++r) {
            float ss = 0.f;
#pragma unroll
            for (int j = 0; j < 4; ++j) ss += (v[r][j].x * v[r][j].x + v[r][j].y * v[r][j].y) + (v[r][j].z * v[r][j].z + v[r][j].w * v[r][j].w);
            const float rstd = rsqrtf(wave_sum(ss) * (1.f / D) + EPS);
#pragma unroll
            for (int j = 0; j < 4; ++j) ((f32x4*)(yout + (size_t)(m + r) * D))[lane_f + 64 * j] = v[r][j] * rstd * ww[j];
        }
    }
    for (int ms = ngw - 1 - gw; ms < MS; ms += ngw) {
        f32x4 v[4]; sum_sample_row(yout + (size_t)MP * D, (const float*)(p.ws + WS_YS), FF / 256, ms, lane_f, v);
        float ss = 0.f;
#pragma unroll
        for (int j = 0; j < 4; ++j) ss += (v[j].x * v[j].x + v[j].y * v[j].y) + (v[j].z * v[j].z + v[j].w * v[j].w);
        const float rstd = rsqrtf(wave_sum(ss) * (1.f / D) + EPS);
#pragma unroll
        for (int j = 0; j < 4; ++j) ((f32x4*)(yout + (size_t)(MP + ms) * D))[lane_f + 64 * j] = v[j] * rstd * ((const f32x4*)p.in[33])[lane_f + 64 * j];
    } }
}

extern "C" void kernel_launch(void* const* d_in, const int* in_sizes, int n_in, void* d_out, int out_size, void* d_ws, size_t ws_size, hipStream_t stream) {
    static int grid_blocks = 0;
    if (grid_blocks == 0) {
        if (n_in != 34 || ws_size < WS_END) { fprintf(stderr, "kernel_launch: unexpected n_in %d or ws_size %zu (< %zu)\n", n_in, ws_size, (size_t)WS_END); grid_blocks = -1; return; }
        int dev = 0, cus = 0, per_cu = 0;
        hipGetDevice(&dev);
        hipDeviceGetAttribute(&cus, hipDeviceAttributeMultiprocessorCount, dev);
        hipFuncSetAttribute((const void*)hymba_fwd, hipFuncAttributeMaxDynamicSharedMemorySize, LDS_BYTES);
        hipOccupancyMaxActiveBlocksPerMultiprocessor(&per_cu, (const void*)hymba_fwd, 512, LDS_BYTES);
        if (per_cu < 1) { fprintf(stderr, "kernel_launch: occupancy query says %d blocks/CU\n", per_cu); per_cu = 1; }
        grid_blocks = cus;
    }
    if (grid_blocks < 0) return;
    if (hipMemsetAsync((char*)d_ws + WS_CTL, 0, 16384, stream) != hipSuccess) { fprintf(stderr, "kernel_launch: memset failed\n"); return; }
    Params p{};
    for (int i = 0; i < 34; ++i) p.in[i] = (const float*)d_in[i];
    p.out = (float*)d_out; p.ws = (unsigned char*)d_ws;
    void* args[] = {&p};
    hipError_t e = hipLaunchCooperativeKernel((const void*)hymba_fwd, dim3(grid_blocks), dim3(512), args, LDS_BYTES, stream);
    if (e != hipSuccess) fprintf(stderr, "cooperative launch failed: %s (grid %d)\n", hipGetErrorString(e), grid_blocks);
}
```

```cpp
#include <hip/hip_runtime.h>
#include <hip/hip_cooperative_groups.h>
#include <cstdio>
#include <cstdint>
namespace cg = cooperative_groups;

#define LAS __attribute__((address_space(3)))
typedef unsigned short bf16_t;
typedef short bf16x8 __attribute__((ext_vector_type(8)));
typedef float f32x4 __attribute__((ext_vector_type(4)));
typedef float f32x2 __attribute__((ext_vector_type(2)));
typedef unsigned u32x4 __attribute__((ext_vector_type(4)));
typedef unsigned u32x2 __attribute__((ext_vector_type(2)));

constexpr int D = 1024, FF = 2816, NIN = 4632, NINP = 4864, DMIX = 2048;
constexpr int MP = 16384, MS = 512, M = MP + MS, SEQ = 2048, NB = 8, NSB = 128;
constexpr int XBC = 2560, SSDW = 1536, NH = 24;
constexpr float EPS = 1e-6f;
constexpr size_t O_Y = 0, O_S5RP = 17301504, O_S5IP = 17317888, O_SSDP = 17334272, O_CONVP = 18907136,
                 O_S5RS = 18968576, O_S5IS = 19230720, O_SSDS = 19492864, O_CONVS = 44658688;
constexpr size_t WS_CTL = 0, WS_BAR = 2048, WS_S5A = 16384, WS_BBAR = WS_S5A + 16384, WS_CMAT = WS_BBAR + 131072, WS_DTRAW = WS_CMAT + 131072,
                 WS_W1T = WS_DTRAW + (size_t)M * 24 * 4, WS_W1D = WS_W1T + (size_t)2 * FF * D * 2, WS_W2T = WS_W1D + (size_t)D * FF * 2,
                 WS_W2D = WS_W2T + (size_t)2 * FF * D * 2, WS_WIN = WS_W2D + (size_t)D * FF * 2, WS_WGLU = WS_WIN + (size_t)NINP * D * 2,
                 WS_WOUT = WS_WGLU + (size_t)512 * 512 * 2, WS_H = WS_WOUT + (size_t)D * DMIX * 2, WS_A = WS_H + (size_t)M * D * 2,
                 WS_XC = WS_A + (size_t)M * NINP * 2, WS_YS = WS_XC + (size_t)M * XBC * 2, WS_S5END = WS_YS + (size_t)M * SSDW * 2, WS_END = WS_S5END + (size_t)256 * 8 * 128 * 4;
constexpr size_t XC_BCN = 0, XC_XSN = (size_t)M * 1024 * 2, XC_XT = XC_XSN + (size_t)MS * SSDW * 2, H_BT = (size_t)M * 512 * 2;
constexpr int LDS_BYTES = 158720;
#define REP_P1 1
#define REP_P6 1
#define REP_P5 1
#define REP_P7 1
constexpr int L_BCAST = 158208, L_XBST = 158224;

struct Params {
    const float* in[34];
    float* out;
    unsigned char* ws;
    int use_cg; int pad;
};

__device__ __forceinline__ unsigned pk2(float lo, float hi) { unsigned r; asm volatile("v_cvt_pk_bf16_f32 %0, %1, %2" : "=v"(r) : "v"(lo), "v"(hi)); return r; }
__device__ __forceinline__ float bflo(unsigned u) { return __uint_as_float(u << 16); }
__device__ __forceinline__ float bfhi(unsigned u) { return __uint_as_float(u & 0xffff0000u); }
__device__ __forceinline__ float bf2f(bf16_t v) { return __uint_as_float((unsigned)v << 16); }
__device__ __forceinline__ float wave_sum(float v) {
#pragma unroll
    for (int o = 1; o < 64; o <<= 1) v += __shfl_xor(v, o);
    return v;
}
__device__ __forceinline__ float silu_f(float x) { return x * __builtin_amdgcn_rcpf(1.f + __expf(-x)); }
__device__ __forceinline__ float sigmoid_f(float x) { return __builtin_amdgcn_rcpf(1.f + __expf(-x)); }
__device__ __forceinline__ float softplus_f(float x) {
    const float u = __expf(-fabsf(x));
    const float ser = u * (1.f - u * (0.5f - u * (0.33333334f - u * 0.25f)));
    const float lg = __logf(1.f + u);
    return fmaxf(x, 0.f) + (u < 0.1f ? ser : lg);
}
__device__ __forceinline__ float gelu_tanh(float y) { const float a = 0.7978845608028654f * (y + 0.044715f * y * y * y); const float t = 1.f - 2.f * __builtin_amdgcn_rcpf(1.f + __expf(2.f * a)); return 0.5f * y * (1.f + t); }
#define LDS_WAIT() asm volatile("s_waitcnt lgkmcnt(0)" ::: "memory")
#define LDS_BARRIER() do { asm volatile("s_waitcnt lgkmcnt(0)" ::: "memory"); __builtin_amdgcn_s_barrier(); asm volatile("" ::: "memory"); } while (0)

namespace pg8 {
constexpr int BM = 256, BK = 64, HALF = 128, HTB = HALF * BK * 2, STAGE_BYTES = 8 * HTB, NXCD = 8, WGM = 8;
__host__ __device__ __forceinline__ int lds_byte(int r, int c) { const int st = (r >> 4) * 2 + (c >> 5), rr = r & 15, cc = c & 31, ob = rr * 64 + cc * 2; return st * 1024 + (ob ^ (((ob >> 9) & 1) << 5)); }
__host__ __device__ __forceinline__ void stage_rc(int b, int& R, int& C) { const int st = b / 1024, sb = b % 1024, swz = sb ^ (((sb >> 9) & 1) << 5); R = (st >> 1) * 16 + swz / 64; C = (st & 1) * 32 + (swz % 64) / 2; }
struct Unit { int pm, pn, kofs; };
struct Gemm { const bf16_t* A; const bf16_t* Bt; int M, N, K, ld; };
struct StaticOrder {
    int nM, nN, nwg, G, c;
    __host__ __device__ void init(int M_, int N_, int G_, int c_) { nM = M_ / BM; nN = N_ / BM; nwg = nM * nN; G = G_; c = c_; }
    __host__ __device__ bool next(int i, Unit& u) const {
        const long L = (long)i * G + c; if (L >= nwg) return false;
        int wgid = (int)L; { const int q = nwg / NXCD, r = nwg % NXCD, xcd = wgid % NXCD, off = wgid / NXCD; wgid = (xcd < r ? xcd * (q + 1) : r * (q + 1) + (xcd - r) * q) + off; }
        const int nig = WGM * nN, gid = wgid / nig, fm = gid * WGM, gsz = (nM - fm) < WGM ? (nM - fm) : WGM;
        u.pm = fm + ((wgid % nig) % gsz); u.pn = (wgid % nig) / gsz; u.kofs = 0; return true;
    }
    __device__ __forceinline__ void a_ready(const Unit&) const {}
    __device__ __forceinline__ void done(const Unit&) const {}
};
struct SplitOrder {
    int nunits, G, c, kslice;
    __host__ __device__ bool next(int i, Unit& u) const { const int L = i * G + c; if (L >= nunits) return false; u.pm = L & 1; u.pn = (L >> 1) & 3; u.kofs = (L >> 3) * kslice; return true; }
    __device__ __forceinline__ void a_ready(const Unit&) const {}
    __device__ __forceinline__ void done(const Unit&) const {}
};

template <bool SP2, class Epi, class Sched>
__device__ __forceinline__ void gemm_phase(LAS unsigned char* lds, const Gemm g, const Sched& S, const Epi& E) {
    int tid = threadIdx.x; asm volatile("" : "+v"(tid));
    const int wid = __builtin_amdgcn_readfirstlane(tid >> 6), lane = tid & 63, wr = wid >> 2, wc = wid & 3, fr = lane & 15, fq = lane >> 4;
    const int K = g.K, nt = K / BK;
    int ldv = g.ld; asm volatile("" : "+s"(ldv));
    unsigned voffA[2], voffB[2];
#pragma unroll
    for (int i = 0; i < 2; ++i) { int R, C; stage_rc(tid * 16 + i * 8192, R, C); voffA[i] = (unsigned)(R * ldv + C) * 2u; voffB[i] = voffA[i]; }
    const size_t kstep = (size_t)(BK * 2);
    const size_t hstepA = (size_t)HALF * ldv * 2, hstepB = hstepA;
    const size_t tstepA = 2 * hstepA, tstepB = tstepA;
    const unsigned ldsw = (unsigned)wid * 1024u;
    const int aoff = lds_byte(wr * 64 + fr, fq * 8), boff = lds_byte(wc * 32 + fr, fq * 8);
#define PG8_SA(b, h) (((b) * 2 + (h)) * HTB)
#define PG8_SB(b, h) ((4 + (b) * 2 + (h)) * HTB)
#define PG8_STAGE(bufoff, gbase, voff) do { _Pragma("unroll") for (int _i = 0; _i < 2; ++_i) \
        __builtin_amdgcn_global_load_lds((const unsigned*)((const char*)(gbase) + (voff)[_i]), (LAS unsigned*)(lds + (bufoff) + ldsw + _i * 8192), 16, 0, 0); } while (0)
#define PG8_LDA(dst, b, h) do { _Pragma("unroll") for (int m = 0; m < 4; ++m) _Pragma("unroll") for (int k = 0; k < 2; ++k) dst[m][k] = *(const LAS bf16x8*)(lds + PG8_SA(b, h) + aoff + m * 2048 + k * 1024); } while (0)
#define PG8_LDB(dst, b, h) do { _Pragma("unroll") for (int n = 0; n < 2; ++n) _Pragma("unroll") for (int k = 0; k < 2; ++k) dst[n][k] = *(const LAS bf16x8*)(lds + PG8_SB(b, h) + boff + n * 2048 + k * 1024); } while (0)
#define PG8_MMA(ai, bj, At, Bt) do { __builtin_amdgcn_s_setprio(1); _Pragma("unroll") for (int m = 0; m < 4; ++m) _Pragma("unroll") for (int n = 0; n < 2; ++n) _Pragma("unroll") for (int k = 0; k < 2; ++k) \
        acc[ai][bj][m][n] = __builtin_amdgcn_mfma_f32_16x16x32_bf16(Bt[n][k], At[m][k], acc[ai][bj][m][n], 0, 0, 0); __builtin_amdgcn_s_setprio(0); } while (0)
#define PG8_WAIT_V(n) asm volatile("s_waitcnt vmcnt(" #n ")" ::: "memory")
#define PG8_WAIT_L(n) asm volatile("s_waitcnt lgkmcnt(" #n ")" ::: "memory")
#define PG8_BAR __builtin_amdgcn_s_barrier()
#define PG8_SCHED __builtin_amdgcn_sched_barrier(0)
    Unit cur, nxt; int ui = 0;
    if (!S.next(0, cur)) return;
    f32x4 acc[2][2][4][2];
#pragma unroll
    for (int a = 0; a < 2; ++a)
#pragma unroll
        for (int b = 0; b < 2; ++b)
#pragma unroll
            for (int m = 0; m < 4; ++m)
#pragma unroll
                for (int n = 0; n < 2; ++n) acc[a][b][m][n] = (f32x4){0.f, 0.f, 0.f, 0.f};
    bf16x8 At[4][2], B0[2][2], B1[2][2];
    const char* cA = (const char*)g.A + (size_t)cur.pm * tstepA + (size_t)cur.kofs * 2; const char* cB = (const char*)g.Bt + (size_t)cur.pn * tstepB + (size_t)cur.kofs * 2;
    S.a_ready(cur);
    if constexpr (SP2) {
        PG8_STAGE(PG8_SB(0, 0), cB, voffB); PG8_STAGE(PG8_SB(0, 1), cB + hstepB, voffB); PG8_STAGE(PG8_SA(0, 0), cA, voffA); PG8_STAGE(PG8_SA(0, 1), cA + hstepA, voffA);
        if (wr == 1) PG8_BAR;
        PG8_WAIT_V(2); PG8_BAR;
    } else {
        PG8_STAGE(PG8_SB(0, 0), cB, voffB); PG8_STAGE(PG8_SA(0, 0), cA, voffA); PG8_STAGE(PG8_SB(0, 1), cB + hstepB, voffB); PG8_STAGE(PG8_SA(0, 1), cA + hstepA, voffA);
        if (wr == 1) PG8_BAR;
        PG8_WAIT_V(4); PG8_BAR;
    }
    PG8_STAGE(PG8_SB(1, 0), cB + kstep, voffB); PG8_STAGE(PG8_SA(1, 0), cA + kstep, voffA); PG8_STAGE(PG8_SB(1, 1), cB + hstepB + kstep, voffB);
    PG8_WAIT_V(6); PG8_BAR;
    for (;;) {
        const bool has_next = S.next(ui + 1, nxt);
        const char* nA = has_next ? (const char*)g.A + (size_t)nxt.pm * tstepA + (size_t)nxt.kofs * 2 : cA; const char* nB = has_next ? (const char*)g.Bt + (size_t)nxt.pn * tstepB + (size_t)nxt.kofs * 2 : cB;
        for (int t = 0; t < nt; t += 2) {
            const bool last = (t == nt - 2);
            const char* a1 = cA + (size_t)(t + 1) * kstep;
            const char* a2 = last ? nA : cA + (size_t)(t + 2) * kstep; const char* b2 = last ? nB : cB + (size_t)(t + 2) * kstep;
            const char* a3 = a2 + kstep; const char* b3 = b2 + kstep;
            if (last && has_next) S.a_ready(nxt);
            if constexpr (SP2) {
            PG8_LDB(B0, 0, 0); PG8_LDB(B1, 0, 1); PG8_SCHED; PG8_LDA(At, 0, 0); PG8_STAGE(PG8_SA(1, 1), a1 + hstepA, voffA);
            PG8_WAIT_V(8); PG8_WAIT_L(0); PG8_BAR; PG8_MMA(0, 0, At, B0); PG8_MMA(0, 1, At, B1); PG8_BAR; PG8_SCHED;
            PG8_LDA(At, 0, 1); PG8_STAGE(PG8_SB(0, 0), b2, voffB); PG8_STAGE(PG8_SB(0, 1), b2 + hstepB, voffB); PG8_STAGE(PG8_SA(0, 0), a2, voffA);
            PG8_WAIT_V(8); PG8_WAIT_L(0); PG8_BAR; PG8_MMA(1, 0, At, B0); PG8_MMA(1, 1, At, B1); PG8_BAR; PG8_SCHED;
            PG8_LDB(B0, 1, 0); PG8_LDB(B1, 1, 1); PG8_SCHED; PG8_LDA(At, 1, 0); PG8_STAGE(PG8_SA(0, 1), a2 + hstepA, voffA);
            PG8_WAIT_V(8); PG8_WAIT_L(0); PG8_BAR; PG8_MMA(0, 0, At, B0); PG8_MMA(0, 1, At, B1); PG8_BAR; PG8_SCHED;
            PG8_LDA(At, 1, 1); PG8_STAGE(PG8_SB(1, 0), b3, voffB); PG8_STAGE(PG8_SB(1, 1), b3 + hstepB, voffB); PG8_STAGE(PG8_SA(1, 0), a3, voffA);
            PG8_WAIT_V(8); PG8_WAIT_L(0); PG8_BAR; PG8_MMA(1, 0, At, B0); PG8_MMA(1, 1, At, B1); PG8_BAR; PG8_SCHED;
            } else {
            PG8_LDB(B0, 0, 0); PG8_SCHED; PG8_LDA(At, 0, 0); PG8_STAGE(PG8_SA(1, 1), a1 + hstepA, voffA);
            PG8_WAIT_L(8); PG8_BAR; PG8_WAIT_L(0); PG8_MMA(0, 0, At, B0); PG8_BAR; PG8_SCHED;
            PG8_LDB(B1, 0, 1); PG8_STAGE(PG8_SB(0, 0), b2, voffB);
            PG8_BAR; PG8_WAIT_L(0); PG8_MMA(0, 1, At, B1); PG8_BAR;
            PG8_LDA(At, 0, 1); PG8_STAGE(PG8_SA(0, 0), a2, voffA);
            PG8_BAR; PG8_WAIT_L(0); PG8_MMA(1, 0, At, B0); PG8_BAR; PG8_SCHED;
            PG8_STAGE(PG8_SB(0, 1), b2 + hstepB, voffB);
            PG8_WAIT_V(6); PG8_BAR; PG8_MMA(1, 1, At, B1); PG8_BAR;
            PG8_LDB(B0, 1, 0); PG8_SCHED; PG8_LDA(At, 1, 0); PG8_STAGE(PG8_SA(0, 1), a2 + hstepA, voffA);
            PG8_WAIT_L(8); PG8_BAR; PG8_WAIT_L(0); PG8_MMA(0, 0, At, B0); PG8_BAR; PG8_SCHED;
            PG8_LDB(B1, 1, 1); PG8_STAGE(PG8_SB(1, 0), b3, voffB);
            PG8_BAR; PG8_WAIT_L(0); PG8_MMA(0, 1, At, B1); PG8_BAR;
            PG8_LDA(At, 1, 1); PG8_STAGE(PG8_SA(1, 0), a3, voffA);
            PG8_BAR; PG8_WAIT_L(0); PG8_MMA(1, 0, At, B0); PG8_BAR; PG8_SCHED;
            PG8_STAGE(PG8_SB(1, 1), b3 + hstepB, voffB);
            PG8_WAIT_V(6); PG8_BAR; PG8_MMA(1, 1, At, B1); PG8_BAR;
                    }
        }
        if constexpr (SP2) { if (wr == 0) PG8_BAR; }
        E(acc, cur, wr, wc, fr, fq); S.done(cur);
        if (!has_next) break;
#pragma unroll
        for (int a = 0; a < 2; ++a)
#pragma unroll
            for (int b = 0; b < 2; ++b)
#pragma unroll
                for (int m = 0; m < 4; ++m)
#pragma unroll
                    for (int n = 0; n < 2; ++n) acc[a][b][m][n] = (f32x4){0.f, 0.f, 0.f, 0.f};
        cur = nxt; cA = nA; cB = nB; ++ui;
        if constexpr (SP2) { if (wr == 1) PG8_BAR; }
    }
    PG8_WAIT_V(0);
    if constexpr (!SP2) { if (wr == 0) PG8_BAR; }
    PG8_BAR;
#undef PG8_SA
#undef PG8_SB
#undef PG8_STAGE
#undef PG8_LDA
#undef PG8_LDB
#undef PG8_MMA
#undef PG8_WAIT_V
#undef PG8_WAIT_L
#undef PG8_BAR
#undef PG8_SCHED
}
}
using pg8::Unit;

struct EpiGateUp {
    bf16_t* act;
    __device__ __forceinline__ void operator()(const f32x4 (&acc)[2][2][4][2], const Unit& u, int wr, int wc, int fr, int fq) const {
#pragma unroll
        for (int ai = 0; ai < 2; ++ai)
#pragma unroll
            for (int m = 0; m < 4; ++m) {
                const int r = u.pm * 256 + ai * 128 + wr * 64 + m * 16 + fr;
                const int j = u.pn * 128 + wc * 32 + 8 * fq;
                const f32x4 g0 = acc[ai][0][m][0], g1 = acc[ai][0][m][1], u0 = acc[ai][1][m][0], u1 = acc[ai][1][m][1];
                u32x4 o; o.x = pk2(silu_f(g0[0]) * u0[0], silu_f(g0[1]) * u0[1]); o.y = pk2(silu_f(g0[2]) * u0[2], silu_f(g0[3]) * u0[3]);
                o.z = pk2(silu_f(g1[0]) * u1[0], silu_f(g1[1]) * u1[1]); o.w = pk2(silu_f(g1[2]) * u1[2], silu_f(g1[3]) * u1[3]);
                *(u32x4*)(act + (size_t)r * FF + j) = o;
            }
    }
};
struct EpiResid {
    const float* rp; const float* rs; float* y; float scale;
    __device__ __forceinline__ void operator()(const f32x4 (&acc)[2][2][4][2], const Unit& u, int wr, int wc, int fr, int fq) const {
#pragma unroll
        for (int ai = 0; ai < 2; ++ai)
#pragma unroll
            for (int m = 0; m < 4; ++m) {
                const int r = u.pm * 256 + ai * 128 + wr * 64 + m * 16 + fr;
                const float* rrow = (r < MP) ? rp + (size_t)r * D : rs + (size_t)(r - MP) * D;
                float* yrow = y + (size_t)r * D;
#pragma unroll
                for (int bj = 0; bj < 2; ++bj)
#pragma unroll
                    for (int n = 0; n < 2; ++n) {
                        const int c = u.pn * 256 + bj * 128 + wc * 32 + n * 16 + 4 * fq;
                        const f32x4 rv = *(const f32x4*)(rrow + c);
                        *(f32x4*)(yrow + c) = rv + acc[ai][bj][m][n] * scale;
                    }
            }
    }
};
struct EpiPart {
    float* part; float scale;
    __device__ __forceinline__ void operator()(const f32x4 (&acc)[2][2][4][2], const Unit& u, int wr, int wc, int fr, int fq) const {
        float* pb = part + (size_t)(u.kofs >> 8) * MS * D;
#pragma unroll
        for (int ai = 0; ai < 2; ++ai)
#pragma unroll
            for (int m = 0; m < 4; ++m) {
                float* yrow = pb + (size_t)(u.pm * 256 + ai * 128 + wr * 64 + m * 16 + fr) * D;
#pragma unroll
                for (int bj = 0; bj < 2; ++bj)
#pragma unroll
                    for (int n = 0; n < 2; ++n) {
                        const int c = u.pn * 256 + bj * 128 + wc * 32 + n * 16 + 4 * fq;
                        *(f32x4*)(yrow + c) = acc[ai][bj][m][n] * scale;
                    }
            }
    }
};
struct EpiProj {
    bf16_t* proj; float* dtraw;
    __device__ __forceinline__ void operator()(const f32x4 (&acc)[2][2][4][2], const Unit& u, int wr, int wc, int fr, int fq) const {
#pragma unroll
        for (int ai = 0; ai < 2; ++ai)
#pragma unroll
            for (int m = 0; m < 4; ++m) {
                const int r = u.pm * 256 + ai * 128 + wr * 64 + m * 16 + fr;
#pragma unroll
                for (int bj = 0; bj < 2; ++bj) {
                    const int c = u.pn * 256 + bj * 128 + wc * 32 + 8 * fq;
                    const f32x4 v0 = acc[ai][bj][m][0], v1 = acc[ai][bj][m][1];
                    if (u.pn == 18) { if (c - 4608 < 24) { *(f32x4*)(dtraw + (size_t)r * 24 + (c - 4608)) = v0; *(f32x4*)(dtraw + (size_t)r * 24 + (c - 4608) + 4) = v1; } }
                    else { u32x4 o; o.x = pk2(v0[0], v0[1]); o.y = pk2(v0[2], v0[3]); o.z = pk2(v1[0], v1[1]); o.w = pk2(v1[2], v1[3]); *(u32x4*)(proj + (size_t)r * NINP + c) = o; }
                }
            }
    }
};
struct EpiGlu {
    const bf16_t* v; const float* bias; bf16_t* mix;
    __device__ __forceinline__ void operator()(const f32x4 (&acc)[2][2][4][2], const Unit& u, int wr, int wc, int fr, int fq) const {
#pragma unroll
        for (int ai = 0; ai < 2; ++ai)
#pragma unroll
            for (int m = 0; m < 4; ++m) {
                const int r = u.pm * 256 + ai * 128 + wr * 64 + m * 16 + fr;
#pragma unroll
                for (int bj = 0; bj < 2; ++bj)
#pragma unroll
                    for (int n = 0; n < 2; ++n) {
                        const int c = u.pn * 256 + bj * 128 + wc * 32 + n * 16 + 4 * fq;
                        const f32x4 a = acc[ai][bj][m][n]; const f32x4 bb = *(const f32x4*)(bias + c);
                        const u32x2 vv = *(const u32x2*)(v + (size_t)r * 512 + c);
                        u32x2 o; o.x = pk2(bflo(vv.x) * sigmoid_f(a[0] + bb[0]), bfhi(vv.x) * sigmoid_f(a[1] + bb[1]));
                        o.y = pk2(bflo(vv.y) * sigmoid_f(a[2] + bb[2]), bfhi(vv.y) * sigmoid_f(a[3] + bb[3]));
                        *(u32x2*)(mix + (size_t)r * DMIX + c) = o;
                    }
            }
    }
};

__device__ __forceinline__ void transpose_item(const float* W, int K, int N, bf16_t* WT, int mode, LAS float* scr, int item, int lane) {
    const int nblk = (N + 63) / 64, kb = item / nblk, nb = item % nblk, k0 = 64 * kb, n0 = 64 * nb;
    const int c4 = lane & 15, rr = lane >> 4, nn = n0 + 4 * c4;
    f32x4 v[16];
#pragma unroll
    for (int i = 0; i < 16; ++i) v[i] = (nn < N) ? *(const f32x4*)(W + (size_t)(k0 + 4 * i + rr) * N + nn) : (f32x4){0.f, 0.f, 0.f, 0.f};
#pragma unroll
    for (int i = 0; i < 16; ++i) { LAS float* d = scr + (4 * i + rr) * 65 + 4 * c4; d[0] = v[i][0]; d[1] = v[i][1]; d[2] = v[i][2]; d[3] = v[i][3]; }
    LDS_WAIT();
    const int c = lane & 7, nrow = lane >> 3;
#pragma unroll
    for (int j = 0; j < 8; ++j) { const int n = nrow + 8 * j; const LAS float* s = scr + (8 * c) * 65 + n;
        u32x4 o; o.x = pk2(s[0 * 65], s[1 * 65]); o.y = pk2(s[2 * 65], s[3 * 65]); o.z = pk2(s[4 * 65], s[5 * 65]); o.w = pk2(s[6 * 65], s[7 * 65]);
        const int jn = n0 + n;
        const int ip = 16 * ((jn >> 2) & 1) + 4 * ((jn >> 3) & 3) + (jn & 3);
        const int row = (mode == 0) ? jn : (mode == 3) ? ((jn & ~31) + ip) : ((jn >> 7) * 256 + ((jn & 127) & ~31) + ip + (mode == 5 ? 128 : 0));
        *(u32x4*)(WT + (size_t)row * K + k0 + 8 * c) = o; }
    LDS_WAIT();
}
constexpr int I_GU = (D / 64) * (FF / 64), I_DN = (FF / 64) * (D / 64), I_IN = (D / 64) * ((NIN + 63) / 64), I_GL = (512 / 64) * (512 / 64), I_OUT = (DMIX / 64) * (D / 64);
constexpr int CV_W1T = 0, CV_W1D = 2 * I_GU, CV_WIN = CV_W1D + I_DN, CV_WGLU = CV_WIN + I_IN, CV_WOUT = CV_WGLU + I_GL, CV_W2T = CV_WOUT + I_OUT, CV_W2D = CV_W2T + 2 * I_GU, CV_END = CV_W2D + I_DN;
__device__ __forceinline__ void convert_items(const Params& p, LAS unsigned char* lds, int lo, int hi, int gw, int ngw, int wave, int lane_in) {
    int lane = lane_in; asm volatile("" : "+v"(lane));
    LAS float* scr = (LAS float*)(lds + wave * 16640);
    for (int it = lo + gw; it < hi; it += ngw) {
        int r = it;
        if (r < CV_W1D) { if (r < I_GU) transpose_item(p.in[7], D, FF, (bf16_t*)(p.ws + WS_W1T), 4, scr, r, lane); else transpose_item(p.in[8], D, FF, (bf16_t*)(p.ws + WS_W1T), 5, scr, r - I_GU, lane); continue; }
        if (r < CV_WIN) { transpose_item(p.in[9], FF, D, (bf16_t*)(p.ws + WS_W1D), 0, scr, r - CV_W1D, lane); continue; }
        if (r < CV_WGLU) { transpose_item(p.in[11], D, NIN, (bf16_t*)(p.ws + WS_WIN), 3, scr, r - CV_WIN, lane); continue; }
        if (r < CV_WOUT) { transpose_item(p.in[20], 512, 512, (bf16_t*)(p.ws + WS_WGLU), 0, scr, r - CV_WGLU, lane); continue; }
        if (r < CV_W2T) { transpose_item(p.in[28], DMIX, D, (bf16_t*)(p.ws + WS_WOUT), 0, scr, r - CV_WOUT, lane); continue; }
        if (r < CV_W2D) { r -= CV_W2T; if (r < I_GU) transpose_item(p.in[30], D, FF, (bf16_t*)(p.ws + WS_W2T), 4, scr, r, lane); else transpose_item(p.in[31], D, FF, (bf16_t*)(p.ws + WS_W2T), 5, scr, r - I_GU, lane); continue; }
        transpose_item(p.in[32], FF, D, (bf16_t*)(p.ws + WS_W2D), 0, scr, r - CV_W2D, lane);
    }
}

__device__ __forceinline__ void sum_sample_row(const float* base, const float* part, int nsl, int ms, int lane, f32x4 (&v)[4]) {
#pragma unroll
    for (int j = 0; j < 4; ++j) v[j] = ((const f32x4*)(base + (size_t)ms * D))[lane + 64 * j];
    for (int s0 = 0; s0 < nsl; s0 += 4) {
        f32x4 t[4][4];
#pragma unroll
        for (int q = 0; q < 4; ++q) { const int sl = (s0 + q < nsl) ? s0 + q : nsl - 1;
#pragma unroll
            for (int j = 0; j < 4; ++j) t[q][j] = ((const f32x4*)(part + ((size_t)sl * MS + ms) * D))[lane + 64 * j]; }
#pragma unroll
        for (int q = 0; q < 4; ++q) { const float wq = (s0 + q < nsl) ? 1.f : 0.f;
#pragma unroll
            for (int j = 0; j < 4; ++j) v[j] += t[q][j] * wq; }
    }
}
__device__ __forceinline__ void rms_phase(const float* srcp, const float* srcs, const float* w, bf16_t* dst, int gw, int ngw, int lane_in, const float* part = nullptr, int nsl = 0, float* wb = nullptr) {
    int lane = lane_in; asm volatile("" : "+v"(lane));
    const int mend = (nsl > 0) ? MP : M;
    for (int m = gw * 4; m < mend; m += ngw * 4) {
        const float* xrow = (m < MP) ? srcp + (size_t)m * D : srcs + (size_t)(m - MP) * D;
        f32x4 v[4][4];
#pragma unroll
        for (int r = 0; r < 4; ++r)
#pragma unroll
            for (int j = 0; j < 4; ++j) v[r][j] = ((const f32x4*)(xrow + (size_t)r * D))[lane + 64 * j];
        f32x4 ww[4];
#pragma unroll
        for (int j = 0; j < 4; ++j) ww[j] = ((const f32x4*)w)[lane + 64 * j];
#pragma unroll
        for (int r = 0; r < 4; ++r) {
            float ss = 0.f;
#pragma unroll
            for (int j = 0; j < 4; ++j) ss += (v[r][j].x * v[r][j].x + v[r][j].y * v[r][j].y) + (v[r][j].z * v[r][j].z + v[r][j].w * v[r][j].w);
            const float rstd = rsqrtf(wave_sum(ss) * (1.f / D) + EPS);
            u32x2* o8 = (u32x2*)(dst + (size_t)(m + r) * D) + lane;
#pragma unroll
            for (int j = 0; j < 4; ++j) { u32x2 o; o.x = pk2(v[r][j].x * rstd * ww[j].x, v[r][j].y * rstd * ww[j].y); o.y = pk2(v[r][j].z * rstd * ww[j].z, v[r][j].w * rstd * ww[j].w); o8[64 * j] = o; }
        }
    }
    if (nsl > 0) {
        for (int ms = ngw - 1 - gw; ms < MS; ms += ngw) {
            f32x4 v[4]; sum_sample_row(srcs, part, nsl, ms, lane, v);
            float ss = 0.f;
#pragma unroll
            for (int j = 0; j < 4; ++j) { ((f32x4*)(wb + (size_t)ms * D))[lane + 64 * j] = v[j]; ss += (v[j].x * v[j].x + v[j].y * v[j].y) + (v[j].z * v[j].z + v[j].w * v[j].w); }
            const float rstd = rsqrtf(wave_sum(ss) * (1.f / D) + EPS);
            u32x2* o8 = (u32x2*)(dst + (size_t)(MP + ms) * D) + lane;
#pragma unroll
            for (int j = 0; j < 4; ++j) { const f32x4 ww = ((const f32x4*)w)[lane + 64 * j]; u32x2 o; o.x = pk2(v[j].x * rstd * ww.x, v[j].y * rstd * ww.y); o.y = pk2(v[j].z * rstd * ww.z, v[j].w * rstd * ww.w); o8[64 * j] = o; }
        }
    }
}

__device__ __forceinline__ void unpack8(const u32x4 u, float (&f)[8]) { f[0] = bflo(u.x); f[1] = bfhi(u.x); f[2] = bflo(u.y); f[3] = bfhi(u.y); f[4] = bflo(u.z); f[5] = bfhi(u.z); f[6] = bflo(u.w); f[7] = bfhi(u.w); }
#define BF_ELEM(v, e) ((((e) & 1) ? ((v)[(e) >> 1] >> 16) : ((v)[(e) >> 1] & 0xffffu)))
__device__ __forceinline__ void conv_phase(const Params& p, int gtid, int nthreads) {
    const bf16_t* proj = (const bf16_t*)(p.ws + WS_A);
    bf16_t* BCN = (bf16_t*)(p.ws + WS_XC + XC_BCN); bf16_t* XSN = (bf16_t*)(p.ws + WS_XC + XC_XSN); bf16_t* XT = (bf16_t*)(p.ws + WS_XC + XC_XT); bf16_t* BT = (bf16_t*)(p.ws + WS_H + H_BT);
    const float* cw = p.in[22]; const float* cb = p.in[23]; const float* sconv = p.in[5];
    const int NT_P = (MP / 16) * 320, NT_S = NSB * 320;
    for (int task = gtid; task < NT_P; task += nthreads) {
        const int cgp = task % 320, rb = task / 320, c0 = cgp * 8, m0 = rb * 16;
        const bool first = (m0 % SEQ) == 0, lastblk = (m0 % SEQ) == SEQ - 16;
        u32x4 raw[19];
#pragma unroll
        for (int i = 0; i < 19; ++i) raw[i] = (i >= 3 || !first) ? *(const u32x4*)(proj + (size_t)(m0 - 3 + i) * NINP + 2048 + c0) : (u32x4){0u, 0u, 0u, 0u};
        float w0[8], w1[8], w2[8], w3[8], bs[8];
#pragma unroll
        for (int e = 0; e < 8; e += 4) { *(f32x4*)&w0[e] = *(const f32x4*)(cw + c0 + e); *(f32x4*)&w1[e] = *(const f32x4*)(cw + XBC + c0 + e); *(f32x4*)&w2[e] = *(const f32x4*)(cw + 2 * XBC + c0 + e);
            *(f32x4*)&w3[e] = *(const f32x4*)(cw + 3 * XBC + c0 + e); *(f32x4*)&bs[e] = *(const f32x4*)(cb + c0 + e); }
        float r0[8], r1[8], r2[8];
        unpack8(raw[0], r0); unpack8(raw[1], r1); unpack8(raw[2], r2);
        u32x4 ov[16];
#pragma unroll
        for (int i = 0; i < 16; ++i) {
            float cur[8]; unpack8(raw[i + 3], cur);
            float o[8];
#pragma unroll
            for (int e = 0; e < 8; ++e) { const float cv = bs[e] + w0[e] * r0[e] + w1[e] * r1[e] + w2[e] * r2[e] + w3[e] * cur[e]; o[e] = silu_f(cv); r0[e] = r1[e]; r1[e] = r2[e]; r2[e] = cur[e]; }
            ov[i].x = pk2(o[0], o[1]); ov[i].y = pk2(o[2], o[3]); ov[i].z = pk2(o[4], o[5]); ov[i].w = pk2(o[6], o[7]);
            if (i >= 13 && lastblk) { float* d = p.out + O_CONVP + ((size_t)(m0 / SEQ) * 3 + (i - 13)) * XBC + c0; *(f32x4*)d = (f32x4){cur[0], cur[1], cur[2], cur[3]}; *(f32x4*)(d + 4) = (f32x4){cur[4], cur[5], cur[6], cur[7]}; }
        }
        const int bb = m0 / SEQ, t0 = m0 % SEQ, cc = t0 >> 7, l0 = t0 & 127;
        if (c0 >= 1536) {
            const int cn = c0 - 1536;
#pragma unroll
            for (int i = 0; i < 16; ++i) *(u32x4*)(BCN + (size_t)(m0 + i) * 1024 + cn) = ov[i];
        }
        if (c0 < 2048) {
            bf16_t* tb = (c0 < 1536) ? XT + ((((size_t)(bb * 16 + cc) * NH + (c0 >> 6)) * 64 + (c0 & 63)) * 128 + l0)
                                     : BT + ((((size_t)(bb * 16 + cc) * 4 + ((c0 - 1536) >> 7)) * 128 + ((c0 - 1536) & 127)) * 128 + l0);
            const bool odd = (gtid & 1) != 0;
            bf16_t* t1 = odd ? tb - 8 * 128 + 8 : tb;
            bf16_t* t2 = odd ? tb + 8 : tb + 8 * 128;
#pragma unroll
            for (int e = 0; e < 8; ++e) {
                u32x4 q0, q1;
                q0.x = BF_ELEM(ov[0], e) | (BF_ELEM(ov[1], e) << 16); q0.y = BF_ELEM(ov[2], e) | (BF_ELEM(ov[3], e) << 16); q0.z = BF_ELEM(ov[4], e) | (BF_ELEM(ov[5], e) << 16); q0.w = BF_ELEM(ov[6], e) | (BF_ELEM(ov[7], e) << 16);
                q1.x = BF_ELEM(ov[8], e) | (BF_ELEM(ov[9], e) << 16); q1.y = BF_ELEM(ov[10], e) | (BF_ELEM(ov[11], e) << 16); q1.z = BF_ELEM(ov[12], e) | (BF_ELEM(ov[13], e) << 16); q1.w = BF_ELEM(ov[14], e) | (BF_ELEM(ov[15], e) << 16);
                const u32x4 snd = odd ? q0 : q1; u32x4 rcv;
                rcv.x = __shfl_xor(snd.x, 1); rcv.y = __shfl_xor(snd.y, 1); rcv.z = __shfl_xor(snd.z, 1); rcv.w = __shfl_xor(snd.w, 1);
                *(u32x4*)(t1 + (size_t)e * 128) = odd ? rcv : q0;
                *(u32x4*)(t2 + (size_t)e * 128) = odd ? q1 : rcv;
            }
        }
    }
    for (int task = gtid; task < NT_S; task += nthreads) {
        const int cgp = task % 320, b = task / 320, c0 = cgp * 8, m0 = MP + b * 4;
        u32x4 raw[4];
#pragma unroll
        for (int i = 0; i < 4; ++i) raw[i] = *(const u32x4*)(proj + (size_t)(m0 + i) * NINP + 2048 + c0);
        float w0[8], w1[8], w2[8], w3[8], bs[8], r0[8], r1[8], r2[8];
        const float* st = sconv + (size_t)b * 3 * XBC + c0;
#pragma unroll
        for (int e = 0; e < 8; e += 4) { *(f32x4*)&w0[e] = *(const f32x4*)(cw + c0 + e); *(f32x4*)&w1[e] = *(const f32x4*)(cw + XBC + c0 + e); *(f32x4*)&w2[e] = *(const f32x4*)(cw + 2 * XBC + c0 + e);
            *(f32x4*)&w3[e] = *(const f32x4*)(cw + 3 * XBC + c0 + e); *(f32x4*)&bs[e] = *(const f32x4*)(cb + c0 + e);
            *(f32x4*)&r0[e] = *(const f32x4*)(st + e); *(f32x4*)&r1[e] = *(const f32x4*)(st + XBC + e); *(f32x4*)&r2[e] = *(const f32x4*)(st + 2 * XBC + e); }
#pragma unroll
        for (int i = 0; i < 4; ++i) {
            float cur[8]; unpack8(raw[i], cur);
            float o[8];
#pragma unroll
            for (int e = 0; e < 8; ++e) { const float cv = bs[e] + w0[e] * r0[e] + w1[e] * r1[e] + w2[e] * r2[e] + w3[e] * cur[e]; o[e] = silu_f(cv); r0[e] = r1[e]; r1[e] = r2[e]; r2[e] = cur[e]; }
            u32x4 ov; ov.x = pk2(o[0], o[1]); ov.y = pk2(o[2], o[3]); ov.z = pk2(o[4], o[5]); ov.w = pk2(o[6], o[7]);
            if (c0 < 1536) *(u32x4*)(XSN + (size_t)(m0 + i - MP) * SSDW + c0) = ov;
            else *(u32x4*)(BCN + (size_t)(m0 + i) * 1024 + (c0 - 1536)) = ov;
            if (i >= 1) { float* d = p.out + O_CONVS + ((size_t)b * 3 + (i - 1)) * XBC + c0; *(f32x4*)d = (f32x4){cur[0], cur[1], cur[2], cur[3]}; *(f32x4*)(d + 4) = (f32x4){cur[4], cur[5], cur[6], cur[7]}; }
        }
    }
}

constexpr int LROW = 272;
constexpr int L_C = 0, L_B = 34816, L_BT = 69632, L_XT = 104448, L_XS = 121856, L_HT = 139264, L_AC = 156672, L_DT = 157184, L_G = 157696;
__device__ __forceinline__ float wave_incl_scan(float v, int lane) {
#pragma unroll
    for (int o = 1; o < 64; o <<= 1) { const float t = __shfl_up(v, o); if (lane >= o) v += t; }
    return v;
}
__device__ __forceinline__ void ssd_prompt_item(const Params& p, LAS unsigned char* lds, int b, int h) {
    int tid = threadIdx.x; asm volatile("" : "+v"(tid));
    const int lane = tid & 63, w = __builtin_amdgcn_readfirstlane(tid >> 6), fr = lane & 15, fq = lane >> 4;
    const int g = h / 6;
    const bf16_t* BCN = (const bf16_t*)(p.ws + WS_XC + XC_BCN); const bf16_t* XT = (const bf16_t*)(p.ws + WS_XC + XC_XT); const bf16_t* BT = (const bf16_t*)(p.ws + WS_H + H_BT);
    const float* dtraw = (const float*)(p.ws + WS_DTRAW); bf16_t* ys = (bf16_t*)(p.ws + WS_YS);
    const float a_h = -__expf(p.in[25][h]), dtb = p.in[24][h], Dh = p.in[26][h];
    f32x4 hacc[4];
#pragma unroll
    for (int i = 0; i < 4; ++i) hacc[i] = (f32x4){0.f, 0.f, 0.f, 0.f};
    for (int i = tid; i < 64 * 17; i += 512) *(LAS u32x4*)(lds + L_HT + i * 16) = (u32x4){0u, 0u, 0u, 0u};
    const int prow = tid >> 4, pc = tid & 15;
    u32x4 pvc[4], pvb[4], pvt[4], pvx[2]; float pdl, pdh;
#define SSD_FETCH(cc) do { const int _m0 = b * SEQ + (cc) * 128; \
        pdl = dtraw[(size_t)(_m0 + lane) * 24 + h]; pdh = dtraw[(size_t)(_m0 + 64 + lane) * 24 + h]; \
        const bf16_t* _bt = BT + (((size_t)(b * 16 + (cc)) * 4 + g) * 128) * 128; const bf16_t* _xt = XT + (((size_t)(b * 16 + (cc)) * NH + h) * 64) * 128; \
        _Pragma("unroll") for (int j = 0; j < 4; ++j) { const bf16_t* _gr = BCN + (size_t)(_m0 + prow + 32 * j) * 1024 + g * 128 + pc * 8; pvb[j] = *(const u32x4*)_gr; pvc[j] = *(const u32x4*)(_gr + 512); \
            pvt[j] = *(const u32x4*)(_bt + (size_t)(prow + 32 * j) * 128 + pc * 8); } \
        _Pragma("unroll") for (int j = 0; j < 2; ++j) pvx[j] = *(const u32x4*)(_xt + (size_t)(prow + 32 * j) * 128 + pc * 8); } while (0)
    SSD_FETCH(0);
    for (int c = 0; c < 16; ++c) {
        const int m0 = b * SEQ + c * 128;
        const float dt_lo = softplus_f(pdl + dtb), dt_hi = softplus_f(pdh + dtb);
        const float ac_lo = wave_incl_scan(dt_lo * a_h, lane); const float tot_lo = __shfl(ac_lo, 63);
        const float ac_hi = wave_incl_scan(dt_hi * a_h, lane) + tot_lo; const float alast = __shfl(ac_hi, 63);
        const float sc_lo = dt_lo * __expf(alast - ac_lo), sc_hi = dt_hi * __expf(alast - ac_hi);
        if (w == 0) { const float ae_lo = __shfl(ac_lo, (lane & 48) + 15), ae_hi = __shfl(ac_hi, (lane & 48) + 15);
            *(LAS float*)(lds + L_G + lane * 4) = dt_lo * __expf(ae_lo - ac_lo); *(LAS float*)(lds + L_G + 256 + lane * 4) = dt_hi * __expf(ae_hi - ac_hi);
            *(LAS float*)(lds + L_AC + lane * 4) = ac_lo; *(LAS float*)(lds + L_AC + 256 + lane * 4) = ac_hi; *(LAS float*)(lds + L_DT + lane * 4) = dt_lo; *(LAS float*)(lds + L_DT + 256 + lane * 4) = dt_hi; }
        float sc[8];
#pragma unroll
        for (int e = 0; e < 8; ++e) { const int src = (pc * 8 + e) & 63; const float vlo = __shfl(sc_lo, src), vhi = __shfl(sc_hi, src); sc[e] = (pc < 8) ? vlo : vhi; }
#pragma unroll
        for (int j = 0; j < 4; ++j) {
            const int r = prow + 32 * j;
            *(LAS u32x4*)(lds + L_C + r * LROW + pc * 16) = pvc[j];
            *(LAS u32x4*)(lds + L_B + r * LROW + pc * 16) = pvb[j];
            *(LAS u32x4*)(lds + L_BT + r * LROW + pc * 16) = pvt[j];
        }
#pragma unroll
        for (int j = 0; j < 2; ++j) {
            const int r = prow + 32 * j;
            float xf[8]; unpack8(pvx[j], xf);
            *(LAS u32x4*)(lds + L_XT + r * LROW + pc * 16) = pvx[j];
            u32x4 q; q.x = pk2(xf[0] * sc[0], xf[1] * sc[1]); q.y = pk2(xf[2] * sc[2], xf[3] * sc[3]); q.z = pk2(xf[4] * sc[4], xf[5] * sc[5]); q.w = pk2(xf[6] * sc[6], xf[7] * sc[7]);
            *(LAS u32x4*)(lds + L_XS + r * LROW + pc * 16) = q;
        }
        LDS_BARRIER();
        if (c < 15) SSD_FETCH(c + 1);
        const int l = 16 * w + fr;
        bf16x8 cfrag[4];
#pragma unroll
        for (int ks = 0; ks < 4; ++ks) cfrag[ks] = *(const LAS bf16x8*)(lds + L_C + l * LROW + (ks * 32 + fq * 8) * 2);
        f32x4 yacc[4];
#pragma unroll
        for (int pb = 0; pb < 4; ++pb) {
            f32x4 a = (f32x4){0.f, 0.f, 0.f, 0.f};
#pragma unroll
            for (int ks = 0; ks < 4; ++ks) { const bf16x8 hf = *(const LAS bf16x8*)(lds + L_HT + (pb * 16 + fr) * LROW + (ks * 32 + fq * 8) * 2); a = __builtin_amdgcn_mfma_f32_16x16x32_bf16(hf, cfrag[ks], a, 0, 0, 0); }
            yacc[pb] = a;
        }
        const float al = *(const LAS float*)(lds + L_AC + l * 4);
        { const float el = __expf(al);
#pragma unroll
          for (int pb = 0; pb < 4; ++pb) yacc[pb] = yacc[pb] * el; }
        f32x4 cbt[8];
#pragma unroll
        for (int sb = 0; sb < 8; ++sb) {
            cbt[sb] = (f32x4){0.f, 0.f, 0.f, 0.f};
            if (sb <= w) {
                f32x4 a = (f32x4){0.f, 0.f, 0.f, 0.f};
#pragma unroll
                for (int ks = 0; ks < 4; ++ks) { const bf16x8 bf = *(const LAS bf16x8*)(lds + L_B + (sb * 16 + fr) * LROW + (ks * 32 + fq * 8) * 2); a = __builtin_amdgcn_mfma_f32_16x16x32_bf16(bf, cfrag[ks], a, 0, 0, 0); }
                cbt[sb] = a;
            }
        }
        LDS_BARRIER();
        const int nks = (w >> 1) + 1;
#pragma unroll
        for (int sb = 0; sb < 8; ++sb) {
            if (sb < 2 * nks) {
                const int s0 = sb * 16 + 4 * fq;
                float mv[4];
                if (sb < w) {
                    const float f = __expf(al - *(const LAS float*)(lds + L_AC + (sb * 16 + 15) * 4));
                    const f32x4 gs = *(const LAS f32x4*)(lds + L_G + s0 * 4);
#pragma unroll
                    for (int e = 0; e < 4; ++e) mv[e] = cbt[sb][e] * f * gs[e];
                } else if (sb == w) {
                    const f32x4 as = *(const LAS f32x4*)(lds + L_AC + s0 * 4), ds = *(const LAS f32x4*)(lds + L_DT + s0 * 4);
#pragma unroll
                    for (int e = 0; e < 4; ++e) { const float v = cbt[sb][e] * __expf(al - as[e]) * ds[e]; mv[e] = ((s0 + e) <= l) ? v : 0.f; if (s0 + e == l) mv[e] += Dh; }
                } else {
#pragma unroll
                    for (int e = 0; e < 4; ++e) mv[e] = 0.f;
                }
                u32x2 o; o.x = pk2(mv[0], mv[1]); o.y = pk2(mv[2], mv[3]);
                *(LAS u32x2*)(lds + L_B + l * LROW + s0 * 2) = o;
            }
        }
        LDS_WAIT();
#pragma unroll
        for (int ks = 0; ks < 4; ++ks) {
            if (ks < nks) {
                const bf16x8 mf = *(const LAS bf16x8*)(lds + L_B + l * LROW + (ks * 32 + fq * 8) * 2);
#pragma unroll
                for (int pb = 0; pb < 4; ++pb) { const bf16x8 xf = *(const LAS bf16x8*)(lds + L_XT + (pb * 16 + fr) * LROW + (ks * 32 + fq * 8) * 2); yacc[pb] = __builtin_amdgcn_mfma_f32_16x16x32_bf16(xf, mf, yacc[pb], 0, 0, 0); }
            }
        }
#pragma unroll
        for (int pb = 0; pb < 4; ++pb) {
            const int pcol = h * 64 + pb * 16 + 4 * fq;
            u32x2 o; o.x = pk2(yacc[pb][0], yacc[pb][1]); o.y = pk2(yacc[pb][2], yacc[pb][3]);
            *(u32x2*)(ys + (size_t)(m0 + l) * SSDW + pcol) = o;
        }
        { const float ea = __expf(alast);
#pragma unroll
          for (int pb = 0; pb < 4; ++pb) hacc[pb] = hacc[pb] * ea; }
#pragma unroll
        for (int ks = 0; ks < 4; ++ks) {
            const bf16x8 btf = *(const LAS bf16x8*)(lds + L_BT + (16 * w + fr) * LROW + (ks * 32 + fq * 8) * 2);
#pragma unroll
            for (int pb = 0; pb < 4; ++pb) { const bf16x8 xsf = *(const LAS bf16x8*)(lds + L_XS + (pb * 16 + fr) * LROW + (ks * 32 + fq * 8) * 2); hacc[pb] = __builtin_amdgcn_mfma_f32_16x16x32_bf16(btf, xsf, hacc[pb], 0, 0, 0); }
        }
#pragma unroll
        for (int pb = 0; pb < 4; ++pb) { u32x2 o; o.x = pk2(hacc[pb][0], hacc[pb][1]); o.y = pk2(hacc[pb][2], hacc[pb][3]); *(LAS u32x2*)(lds + L_HT + (pb * 16 + fr) * LROW + (16 * w + 4 * fq) * 2) = o; }
        LDS_BARRIER();
    }
    float* so = p.out + O_SSDP + ((size_t)(b * NH + h) * 64) * 128;
#pragma unroll
    for (int pb = 0; pb < 4; ++pb) *(f32x4*)(so + (size_t)(pb * 16 + fr) * 128 + 16 * w + 4 * fq) = hacc[pb];
}

template <int MODE>
__device__ __forceinline__ void s5_wave_item(const Params& p, LAS unsigned char* wl, int g, int bidx, int seg, int m_start, int nrows, int lane_in) {
    int lane = lane_in; asm volatile("" : "+v"(lane));
    const int fr = lane & 15, fq = lane >> 4;
    const bf16_t* proj = (const bf16_t*)(p.ws + WS_A); bf16_t* vbuf = (bf16_t*)(p.ws + WS_H);
    const bf16_t* BBAR = (const bf16_t*)(p.ws + WS_BBAR); const bf16_t* CMAT = (const bf16_t*)(p.ws + WS_CMAT); const float* AB = (const float*)(p.ws + WS_S5A);
    float* S5E = (float*)(p.ws + WS_S5END);
    const bf16x8 zf = (bf16x8){0, 0, 0, 0, 0, 0, 0, 0};
    bf16x8 bfrag[8], cfrag[4];
#pragma unroll
    for (int t = 0; t < 8; ++t) bfrag[t] = (fq < 2) ? *(const bf16x8*)(BBAR + ((size_t)(g * 128 + t * 16 + fr)) * 16 + fq * 8) : zf;
    if (MODE != 1) {
#pragma unroll
        for (int ks = 0; ks < 4; ++ks) cfrag[ks] = *(const bf16x8*)(CMAT + ((size_t)(g * 16 + fr)) * 128 + ks * 32 + fq * 8);
    }
    const float ar = AB[g * 64 + lane], ai = AB[2048 + g * 64 + lane];
    const f32x4 d4 = *(const f32x4*)(p.in[19] + g * 16 + 4 * fq);
    LAS float* sBu = (LAS float*)wl; LAS bf16_t* sS = (LAS bf16_t*)(wl + 8448);
    float sr = 0.f, si = 0.f;
    if (MODE == 2 && seg > 0) {
        float pr = ar, pi = ai;
#pragma unroll
        for (int q = 0; q < 8; ++q) { const float nr = pr * pr - pi * pi, ni = 2.f * pr * pi; pr = nr; pi = ni; }
        for (int j = 0; j < seg; ++j) {
            const float* e = S5E + ((size_t)((bidx * 32 + g) * 8 + j)) * 128;
            const float er = e[lane], ei = e[64 + lane];
            const float nr = pr * sr - pi * si + er, ni = pr * si + pi * sr + ei; sr = nr; si = ni;
        }
    }
    bf16x8 uf_n; u32x2 u4_n;
    { const bf16_t* urow = proj + (size_t)(m_start + fr) * NINP + g * 16; uf_n = (fq < 2) ? *(const bf16x8*)(urow + fq * 8) : zf; u4_n = *(const u32x2*)(urow + 4 * fq); }
    for (int m0 = m_start; m0 < m_start + nrows; m0 += 16) {
        const bf16x8 uf = uf_n; const u32x2 u4 = u4_n;
        { const int mn = (m0 + 16 < m_start + nrows) ? m0 + 16 : m0; const bf16_t* urow = proj + (size_t)(mn + fr) * NINP + g * 16; uf_n = (fq < 2) ? *(const bf16x8*)(urow + fq * 8) : zf; u4_n = *(const u32x2*)(urow + 4 * fq); }
#pragma unroll
        for (int t = 0; t < 8; ++t) {
            f32x4 a = (f32x4){0.f, 0.f, 0.f, 0.f};
            a = __builtin_amdgcn_mfma_f32_16x16x32_bf16(bfrag[t], uf, a, 0, 0, 0);
            *(LAS f32x4*)(sBu + fr * 132 + t * 16 + 4 * fq) = a;
        }
        LDS_WAIT();
        {
            float br[16], bi[16]; unsigned pkv[16];
#pragma unroll
            for (int t = 0; t < 16; ++t) { br[t] = sBu[t * 132 + lane]; bi[t] = sBu[t * 132 + 64 + lane]; }
            float s0r[4], s0i[4];
            if (MODE == 0) {
#pragma unroll
                for (int q = 0; q < 4; ++q) { const int bb = ((m0 - MP) >> 2) + q; s0r[q] = p.in[2][((size_t)bb * 32 + g) * 64 + lane]; s0i[q] = p.in[3][((size_t)bb * 32 + g) * 64 + lane]; }
            }
#pragma unroll
            for (int t = 0; t < 16; ++t) {
                if (MODE == 0 && (t & 3) == 0) { sr = s0r[t >> 2]; si = s0i[t >> 2]; }
                const float nr = ar * sr - ai * si + br[t], ni = ar * si + ai * sr + bi[t];
                sr = nr; si = ni;
                if (MODE != 1) pkv[t] = pk2(sr, si);
                if (MODE == 0 && (t & 3) == 3) { const int bb = (m0 - MP + t) >> 2; p.out[O_S5RS + ((size_t)bb * 32 + g) * 64 + lane] = sr; p.out[O_S5IS + ((size_t)bb * 32 + g) * 64 + lane] = si; }
            }
            if (MODE != 1) {
#pragma unroll
                for (int t = 0; t < 16; ++t) { sS[t * 136 + lane] = (bf16_t)(pkv[t] & 0xffff); sS[t * 136 + 64 + lane] = (bf16_t)(pkv[t] >> 16); }
            }
        }
        LDS_WAIT();
        if (MODE != 1) {
            f32x4 y = (f32x4){0.f, 0.f, 0.f, 0.f};
#pragma unroll
            for (int ks = 0; ks < 4; ++ks) { const bf16x8 sf = *(const LAS bf16x8*)(sS + fr * 136 + ks * 32 + fq * 8); y = __builtin_amdgcn_mfma_f32_16x16x32_bf16(cfrag[ks], sf, y, 0, 0, 0); }
            const float y0 = y[0] + d4[0] * bflo(u4.x), y1 = y[1] + d4[1] * bfhi(u4.x), y2 = y[2] + d4[2] * bflo(u4.y), y3 = y[3] + d4[3] * bfhi(u4.y);
            u32x2 o; o.x = pk2(gelu_tanh(y0), gelu_tanh(y1)); o.y = pk2(gelu_tanh(y2), gelu_tanh(y3));
            *(u32x2*)(vbuf + (size_t)(m0 + fr) * 512 + g * 16 + 4 * fq) = o;
            LDS_WAIT();
        }
    }
    if (MODE == 1) { float* e = S5E + ((size_t)((bidx * 32 + g) * 8 + seg)) * 128; e[lane] = sr; e[64 + lane] = si; }
    if (MODE == 2 && seg == 7) { p.out[O_S5RP + ((size_t)bidx * 32 + g) * 64 + lane] = sr; p.out[O_S5IP + ((size_t)bidx * 32 + g) * 64 + lane] = si; }
}

#define SMP_LOAD(HS, BS, CS, DS, XS_, PS, pr_) do { const int _b = (pr_) / NH, _h = (pr_) % NH, _g = _h / 6; \
        PS[0] = p.in[25][_h]; PS[1] = p.in[24][_h]; PS[2] = p.in[26][_h]; \
        const float* _h0 = p.in[4] + ((size_t)(_b * NH + _h) * 64 + pp) * 128 + n0; \
        _Pragma("unroll") for (int j = 0; j < 4; ++j) HS[j] = *(const f32x4*)(_h0 + 4 * j); \
        _Pragma("unroll") for (int t = 0; t < 4; ++t) { const int _m = MP + _b * 4 + t; const bf16_t* _row = BCN + (size_t)_m * 1024 + _g * 128 + n0; \
            DS[t] = dtraw[(size_t)_m * 24 + _h]; XS_[t] = *(const unsigned*)(XSN + (size_t)(_m - MP) * SSDW + _h * 64 + (pp & ~1)); \
            BS[t][0] = *(const u32x4*)_row; BS[t][1] = *(const u32x4*)(_row + 8); CS[t][0] = *(const u32x4*)(_row + 512); CS[t][1] = *(const u32x4*)(_row + 520); } } while (0)
#define SMP_COMPUTE(HS, BS, CS, DS, XS_, PS, pr_) do { const int _b = (pr_) / NH, _h = (pr_) % NH; \
        const float a_h = -__expf(PS[0]), dtb = PS[1], Dh = PS[2]; \
        float hv[16]; \
        _Pragma("unroll") for (int j = 0; j < 4; ++j) { hv[4 * j] = HS[j][0]; hv[4 * j + 1] = HS[j][1]; hv[4 * j + 2] = HS[j][2]; hv[4 * j + 3] = HS[j][3]; } \
        _Pragma("unroll") for (int t = 0; t < 4; ++t) { const int _m = MP + _b * 4 + t; \
            const float dt = softplus_f(DS[t] + dtb), dec = __expf(dt * a_h); const float xv = (pp & 1) ? bfhi(XS_[t]) : bflo(XS_[t]), xd = xv * dt; \
            float acc = 0.f; \
            _Pragma("unroll") for (int hf = 0; hf < 2; ++hf) { float Bv[8], Cv[8]; unpack8(BS[t][hf], Bv); unpack8(CS[t][hf], Cv); \
                _Pragma("unroll") for (int j = 0; j < 8; ++j) { hv[8 * hf + j] = hv[8 * hf + j] * dec + xd * Bv[j]; acc += hv[8 * hf + j] * Cv[j]; } } \
            acc += __shfl_xor(acc, 1); acc += __shfl_xor(acc, 2); acc += __shfl_xor(acc, 4); \
            if ((tid & 7) == 0) ys[(size_t)_m * SSDW + _h * 64 + pp] = (bf16_t)(pk2(acc + Dh * xv, 0.f) & 0xffff); } \
        float* _ho = p.out + O_SSDS + ((size_t)(_b * NH + _h) * 64 + pp) * 128 + n0; \
        _Pragma("unroll") for (int j = 0; j < 16; j += 4) *(f32x4*)(_ho + j) = (f32x4){hv[j], hv[j + 1], hv[j + 2], hv[j + 3]}; } while (0)
constexpr int SMP_PAIRS = 6;
__device__ __forceinline__ void ssd_sample_item(const Params& p, int item) {
    int tid = threadIdx.x; asm volatile("" : "+v"(tid));
    const int pp = tid >> 3, n0 = (tid & 7) * 16;
    const bf16_t* BCN = (const bf16_t*)(p.ws + WS_XC + XC_BCN); const bf16_t* XSN = (const bf16_t*)(p.ws + WS_XC + XC_XSN); const float* dtraw = (const float*)(p.ws + WS_DTRAW); bf16_t* ys = (bf16_t*)(p.ws + WS_YS);
    f32x4 hA[4], hB[4]; u32x4 bA[4][2], cA[4][2], bB[4][2], cB[4][2]; float dA[4], dB[4], sA3[3], sB3[3]; unsigned xA[4], xB[4];
    const int pr0 = item * SMP_PAIRS;
    SMP_LOAD(hA, bA, cA, dA, xA, sA3, pr0);
#pragma unroll
    for (int k = 0; k < SMP_PAIRS; k += 2) {
        const int pr = pr0 + k;
        SMP_LOAD(hB, bB, cB, dB, xB, sB3, pr + 1);
        SMP_COMPUTE(hA, bA, cA, dA, xA, sA3, pr);
        if (k + 2 < SMP_PAIRS) SMP_LOAD(hA, bA, cA, dA, xA, sA3, pr + 2);
        SMP_COMPUTE(hB, bB, cB, dB, xB, sB3, pr + 1);
    }
}

__device__ __forceinline__ void gatenorm_phase(const Params& p, int gw, int ngw, int lane_in) {
    int lane = lane_in; asm volatile("" : "+v"(lane));
    const bf16_t* proj = (const bf16_t*)(p.ws + WS_A); const bf16_t* ys = (const bf16_t*)(p.ws + WS_YS); bf16_t* mix = (bf16_t*)(p.ws + WS_XC);
    const float* nw = p.in[27];
    for (int m = gw * 2; m < M; m += ngw * 2) {
        u32x4 yr[2][3], zr[2][3];
#pragma unroll
        for (int r = 0; r < 2; ++r)
#pragma unroll
            for (int j = 0; j < 3; ++j) { const int c0 = (lane + 64 * j) * 8; yr[r][j] = *(const u32x4*)(ys + (size_t)(m + r) * SSDW + c0); zr[r][j] = *(const u32x4*)(proj + (size_t)(m + r) * NINP + 512 + c0); }
#pragma unroll
        for (int r = 0; r < 2; ++r) {
            float gv[3][8]; float sg[4] = {0.f, 0.f, 0.f, 0.f};
#pragma unroll
            for (int j = 0; j < 3; ++j) {
                float yv[8], zv[8]; unpack8(yr[r][j], yv); unpack8(zr[r][j], zv);
                float ss = 0.f;
#pragma unroll
                for (int e = 0; e < 8; ++e) { gv[j][e] = yv[e] * silu_f(zv[e]); ss += gv[j][e] * gv[j][e]; }
                const int grp = (lane + 64 * j) / 48;
#pragma unroll
                for (int q = 0; q < 4; ++q) sg[q] += (grp == q) ? ss : 0.f;
            }
            float rs[4];
#pragma unroll
            for (int q = 0; q < 4; ++q) rs[q] = rsqrtf(wave_sum(sg[q]) * (1.f / 384.f) + EPS);
#pragma unroll
            for (int j = 0; j < 3; ++j) {
                const int c0 = (lane + 64 * j) * 8, grp = (lane + 64 * j) / 48;
                const float rstd = grp == 0 ? rs[0] : (grp == 1 ? rs[1] : (grp == 2 ? rs[2] : rs[3]));
                const f32x4 n0 = *(const f32x4*)(nw + c0), n1 = *(const f32x4*)(nw + c0 + 4);
                u32x4 o; o.x = pk2(gv[j][0] * rstd * n0[0], gv[j][1] * rstd * n0[1]); o.y = pk2(gv[j][2] * rstd * n0[2], gv[j][3] * rstd * n0[3]);
                o.z = pk2(gv[j][4] * rstd * n1[0], gv[j][5] * rstd * n1[1]); o.w = pk2(gv[j][6] * rstd * n1[2], gv[j][7] * rstd * n1[3]);
                *(u32x4*)(mix + (size_t)(m + r) * DMIX + 512 + c0) = o;
            }
        }
    }
}

#define XB_TMO      128
#define XB_XCNT(j)  (256  + 64 * (j))
#define XB_XSUB(j)  (1280 + 64 * (j))
#define XB_XGEN(j)  (2304 + 64 * (j))
#define XB_TOP      3328
#define XB_TOPGEN   3392
#define XCD_BAR_WORDS 3456
#define XB_SPIN_CAP (1u << 18)

__device__ __forceinline__ unsigned xb_ld(unsigned* p)              { return __hip_atomic_load(p, __ATOMIC_RELAXED, __HIP_MEMORY_SCOPE_AGENT); }
__device__ __forceinline__ unsigned xb_add(unsigned* p, unsigned v) { return __hip_atomic_fetch_add(p, v, __ATOMIC_RELAXED, __HIP_MEMORY_SCOPE_AGENT); }
__device__ __forceinline__ unsigned xb_xcc_id() { return (unsigned)__builtin_amdgcn_s_getreg((3 << 11) | 20) & 0xFu; }
#define XB_SPIN(cond, bar) do { unsigned _sp = 0; while (cond) { __builtin_amdgcn_s_sleep(1); \
    if ((++_sp & 255u) == 0u) { if (xb_ld(&(bar)[XB_TMO])) break; if (_sp > XB_SPIN_CAP) { atomicAdd(&(bar)[XB_TMO], 1u); break; } } } } while (0)

struct XcdBarrier {
    unsigned* bar; unsigned x;
    volatile LAS unsigned* st;
};

__device__ __forceinline__ XcdBarrier xcd_barrier_post(unsigned* bar, volatile LAS unsigned* st) {
    XcdBarrier b; b.bar = bar; b.x = xb_xcc_id(); b.st = st;
    if (threadIdx.x == 0) (void)xb_add(&bar[XB_XCNT(b.x)], 1u);
    return b;
}
__device__ __forceinline__ void xcd_barrier_complete(unsigned* bar, unsigned x, unsigned& nloc, unsigned& nx) {
    const unsigned G = gridDim.x * gridDim.y * gridDim.z;
    unsigned sum, cnt, mine, sp = 0u;
    for (;;) {
        sum = 0u; cnt = 0u; mine = 0u;
#pragma unroll
        for (unsigned j = 0; j < 16; ++j) { const unsigned c = xb_ld(&bar[XB_XCNT(j)]); sum += c; cnt += (c > 0u) ? 1u : 0u; mine = (j == x) ? c : mine; }
        if (sum == G) break;
        __builtin_amdgcn_s_sleep(1);
        if ((++sp & 255u) == 0u) { if (xb_ld(&bar[XB_TMO])) break; if (sp > XB_SPIN_CAP) { atomicAdd(&bar[XB_TMO], 1u); break; } }
    }
    nloc = mine > 0u ? mine : 1u; nx = cnt > 0u ? cnt : 1u;
}

__device__ __forceinline__ void xcd_barrier(const XcdBarrier& b) {
    asm volatile("s_waitcnt vmcnt(0)" ::: "memory");
    __syncthreads();
    if (threadIdx.x == 0) {
        unsigned* bar = b.bar;
        __builtin_amdgcn_s_waitcnt(0);
        unsigned nloc = b.st[0], nx = b.st[1];
        if (nloc == 0u) { xcd_barrier_complete(bar, b.x, nloc, nx); b.st[0] = nloc; b.st[1] = nx; }
        const unsigned old = xb_add(&bar[XB_XSUB(b.x)], 1u);
        const unsigned gen = old / nloc;
        if (old + 1u == (gen + 1u) * nloc) {
            __builtin_amdgcn_fence(__ATOMIC_RELEASE, "agent");
            asm volatile("s_waitcnt vmcnt(0)" ::: "memory");
            const unsigned og = xb_add(&bar[XB_TOP], 1u);
            const unsigned tg = og / nx;
            if (og + 1u == (tg + 1u) * nx) xb_add(&bar[XB_TOPGEN], 1u);
            else XB_SPIN(xb_ld(&bar[XB_TOPGEN]) == tg, bar);
            __builtin_amdgcn_fence(__ATOMIC_ACQUIRE, "agent");
            xb_add(&bar[XB_XGEN(b.x)], 1u);
            asm volatile("s_waitcnt vmcnt(0)" ::: "memory");
        } else {
            XB_SPIN(xb_ld(&bar[XB_XGEN(b.x)]) == gen, bar);
            __builtin_amdgcn_fence(__ATOMIC_ACQUIRE, "agent");
            asm volatile("s_waitcnt vmcnt(0)" ::: "memory");
        }
    }
    __syncthreads();
}

__device__ __forceinline__ void seam(const XcdBarrier& b0) { XcdBarrier b = b0; asm volatile("" : "+s"(b.bar)); asm volatile("" : "+s"(b.x)); xcd_barrier(b); }

__global__ void __launch_bounds__(512, 2) hymba_fwd(Params p) {
    extern __shared__ __attribute__((aligned(16))) unsigned char smem[];
    LAS unsigned char* lds = (LAS unsigned char*)smem;
    cg::grid_group grid = cg::this_grid();
    const int tid = threadIdx.x, lane = tid & 63, wave = __builtin_amdgcn_readfirstlane(tid >> 6);
    const int G = gridDim.x, bid = blockIdx.x;
    const int gw = bid * 8 + wave, ngw = G * 8, gtid = bid * 512 + tid, nthreads = G * 512;
    unsigned* ctl = (unsigned*)(p.ws + WS_CTL);
    volatile LAS unsigned* xst = (volatile LAS unsigned*)(lds + L_XBST);
    if (tid == 0) { xst[0] = 0u; xst[1] = 0u; }
    __syncthreads();
    const XcdBarrier xb = xcd_barrier_post((unsigned*)(p.ws + WS_BAR), xst);
    bf16_t* W1T = (bf16_t*)(p.ws + WS_W1T); bf16_t* W1D = (bf16_t*)(p.ws + WS_W1D); bf16_t* W2T = (bf16_t*)(p.ws + WS_W2T); bf16_t* W2D = (bf16_t*)(p.ws + WS_W2D);
    bf16_t* WIN = (bf16_t*)(p.ws + WS_WIN); bf16_t* WGLU = (bf16_t*)(p.ws + WS_WGLU); bf16_t* WOUT = (bf16_t*)(p.ws + WS_WOUT);
    bf16_t* HB = (bf16_t*)(p.ws + WS_H); bf16_t* AB = (bf16_t*)(p.ws + WS_A); bf16_t* XC = (bf16_t*)(p.ws + WS_XC);
    float* yout = p.out + O_Y;
    pg8::StaticOrder S;

    {
        convert_items(p, lds, CV_W1T, CV_W1D, gw, ngw, wave, lane);
        rms_phase(p.in[0], p.in[1], p.in[6], HB, gw, ngw, lane);
        for (int i = gtid; i < MS * D / 4; i += nthreads) ((f32x4*)(yout + (size_t)MP * D))[i] = ((const f32x4*)p.in[1])[i];
    }
    if (p.use_cg) grid.sync();
    seam(xb);
    for (int rep = 0; rep < REP_P1; ++rep) { S.init(M, 2 * FF, G, bid); pg8::gemm_phase<true>(lds, pg8::Gemm{HB, W1T, M, 2 * FF, D, D}, S, EpiGateUp{AB});
        { const int nfull = S.nwg % G; if (nfull > 0 && bid >= nfull) convert_items(p, lds, CV_W1D, CV_WIN, (bid - nfull) * 8 + wave, (G - nfull) * 8, wave, lane); else if (nfull == 0) convert_items(p, lds, CV_W1D, CV_WIN, gw, ngw, wave, lane); }
        if (gtid >= nthreads - 2048) {
            const int idx = gtid - (nthreads - 2048), g = idx >> 6, pp = idx & 63;
            const double lr = p.in[12][idx], li = p.in[13][idx], step = exp((double)p.in[14][g]);
            const double mag = exp(lr * step), ang = li * step;
            const double are = mag * cos(ang), aim = mag * sin(ang);
            const double den = lr * lr + li * li, nre = are - 1.0, nim = aim;
            const float cre = (float)((nre * lr + nim * li) / den), cim = (float)((nim * lr - nre * li) / den);
            float* ABf = (float*)(p.ws + WS_S5A); ABf[idx] = (float)are; ABf[2048 + idx] = (float)aim;
            bf16_t* BBAR = (bf16_t*)(p.ws + WS_BBAR); bf16_t* CMAT = (bf16_t*)(p.ws + WS_CMAT);
            const float* bre = p.in[15] + (size_t)idx * 16; const float* bim = p.in[16] + (size_t)idx * 16;
#pragma unroll
            for (int hh = 0; hh < 16; hh += 2) {
                const float r0 = cre * bre[hh] - cim * bim[hh], r1 = cre * bre[hh + 1] - cim * bim[hh + 1];
                const float i0 = cre * bim[hh] + cim * bre[hh], i1 = cre * bim[hh + 1] + cim * bre[hh + 1];
                *(unsigned*)(BBAR + ((size_t)(g * 128 + pp)) * 16 + hh) = pk2(r0, r1);
                *(unsigned*)(BBAR + ((size_t)(g * 128 + 64 + pp)) * 16 + hh) = pk2(i0, i1);
            }
#pragma unroll
            for (int hh = 0; hh < 16; ++hh) {
                const float cr = p.in[17][((size_t)g * 16 + hh) * 64 + pp], ci = p.in[18][((size_t)g * 16 + hh) * 64 + pp];
                const unsigned pk = pk2(cr, -ci);
                CMAT[((size_t)(g * 16 + hh)) * 128 + pp] = (bf16_t)(pk & 0xffff); CMAT[((size_t)(g * 16 + hh)) * 128 + 64 + pp] = (bf16_t)(pk >> 16);
            }
        }
        seam(xb); }
    { S.init(MP, D, G, bid); pg8::gemm_phase<true>(lds, pg8::Gemm{AB, W1D, MP, D, FF, FF}, S, EpiResid{p.in[0], p.in[1], yout, 0.5f});
      pg8::SplitOrder S2{8 * (FF / 256), G, bid, 256}; pg8::gemm_phase<false>(lds, pg8::Gemm{AB + (size_t)MP * FF, W1D, MS, D, 256, FF}, S2, EpiPart{(float*)(p.ws + WS_YS), 0.5f}); }
    { const int nsp = 8 * (FF / 256); if (G > nsp) { if (bid >= nsp) convert_items(p, lds, CV_WIN, CV_WGLU, (bid - nsp) * 8 + wave, (G - nsp) * 8, wave, lane); } else convert_items(p, lds, CV_WIN, CV_WGLU, gw, ngw, wave, lane); }
    seam(xb);
    rms_phase(yout, yout + (size_t)MP * D, p.in[10], HB, gw, ngw, lane, (const float*)(p.ws + WS_YS), FF / 256, yout + (size_t)MP * D);
    seam(xb);
    { S.init(M, NINP, G, bid); pg8::gemm_phase<true>(lds, pg8::Gemm{HB, WIN, M, NINP, D, D}, S, EpiProj{AB, (float*)(p.ws + WS_DTRAW)}); }
    { const int nfull = S.nwg % G; if (nfull > 0 && bid >= nfull) convert_items(p, lds, CV_WGLU, CV_W2T, (bid - nfull) * 8 + wave, (G - nfull) * 8, wave, lane); else if (nfull == 0) convert_items(p, lds, CV_WGLU, CV_W2T, gw, ngw, wave, lane); }
    seam(xb);
    for (int rep = 0; rep < REP_P5; ++rep) {
        for (int wi = gw; wi < 256 * 7; wi += ngw) { const int pair = wi / 7, sg = wi % 7; s5_wave_item<1>(p, lds + wave * 12800, pair & 31, pair >> 5, sg, (pair >> 5) * SEQ + sg * 256, 256, lane); }
        conv_phase(p, gtid, nthreads); seam(xb); }
    for (int rep = 0; rep < REP_P6; ++rep) {
        volatile LAS int* bc = (volatile LAS int*)(lds + L_BCAST);
        constexpr int N_SSDP = NB * NH, N_S5P = 256, N_S5S = 128, N_SSDS = NSB * NH / SMP_PAIRS;
        for (;;) {
            __syncthreads();
            if (tid == 0) *bc = (int)atomicAdd(&ctl[rep * 64], 1u);
            __syncthreads();
            int it = *bc;
            if (it >= N_SSDP + N_S5P + N_S5S + N_SSDS) break;
            if (it < N_SSDP) { ssd_prompt_item(p, lds, it / NH, it % NH); continue; }
            it -= N_SSDP;
            if (it < N_SSDS) { ssd_sample_item(p, it); continue; }
            it -= N_SSDS;
            if (it < N_S5P) { const int pair = it; s5_wave_item<2>(p, lds + wave * 12800, pair & 31, pair >> 5, wave, (pair >> 5) * SEQ + wave * 256, 256, lane); continue; }
            it -= N_S5P;
            { const int idx = it * 8 + wave; s5_wave_item<0>(p, lds + wave * 12800, idx & 31, 0, 0, MP + (idx >> 5) * 16, 16, lane); }
        }
        seam(xb);
    }
    { S.init(M, 512, G, bid); pg8::gemm_phase<true>(lds, pg8::Gemm{HB, WGLU, M, 512, 512, 512}, S, EpiGlu{HB, p.in[21], XC}); }
    { const int nglu = S.nwg; if (G > nglu) { if (bid >= nglu) convert_items(p, lds, CV_W2T, CV_END, (bid - nglu) * 8 + wave, (G - nglu) * 8, wave, lane); } else convert_items(p, lds, CV_W2T, CV_END, gw, ngw, wave, lane); }
    for (int rep = 0; rep < REP_P7; ++rep) { gatenorm_phase(p, gw, ngw, lane); seam(xb); }
    { S.init(MP, D, G, bid); pg8::gemm_phase<true>(lds, pg8::Gemm{XC, WOUT, MP, D, DMIX, DMIX}, S, EpiResid{yout, yout + (size_t)MP * D, yout, 1.0f});
      pg8::SplitOrder S2{8 * (DMIX / 256), G, bid, 256}; pg8::gemm_phase<false>(lds, pg8::Gemm{XC + (size_t)MP * DMIX, WOUT, MS, D, 256, DMIX}, S2, EpiPart{(float*)(p.ws + WS_YS), 1.0f}); }
    seam(xb);
    rms_phase(yout, yout + (size_t)MP * D, p.in[29], HB, gw, ngw, lane, (const float*)(p.ws + WS_YS), DMIX / 256, yout + (size_t)MP * D);
    seam(xb);
    { S.init(M, 2 * FF, G, bid); pg8::gemm_phase<true>(lds, pg8::Gemm{HB, W2T, M, 2 * FF, D, D}, S, EpiGateUp{AB}); }
    seam(xb);
    { S.init(MP, D, G, bid); pg8::gemm_phase<true>(lds, pg8::Gemm{AB, W2D, MP, D, FF, FF}, S, EpiResid{yout, yout + (size_t)MP * D, yout, 0.5f});
      pg8::SplitOrder S2{8 * (FF / 256), G, bid, 256}; pg8::gemm_phase<false>(lds, pg8::Gemm{AB + (size_t)MP * FF, W2D, MS, D, 256, FF}, S2, EpiPart{(float*)(p.ws + WS_YS), 0.5f}); }
    seam(xb);
    { int lane_f = lane; asm volatile("" : "+v"(lane_f));
    for (int m = gw * 4; m < MP; m += ngw * 4) {
        f32x4 v[4][4], ww[4];
#pragma unroll
        for (int r = 0; r < 4; ++r)
#pragma unroll
            for (int j = 0; j < 4; ++j) v[r][j] = ((const f32x4*)(yout + (size_t)(m + r) * D))[lane_f + 64 * j];
#pragma unroll
        for (int j = 0; j < 4; ++j) ww[j] = ((const f32x4*)p.in[33])[lane_f + 64 * j];
#pragma unroll
        for (int r = 0; r < 4; ++r) {
            float ss = 0.f;
#pragma unroll
            for (int j = 0; j < 4; ++j) ss += (v[r][j].x * v[r][j].x + v[r][j].y * v[r][j].y) + (v[r][j].z * v[r][j].z + v[r][j].w * v[r][j].w);
            const float rstd = rsqrtf(wave_sum(ss) * (1.f / D) + EPS);
#pragma unroll
            for (int j = 0; j < 4; ++j) ((f32x4*)(yout + (size_t)(m + r) * D))[lane_f + 64 * j] = v[r][j] * rstd * ww[j];
        }
    }
    for (int ms = ngw - 1 - gw; ms < MS; ms += ngw) {
        f32x4 v[4]; sum_sample_row(yout + (size_t)MP * D, (const float*)(p.ws + WS_YS), FF / 256, ms, lane_f, v);
        float ss = 0.f;
#pragma unroll
        for (int j = 0; j < 4; ++j) ss += (v[j].x * v[j].x + v[j].y * v[j].y) + (v[j].z * v[j].z + v[j].w * v[j].w);
        const float rstd = rsqrtf(wave_sum(ss) * (1.f / D) + EPS);
#pragma unroll
        for (int j = 0; j < 4; ++j) ((f32x4*)(yout + (size_t)(MP + ms) * D))[lane_f + 64 * j] = v[j] * rstd * ((const f32x4*)p.in[33])[lane_f + 64 * j];
    } }
}

extern "C" void kernel_launch(void* const* d_in, const int* in_sizes, int n_in, void* d_out, int out_size, void* d_ws, size_t ws_size, hipStream_t stream) {
    static int grid_blocks = 0;
    if (grid_blocks == 0) {
        if (n_in != 34 || ws_size < WS_END) { fprintf(stderr, "kernel_launch: unexpected n_in %d or ws_size %zu (< %zu)\n", n_in, ws_size, (size_t)WS_END); grid_blocks = -1; return; }
        int dev = 0, cus = 0, per_cu = 0;
        hipGetDevice(&dev);
        hipDeviceGetAttribute(&cus, hipDeviceAttributeMultiprocessorCount, dev);
        hipFuncSetAttribute((const void*)hymba_fwd, hipFuncAttributeMaxDynamicSharedMemorySize, LDS_BYTES);
        hipOccupancyMaxActiveBlocksPerMultiprocessor(&per_cu, (const void*)hymba_fwd, 512, LDS_BYTES);
        if (per_cu < 1) { fprintf(stderr, "kernel_launch: occupancy query says %d blocks/CU\n", per_cu); per_cu = 1; }
        grid_blocks = cus;
    }
    if (grid_blocks < 0) return;
    if (hipMemsetAsync((char*)d_ws + WS_CTL, 0, 16384, stream) != hipSuccess) { fprintf(stderr, "kernel_launch: memset failed\n"); return; }
    Params p{};
    for (int i = 0; i < 34; ++i) p.in[i] = (const float*)d_in[i];
    p.out = (float*)d_out; p.ws = (unsigned char*)d_ws;
    void* args[] = {&p};
    hipError_t e = hipLaunchCooperativeKernel((const void*)hymba_fwd, dim3(grid_blocks), dim3(512), args, LDS_BYTES, stream);
    if (e != hipSuccess) fprintf(stderr, "cooperative launch failed: %s (grid %d)\n", hipGetErrorString(e), grid_blocks);
}
```

```cpp
#include <hip/hip_runtime.h>
#include <hip/hip_cooperative_groups.h>
#include <cstdio>
#include <cstdint>
namespace cg = cooperative_groups;

#define LAS __attribute__((address_space(3)))
typedef unsigned short bf16_t;
typedef short bf16x8 __attribute__((ext_vector_type(8)));
typedef float f32x4 __attribute__((ext_vector_type(4)));
typedef float f32x2 __attribute__((ext_vector_type(2)));
typedef unsigned u32x4 __attribute__((ext_vector_type(4)));
typedef unsigned u32x2 __attribute__((ext_vector_type(2)));

constexpr int D = 1024, FF = 2816, NIN = 4632, NINP = 4864, DMIX = 2048;
constexpr int MP = 16384, MS = 512, M = MP + MS, SEQ = 2048, NB = 8, NSB = 128;
constexpr int XBC = 2560, SSDW = 1536, NH = 24;
constexpr float EPS = 1e-6f;
constexpr size_t O_Y = 0, O_S5RP = 17301504, O_S5IP = 17317888, O_SSDP = 17334272, O_CONVP = 18907136,
                 O_S5RS = 18968576, O_S5IS = 19230720, O_SSDS = 19492864, O_CONVS = 44658688;
constexpr size_t WS_CTL = 0, WS_BAR = 2048, WS_S5A = 16384, WS_BBAR = WS_S5A + 16384, WS_CMAT = WS_BBAR + 131072, WS_DTRAW = WS_CMAT + 131072,
                 WS_W1T = WS_DTRAW + (size_t)M * 24 * 4, WS_W1D = WS_W1T + (size_t)2 * FF * D * 2, WS_W2T = WS_W1D + (size_t)D * FF * 2,
                 WS_W2D = WS_W2T + (size_t)2 * FF * D * 2, WS_WIN = WS_W2D + (size_t)D * FF * 2, WS_WGLU = WS_WIN + (size_t)NINP * D * 2,
                 WS_WOUT = WS_WGLU + (size_t)512 * 512 * 2, WS_H = WS_WOUT + (size_t)D * DMIX * 2, WS_A = WS_H + (size_t)M * D * 2,
                 WS_XC = WS_A + (size_t)M * NINP * 2, WS_YS = WS_XC + (size_t)M * XBC * 2, WS_S5END = WS_YS + (size_t)M * SSDW * 2, WS_END = WS_S5END + (size_t)256 * 8 * 128 * 4;
constexpr size_t XC_BCN = 0, XC_XSN = (size_t)M * 1024 * 2, XC_XT = XC_XSN + (size_t)MS * SSDW * 2, H_BT = (size_t)M * 512 * 2;
constexpr int LDS_BYTES = 158720;
#define REP_P1 1
#define REP_P6 1
#define REP_P5 1
#define REP_P7 1
constexpr int L_BCAST = 158208, L_XBST = 158224;

struct Params {
    const float* in[34];
    float* out;
    unsigned char* ws;
    int use_cg; int pad;
};

__device__ __forceinline__ unsigned pk2(float lo, float hi) { unsigned r; asm("v_cvt_pk_bf16_f32 %0, %1, %2" : "=v"(r) : "v"(lo), "v"(hi)); return r; }
__device__ __forceinline__ float bflo(unsigned u) { return __uint_as_float(u << 16); }
__device__ __forceinline__ float bfhi(unsigned u) { return __uint_as_float(u & 0xffff0000u); }
__device__ __forceinline__ float bf2f(bf16_t v) { return __uint_as_float((unsigned)v << 16); }
__device__ __forceinline__ float wave_sum(float v) {
#pragma unroll
    for (int o = 1; o < 64; o <<= 1) v += __shfl_xor(v, o);
    return v;
}
__device__ __forceinline__ float silu_f(float x) { return x * __builtin_amdgcn_rcpf(1.f + __expf(-x)); }
__device__ __forceinline__ float sigmoid_f(float x) { return __builtin_amdgcn_rcpf(1.f + __expf(-x)); }
__device__ __forceinline__ float softplus_f(float x) {
    const float u = __expf(-fabsf(x));
    const float ser = u * (1.f - u * (0.5f - u * (0.33333334f - u * 0.25f)));
    const float lg = __logf(1.f + u);
    return fmaxf(x, 0.f) + (u < 0.1f ? ser : lg);
}
__device__ __forceinline__ float gelu_tanh(float y) { const float a = 0.7978845608028654f * (y + 0.044715f * y * y * y); const float t = 1.f - 2.f * __builtin_amdgcn_rcpf(1.f + __expf(2.f * a)); return 0.5f * y * (1.f + t); }
#define LDS_WAIT() asm volatile("s_waitcnt lgkmcnt(0)" ::: "memory")
#define LDS_BARRIER() do { asm volatile("s_waitcnt lgkmcnt(0)" ::: "memory"); __builtin_amdgcn_s_barrier(); asm volatile("" ::: "memory"); } while (0)

namespace pg8 {
constexpr int BM = 256, BK = 64, HALF = 128, HTB = HALF * BK * 2, STAGE_BYTES = 8 * HTB, NXCD = 8, WGM = 8;
__host__ __device__ __forceinline__ int lds_byte(int r, int c) { const int st = (r >> 4) * 2 + (c >> 5), rr = r & 15, cc = c & 31, ob = rr * 64 + cc * 2; return st * 1024 + (ob ^ (((ob >> 9) & 1) << 5)); }
__host__ __device__ __forceinline__ void stage_rc(int b, int& R, int& C) { const int st = b / 1024, sb = b % 1024, swz = sb ^ (((sb >> 9) & 1) << 5); R = (st >> 1) * 16 + swz / 64; C = (st & 1) * 32 + (swz % 64) / 2; }
struct Unit { int pm, pn, kofs; };
struct Gemm { const bf16_t* A; const bf16_t* Bt; int M, N, K, ld; };
struct StaticOrder {
    int nM, nN, nwg, G, c;
    __host__ __device__ void init(int M_, int N_, int G_, int c_) { nM = M_ / BM; nN = N_ / BM; nwg = nM * nN; G = G_; c = c_; }
    __host__ __device__ bool next(int i, Unit& u) const {
        const long L = (long)i * G + c; if (L >= nwg) return false;
        int wgid = (int)L; { const int q = nwg / NXCD, r = nwg % NXCD, xcd = wgid % NXCD, off = wgid / NXCD; wgid = (xcd < r ? xcd * (q + 1) : r * (q + 1) + (xcd - r) * q) + off; }
        const int nig = WGM * nN, gid = wgid / nig, fm = gid * WGM, gsz = (nM - fm) < WGM ? (nM - fm) : WGM;
        u.pm = fm + ((wgid % nig) % gsz); u.pn = (wgid % nig) / gsz; u.kofs = 0; return true;
    }
    __device__ __forceinline__ void a_ready(const Unit&) const {}
    __device__ __forceinline__ void done(const Unit&) const {}
};
struct SplitOrder {
    int nunits, G, c, kslice;
    __host__ __device__ bool next(int i, Unit& u) const { const int L = i * G + c; if (L >= nunits) return false; u.pm = L & 1; u.pn = (L >> 1) & 3; u.kofs = (L >> 3) * kslice; return true; }
    __device__ __forceinline__ void a_ready(const Unit&) const {}
    __device__ __forceinline__ void done(const Unit&) const {}
};

template <bool SP2, class Epi, class Sched>
__device__ __forceinline__ void gemm_phase(LAS unsigned char* lds, const Gemm g, const Sched& S, const Epi& E) {
    int tid = threadIdx.x; asm volatile("" : "+v"(tid));
    const int wid = __builtin_amdgcn_readfirstlane(tid >> 6), lane = tid & 63, wr = wid >> 2, wc = wid & 3, fr = lane & 15, fq = lane >> 4;
    const int K = g.K, nt = K / BK;
    int ldv = g.ld; asm volatile("" : "+s"(ldv));
    unsigned voffA[2], voffB[2];
#pragma unroll
    for (int i = 0; i < 2; ++i) { int R, C; stage_rc(tid * 16 + i * 8192, R, C); voffA[i] = (unsigned)(R * ldv + C) * 2u; voffB[i] = voffA[i]; }
    const size_t kstep = (size_t)(BK * 2);
    const size_t hstepA = (size_t)HALF * ldv * 2, hstepB = hstepA;
    const size_t tstepA = 2 * hstepA, tstepB = tstepA;
    const unsigned ldsw = (unsigned)wid * 1024u;
    const int aoff = lds_byte(wr * 64 + fr, fq * 8), boff = lds_byte(wc * 32 + fr, fq * 8);
#define PG8_SA(b, h) (((b) * 2 + (h)) * HTB)
#define PG8_SB(b, h) ((4 + (b) * 2 + (h)) * HTB)
#define PG8_STAGE(bufoff, gbase, voff) do { _Pragma("unroll") for (int _i = 0; _i < 2; ++_i) \
        __builtin_amdgcn_global_load_lds((const unsigned*)((const char*)(gbase) + (voff)[_i]), (LAS unsigned*)(lds + (bufoff) + ldsw + _i * 8192), 16, 0, 0); } while (0)
#define PG8_LDA(dst, b, h) do { _Pragma("unroll") for (int m = 0; m < 4; ++m) _Pragma("unroll") for (int k = 0; k < 2; ++k) dst[m][k] = *(const LAS bf16x8*)(lds + PG8_SA(b, h) + aoff + m * 2048 + k * 1024); } while (0)
#define PG8_LDB(dst, b, h) do { _Pragma("unroll") for (int n = 0; n < 2; ++n) _Pragma("unroll") for (int k = 0; k < 2; ++k) dst[n][k] = *(const LAS bf16x8*)(lds + PG8_SB(b, h) + boff + n * 2048 + k * 1024); } while (0)
#define PG8_MMA(ai, bj, At, Bt) do { __builtin_amdgcn_s_setprio(1); _Pragma("unroll") for (int m = 0; m < 4; ++m) _Pragma("unroll") for (int n = 0; n < 2; ++n) _Pragma("unroll") for (int k = 0; k < 2; ++k) \
        acc[ai][bj][m][n] = __builtin_amdgcn_mfma_f32_16x16x32_bf16(Bt[n][k], At[m][k], acc[ai][bj][m][n], 0, 0, 0); __builtin_amdgcn_s_setprio(0); } while (0)
#define PG8_WAIT_V(n) asm volatile("s_waitcnt vmcnt(" #n ")" ::: "memory")
#define PG8_WAIT_L(n) asm volatile("s_waitcnt lgkmcnt(" #n ")" ::: "memory")
#define PG8_BAR __builtin_amdgcn_s_barrier()
#define PG8_SCHED __builtin_amdgcn_sched_barrier(0)
    Unit cur, nxt; int ui = 0;
    if (!S.next(0, cur)) return;
    f32x4 acc[2][2][4][2];
#pragma unroll
    for (int a = 0; a < 2; ++a)
#pragma unroll
        for (int b = 0; b < 2; ++b)
#pragma unroll
            for (int m = 0; m < 4; ++m)
#pragma unroll
                for (int n = 0; n < 2; ++n) acc[a][b][m][n] = (f32x4){0.f, 0.f, 0.f, 0.f};
    bf16x8 At[4][2], B0[2][2], B1[2][2];
    const char* cA = (const char*)g.A + (size_t)cur.pm * tstepA + (size_t)cur.kofs * 2; const char* cB = (const char*)g.Bt + (size_t)cur.pn * tstepB + (size_t)cur.kofs * 2;
    S.a_ready(cur);
    if constexpr (SP2) {
        PG8_STAGE(PG8_SB(0, 0), cB, voffB); PG8_STAGE(PG8_SB(0, 1), cB + hstepB, voffB); PG8_STAGE(PG8_SA(0, 0), cA, voffA); PG8_STAGE(PG8_SA(0, 1), cA + hstepA, voffA);
        if (wr == 1) PG8_BAR;
        PG8_WAIT_V(2); PG8_BAR;
    } else {
        PG8_STAGE(PG8_SB(0, 0), cB, voffB); PG8_STAGE(PG8_SA(0, 0), cA, voffA); PG8_STAGE(PG8_SB(0, 1), cB + hstepB, voffB); PG8_STAGE(PG8_SA(0, 1), cA + hstepA, voffA);
        if (wr == 1) PG8_BAR;
        PG8_WAIT_V(4); PG8_BAR;
    }
    PG8_STAGE(PG8_SB(1, 0), cB + kstep, voffB); PG8_STAGE(PG8_SA(1, 0), cA + kstep, voffA); PG8_STAGE(PG8_SB(1, 1), cB + hstepB + kstep, voffB);
    PG8_WAIT_V(6); PG8_BAR;
    for (;;) {
        const bool has_next = S.next(ui + 1, nxt);
        const char* nA = has_next ? (const char*)g.A + (size_t)nxt.pm * tstepA + (size_t)nxt.kofs * 2 : cA; const char* nB = has_next ? (const char*)g.Bt + (size_t)nxt.pn * tstepB + (size_t)nxt.kofs * 2 : cB;
        for (int t = 0; t < nt; t += 2) {
            const bool last = (t == nt - 2);
            const char* a1 = cA + (size_t)(t + 1) * kstep;
            const char* a2 = last ? nA : cA + (size_t)(t + 2) * kstep; const char* b2 = last ? nB : cB + (size_t)(t + 2) * kstep;
            const char* a3 = a2 + kstep; const char* b3 = b2 + kstep;
            if (last && has_next) S.a_ready(nxt);
            if constexpr (SP2) {
            PG8_LDB(B0, 0, 0); PG8_LDB(B1, 0, 1); PG8_SCHED; PG8_LDA(At, 0, 0); PG8_STAGE(PG8_SA(1, 1), a1 + hstepA, voffA);
            PG8_WAIT_V(8); PG8_WAIT_L(0); PG8_BAR; PG8_MMA(0, 0, At, B0); PG8_MMA(0, 1, At, B1); PG8_BAR; PG8_SCHED;
            PG8_LDA(At, 0, 1); PG8_STAGE(PG8_SB(0, 0), b2, voffB); PG8_STAGE(PG8_SB(0, 1), b2 + hstepB, voffB); PG8_STAGE(PG8_SA(0, 0), a2, voffA);
            PG8_WAIT_V(8); PG8_WAIT_L(0); PG8_BAR; PG8_MMA(1, 0, At, B0); PG8_MMA(1, 1, At, B1); PG8_BAR; PG8_SCHED;
            PG8_LDB(B0, 1, 0); PG8_LDB(B1, 1, 1); PG8_SCHED; PG8_LDA(At, 1, 0); PG8_STAGE(PG8_SA(0, 1), a2 + hstepA, voffA);
            PG8_WAIT_V(8); PG8_WAIT_L(0); PG8_BAR; PG8_MMA(0, 0, At, B0); PG8_MMA(0, 1, At, B1); PG8_BAR; PG8_SCHED;
            PG8_LDA(At, 1, 1); PG8_STAGE(PG8_SB(1, 0), b3, voffB); PG8_STAGE(PG8_SB(1, 1), b3 + hstepB, voffB); PG8_STAGE(PG8_SA(1, 0), a3, voffA);
            PG8_WAIT_V(8); PG8_WAIT_L(0); PG8_BAR; PG8_MMA(1, 0, At, B0); PG8_MMA(1, 1, At, B1); PG8_BAR; PG8_SCHED;
            } else {
            PG8_LDB(B0, 0, 0); PG8_SCHED; PG8_LDA(At, 0, 0); PG8_STAGE(PG8_SA(1, 1), a1 + hstepA, voffA);
            PG8_WAIT_L(8); PG8_BAR; PG8_WAIT_L(0); PG8_MMA(0, 0, At, B0); PG8_BAR; PG8_SCHED;
            PG8_LDB(B1, 0, 1); PG8_STAGE(PG8_SB(0, 0), b2, voffB);
            PG8_BAR; PG8_WAIT_L(0); PG8_MMA(0, 1, At, B1); PG8_BAR;
            PG8_LDA(At, 0, 1); PG8_STAGE(PG8_SA(0, 0), a2, voffA);
            PG8_BAR; PG8_WAIT_L(0); PG8_MMA(1, 0, At, B0); PG8_BAR; PG8_SCHED;
            PG8_STAGE(PG8_SB(0, 1), b2 + hstepB, voffB);
            PG8_WAIT_V(6); PG8_BAR; PG8_MMA(1, 1, At, B1); PG8_BAR;
            PG8_LDB(B0, 1, 0); PG8_SCHED; PG8_LDA(At, 1, 0); PG8_STAGE(PG8_SA(0, 1), a2 + hstepA, voffA);
            PG8_WAIT_L(8); PG8_BAR; PG8_WAIT_L(0); PG8_MMA(0, 0, At, B0); PG8_BAR; PG8_SCHED;
            PG8_LDB(B1, 1, 1); PG8_STAGE(PG8_SB(1, 0), b3, voffB);
            PG8_BAR; PG8_WAIT_L(0); PG8_MMA(0, 1, At, B1); PG8_BAR;
            PG8_LDA(At, 1, 1); PG8_STAGE(PG8_SA(1, 0), a3, voffA);
            PG8_BAR; PG8_WAIT_L(0); PG8_MMA(1, 0, At, B0); PG8_BAR; PG8_SCHED;
            PG8_STAGE(PG8_SB(1, 1), b3 + hstepB, voffB);
            PG8_WAIT_V(6); PG8_BAR; PG8_MMA(1, 1, At, B1); PG8_BAR;
                    }
        }
        if constexpr (SP2) { if (wr == 0) PG8_BAR; }
        E(acc, cur, wr, wc, fr, fq); S.done(cur);
        if (!has_next) break;
#pragma unroll
        for (int a = 0; a < 2; ++a)
#pragma unroll
            for (int b = 0; b < 2; ++b)
#pragma unroll
                for (int m = 0; m < 4; ++m)
#pragma unroll
                    for (int n = 0; n < 2; ++n) acc[a][b][m][n] = (f32x4){0.f, 0.f, 0.f, 0.f};
        cur = nxt; cA = nA; cB = nB; ++ui;
        if constexpr (SP2) { if (wr == 1) PG8_BAR; }
    }
    PG8_WAIT_V(0);
    if constexpr (!SP2) { if (wr == 0) PG8_BAR; }
    PG8_BAR;
#undef PG8_SA
#undef PG8_SB
#undef PG8_STAGE
#undef PG8_LDA
#undef PG8_LDB
#undef PG8_MMA
#undef PG8_WAIT_V
#undef PG8_WAIT_L
#undef PG8_BAR
#undef PG8_SCHED
}
}
using pg8::Unit;

struct EpiGateUp {
    bf16_t* act;
    __device__ __forceinline__ void operator()(const f32x4 (&acc)[2][2][4][2], const Unit& u, int wr, int wc, int fr, int fq) const {
#pragma unroll
        for (int ai = 0; ai < 2; ++ai)
#pragma unroll
            for (int m = 0; m < 4; ++m) {
                const int r = u.pm * 256 + ai * 128 + wr * 64 + m * 16 + fr;
                const int j = u.pn * 128 + wc * 32 + 8 * fq;
                const f32x4 g0 = acc[ai][0][m][0], g1 = acc[ai][0][m][1], u0 = acc[ai][1][m][0], u1 = acc[ai][1][m][1];
                u32x4 o; o.x = pk2(silu_f(g0[0]) * u0[0], silu_f(g0[1]) * u0[1]); o.y = pk2(silu_f(g0[2]) * u0[2], silu_f(g0[3]) * u0[3]);
                o.z = pk2(silu_f(g1[0]) * u1[0], silu_f(g1[1]) * u1[1]); o.w = pk2(silu_f(g1[2]) * u1[2], silu_f(g1[3]) * u1[3]);
                *(u32x4*)(act + (size_t)r * FF + j) = o;
            }
    }
};
struct EpiResid {
    const float* rp; const float* rs; float* y; float scale;
    __device__ __forceinline__ void operator()(const f32x4 (&acc)[2][2][4][2], const Unit& u, int wr, int wc, int fr, int fq) const {
#pragma unroll
        for (int ai = 0; ai < 2; ++ai)
#pragma unroll
            for (int m = 0; m < 4; ++m) {
                const int r = u.pm * 256 + ai * 128 + wr * 64 + m * 16 + fr;
                const float* rrow = (r < MP) ? rp + (size_t)r * D : rs + (size_t)(r - MP) * D;
                float* yrow = y + (size_t)r * D;
#pragma unroll
                for (int bj = 0; bj < 2; ++bj)
#pragma unroll
                    for (int n = 0; n < 2; ++n) {
                        const int c = u.pn * 256 + bj * 128 + wc * 32 + n * 16 + 4 * fq;
                        const f32x4 rv = *(const f32x4*)(rrow + c);
                        *(f32x4*)(yrow + c) = rv + acc[ai][bj][m][n] * scale;
                    }
            }
    }
};
struct EpiPart {
    float* part; float scale;
    __device__ __forceinline__ void operator()(const f32x4 (&acc)[2][2][4][2], const Unit& u, int wr, int wc, int fr, int fq) const {
        float* pb = part + (size_t)(u.kofs >> 8) * MS * D;
#pragma unroll
        for (int ai = 0; ai < 2; ++ai)
#pragma unroll
            for (int m = 0; m < 4; ++m) {
                float* yrow = pb + (size_t)(u.pm * 256 + ai * 128 + wr * 64 + m * 16 + fr) * D;
#pragma unroll
                for (int bj = 0; bj < 2; ++bj)
#pragma unroll
                    for (int n = 0; n < 2; ++n) {
                        const int c = u.pn * 256 + bj * 128 + wc * 32 + n * 16 + 4 * fq;
                        *(f32x4*)(yrow + c) = acc[ai][bj][m][n] * scale;
                    }
            }
    }
};
struct EpiProj {
    bf16_t* proj; float* dtraw;
    __device__ __forceinline__ void operator()(const f32x4 (&acc)[2][2][4][2], const Unit& u, int wr, int wc, int fr, int fq) const {
#pragma unroll
        for (int ai = 0; ai < 2; ++ai)
#pragma unroll
            for (int m = 0; m < 4; ++m) {
                const int r = u.pm * 256 + ai * 128 + wr * 64 + m * 16 + fr;
#pragma unroll
                for (int bj = 0; bj < 2; ++bj) {
                    const int c = u.pn * 256 + bj * 128 + wc * 32 + 8 * fq;
                    const f32x4 v0 = acc[ai][bj][m][0], v1 = acc[ai][bj][m][1];
                    if (u.pn == 18) { if (c - 4608 < 24) { *(f32x4*)(dtraw + (size_t)r * 24 + (c - 4608)) = v0; *(f32x4*)(dtraw + (size_t)r * 24 + (c - 4608) + 4) = v1; } }
                    else { u32x4 o; o.x = pk2(v0[0], v0[1]); o.y = pk2(v0[2], v0[3]); o.z = pk2(v1[0], v1[1]); o.w = pk2(v1[2], v1[3]); *(u32x4*)(proj + (size_t)r * NINP + c) = o; }
                }
            }
    }
};
struct EpiGlu {
    const bf16_t* v; const float* bias; bf16_t* mix;
    __device__ __forceinline__ void operator()(const f32x4 (&acc)[2][2][4][2], const Unit& u, int wr, int wc, int fr, int fq) const {
#pragma unroll
        for (int ai = 0; ai < 2; ++ai)
#pragma unroll
            for (int m = 0; m < 4; ++m) {
                const int r = u.pm * 256 + ai * 128 + wr * 64 + m * 16 + fr;
#pragma unroll
                for (int bj = 0; bj < 2; ++bj)
#pragma unroll
                    for (int n = 0; n < 2; ++n) {
                        const int c = u.pn * 256 + bj * 128 + wc * 32 + n * 16 + 4 * fq;
                        const f32x4 a = acc[ai][bj][m][n]; const f32x4 bb = *(const f32x4*)(bias + c);
                        const u32x2 vv = *(const u32x2*)(v + (size_t)r * 512 + c);
                        u32x2 o; o.x = pk2(bflo(vv.x) * sigmoid_f(a[0] + bb[0]), bfhi(vv.x) * sigmoid_f(a[1] + bb[1]));
                        o.y = pk2(bflo(vv.y) * sigmoid_f(a[2] + bb[2]), bfhi(vv.y) * sigmoid_f(a[3] + bb[3]));
                        *(u32x2*)(mix + (size_t)r * DMIX + c) = o;
                    }
            }
    }
};

__device__ __forceinline__ void transpose_item(const float* W, int K, int N, bf16_t* WT, int mode, LAS float* scr, int item, int lane) {
    const int nblk = (N + 63) / 64, kb = item / nblk, nb = item % nblk, k0 = 64 * kb, n0 = 64 * nb;
    const int c4 = lane & 15, rr = lane >> 4, nn = n0 + 4 * c4;
    f32x4 v[16];
#pragma unroll
    for (int i = 0; i < 16; ++i) v[i] = (nn < N) ? *(const f32x4*)(W + (size_t)(k0 + 4 * i + rr) * N + nn) : (f32x4){0.f, 0.f, 0.f, 0.f};
#pragma unroll
    for (int i = 0; i < 16; ++i) { LAS float* d = scr + (4 * i + rr) * 65 + 4 * c4; d[0] = v[i][0]; d[1] = v[i][1]; d[2] = v[i][2]; d[3] = v[i][3]; }
    LDS_WAIT();
    const int c = lane & 7, nrow = lane >> 3;
#pragma unroll
    for (int j = 0; j < 8; ++j) { const int n = nrow + 8 * j; const LAS float* s = scr + (8 * c) * 65 + n;
        u32x4 o; o.x = pk2(s[0 * 65], s[1 * 65]); o.y = pk2(s[2 * 65], s[3 * 65]); o.z = pk2(s[4 * 65], s[5 * 65]); o.w = pk2(s[6 * 65], s[7 * 65]);
        const int jn = n0 + n;
        const int ip = 16 * ((jn >> 2) & 1) + 4 * ((jn >> 3) & 3) + (jn & 3);
        const int row = (mode == 0) ? jn : (mode == 3) ? ((jn & ~31) + ip) : ((jn >> 7) * 256 + ((jn & 127) & ~31) + ip + (mode == 5 ? 128 : 0));
        *(u32x4*)(WT + (size_t)row * K + k0 + 8 * c) = o; }
    LDS_WAIT();
}
constexpr int I_GU = (D / 64) * (FF / 64), I_DN = (FF / 64) * (D / 64), I_IN = (D / 64) * ((NIN + 63) / 64), I_GL = (512 / 64) * (512 / 64), I_OUT = (DMIX / 64) * (D / 64);
constexpr int CV_W1T = 0, CV_W1D = 2 * I_GU, CV_WIN = CV_W1D + I_DN, CV_WGLU = CV_WIN + I_IN, CV_WOUT = CV_WGLU + I_GL, CV_W2T = CV_WOUT + I_OUT, CV_W2D = CV_W2T + 2 * I_GU, CV_END = CV_W2D + I_DN;
__device__ __forceinline__ void convert_items(const Params& p, LAS unsigned char* lds, int lo, int hi, int gw, int ngw, int wave, int lane_in) {
    int lane = lane_in; asm volatile("" : "+v"(lane));
    LAS float* scr = (LAS float*)(lds + wave * 16640);
    for (int it = lo + gw; it < hi; it += ngw) {
        int r = it;
        if (r < CV_W1D) { if (r < I_GU) transpose_item(p.in[7], D, FF, (bf16_t*)(p.ws + WS_W1T), 4, scr, r, lane); else transpose_item(p.in[8], D, FF, (bf16_t*)(p.ws + WS_W1T), 5, scr, r - I_GU, lane); continue; }
        if (r < CV_WIN) { transpose_item(p.in[9], FF, D, (bf16_t*)(p.ws + WS_W1D), 0, scr, r - CV_W1D, lane); continue; }
        if (r < CV_WGLU) { transpose_item(p.in[11], D, NIN, (bf16_t*)(p.ws + WS_WIN), 3, scr, r - CV_WIN, lane); continue; }
        if (r < CV_WOUT) { transpose_item(p.in[20], 512, 512, (bf16_t*)(p.ws + WS_WGLU), 0, scr, r - CV_WGLU, lane); continue; }
        if (r < CV_W2T) { transpose_item(p.in[28], DMIX, D, (bf16_t*)(p.ws + WS_WOUT), 0, scr, r - CV_WOUT, lane); continue; }
        if (r < CV_W2D) { r -= CV_W2T; if (r < I_GU) transpose_item(p.in[30], D, FF, (bf16_t*)(p.ws + WS_W2T), 4, scr, r, lane); else transpose_item(p.in[31], D, FF, (bf16_t*)(p.ws + WS_W2T), 5, scr, r - I_GU, lane); continue; }
        transpose_item(p.in[32], FF, D, (bf16_t*)(p.ws + WS_W2D), 0, scr, r - CV_W2D, lane);
    }
}

__device__ __forceinline__ void sum_sample_row(const float* base, const float* part, int nsl, int ms, int lane, f32x4 (&v)[4]) {
#pragma unroll
    for (int j = 0; j < 4; ++j) v[j] = ((const f32x4*)(base + (size_t)ms * D))[lane + 64 * j];
    for (int s0 = 0; s0 < nsl; s0 += 4) {
        f32x4 t[4][4];
#pragma unroll
        for (int q = 0; q < 4; ++q) { const int sl = (s0 + q < nsl) ? s0 + q : nsl - 1;
#pragma unroll
            for (int j = 0; j < 4; ++j) t[q][j] = ((const f32x4*)(part + ((size_t)sl * MS + ms) * D))[lane + 64 * j]; }
#pragma unroll
        for (int q = 0; q < 4; ++q) { const float wq = (s0 + q < nsl) ? 1.f : 0.f;
#pragma unroll
            for (int j = 0; j < 4; ++j) v[j] += t[q][j] * wq; }
    }
}
__device__ __forceinline__ void rms_phase(const float* srcp, const float* srcs, const float* w, bf16_t* dst, int gw, int ngw, int lane_in, const float* part = nullptr, int nsl = 0, float* wb = nullptr) {
    int lane = lane_in; asm volatile("" : "+v"(lane));
    const int mend = (nsl > 0) ? MP : M;
    for (int m = gw * 4; m < mend; m += ngw * 4) {
        const float* xrow = (m < MP) ? srcp + (size_t)m * D : srcs + (size_t)(m - MP) * D;
        f32x4 v[4][4];
#pragma unroll
        for (int r = 0; r < 4; ++r)
#pragma unroll
            for (int j = 0; j < 4; ++j) v[r][j] = ((const f32x4*)(xrow + (size_t)r * D))[lane + 64 * j];
        f32x4 ww[4];
#pragma unroll
        for (int j = 0; j < 4; ++j) ww[j] = ((const f32x4*)w)[lane + 64 * j];
#pragma unroll
        for (int r = 0; r < 4; ++r) {
            float ss = 0.f;
#pragma unroll
            for (int j = 0; j < 4; ++j) ss += (v[r][j].x * v[r][j].x + v[r][j].y * v[r][j].y) + (v[r][j].z * v[r][j].z + v[r][j].w * v[r][j].w);
            const float rstd = rsqrtf(wave_sum(ss) * (1.f / D) + EPS);
            u32x2* o8 = (u32x2*)(dst + (size_t)(m + r) * D) + lane;
#pragma unroll
            for (int j = 0; j < 4; ++j) { u32x2 o; o.x = pk2(v[r][j].x * rstd * ww[j].x, v[r][j].y * rstd * ww[j].y); o.y = pk2(v[r][j].z * rstd * ww[j].z, v[r][j].w * rstd * ww[j].w); o8[64 * j] = o; }
        }
    }
    if (nsl > 0) {
        for (int ms = ngw - 1 - gw; ms < MS; ms += ngw) {
            f32x4 v[4]; sum_sample_row(srcs, part, nsl, ms, lane, v);
            float ss = 0.f;
#pragma unroll
            for (int j = 0; j < 4; ++j) { ((f32x4*)(wb + (size_t)ms * D))[lane + 64 * j] = v[j]; ss += (v[j].x * v[j].x + v[j].y * v[j].y) + (v[j].z * v[j].z + v[j].w * v[j].w); }
            const float rstd = rsqrtf(wave_sum(ss) * (1.f / D) + EPS);
            u32x2* o8 = (u32x2*)(dst + (size_t)(MP + ms) * D) + lane;
#pragma unroll
            for (int j = 0; j < 4; ++j) { const f32x4 ww = ((const f32x4*)w)[lane + 64 * j]; u32x2 o; o.x = pk2(v[j].x * rstd * ww.x, v[j].y * rstd * ww.y); o.y = pk2(v[j].z * rstd * ww.z, v[j].w * rstd * ww.w); o8[64 * j] = o; }
        }
    }
}

__device__ __forceinline__ void unpack8(const u32x4 u, float (&f)[8]) { f[0] = bflo(u.x); f[1] = bfhi(u.x); f[2] = bflo(u.y); f[3] = bfhi(u.y); f[4] = bflo(u.z); f[5] = bfhi(u.z); f[6] = bflo(u.w); f[7] = bfhi(u.w); }
#define BF_ELEM(v, e) ((((e) & 1) ? ((v)[(e) >> 1] >> 16) : ((v)[(e) >> 1] & 0xffffu)))
__device__ __forceinline__ void conv_phase(const Params& p, int gtid, int nthreads) {
    const bf16_t* proj = (const bf16_t*)(p.ws + WS_A);
    bf16_t* BCN = (bf16_t*)(p.ws + WS_XC + XC_BCN); bf16_t* XSN = (bf16_t*)(p.ws + WS_XC + XC_XSN); bf16_t* XT = (bf16_t*)(p.ws + WS_XC + XC_XT); bf16_t* BT = (bf16_t*)(p.ws + WS_H + H_BT);
    const float* cw = p.in[22]; const float* cb = p.in[23]; const float* sconv = p.in[5];
    const int NT_P = (MP / 16) * 320, NT_S = NSB * 320;
    for (int task = gtid; task < NT_P; task += nthreads) {
        const int cgp = task % 320, rb = task / 320, c0 = cgp * 8, m0 = rb * 16;
        const bool first = (m0 % SEQ) == 0, lastblk = (m0 % SEQ) == SEQ - 16;
        u32x4 raw[19];
#pragma unroll
        for (int i = 0; i < 19; ++i) raw[i] = (i >= 3 || !first) ? *(const u32x4*)(proj + (size_t)(m0 - 3 + i) * NINP + 2048 + c0) : (u32x4){0u, 0u, 0u, 0u};
        float w0[8], w1[8], w2[8], w3[8], bs[8];
#pragma unroll
        for (int e = 0; e < 8; e += 4) { *(f32x4*)&w0[e] = *(const f32x4*)(cw + c0 + e); *(f32x4*)&w1[e] = *(const f32x4*)(cw + XBC + c0 + e); *(f32x4*)&w2[e] = *(const f32x4*)(cw + 2 * XBC + c0 + e);
            *(f32x4*)&w3[e] = *(const f32x4*)(cw + 3 * XBC + c0 + e); *(f32x4*)&bs[e] = *(const f32x4*)(cb + c0 + e); }
        float r0[8], r1[8], r2[8];
        unpack8(raw[0], r0); unpack8(raw[1], r1); unpack8(raw[2], r2);
        u32x4 ov[16];
#pragma unroll
        for (int i = 0; i < 16; ++i) {
            float cur[8]; unpack8(raw[i + 3], cur);
            float o[8];
#pragma unroll
            for (int e = 0; e < 8; ++e) { const float cv = bs[e] + w0[e] * r0[e] + w1[e] * r1[e] + w2[e] * r2[e] + w3[e] * cur[e]; o[e] = silu_f(cv); r0[e] = r1[e]; r1[e] = r2[e]; r2[e] = cur[e]; }
            ov[i].x = pk2(o[0], o[1]); ov[i].y = pk2(o[2], o[3]); ov[i].z = pk2(o[4], o[5]); ov[i].w = pk2(o[6], o[7]);
            if (i >= 13 && lastblk) { float* d = p.out + O_CONVP + ((size_t)(m0 / SEQ) * 3 + (i - 13)) * XBC + c0; *(f32x4*)d = (f32x4){cur[0], cur[1], cur[2], cur[3]}; *(f32x4*)(d + 4) = (f32x4){cur[4], cur[5], cur[6], cur[7]}; }
        }
        const int bb = m0 / SEQ, t0 = m0 % SEQ, cc = t0 >> 7, l0 = t0 & 127;
        if (c0 >= 1536) {
            const int cn = c0 - 1536;
#pragma unroll
            for (int i = 0; i < 16; ++i) *(u32x4*)(BCN + (size_t)(m0 + i) * 1024 + cn) = ov[i];
        }
        if (c0 < 2048) {
            bf16_t* tb = (c0 < 1536) ? XT + ((((size_t)(bb * 16 + cc) * NH + (c0 >> 6)) * 64 + (c0 & 63)) * 128 + l0)
                                     : BT + ((((size_t)(bb * 16 + cc) * 4 + ((c0 - 1536) >> 7)) * 128 + ((c0 - 1536) & 127)) * 128 + l0);
            const bool odd = (gtid & 1) != 0;
            bf16_t* t1 = odd ? tb - 8 * 128 + 8 : tb;
            bf16_t* t2 = odd ? tb + 8 : tb + 8 * 128;
#pragma unroll
            for (int e = 0; e < 8; ++e) {
                u32x4 q0, q1;
                q0.x = BF_ELEM(ov[0], e) | (BF_ELEM(ov[1], e) << 16); q0.y = BF_ELEM(ov[2], e) | (BF_ELEM(ov[3], e) << 16); q0.z = BF_ELEM(ov[4], e) | (BF_ELEM(ov[5], e) << 16); q0.w = BF_ELEM(ov[6], e) | (BF_ELEM(ov[7], e) << 16);
                q1.x = BF_ELEM(ov[8], e) | (BF_ELEM(ov[9], e) << 16); q1.y = BF_ELEM(ov[10], e) | (BF_ELEM(ov[11], e) << 16); q1.z = BF_ELEM(ov[12], e) | (BF_ELEM(ov[13], e) << 16); q1.w = BF_ELEM(ov[14], e) | (BF_ELEM(ov[15], e) << 16);
                const u32x4 snd = odd ? q0 : q1; u32x4 rcv;
                rcv.x = __shfl_xor(snd.x, 1); rcv.y = __shfl_xor(snd.y, 1); rcv.z = __shfl_xor(snd.z, 1); rcv.w = __shfl_xor(snd.w, 1);
                *(u32x4*)(t1 + (size_t)e * 128) = odd ? rcv : q0;
                *(u32x4*)(t2 + (size_t)e * 128) = odd ? q1 : rcv;
            }
        }
    }
    for (int task = gtid; task < NT_S; task += nthreads) {
        const int cgp = task % 320, b = task / 320, c0 = cgp * 8, m0 = MP + b * 4;
        u32x4 raw[4];
#pragma unroll
        for (int i = 0; i < 4; ++i) raw[i] = *(const u32x4*)(proj + (size_t)(m0 + i) * NINP + 2048 + c0);
        float w0[8], w1[8], w2[8], w3[8], bs[8], r0[8], r1[8], r2[8];
        const float* st = sconv + (size_t)b * 3 * XBC + c0;
#pragma unroll
        for (int e = 0; e < 8; e += 4) { *(f32x4*)&w0[e] = *(const f32x4*)(cw + c0 + e); *(f32x4*)&w1[e] = *(const f32x4*)(cw + XBC + c0 + e); *(f32x4*)&w2[e] = *(const f32x4*)(cw + 2 * XBC + c0 + e);
            *(f32x4*)&w3[e] = *(const f32x4*)(cw + 3 * XBC + c0 + e); *(f32x4*)&bs[e] = *(const f32x4*)(cb + c0 + e);
            *(f32x4*)&r0[e] = *(const f32x4*)(st + e); *(f32x4*)&r1[e] = *(const f32x4*)(st + XBC + e); *(f32x4*)&r2[e] = *(const f32x4*)(st + 2 * XBC + e); }
#pragma unroll
        for (int i = 0; i < 4; ++i) {
            float cur[8]; unpack8(raw[i], cur);
            float o[8];
#pragma unroll
            for (int e = 0; e < 8; ++e) { const float cv = bs[e] + w0[e] * r0[e] + w1[e] * r1[e] + w2[e] * r2[e] + w3[e] * cur[e]; o[e] = silu_f(cv); r0[e] = r1[e]; r1[e] = r2[e]; r2[e] = cur[e]; }
            u32x4 ov; ov.x = pk2(o[0], o[1]); ov.y = pk2(o[2], o[3]); ov.z = pk2(o[4], o[5]); ov.w = pk2(o[6], o[7]);
            if (c0 < 1536) *(u32x4*)(XSN + (size_t)(m0 + i - MP) * SSDW + c0) = ov;
            else *(u32x4*)(BCN + (size_t)(m0 + i) * 1024 + (c0 - 1536)) = ov;
            if (i >= 1) { float* d = p.out + O_CONVS + ((size_t)b * 3 + (i - 1)) * XBC + c0; *(f32x4*)d = (f32x4){cur[0], cur[1], cur[2], cur[3]}; *(f32x4*)(d + 4) = (f32x4){cur[4], cur[5], cur[6], cur[7]}; }
        }
    }
}

constexpr int LROW = 272;
constexpr int L_C = 0, L_B = 34816, L_BT = 69632, L_XT = 104448, L_XS = 121856, L_HT = 139264, L_AC = 156672, L_DT = 157184, L_G = 157696;
__device__ __forceinline__ float wave_incl_scan(float v, int lane) {
#pragma unroll
    for (int o = 1; o < 64; o <<= 1) { const float t = __shfl_up(v, o); if (lane >= o) v += t; }
    return v;
}
__device__ __forceinline__ void ssd_prompt_item(const Params& p, LAS unsigned char* lds, int b, int h) {
    int tid = threadIdx.x; asm volatile("" : "+v"(tid));
    const int lane = tid & 63, w = __builtin_amdgcn_readfirstlane(tid >> 6), fr = lane & 15, fq = lane >> 4;
    const int g = h / 6;
    const bf16_t* BCN = (const bf16_t*)(p.ws + WS_XC + XC_BCN); const bf16_t* XT = (const bf16_t*)(p.ws + WS_XC + XC_XT); const bf16_t* BT = (const bf16_t*)(p.ws + WS_H + H_BT);
    const float* dtraw = (const float*)(p.ws + WS_DTRAW); bf16_t* ys = (bf16_t*)(p.ws + WS_YS);
    const float a_h = -__expf(p.in[25][h]), dtb = p.in[24][h], Dh = p.in[26][h];
    f32x4 hacc[4];
#pragma unroll
    for (int i = 0; i < 4; ++i) hacc[i] = (f32x4){0.f, 0.f, 0.f, 0.f};
    for (int i = tid; i < 64 * 17; i += 512) *(LAS u32x4*)(lds + L_HT + i * 16) = (u32x4){0u, 0u, 0u, 0u};
    const int prow = tid >> 4, pc = tid & 15;
    u32x4 pvc[4], pvb[4], pvt[4], pvx[2]; float pdl, pdh;
#define SSD_FETCH(cc) do { const int _m0 = b * SEQ + (cc) * 128; \
        pdl = dtraw[(size_t)(_m0 + lane) * 24 + h]; pdh = dtraw[(size_t)(_m0 + 64 + lane) * 24 + h]; \
        const bf16_t* _bt = BT + (((size_t)(b * 16 + (cc)) * 4 + g) * 128) * 128; const bf16_t* _xt = XT + (((size_t)(b * 16 + (cc)) * NH + h) * 64) * 128; \
        _Pragma("unroll") for (int j = 0; j < 4; ++j) { const bf16_t* _gr = BCN + (size_t)(_m0 + prow + 32 * j) * 1024 + g * 128 + pc * 8; pvb[j] = *(const u32x4*)_gr; pvc[j] = *(const u32x4*)(_gr + 512); \
            pvt[j] = *(const u32x4*)(_bt + (size_t)(prow + 32 * j) * 128 + pc * 8); } \
        _Pragma("unroll") for (int j = 0; j < 2; ++j) pvx[j] = *(const u32x4*)(_xt + (size_t)(prow + 32 * j) * 128 + pc * 8); } while (0)
    SSD_FETCH(0);
    for (int c = 0; c < 16; ++c) {
        const int m0 = b * SEQ + c * 128;
        const float dt_lo = softplus_f(pdl + dtb), dt_hi = softplus_f(pdh + dtb);
        const float ac_lo = wave_incl_scan(dt_lo * a_h, lane); const float tot_lo = __shfl(ac_lo, 63);
        const float ac_hi = wave_incl_scan(dt_hi * a_h, lane) + tot_lo; const float alast = __shfl(ac_hi, 63);
        const float sc_lo = dt_lo * __expf(alast - ac_lo), sc_hi = dt_hi * __expf(alast - ac_hi);
        if (w == 0) { const float ae_lo = __shfl(ac_lo, (lane & 48) + 15), ae_hi = __shfl(ac_hi, (lane & 48) + 15);
            *(LAS float*)(lds + L_G + lane * 4) = dt_lo * __expf(ae_lo - ac_lo); *(LAS float*)(lds + L_G + 256 + lane * 4) = dt_hi * __expf(ae_hi - ac_hi);
            *(LAS float*)(lds + L_AC + lane * 4) = ac_lo; *(LAS float*)(lds + L_AC + 256 + lane * 4) = ac_hi; *(LAS float*)(lds + L_DT + lane * 4) = dt_lo; *(LAS float*)(lds + L_DT + 256 + lane * 4) = dt_hi; }
        float sc[8];
#pragma unroll
        for (int e = 0; e < 8; ++e) { const int src = (pc * 8 + e) & 63; const float vlo = __shfl(sc_lo, src), vhi = __shfl(sc_hi, src); sc[e] = (pc < 8) ? vlo : vhi; }
#pragma unroll
        for (int j = 0; j < 4; ++j) {
            const int r = prow + 32 * j;
            *(LAS u32x4*)(lds + L_C + r * LROW + pc * 16) = pvc[j];
            *(LAS u32x4*)(lds + L_B + r * LROW + pc * 16) = pvb[j];
            *(LAS u32x4*)(lds + L_BT + r * LROW + pc * 16) = pvt[j];
        }
#pragma unroll
        for (int j = 0; j < 2; ++j) {
            const int r = prow + 32 * j;
            float xf[8]; unpack8(pvx[j], xf);
            *(LAS u32x4*)(lds + L_XT + r * LROW + pc * 16) = pvx[j];
            u32x4 q; q.x = pk2(xf[0] * sc[0], xf[1] * sc[1]); q.y = pk2(xf[2] * sc[2], xf[3] * sc[3]); q.z = pk2(xf[4] * sc[4], xf[5] * sc[5]); q.w = pk2(xf[6] * sc[6], xf[7] * sc[7]);
            *(LAS u32x4*)(lds + L_XS + r * LROW + pc * 16) = q;
        }
        LDS_BARRIER();
        if (c < 15) SSD_FETCH(c + 1);
        const int l = 16 * w + fr;
        bf16x8 cfrag[4];
#pragma unroll
        for (int ks = 0; ks < 4; ++ks) cfrag[ks] = *(const LAS bf16x8*)(lds + L_C + l * LROW + (ks * 32 + fq * 8) * 2);
        f32x4 yacc[4];
#pragma unroll
        for (int pb = 0; pb < 4; ++pb) {
            f32x4 a = (f32x4){0.f, 0.f, 0.f, 0.f};
#pragma unroll
            for (int ks = 0; ks < 4; ++ks) { const bf16x8 hf = *(const LAS bf16x8*)(lds + L_HT + (pb * 16 + fr) * LROW + (ks * 32 + fq * 8) * 2); a = __builtin_amdgcn_mfma_f32_16x16x32_bf16(hf, cfrag[ks], a, 0, 0, 0); }
            yacc[pb] = a;
        }
        const float al = *(const LAS float*)(lds + L_AC + l * 4);
        { const float el = __expf(al);
#pragma unroll
          for (int pb = 0; pb < 4; ++pb) yacc[pb] = yacc[pb] * el; }
        f32x4 cbt[8];
#pragma unroll
        for (int sb = 0; sb < 8; ++sb) {
            cbt[sb] = (f32x4){0.f, 0.f, 0.f, 0.f};
            if (sb <= w) {
                f32x4 a = (f32x4){0.f, 0.f, 0.f, 0.f};
#pragma unroll
                for (int ks = 0; ks < 4; ++ks) { const bf16x8 bf = *(const LAS bf16x8*)(lds + L_B + (sb * 16 + fr) * LROW + (ks * 32 + fq * 8) * 2); a = __builtin_amdgcn_mfma_f32_16x16x32_bf16(bf, cfrag[ks], a, 0, 0, 0); }
                cbt[sb] = a;
            }
        }
        LDS_BARRIER();
        const int nks = (w >> 1) + 1;
#pragma unroll
        for (int sb = 0; sb < 8; ++sb) {
            if (sb < 2 * nks) {
                const int s0 = sb * 16 + 4 * fq;
                float mv[4];
                if (sb < w) {
                    const float f = __expf(al - *(const LAS float*)(lds + L_AC + (sb * 16 + 15) * 4));
                    const f32x4 gs = *(const LAS f32x4*)(lds + L_G + s0 * 4);
#pragma unroll
                    for (int e = 0; e < 4; ++e) mv[e] = cbt[sb][e] * f * gs[e];
                } else if (sb == w) {
                    const f32x4 as = *(const LAS f32x4*)(lds + L_AC + s0 * 4), ds = *(const LAS f32x4*)(lds + L_DT + s0 * 4);
#pragma unroll
                    for (int e = 0; e < 4; ++e) { const float v = cbt[sb][e] * __expf(al - as[e]) * ds[e]; mv[e] = ((s0 + e) <= l) ? v : 0.f; if (s0 + e == l) mv[e] += Dh; }
                } else {
#pragma unroll
                    for (int e = 0; e < 4; ++e) mv[e] = 0.f;
                }
                u32x2 o; o.x = pk2(mv[0], mv[1]); o.y = pk2(mv[2], mv[3]);
                *(LAS u32x2*)(lds + L_B + l * LROW + s0 * 2) = o;
            }
        }
        LDS_WAIT();
#pragma unroll
        for (int ks = 0; ks < 4; ++ks) {
            if (ks < nks) {
                const bf16x8 mf = *(const LAS bf16x8*)(lds + L_B + l * LROW + (ks * 32 + fq * 8) * 2);
#pragma unroll
                for (int pb = 0; pb < 4; ++pb) { const bf16x8 xf = *(const LAS bf16x8*)(lds + L_XT + (pb * 16 + fr) * LROW + (ks * 32 + fq * 8) * 2); yacc[pb] = __builtin_amdgcn_mfma_f32_16x16x32_bf16(xf, mf, yacc[pb], 0, 0, 0); }
            }
        }
#pragma unroll
        for (int pb = 0; pb < 4; ++pb) {
            const int pcol = h * 64 + pb * 16 + 4 * fq;
            u32x2 o; o.x = pk2(yacc[pb][0], yacc[pb][1]); o.y = pk2(yacc[pb][2], yacc[pb][3]);
            *(u32x2*)(ys + (size_t)(m0 + l) * SSDW + pcol) = o;
        }
        { const float ea = __expf(alast);
#pragma unroll
          for (int pb = 0; pb < 4; ++pb) hacc[pb] = hacc[pb] * ea; }
#pragma unroll
        for (int ks = 0; ks < 4; ++ks) {
            const bf16x8 btf = *(const LAS bf16x8*)(lds + L_BT + (16 * w + fr) * LROW + (ks * 32 + fq * 8) * 2);
#pragma unroll
            for (int pb = 0; pb < 4; ++pb) { const bf16x8 xsf = *(const LAS bf16x8*)(lds + L_XS + (pb * 16 + fr) * LROW + (ks * 32 + fq * 8) * 2); hacc[pb] = __builtin_amdgcn_mfma_f32_16x16x32_bf16(btf, xsf, hacc[pb], 0, 0, 0); }
        }
#pragma unroll
        for (int pb = 0; pb < 4; ++pb) { u32x2 o; o.x = pk2(hacc[pb][0], hacc[pb][1]); o.y = pk2(hacc[pb][2], hacc[pb][3]); *(LAS u32x2*)(lds + L_HT + (pb * 16 + fr) * LROW + (16 * w + 4 * fq) * 2) = o; }
        LDS_BARRIER();
    }
    float* so = p.out + O_SSDP + ((size_t)(b * NH + h) * 64) * 128;
#pragma unroll
    for (int pb = 0; pb < 4; ++pb) *(f32x4*)(so + (size_t)(pb * 16 + fr) * 128 + 16 * w + 4 * fq) = hacc[pb];
}

template <int MODE>
__device__ __forceinline__ void s5_wave_item(const Params& p, LAS unsigned char* wl, int g, int bidx, int seg, int m_start, int nrows, int lane_in) {
    int lane = lane_in; asm volatile("" : "+v"(lane));
    const int fr = lane & 15, fq = lane >> 4;
    const bf16_t* proj = (const bf16_t*)(p.ws + WS_A); bf16_t* vbuf = (bf16_t*)(p.ws + WS_H);
    const bf16_t* BBAR = (const bf16_t*)(p.ws + WS_BBAR); const bf16_t* CMAT = (const bf16_t*)(p.ws + WS_CMAT); const float* AB = (const float*)(p.ws + WS_S5A);
    float* S5E = (float*)(p.ws + WS_S5END);
    const bf16x8 zf = (bf16x8){0, 0, 0, 0, 0, 0, 0, 0};
    bf16x8 bfrag[8], cfrag[4];
#pragma unroll
    for (int t = 0; t < 8; ++t) bfrag[t] = (fq < 2) ? *(const bf16x8*)(BBAR + ((size_t)(g * 128 + t * 16 + fr)) * 16 + fq * 8) : zf;
    if (MODE != 1) {
#pragma unroll
        for (int ks = 0; ks < 4; ++ks) cfrag[ks] = *(const bf16x8*)(CMAT + ((size_t)(g * 16 + fr)) * 128 + ks * 32 + fq * 8);
    }
    const float ar = AB[g * 64 + lane], ai = AB[2048 + g * 64 + lane];
    const f32x4 d4 = *(const f32x4*)(p.in[19] + g * 16 + 4 * fq);
    LAS float* sBu = (LAS float*)wl; LAS bf16_t* sS = (LAS bf16_t*)(wl + 8448);
    float sr = 0.f, si = 0.f;
    if (MODE == 2 && seg > 0) {
        float pr = ar, pi = ai;
#pragma unroll
        for (int q = 0; q < 8; ++q) { const float nr = pr * pr - pi * pi, ni = 2.f * pr * pi; pr = nr; pi = ni; }
        for (int j = 0; j < seg; ++j) {
            const float* e = S5E + ((size_t)((bidx * 32 + g) * 8 + j)) * 128;
            const float er = e[lane], ei = e[64 + lane];
            const float nr = pr * sr - pi * si + er, ni = pr * si + pi * sr + ei; sr = nr; si = ni;
        }
    }
    bf16x8 uf_n; u32x2 u4_n;
    { const bf16_t* urow = proj + (size_t)(m_start + fr) * NINP + g * 16; uf_n = (fq < 2) ? *(const bf16x8*)(urow + fq * 8) : zf; u4_n = *(const u32x2*)(urow + 4 * fq); }
    for (int m0 = m_start; m0 < m_start + nrows; m0 += 16) {
        const bf16x8 uf = uf_n; const u32x2 u4 = u4_n;
        { const int mn = (m0 + 16 < m_start + nrows) ? m0 + 16 : m0; const bf16_t* urow = proj + (size_t)(mn + fr) * NINP + g * 16; uf_n = (fq < 2) ? *(const bf16x8*)(urow + fq * 8) : zf; u4_n = *(const u32x2*)(urow + 4 * fq); }
#pragma unroll
        for (int t = 0; t < 8; ++t) {
            f32x4 a = (f32x4){0.f, 0.f, 0.f, 0.f};
            a = __builtin_amdgcn_mfma_f32_16x16x32_bf16(bfrag[t], uf, a, 0, 0, 0);
            *(LAS f32x4*)(sBu + fr * 132 + t * 16 + 4 * fq) = a;
        }
        LDS_WAIT();
        {
            float br[16], bi[16]; unsigned pkv[16];
#pragma unroll
            for (int t = 0; t < 16; ++t) { br[t] = sBu[t * 132 + lane]; bi[t] = sBu[t * 132 + 64 + lane]; }
            float s0r[4], s0i[4];
            if (MODE == 0) {
#pragma unroll
                for (int q = 0; q < 4; ++q) { const int bb = ((m0 - MP) >> 2) + q; s0r[q] = p.in[2][((size_t)bb * 32 + g) * 64 + lane]; s0i[q] = p.in[3][((size_t)bb * 32 + g) * 64 + lane]; }
            }
#pragma unroll
            for (int t = 0; t < 16; ++t) {
                if (MODE == 0 && (t & 3) == 0) { sr = s0r[t >> 2]; si = s0i[t >> 2]; }
                const float nr = ar * sr - ai * si + br[t], ni = ar * si + ai * sr + bi[t];
                sr = nr; si = ni;
                if (MODE != 1) pkv[t] = pk2(sr, si);
                if (MODE == 0 && (t & 3) == 3) { const int bb = (m0 - MP + t) >> 2; p.out[O_S5RS + ((size_t)bb * 32 + g) * 64 + lane] = sr; p.out[O_S5IS + ((size_t)bb * 32 + g) * 64 + lane] = si; }
            }
            if (MODE != 1) {
#pragma unroll
                for (int t = 0; t < 16; ++t) { sS[t * 136 + lane] = (bf16_t)(pkv[t] & 0xffff); sS[t * 136 + 64 + lane] = (bf16_t)(pkv[t] >> 16); }
            }
        }
        LDS_WAIT();
        if (MODE != 1) {
            f32x4 y = (f32x4){0.f, 0.f, 0.f, 0.f};
#pragma unroll
            for (int ks = 0; ks < 4; ++ks) { const bf16x8 sf = *(const LAS bf16x8*)(sS + fr * 136 + ks * 32 + fq * 8); y = __builtin_amdgcn_mfma_f32_16x16x32_bf16(cfrag[ks], sf, y, 0, 0, 0); }
            const float y0 = y[0] + d4[0] * bflo(u4.x), y1 = y[1] + d4[1] * bfhi(u4.x), y2 = y[2] + d4[2] * bflo(u4.y), y3 = y[3] + d4[3] * bfhi(u4.y);
            u32x2 o; o.x = pk2(gelu_tanh(y0), gelu_tanh(y1)); o.y = pk2(gelu_tanh(y2), gelu_tanh(y3));
            *(u32x2*)(vbuf + (size_t)(m0 + fr) * 512 + g * 16 + 4 * fq) = o;
            LDS_WAIT();
        }
    }
    if (MODE == 1) { float* e = S5E + ((size_t)((bidx * 32 + g) * 8 + seg)) * 128; e[lane] = sr; e[64 + lane] = si; }
    if (MODE == 2 && seg == 7) { p.out[O_S5RP + ((size_t)bidx * 32 + g) * 64 + lane] = sr; p.out[O_S5IP + ((size_t)bidx * 32 + g) * 64 + lane] = si; }
}

#define SMP_LOAD(HS, BS, CS, DS, XS_, PS, pr_) do { const int _b = (pr_) / NH, _h = (pr_) % NH, _g = _h / 6; \
        PS[0] = p.in[25][_h]; PS[1] = p.in[24][_h]; PS[2] = p.in[26][_h]; \
        const float* _h0 = p.in[4] + ((size_t)(_b * NH + _h) * 64 + pp) * 128 + n0; \
        _Pragma("unroll") for (int j = 0; j < 4; ++j) HS[j] = *(const f32x4*)(_h0 + 4 * j); \
        _Pragma("unroll") for (int t = 0; t < 4; ++t) { const int _m = MP + _b * 4 + t; const bf16_t* _row = BCN + (size_t)_m * 1024 + _g * 128 + n0; \
            DS[t] = dtraw[(size_t)_m * 24 + _h]; XS_[t] = *(const unsigned*)(XSN + (size_t)(_m - MP) * SSDW + _h * 64 + (pp & ~1)); \
            BS[t][0] = *(const u32x4*)_row; BS[t][1] = *(const u32x4*)(_row + 8); CS[t][0] = *(const u32x4*)(_row + 512); CS[t][1] = *(const u32x4*)(_row + 520); } } while (0)
#define SMP_COMPUTE(HS, BS, CS, DS, XS_, PS, pr_) do { const int _b = (pr_) / NH, _h = (pr_) % NH; \
        const float a_h = -__expf(PS[0]), dtb = PS[1], Dh = PS[2]; \
        float hv[16]; \
        _Pragma("unroll") for (int j = 0; j < 4; ++j) { hv[4 * j] = HS[j][0]; hv[4 * j + 1] = HS[j][1]; hv[4 * j + 2] = HS[j][2]; hv[4 * j + 3] = HS[j][3]; } \
        _Pragma("unroll") for (int t = 0; t < 4; ++t) { const int _m = MP + _b * 4 + t; \
            const float dt = softplus_f(DS[t] + dtb), dec = __expf(dt * a_h); const float xv = (pp & 1) ? bfhi(XS_[t]) : bflo(XS_[t]), xd = xv * dt; \
            float acc = 0.f; \
            _Pragma("unroll") for (int hf = 0; hf < 2; ++hf) { float Bv[8], Cv[8]; unpack8(BS[t][hf], Bv); unpack8(CS[t][hf], Cv); \
                _Pragma("unroll") for (int j = 0; j < 8; ++j) { hv[8 * hf + j] = hv[8 * hf + j] * dec + xd * Bv[j]; acc += hv[8 * hf + j] * Cv[j]; } } \
            acc += __shfl_xor(acc, 1); acc += __shfl_xor(acc, 2); acc += __shfl_xor(acc, 4); \
            if ((tid & 7) == 0) ys[(size_t)_m * SSDW + _h * 64 + pp] = (bf16_t)(pk2(acc + Dh * xv, 0.f) & 0xffff); } \
        float* _ho = p.out + O_SSDS + ((size_t)(_b * NH + _h) * 64 + pp) * 128 + n0; \
        _Pragma("unroll") for (int j = 0; j < 16; j += 4) *(f32x4*)(_ho + j) = (f32x4){hv[j], hv[j + 1], hv[j + 2], hv[j + 3]}; } while (0)
constexpr int SMP_PAIRS = 6;
__device__ __forceinline__ void ssd_sample_item(const Params& p, int item) {
    int tid = threadIdx.x; asm volatile("" : "+v"(tid));
    const int pp = tid >> 3, n0 = (tid & 7) * 16;
    const bf16_t* BCN = (const bf16_t*)(p.ws + WS_XC + XC_BCN); const bf16_t* XSN = (const bf16_t*)(p.ws + WS_XC + XC_XSN); const float* dtraw = (const float*)(p.ws + WS_DTRAW); bf16_t* ys = (bf16_t*)(p.ws + WS_YS);
    f32x4 hA[4], hB[4]; u32x4 bA[4][2], cA[4][2], bB[4][2], cB[4][2]; float dA[4], dB[4], sA3[3], sB3[3]; unsigned xA[4], xB[4];
    const int pr0 = item * SMP_PAIRS;
    SMP_LOAD(hA, bA, cA, dA, xA, sA3, pr0);
#pragma unroll
    for (int k = 0; k < SMP_PAIRS; k += 2) {
        const int pr = pr0 + k;
        SMP_LOAD(hB, bB, cB, dB, xB, sB3, pr + 1);
        SMP_COMPUTE(hA, bA, cA, dA, xA, sA3, pr);
        if (k + 2 < SMP_PAIRS) SMP_LOAD(hA, bA, cA, dA, xA, sA3, pr + 2);
        SMP_COMPUTE(hB, bB, cB, dB, xB, sB3, pr + 1);
    }
}

__device__ __forceinline__ void gatenorm_phase(const Params& p, int gw, int ngw, int lane_in) {
    int lane = lane_in; asm volatile("" : "+v"(lane));
    const bf16_t* proj = (const bf16_t*)(p.ws + WS_A); const bf16_t* ys = (const bf16_t*)(p.ws + WS_YS); bf16_t* mix = (bf16_t*)(p.ws + WS_XC);
    const float* nw = p.in[27];
    for (int m = gw * 2; m < M; m += ngw * 2) {
        u32x4 yr[2][3], zr[2][3];
#pragma unroll
        for (int r = 0; r < 2; ++r)
#pragma unroll
            for (int j = 0; j < 3; ++j) { const int c0 = (lane + 64 * j) * 8; yr[r][j] = *(const u32x4*)(ys + (size_t)(m + r) * SSDW + c0); zr[r][j] = *(const u32x4*)(proj + (size_t)(m + r) * NINP + 512 + c0); }
#pragma unroll
        for (int r = 0; r < 2; ++r) {
            float gv[3][8]; float sg[4] = {0.f, 0.f, 0.f, 0.f};
#pragma unroll
            for (int j = 0; j < 3; ++j) {
                float yv[8], zv[8]; unpack8(yr[r][j], yv); unpack8(zr[r][j], zv);
                float ss = 0.f;
#pragma unroll
                for (int e = 0; e < 8; ++e) { gv[j][e] = yv[e] * silu_f(zv[e]); ss += gv[j][e] * gv[j][e]; }
                const int grp = (lane + 64 * j) / 48;
#pragma unroll
                for (int q = 0; q < 4; ++q) sg[q] += (grp == q) ? ss : 0.f;
            }
            float rs[4];
#pragma unroll
            for (int q = 0; q < 4; ++q) rs[q] = rsqrtf(wave_sum(sg[q]) * (1.f / 384.f) + EPS);
#pragma unroll
            for (int j = 0; j < 3; ++j) {
                const int c0 = (lane + 64 * j) * 8, grp = (lane + 64 * j) / 48;
                const float rstd = grp == 0 ? rs[0] : (grp == 1 ? rs[1] : (grp == 2 ? rs[2] : rs[3]));
                const f32x4 n0 = *(const f32x4*)(nw + c0), n1 = *(const f32x4*)(nw + c0 + 4);
                u32x4 o; o.x = pk2(gv[j][0] * rstd * n0[0], gv[j][1] * rstd * n0[1]); o.y = pk2(gv[j][2] * rstd * n0[2], gv[j][3] * rstd * n0[3]);
                o.z = pk2(gv[j][4] * rstd * n1[0], gv[j][5] * rstd * n1[1]); o.w = pk2(gv[j][6] * rstd * n1[2], gv[j][7] * rstd * n1[3]);
                *(u32x4*)(mix + (size_t)(m + r) * DMIX + 512 + c0) = o;
            }
        }
    }
}

#define XB_TMO      128
#define XB_XCNT(j)  (256  + 64 * (j))
#define XB_XSUB(j)  (1280 + 64 * (j))
#define XB_XGEN(j)  (2304 + 64 * (j))
#define XB_TOP      3328
#define XB_TOPGEN   3392
#define XCD_BAR_WORDS 3456
#define XB_SPIN_CAP (1u << 18)

__device__ __forceinline__ unsigned xb_ld(unsigned* p)              { return __hip_atomic_load(p, __ATOMIC_RELAXED, __HIP_MEMORY_SCOPE_AGENT); }
__device__ __forceinline__ unsigned xb_add(unsigned* p, unsigned v) { return __hip_atomic_fetch_add(p, v, __ATOMIC_RELAXED, __HIP_MEMORY_SCOPE_AGENT); }
__device__ __forceinline__ unsigned xb_xcc_id() { return (unsigned)__builtin_amdgcn_s_getreg((3 << 11) | 20) & 0xFu; }
#define XB_SPIN(cond, bar) do { unsigned _sp = 0; while (cond) { __builtin_amdgcn_s_sleep(1); \
    if ((++_sp & 255u) == 0u) { if (xb_ld(&(bar)[XB_TMO])) break; if (_sp > XB_SPIN_CAP) { atomicAdd(&(bar)[XB_TMO], 1u); break; } } } } while (0)

struct XcdBarrier {
    unsigned* bar; unsigned x;
    volatile LAS unsigned* st;
};

__device__ __forceinline__ XcdBarrier xcd_barrier_post(unsigned* bar, volatile LAS unsigned* st) {
    XcdBarrier b; b.bar = bar; b.x = xb_xcc_id(); b.st = st;
    if (threadIdx.x == 0) (void)xb_add(&bar[XB_XCNT(b.x)], 1u);
    return b;
}
__device__ __forceinline__ void xcd_barrier_complete(unsigned* bar, unsigned x, unsigned& nloc, unsigned& nx) {
    const unsigned G = gridDim.x * gridDim.y * gridDim.z;
    unsigned sum, cnt, mine, sp = 0u;
    for (;;) {
        sum = 0u; cnt = 0u; mine = 0u;
#pragma unroll
        for (unsigned j = 0; j < 16; ++j) { const unsigned c = xb_ld(&bar[XB_XCNT(j)]); sum += c; cnt += (c > 0u) ? 1u : 0u; mine = (j == x) ? c : mine; }
        if (sum == G) break;
        __builtin_amdgcn_s_sleep(1);
        if ((++sp & 255u) == 0u) { if (xb_ld(&bar[XB_TMO])) break; if (sp > XB_SPIN_CAP) { atomicAdd(&bar[XB_TMO], 1u); break; } }
    }
    nloc = mine > 0u ? mine : 1u; nx = cnt > 0u ? cnt : 1u;
}

__device__ __forceinline__ void xcd_barrier(const XcdBarrier& b) {
    asm volatile("s_waitcnt vmcnt(0)" ::: "memory");
    __syncthreads();
    if (threadIdx.x == 0) {
        unsigned* bar = b.bar;
        __builtin_amdgcn_s_waitcnt(0);
        unsigned nloc = b.st[0], nx = b.st[1];
        if (nloc == 0u) { xcd_barrier_complete(bar, b.x, nloc, nx); b.st[0] = nloc; b.st[1] = nx; }
        const unsigned old = xb_add(&bar[XB_XSUB(b.x)], 1u);
        const unsigned gen = old / nloc;
        if (old + 1u == (gen + 1u) * nloc) {
            __builtin_amdgcn_fence(__ATOMIC_RELEASE, "agent");
            asm volatile("s_waitcnt vmcnt(0)" ::: "memory");
            const unsigned og = xb_add(&bar[XB_TOP], 1u);
            const unsigned tg = og / nx;
            if (og + 1u == (tg + 1u) * nx) xb_add(&bar[XB_TOPGEN], 1u);
            else XB_SPIN(xb_ld(&bar[XB_TOPGEN]) == tg, bar);
            __builtin_amdgcn_fence(__ATOMIC_ACQUIRE, "agent");
            xb_add(&bar[XB_XGEN(b.x)], 1u);
            asm volatile("s_waitcnt vmcnt(0)" ::: "memory");
        } else {
            XB_SPIN(xb_ld(&bar[XB_XGEN(b.x)]) == gen, bar);
            __builtin_amdgcn_fence(__ATOMIC_ACQUIRE, "agent");
            asm volatile("s_waitcnt vmcnt(0)" ::: "memory");
        }
    }
    __syncthreads();
}

__device__ __forceinline__ void seam(const XcdBarrier& b0) { XcdBarrier b = b0; asm volatile("" : "+s"(b.bar)); asm volatile("" : "+s"(b.x)); xcd_barrier(b); }

__global__ void __launch_bounds__(512, 2) hymba_fwd(Params p) {
    extern __shared__ __attribute__((aligned(16))) unsigned char smem[];
    LAS unsigned char* lds = (LAS unsigned char*)smem;
    cg::grid_group grid = cg::this_grid();
    const int tid = threadIdx.x, lane = tid & 63, wave = __builtin_amdgcn_readfirstlane(tid >> 6);
    const int G = gridDim.x, bid = blockIdx.x;
    const int gw = bid * 8 + wave, ngw = G * 8, gtid = bid * 512 + tid, nthreads = G * 512;
    unsigned* ctl = (unsigned*)(p.ws + WS_CTL);
    volatile LAS unsigned* xst = (volatile LAS unsigned*)(lds + L_XBST);
    if (tid == 0) { xst[0] = 0u; xst[1] = 0u; }
    __syncthreads();
    const XcdBarrier xb = xcd_barrier_post((unsigned*)(p.ws + WS_BAR), xst);
    bf16_t* W1T = (bf16_t*)(p.ws + WS_W1T); bf16_t* W1D = (bf16_t*)(p.ws + WS_W1D); bf16_t* W2T = (bf16_t*)(p.ws + WS_W2T); bf16_t* W2D = (bf16_t*)(p.ws + WS_W2D);
    bf16_t* WIN = (bf16_t*)(p.ws + WS_WIN); bf16_t* WGLU = (bf16_t*)(p.ws + WS_WGLU); bf16_t* WOUT = (bf16_t*)(p.ws + WS_WOUT);
    bf16_t* HB = (bf16_t*)(p.ws + WS_H); bf16_t* AB = (bf16_t*)(p.ws + WS_A); bf16_t* XC = (bf16_t*)(p.ws + WS_XC);
    float* yout = p.out + O_Y;
    pg8::StaticOrder S;

    {
        convert_items(p, lds, CV_W1T, CV_W1D, gw, ngw, wave, lane);
        rms_phase(p.in[0], p.in[1], p.in[6], HB, gw, ngw, lane);
        for (int i = gtid; i < MS * D / 4; i += nthreads) ((f32x4*)(yout + (size_t)MP * D))[i] = ((const f32x4*)p.in[1])[i];
    }
    if (p.use_cg) grid.sync();
    seam(xb);
    for (int rep = 0; rep < REP_P1; ++rep) { S.init(M, 2 * FF, G, bid); pg8::gemm_phase<true>(lds, pg8::Gemm{HB, W1T, M, 2 * FF, D, D}, S, EpiGateUp{AB});
        { const int nfull = S.nwg % G; if (nfull > 0 && bid >= nfull) convert_items(p, lds, CV_W1D, CV_WIN, (bid - nfull) * 8 + wave, (G - nfull) * 8, wave, lane); else if (nfull == 0) convert_items(p, lds, CV_W1D, CV_WIN, gw, ngw, wave, lane); }
        if (gtid >= nthreads - 2048) {
            const int idx = gtid - (nthreads - 2048), g = idx >> 6, pp = idx & 63;
            const double lr = p.in[12][idx], li = p.in[13][idx], step = exp((double)p.in[14][g]);
            const double mag = exp(lr * step), ang = li * step;
            const double are = mag * cos(ang), aim = mag * sin(ang);
            const double den = lr * lr + li * li, nre = are - 1.0, nim = aim;
            const float cre = (float)((nre * lr + nim * li) / den), cim = (float)((nim * lr - nre * li) / den);
            float* ABf = (float*)(p.ws + WS_S5A); ABf[idx] = (float)are; ABf[2048 + idx] = (float)aim;
            bf16_t* BBAR = (bf16_t*)(p.ws + WS_BBAR); bf16_t* CMAT = (bf16_t*)(p.ws + WS_CMAT);
            const float* bre = p.in[15] + (size_t)idx * 16; const float* bim = p.in[16] + (size_t)idx * 16;
#pragma unroll
            for (int hh = 0; hh < 16; hh += 2) {
                const float r0 = cre * bre[hh] - cim * bim[hh], r1 = cre * bre[hh + 1] - cim * bim[hh + 1];
                const float i0 = cre * bim[hh] + cim * bre[hh], i1 = cre * bim[hh + 1] + cim * bre[hh + 1];
                *(unsigned*)(BBAR + ((size_t)(g * 128 + pp)) * 16 + hh) = pk2(r0, r1);
                *(unsigned*)(BBAR + ((size_t)(g * 128 + 64 + pp)) * 16 + hh) = pk2(i0, i1);
            }
#pragma unroll
            for (int hh = 0; hh < 16; ++hh) {
                const float cr = p.in[17][((size_t)g * 16 + hh) * 64 + pp], ci = p.in[18][((size_t)g * 16 + hh) * 64 + pp];
                const unsigned pk = pk2(cr, -ci);
                CMAT[((size_t)(g * 16 + hh)) * 128 + pp] = (bf16_t)(pk & 0xffff); CMAT[((size_t)(g * 16 + hh)) * 128 + 64 + pp] = (bf16_t)(pk >> 16);
            }
        }
        seam(xb); }
    { S.init(MP, D, G, bid); pg8::gemm_phase<true>(lds, pg8::Gemm{AB, W1D, MP, D, FF, FF}, S, EpiResid{p.in[0], p.in[1], yout, 0.5f});
      pg8::SplitOrder S2{8 * (FF / 256), G, bid, 256}; pg8::gemm_phase<false>(lds, pg8::Gemm{AB + (size_t)MP * FF, W1D, MS, D, 256, FF}, S2, EpiPart{(float*)(p.ws + WS_YS), 0.5f}); }
    { const int nsp = 8 * (FF / 256); if (G > nsp) { if (bid >= nsp) convert_items(p, lds, CV_WIN, CV_WGLU, (bid - nsp) * 8 + wave, (G - nsp) * 8, wave, lane); } else convert_items(p, lds, CV_WIN, CV_WGLU, gw, ngw, wave, lane); }
    seam(xb);
    rms_phase(yout, yout + (size_t)MP * D, p.in[10], HB, gw, ngw, lane, (const float*)(p.ws + WS_YS), FF / 256, yout + (size_t)MP * D);
    seam(xb);
    { S.init(M, NINP, G, bid); pg8::gemm_phase<true>(lds, pg8::Gemm{HB, WIN, M, NINP, D, D}, S, EpiProj{AB, (float*)(p.ws + WS_DTRAW)}); }
    { const int nfull = S.nwg % G; if (nfull > 0 && bid >= nfull) convert_items(p, lds, CV_WGLU, CV_W2T, (bid - nfull) * 8 + wave, (G - nfull) * 8, wave, lane); else if (nfull == 0) convert_items(p, lds, CV_WGLU, CV_W2T, gw, ngw, wave, lane); }
    seam(xb);
    for (int rep = 0; rep < REP_P5; ++rep) {
        for (int wi = gw; wi < 256 * 7; wi += ngw) { const int pair = wi / 7, sg = wi % 7; s5_wave_item<1>(p, lds + wave * 12800, pair & 31, pair >> 5, sg, (pair >> 5) * SEQ + sg * 256, 256, lane); }
        conv_phase(p, gtid, nthreads); seam(xb); }
    for (int rep = 0; rep < REP_P6; ++rep) {
        volatile LAS int* bc = (volatile LAS int*)(lds + L_BCAST);
        constexpr int N_SSDP = NB * NH, N_S5P = 256, N_S5S = 128, N_SSDS = NSB * NH / SMP_PAIRS;
        for (;;) {
            __syncthreads();
            if (tid == 0) *bc = (int)atomicAdd(&ctl[rep * 64], 1u);
            __syncthreads();
            int it = *bc;
            if (it >= N_SSDP + N_S5P + N_S5S + N_SSDS) break;
            if (it < N_SSDP) { ssd_prompt_item(p, lds, it / NH, it % NH); continue; }
            it -= N_SSDP;
            if (it < N_SSDS) { ssd_sample_item(p, it); continue; }
            it -= N_SSDS;
            if (it < N_S5P) { const int pair = it; s5_wave_item<2>(p, lds + wave * 12800, pair & 31, pair >> 5, wave, (pair >> 5) * SEQ + wave * 256, 256, lane); continue; }
            it -= N_S5P;
            { const int idx = it * 8 + wave; s5_wave_item<0>(p, lds + wave * 12800, idx & 31, 0, 0, MP + (idx >> 5) * 16, 16, lane); }
        }
        seam(xb);
    }
    { S.init(M, 512, G, bid); pg8::gemm_phase<true>(lds, pg8::Gemm{HB, WGLU, M, 512, 512, 512}, S, EpiGlu{HB, p.in[21], XC}); }
    { const int nglu = S.nwg; if (G > nglu) { if (bid >= nglu) convert_items(p, lds, CV_W2T, CV_END, (bid - nglu) * 8 + wave, (G - nglu) * 8, wave, lane); } else convert_items(p, lds, CV_W2T, CV_END, gw, ngw, wave, lane); }
    for (int rep = 0; rep < REP_P7; ++rep) { gatenorm_phase(p, gw, ngw, lane); seam(xb); }
    { S.init(MP, D, G, bid); pg8::gemm_phase<true>(lds, pg8::Gemm{XC, WOUT, MP, D, DMIX, DMIX}, S, EpiResid{yout, yout + (size_t)MP * D, yout, 1.0f});
      pg8::SplitOrder S2{8 * (DMIX / 256), G, bid, 256}; pg8::gemm_phase<false>(lds, pg8::Gemm{XC + (size_t)MP * DMIX, WOUT, MS, D, 256, DMIX}, S2, EpiPart{(float*)(p.ws + WS_YS), 1.0f}); }
    seam(xb);
    rms_phase(yout, yout + (size_t)MP * D, p.in[29], HB, gw, ngw, lane, (const float*)(p.ws + WS_YS), DMIX / 256, yout + (size_t)MP * D);
    seam(xb);
    { S.init(M, 2 * FF, G, bid); pg8::gemm_phase<true>(lds, pg8::Gemm{HB, W2T, M, 2 * FF, D, D}, S, EpiGateUp{AB}); }
    seam(xb);
    { S.init(MP, D, G, bid); pg8::gemm_phase<true>(lds, pg8::Gemm{AB, W2D, MP, D, FF, FF}, S, EpiResid{yout, yout + (size_t)MP * D, yout, 0.5f});
      pg8::SplitOrder S2{8 * (FF / 256), G, bid, 256}; pg8::gemm_phase<false>(lds, pg8::Gemm{AB + (size_t)MP * FF, W2D, MS, D, 256, FF}, S2, EpiPart{(float*)(p.ws + WS_YS), 0.5f}); }
    seam(xb);
    { int lane_f = lane; asm volatile("" : "+v"(lane_f));
    for (int m = gw * 4; m < MP; m += ngw * 4) {
        f32x4 v[4][4], ww[4];
#pragma unroll
        for (int r = 0; r < 4; ++r)
#pragma unroll
            for (int j = 0; j < 4; ++j) v[r][j] = ((const f32x4*)(yout + (size_t)(m + r) * D))[lane_f + 64 * j];
#pragma unroll
        for (int j = 0; j < 4; ++j) ww[j] = ((const f32x4*)p.in[33])[lane_f + 64 * j];
#pragma unroll
        for (int r = 0; r < 4; ++r) {
            float ss = 0.f;
#pragma unroll
            for (int j = 0; j < 4; ++j) ss += (v[r][j].x * v[r][j].x + v[r][j].y * v[r][j].y) + (v[r][j].z * v[r][j].z + v[r][j].w * v[r][j].w);
            const float rstd = rsqrtf(wave_sum(ss) * (1.f / D) + EPS);
#pragma unroll
            for (int j = 0; j < 4; ++j) ((f32x4*)(yout + (size_t)(m + r) * D))[lane_f + 64 * j] = v[r][j] * rstd * ww[j];
        }
    }
    for (int ms = ngw - 1 - gw; ms < MS; ms += ngw) {
        f32x4 v[4]; sum_sample_row(yout + (size_t)MP * D, (const float*)(p.ws + WS_YS), FF / 256, ms, lane_f, v);
        float ss = 0.f;
#pragma unroll
        for (int j = 0; j < 4; ++j) ss += (v[j].x * v[j].x + v[j].y * v[j].y) + (v[j].z * v[j].z + v[j].w * v[j].w);
        const float rstd = rsqrtf(wave_sum(ss) * (1.f / D) + EPS);
#pragma unroll
        for (int j = 0; j < 4; ++j) ((f32x4*)(yout + (size_t)(MP + ms) * D))[lane_f + 64 * j] = v[j] * rstd * ((const f32x4*)p.in[33])[lane_f + 64 * j];
    } }
}

extern "C" void kernel_launch(void* const* d_in, const int* in_sizes, int n_in, void* d_out, int out_size, void* d_ws, size_t ws_size, hipStream_t stream) {
    static int grid_blocks = 0;
    if (grid_blocks == 0) {
        if (n_in != 34 || ws_size < WS_END) { fprintf(stderr, "kernel_launch: unexpected n_in %d or ws_size %zu (< %zu)\n", n_in, ws_size, (size_t)WS_END); grid_blocks = -1; return; }
        int dev = 0, cus = 0, per_cu = 0;
        hipGetDevice(&dev);
        hipDeviceGetAttribute(&cus, hipDeviceAttributeMultiprocessorCount, dev);
        hipFuncSetAttribute((const void*)hymba_fwd, hipFuncAttributeMaxDynamicSharedMemorySize, LDS_BYTES);
        hipOccupancyMaxActiveBlocksPerMultiprocessor(&per_cu, (const void*)hymba_fwd, 512, LDS_BYTES);
        if (per_cu < 1) { fprintf(stderr, "kernel_launch: occupancy query says %d blocks/CU\n", per_cu); per_cu = 1; }
        grid_blocks = cus;
    }
    if (grid_blocks < 0) return;
    if (hipMemsetAsync((char*)d_ws + WS_CTL, 0, 16384, stream) != hipSuccess) { fprintf(stderr, "kernel_launch: memset failed\n"); return; }
    Params p{};
    for (int i = 0; i < 34; ++i) p.in[i] = (const float*)d_in[i];
    p.out = (float*)d_out; p.ws = (unsigned char*)d_ws;
    void* args[] = {&p};
    hipError_t e = hipLaunchCooperativeKernel((const void*)hymba_fwd, dim3(grid_blocks), dim3(512), args, LDS_BYTES, stream);
    if (e != hipSuccess) fprintf(stderr, "cooperative launch failed: %s (grid %d)\n", hipGetErrorString(e), grid_blocks);
}
```

```cpp
#include <hip/hip_runtime.h>
#include <hip/hip_cooperative_groups.h>
#include <cstdio>
#include <cstdint>
namespace cg = cooperative_groups;

#define LAS __attribute__((address_space(3)))
typedef unsigned short bf16_t;
typedef short bf16x8 __attribute__((ext_vector_type(8)));
typedef float f32x4 __attribute__((ext_vector_type(4)));
typedef float f32x2 __attribute__((ext_vector_type(2)));
typedef unsigned u32x4 __attribute__((ext_vector_type(4)));
typedef unsigned u32x2 __attribute__((ext_vector_type(2)));

constexpr int D = 1024, FF = 2816, NIN = 4632, NINP = 4864, DMIX = 2048;
constexpr int MP = 16384, MS = 512, M = MP + MS, SEQ = 2048, NB = 8, NSB = 128;
constexpr int XBC = 2560, SSDW = 1536, NH = 24;
constexpr float EPS = 1e-6f;
constexpr size_t O_Y = 0, O_S5RP = 17301504, O_S5IP = 17317888, O_SSDP = 17334272, O_CONVP = 18907136,
                 O_S5RS = 18968576, O_S5IS = 19230720, O_SSDS = 19492864, O_CONVS = 44658688;
constexpr size_t WS_CTL = 0, WS_BAR = 2048, WS_S5A = 16384, WS_BBAR = WS_S5A + 16384, WS_CMAT = WS_BBAR + 131072, WS_DTRAW = WS_CMAT + 131072,
                 WS_W1T = WS_DTRAW + (size_t)M * 24 * 4, WS_W1D = WS_W1T + (size_t)2 * FF * D * 2, WS_W2T = WS_W1D + (size_t)D * FF * 2,
                 WS_W2D = WS_W2T + (size_t)2 * FF * D * 2, WS_WIN = WS_W2D + (size_t)D * FF * 2, WS_WGLU = WS_WIN + (size_t)NINP * D * 2,
                 WS_WOUT = WS_WGLU + (size_t)512 * 512 * 2, WS_H = WS_WOUT + (size_t)D * DMIX * 2, WS_A = WS_H + (size_t)M * D * 2,
                 WS_XC = WS_A + (size_t)M * NINP * 2, WS_YS = WS_XC + (size_t)M * XBC * 2, WS_S5END = WS_YS + (size_t)M * SSDW * 2, WS_END = WS_S5END + (size_t)256 * 8 * 128 * 4;
constexpr size_t XC_BCN = 0, XC_XSN = (size_t)M * 1024 * 2, XC_XT = XC_XSN + (size_t)MS * SSDW * 2, H_BT = (size_t)M * 512 * 2;
constexpr int LDS_BYTES = 158720;
#define REP_P1 1
#define REP_P6 1
#define REP_P5 1
#define REP_P7 1
constexpr int L_BCAST = 158208, L_XBST = 158224;

struct Params {
    const float* in[34];
    float* out;
    unsigned char* ws;
    int use_cg; int pad;
};

__device__ __forceinline__ unsigned pk2(float lo, float hi) { unsigned r; asm("v_cvt_pk_bf16_f32 %0, %1, %2" : "=v"(r) : "v"(lo), "v"(hi)); return r; }
__device__ __forceinline__ float bflo(unsigned u) { return __uint_as_float(u << 16); }
__device__ __forceinline__ float bfhi(unsigned u) { return __uint_as_float(u & 0xffff0000u); }
__device__ __forceinline__ float bf2f(bf16_t v) { return __uint_as_float((unsigned)v << 16); }
__device__ __forceinline__ float wave_sum(float v) {
#pragma unroll
    for (int o = 1; o < 64; o <<= 1) v += __shfl_xor(v, o);
    return v;
}
__device__ __forceinline__ float silu_f(float x) { return x * __builtin_amdgcn_rcpf(1.f + __expf(-x)); }
__device__ __forceinline__ float sigmoid_f(float x) { return __builtin_amdgcn_rcpf(1.f + __expf(-x)); }
__device__ __forceinline__ float softplus_f(float x) {
    const float u = __expf(-fabsf(x));
    const float ser = u * (1.f - u * (0.5f - u * (0.33333334f - u * 0.25f)));
    const float lg = __logf(1.f + u);
    return fmaxf(x, 0.f) + (u < 0.1f ? ser : lg);
}
__device__ __forceinline__ float gelu_tanh(float y) { const float a = 0.7978845608028654f * (y + 0.044715f * y * y * y); const float t = 1.f - 2.f * __builtin_amdgcn_rcpf(1.f + __expf(2.f * a)); return 0.5f * y * (1.f + t); }
#define LDS_WAIT() asm volatile("s_waitcnt lgkmcnt(0)" ::: "memory")
#define LDS_BARRIER() do { asm volatile("s_waitcnt lgkmcnt(0)" ::: "memory"); __builtin_amdgcn_s_barrier(); asm volatile("" ::: "memory"); } while (0)

namespace pg8 {
constexpr int BM = 256, BK = 64, HALF = 128, HTB = HALF * BK * 2, STAGE_BYTES = 8 * HTB, NXCD = 8, WGM = 8;
__host__ __device__ __forceinline__ int lds_byte(int r, int c) { const int st = (r >> 4) * 2 + (c >> 5), rr = r & 15, cc = c & 31, ob = rr * 64 + cc * 2; return st * 1024 + (ob ^ (((ob >> 9) & 1) << 5)); }
__host__ __device__ __forceinline__ void stage_rc(int b, int& R, int& C) { const int st = b / 1024, sb = b % 1024, swz = sb ^ (((sb >> 9) & 1) << 5); R = (st >> 1) * 16 + swz / 64; C = (st & 1) * 32 + (swz % 64) / 2; }
struct Unit { int pm, pn, kofs; };
struct Gemm { const bf16_t* A; const bf16_t* Bt; int M, N, K, ld; };
struct StaticOrder {
    int nM, nN, nwg, G, c;
    __host__ __device__ void init(int M_, int N_, int G_, int c_) { nM = M_ / BM; nN = N_ / BM; nwg = nM * nN; G = G_; c = c_; }
    __host__ __device__ bool next(int i, Unit& u) const {
        const long L = (long)i * G + c; if (L >= nwg) return false;
        int wgid = (int)L; { const int q = nwg / NXCD, r = nwg % NXCD, xcd = wgid % NXCD, off = wgid / NXCD; wgid = (xcd < r ? xcd * (q + 1) : r * (q + 1) + (xcd - r) * q) + off; }
        const int nig = WGM * nN, gid = wgid / nig, fm = gid * WGM, gsz = (nM - fm) < WGM ? (nM - fm) : WGM;
        u.pm = fm + ((wgid % nig) % gsz); u.pn = (wgid % nig) / gsz; u.kofs = 0; return true;
    }
    __device__ __forceinline__ void a_ready(const Unit&) const {}
    __device__ __forceinline__ void done(const Unit&) const {}
};
struct SplitOrder {
    int nunits, G, c, kslice;
    __host__ __device__ bool next(int i, Unit& u) const { const int L = i * G + c; if (L >= nunits) return false; u.pm = L & 1; u.pn = (L >> 1) & 3; u.kofs = (L >> 3) * kslice; return true; }
    __device__ __forceinline__ void a_ready(const Unit&) const {}
    __device__ __forceinline__ void done(const Unit&) const {}
};

template <bool SP2, class Epi, class Sched>
__device__ __forceinline__ void gemm_phase(LAS unsigned char* lds, const Gemm g, const Sched& S, const Epi& E) {
    int tid = threadIdx.x; asm volatile("" : "+v"(tid));
    const int wid = __builtin_amdgcn_readfirstlane(tid >> 6), lane = tid & 63, wr = wid >> 2, wc = wid & 3, fr = lane & 15, fq = lane >> 4;
    const int K = g.K, nt = K / BK;
    int ldv = g.ld; asm volatile("" : "+s"(ldv));
    unsigned voffA[2], voffB[2];
#pragma unroll
    for (int i = 0; i < 2; ++i) { int R, C; stage_rc(tid * 16 + i * 8192, R, C); voffA[i] = (unsigned)(R * ldv + C) * 2u; voffB[i] = voffA[i]; }
    const size_t kstep = (size_t)(BK * 2);
    const size_t hstepA = (size_t)HALF * ldv * 2, hstepB = hstepA;
    const size_t tstepA = 2 * hstepA, tstepB = tstepA;
    const unsigned ldsw = (unsigned)wid * 1024u;
    const int aoff = lds_byte(wr * 64 + fr, fq * 8), boff = lds_byte(wc * 32 + fr, fq * 8);
#define PG8_SA(b, h) (((b) * 2 + (h)) * HTB)
#define PG8_SB(b, h) ((4 + (b) * 2 + (h)) * HTB)
#define PG8_STAGE(bufoff, gbase, voff) do { _Pragma("unroll") for (int _i = 0; _i < 2; ++_i) \
        __builtin_amdgcn_global_load_lds((const unsigned*)((const char*)(gbase) + (voff)[_i]), (LAS unsigned*)(lds + (bufoff) + ldsw + _i * 8192), 16, 0, 0); } while (0)
#define PG8_LDA(dst, b, h) do { _Pragma("unroll") for (int m = 0; m < 4; ++m) _Pragma("unroll") for (int k = 0; k < 2; ++k) dst[m][k] = *(const LAS bf16x8*)(lds + PG8_SA(b, h) + aoff + m * 2048 + k * 1024); } while (0)
#define PG8_LDB(dst, b, h) do { _Pragma("unroll") for (int n = 0; n < 2; ++n) _Pragma("unroll") for (int k = 0; k < 2; ++k) dst[n][k] = *(const LAS bf16x8*)(lds + PG8_SB(b, h) + boff + n * 2048 + k * 1024); } while (0)
#define PG8_MMA(ai, bj, At, Bt) do { __builtin_amdgcn_s_setprio(1); _Pragma("unroll") for (int m = 0; m < 4; ++m) _Pragma("unroll") for (int n = 0; n < 2; ++n) _Pragma("unroll") for (int k = 0; k < 2; ++k) \
        acc[ai][bj][m][n] = __builtin_amdgcn_mfma_f32_16x16x32_bf16(Bt[n][k], At[m][k], acc[ai][bj][m][n], 0, 0, 0); __builtin_amdgcn_s_setprio(0); } while (0)
#define PG8_WAIT_V(n) asm volatile("s_waitcnt vmcnt(" #n ")" ::: "memory")
#define PG8_WAIT_L(n) asm volatile("s_waitcnt lgkmcnt(" #n ")" ::: "memory")
#define PG8_BAR __builtin_amdgcn_s_barrier()
#define PG8_SCHED __builtin_amdgcn_sched_barrier(0)
    Unit cur, nxt; int ui = 0;
    if (!S.next(0, cur)) return;
    f32x4 acc[2][2][4][2];
#pragma unroll
    for (int a = 0; a < 2; ++a)
#pragma unroll
        for (int b = 0; b < 2; ++b)
#pragma unroll
            for (int m = 0; m < 4; ++m)
#pragma unroll
                for (int n = 0; n < 2; ++n) acc[a][b][m][n] = (f32x4){0.f, 0.f, 0.f, 0.f};
    bf16x8 At[4][2], B0[2][2], B1[2][2];
    const char* cA = (const char*)g.A + (size_t)cur.pm * tstepA + (size_t)cur.kofs * 2; const char* cB = (const char*)g.Bt + (size_t)cur.pn * tstepB + (size_t)cur.kofs * 2;
    S.a_ready(cur);
    if constexpr (SP2) {
        PG8_STAGE(PG8_SB(0, 0), cB, voffB); PG8_STAGE(PG8_SB(0, 1), cB + hstepB, voffB); PG8_STAGE(PG8_SA(0, 0), cA, voffA); PG8_STAGE(PG8_SA(0, 1), cA + hstepA, voffA);
        if (wr == 1) PG8_BAR;
        PG8_WAIT_V(2); PG8_BAR;
    } else {
        PG8_STAGE(PG8_SB(0, 0), cB, voffB); PG8_STAGE(PG8_SA(0, 0), cA, voffA); PG8_STAGE(PG8_SB(0, 1), cB + hstepB, voffB); PG8_STAGE(PG8_SA(0, 1), cA + hstepA, voffA);
        if (wr == 1) PG8_BAR;
        PG8_WAIT_V(4); PG8_BAR;
    }
    PG8_STAGE(PG8_SB(1, 0), cB + kstep, voffB); PG8_STAGE(PG8_SA(1, 0), cA + kstep, voffA); PG8_STAGE(PG8_SB(1, 1), cB + hstepB + kstep, voffB);
    PG8_WAIT_V(6); PG8_BAR;
    for (;;) {
        const bool has_next = S.next(ui + 1, nxt);
        const char* nA = has_next ? (const char*)g.A + (size_t)nxt.pm * tstepA + (size_t)nxt.kofs * 2 : cA; const char* nB = has_next ? (const char*)g.Bt + (size_t)nxt.pn * tstepB + (size_t)nxt.kofs * 2 : cB;
        for (int t = 0; t < nt; t += 2) {
            const bool last = (t == nt - 2);
            const char* a1 = cA + (size_t)(t + 1) * kstep;
            const char* a2 = last ? nA : cA + (size_t)(t + 2) * kstep; const char* b2 = last ? nB : cB + (size_t)(t + 2) * kstep;
            const char* a3 = a2 + kstep; const char* b3 = b2 + kstep;
            if (last && has_next) S.a_ready(nxt);
            if constexpr (SP2) {
            PG8_LDB(B0, 0, 0); PG8_LDB(B1, 0, 1); PG8_SCHED; PG8_LDA(At, 0, 0); PG8_STAGE(PG8_SA(1, 1), a1 + hstepA, voffA);
            PG8_WAIT_V(8); PG8_WAIT_L(0); PG8_BAR; PG8_MMA(0, 0, At, B0); PG8_MMA(0, 1, At, B1); PG8_BAR; PG8_SCHED;
            PG8_LDA(At, 0, 1); PG8_STAGE(PG8_SB(0, 0), b2, voffB); PG8_STAGE(PG8_SB(0, 1), b2 + hstepB, voffB); PG8_STAGE(PG8_SA(0, 0), a2, voffA);
            PG8_WAIT_V(8); PG8_WAIT_L(0); PG8_BAR; PG8_MMA(1, 0, At, B0); PG8_MMA(1, 1, At, B1); PG8_BAR; PG8_SCHED;
            PG8_LDB(B0, 1, 0); PG8_LDB(B1, 1, 1); PG8_SCHED; PG8_LDA(At, 1, 0); PG8_STAGE(PG8_SA(0, 1), a2 + hstepA, voffA);
            PG8_WAIT_V(8); PG8_WAIT_L(0); PG8_BAR; PG8_MMA(0, 0, At, B0); PG8_MMA(0, 1, At, B1); PG8_BAR; PG8_SCHED;
            PG8_LDA(At, 1, 1); PG8_STAGE(PG8_SB(1, 0), b3, voffB); PG8_STAGE(PG8_SB(1, 1), b3 + hstepB, voffB); PG8_STAGE(PG8_SA(1, 0), a3, voffA);
            PG8_WAIT_V(8); PG8_WAIT_L(0); PG8_BAR; PG8_MMA(1, 0, At, B0); PG8_MMA(1, 1, At, B1); PG8_BAR; PG8_SCHED;
            } else {
            PG8_LDB(B0, 0, 0); PG8_SCHED; PG8_LDA(At, 0, 0); PG8_STAGE(PG8_SA(1, 1), a1 + hstepA, voffA);
            PG8_WAIT_L(8); PG8_BAR; PG8_WAIT_L(0); PG8_MMA(0, 0, At, B0); PG8_BAR; PG8_SCHED;
            PG8_LDB(B1, 0, 1); PG8_STAGE(PG8_SB(0, 0), b2, voffB);
            PG8_BAR; PG8_WAIT_L(0); PG8_MMA(0, 1, At, B1); PG8_BAR;
            PG8_LDA(At, 0, 1); PG8_STAGE(PG8_SA(0, 0), a2, voffA);
            PG8_BAR; PG8_WAIT_L(0); PG8_MMA(1, 0, At, B0); PG8_BAR; PG8_SCHED;
            PG8_STAGE(PG8_SB(0, 1), b2 + hstepB, voffB);
            PG8_WAIT_V(6); PG8_BAR; PG8_MMA(1, 1, At, B1); PG8_BAR;
            PG8_LDB(B0, 1, 0); PG8_SCHED; PG8_LDA(At, 1, 0); PG8_STAGE(PG8_SA(0, 1), a2 + hstepA, voffA);
            PG8_WAIT_L(8); PG8_BAR; PG8_WAIT_L(0); PG8_MMA(0, 0, At, B0); PG8_BAR; PG8_SCHED;
            PG8_LDB(B1, 1, 1); PG8_STAGE(PG8_SB(1, 0), b3, voffB);
            PG8_BAR; PG8_WAIT_L(0); PG8_MMA(0, 1, At, B1); PG8_BAR;
            PG8_LDA(At, 1, 1); PG8_STAGE(PG8_SA(1, 0), a3, voffA);
            PG8_BAR; PG8_WAIT_L(0); PG8_MMA(1, 0, At, B0); PG8_BAR; PG8_SCHED;
            PG8_STAGE(PG8_SB(1, 1), b3 + hstepB, voffB);
            PG8_WAIT_V(6); PG8_BAR; PG8_MMA(1, 1, At, B1); PG8_BAR;
                    }
        }
        if constexpr (SP2) { if (wr == 0) PG8_BAR; }
        E(acc, cur, wr, wc, fr, fq); S.done(cur);
        if (!has_next) break;
#pragma unroll
        for (int a = 0; a < 2; ++a)
#pragma unroll
            for (int b = 0; b < 2; ++b)
#pragma unroll
                for (int m = 0; m < 4; ++m)
#pragma unroll
                    for (int n = 0; n < 2; ++n) acc[a][b][m][n] = (f32x4){0.f, 0.f, 0.f, 0.f};
        cur = nxt; cA = nA; cB = nB; ++ui;
        if constexpr (SP2) { if (wr == 1) PG8_BAR; }
    }
    PG8_WAIT_V(0);
    if constexpr (!SP2) { if (wr == 0) PG8_BAR; }
    PG8_BAR;
#undef PG8_SA
#undef PG8_SB
#undef PG8_STAGE
#undef PG8_LDA
#undef PG8_LDB
#undef PG8_MMA
#undef PG8_WAIT_V
#undef PG8_WAIT_L
#undef PG8_BAR
#undef PG8_SCHED
}
}
using pg8::Unit;

struct EpiGateUp {
    bf16_t* act;
    __device__ __forceinline__ void operator()(const f32x4 (&acc)[2][2][4][2], const Unit& u, int wr, int wc, int fr, int fq) const {
#pragma unroll
        for (int ai = 0; ai < 2; ++ai)
#pragma unroll
            for (int m = 0; m < 4; ++m) {
                const int r = u.pm * 256 + ai * 128 + wr * 64 + m * 16 + fr;
                const int j = u.pn * 128 + wc * 32 + 8 * fq;
                const f32x4 g0 = acc[ai][0][m][0], g1 = acc[ai][0][m][1], u0 = acc[ai][1][m][0], u1 = acc[ai][1][m][1];
                u32x4 o; o.x = pk2(silu_f(g0[0]) * u0[0], silu_f(g0[1]) * u0[1]); o.y = pk2(silu_f(g0[2]) * u0[2], silu_f(g0[3]) * u0[3]);
                o.z = pk2(silu_f(g1[0]) * u1[0], silu_f(g1[1]) * u1[1]); o.w = pk2(silu_f(g1[2]) * u1[2], silu_f(g1[3]) * u1[3]);
                *(u32x4*)(act + (size_t)r * FF + j) = o;
            }
    }
};
struct EpiResid {
    const float* rp; const float* rs; float* y; float scale;
    __device__ __forceinline__ void operator()(const f32x4 (&acc)[2][2][4][2], const Unit& u, int wr, int wc, int fr, int fq) const {
#pragma unroll
        for (int ai = 0; ai < 2; ++ai)
#pragma unroll
            for (int m = 0; m < 4; ++m) {
                const int r = u.pm * 256 + ai * 128 + wr * 64 + m * 16 + fr;
                const float* rrow = (r < MP) ? rp + (size_t)r * D : rs + (size_t)(r - MP) * D;
                float* yrow = y + (size_t)r * D;
#pragma unroll
                for (int bj = 0; bj < 2; ++bj)
#pragma unroll
                    for (int n = 0; n < 2; ++n) {
                        const int c = u.pn * 256 + bj * 128 + wc * 32 + n * 16 + 4 * fq;
                        const f32x4 rv = *(const f32x4*)(rrow + c);
                        *(f32x4*)(yrow + c) = rv + acc[ai][bj][m][n] * scale;
                    }
            }
    }
};
struct EpiPart {
    float* part; float scale;
    __device__ __forceinline__ void operator()(const f32x4 (&acc)[2][2][4][2], const Unit& u, int wr, int wc, int fr, int fq) const {
        float* pb = part + (size_t)(u.kofs >> 8) * MS * D;
#pragma unroll
        for (int ai = 0; ai < 2; ++ai)
#pragma unroll
            for (int m = 0; m < 4; ++m) {
                float* yrow = pb + (size_t)(u.pm * 256 + ai * 128 + wr * 64 + m * 16 + fr) * D;
#pragma unroll
                for (int bj = 0; bj < 2; ++bj)
#pragma unroll
                    for (int n = 0; n < 2; ++n) {
                        const int c = u.pn * 256 + bj * 128 + wc * 32 + n * 16 + 4 * fq;
                        *(f32x4*)(yrow + c) = acc[ai][bj][m][n] * scale;
                    }
            }
    }
};
struct EpiProj {
    bf16_t* proj; float* dtraw;
    __device__ __forceinline__ void operator()(const f32x4 (&acc)[2][2][4][2], const Unit& u, int wr, int wc, int fr, int fq) const {
#pragma unroll
        for (int ai = 0; ai < 2; ++ai)
#pragma unroll
            for (int m = 0; m < 4; ++m) {
                const int r = u.pm * 256 + ai * 128 + wr * 64 + m * 16 + fr;
#pragma unroll
                for (int bj = 0; bj < 2; ++bj) {
                    const int c = u.pn * 256 + bj * 128 + wc * 32 + 8 * fq;
                    const f32x4 v0 = acc[ai][bj][m][0], v1 = acc[ai][bj][m][1];
                    if (u.pn == 18) { if (c - 4608 < 24) { *(f32x4*)(dtraw + (size_t)r * 24 + (c - 4608)) = v0; *(f32x4*)(dtraw + (size_t)r * 24 + (c - 4608) + 4) = v1; } }
                    else { u32x4 o; o.x = pk2(v0[0], v0[1]); o.y = pk2(v0[2], v0[3]); o.z = pk2(v1[0], v1[1]); o.w = pk2(v1[2], v1[3]); *(u32x4*)(proj + (size_t)r * NINP + c) = o; }
                }
            }
    }
};
struct EpiGlu {
    const bf16_t* v; const float* bias; bf16_t* mix;
    __device__ __forceinline__ void operator()(const f32x4 (&acc)[2][2][4][2], const Unit& u, int wr, int wc, int fr, int fq) const {
#pragma unroll
        for (int ai = 0; ai < 2; ++ai)
#pragma unroll
            for (int m = 0; m < 4; ++m) {
                const int r = u.pm * 256 + ai * 128 + wr * 64 + m * 16 + fr;
#pragma unroll
                for (int bj = 0; bj < 2; ++bj)
#pragma unroll
                    for (int n = 0; n < 2; ++n) {
                        const int c = u.pn * 256 + bj * 128 + wc * 32 + n * 16 + 4 * fq;
                        const f32x4 a = acc[ai][bj][m][n]; const f32x4 bb = *(const f32x4*)(bias + c);
                        const u32x2 vv = *(const u32x2*)(v + (size_t)r * 512 + c);
                        u32x2 o; o.x = pk2(bflo(vv.x) * sigmoid_f(a[0] + bb[0]), bfhi(vv.x) * sigmoid_f(a[1] + bb[1]));
                        o.y = pk2(bflo(vv.y) * sigmoid_f(a[2] + bb[2]), bfhi(vv.y) * sigmoid_f(a[3] + bb[3]));
                        *(u32x2*)(mix + (size_t)r * DMIX + c) = o;
                    }
            }
    }
};

__device__ __forceinline__ void transpose_item(const float* W, int K, int N, bf16_t* WT, int mode, LAS float* scr, int item, int lane) {
    const int nblk = (N + 63) / 64, kb = item / nblk, nb = item % nblk, k0 = 64 * kb, n0 = 64 * nb;
    const int c4 = lane & 15, rr = lane >> 4, nn = n0 + 4 * c4;
    f32x4 v[16];
#pragma unroll
    for (int i = 0; i < 16; ++i) v[i] = (nn < N) ? *(const f32x4*)(W + (size_t)(k0 + 4 * i + rr) * N + nn) : (f32x4){0.f, 0.f, 0.f, 0.f};
#pragma unroll
    for (int i = 0; i < 16; ++i) { LAS float* d = scr + (4 * i + rr) * 65 + 4 * c4; d[0] = v[i][0]; d[1] = v[i][1]; d[2] = v[i][2]; d[3] = v[i][3]; }
    LDS_WAIT();
    const int c = lane & 7, nrow = lane >> 3;
#pragma unroll
    for (int j = 0; j < 8; ++j) { const int n = nrow + 8 * j; const LAS float* s = scr + (8 * c) * 65 + n;
        u32x4 o; o.x = pk2(s[0 * 65], s[1 * 65]); o.y = pk2(s[2 * 65], s[3 * 65]); o.z = pk2(s[4 * 65], s[5 * 65]); o.w = pk2(s[6 * 65], s[7 * 65]);
        const int jn = n0 + n;
        const int ip = 16 * ((jn >> 2) & 1) + 4 * ((jn >> 3) & 3) + (jn & 3);
        const int row = (mode == 0) ? jn : (mode == 3) ? ((jn & ~31) + ip) : ((jn >> 7) * 256 + ((jn & 127) & ~31) + ip + (mode == 5 ? 128 : 0));
        *(u32x4*)(WT + (size_t)row * K + k0 + 8 * c) = o; }
    LDS_WAIT();
}
constexpr int I_GU = (D / 64) * (FF / 64), I_DN = (FF / 64) * (D / 64), I_IN = (D / 64) * ((NIN + 63) / 64), I_GL = (512 / 64) * (512 / 64), I_OUT = (DMIX / 64) * (D / 64);
constexpr int CV_W1T = 0, CV_W1D = 2 * I_GU, CV_WIN = CV_W1D + I_DN, CV_WGLU = CV_WIN + I_IN, CV_WOUT = CV_WGLU + I_GL, CV_W2T = CV_WOUT + I_OUT, CV_W2D = CV_W2T + 2 * I_GU, CV_END = CV_W2D + I_DN;
__device__ __forceinline__ void convert_items(const Params& p, LAS unsigned char* lds, int lo, int hi, int gw, int ngw, int wave, int lane_in) {
    int lane = lane_in; asm volatile("" : "+v"(lane));
    LAS float* scr = (LAS float*)(lds + wave * 16640);
    for (int it = lo + gw; it < hi; it += ngw) {
        int r = it;
        if (r < CV_W1D) { if (r < I_GU) transpose_item(p.in[7], D, FF, (bf16_t*)(p.ws + WS_W1T), 4, scr, r, lane); else transpose_item(p.in[8], D, FF, (bf16_t*)(p.ws + WS_W1T), 5, scr, r - I_GU, lane); continue; }
        if (r < CV_WIN) { transpose_item(p.in[9], FF, D, (bf16_t*)(p.ws + WS_W1D), 0, scr, r - CV_W1D, lane); continue; }
        if (r < CV_WGLU) { transpose_item(p.in[11], D, NIN, (bf16_t*)(p.ws + WS_WIN), 3, scr, r - CV_WIN, lane); continue; }
        if (r < CV_WOUT) { transpose_item(p.in[20], 512, 512, (bf16_t*)(p.ws + WS_WGLU), 0, scr, r - CV_WGLU, lane); continue; }
        if (r < CV_W2T) { transpose_item(p.in[28], DMIX, D, (bf16_t*)(p.ws + WS_WOUT), 0, scr, r - CV_WOUT, lane); continue; }
        if (r < CV_W2D) { r -= CV_W2T; if (r < I_GU) transpose_item(p.in[30], D, FF, (bf16_t*)(p.ws + WS_W2T), 4, scr, r, lane); else transpose_item(p.in[31], D, FF, (bf16_t*)(p.ws + WS_W2T), 5, scr, r - I_GU, lane); continue; }
        transpose_item(p.in[32], FF, D, (bf16_t*)(p.ws + WS_W2D), 0, scr, r - CV_W2D, lane);
    }
}

__device__ __forceinline__ void sum_sample_row(const float* base, const float* part, int nsl, int ms, int lane, f32x4 (&v)[4]) {
#pragma unroll
    for (int j = 0; j < 4; ++j) v[j] = ((const f32x4*)(base + (size_t)ms * D))[lane + 64 * j];
    for (int s0 = 0; s0 < nsl; s0 += 4) {
        f32x4 t[4][4];
#pragma unroll
        for (int q = 0; q < 4; ++q) { const int sl = (s0 + q < nsl) ? s0 + q : nsl - 1;
#pragma unroll
            for (int j = 0; j < 4; ++j) t[q][j] = ((const f32x4*)(part + ((size_t)sl * MS + ms) * D))[lane + 64 * j]; }
#pragma unroll
        for (int q = 0; q < 4; ++q) { const float wq = (s0 + q < nsl) ? 1.f : 0.f;
#pragma unroll
            for (int j = 0; j < 4; ++j) v[j] += t[q][j] * wq; }
    }
}
__device__ __forceinline__ void rms_phase(const float* srcp, const float* srcs, const float* w, bf16_t* dst, int gw, int ngw, int lane_in, const float* part = nullptr, int nsl = 0, float* wb = nullptr) {
    int lane = lane_in; asm volatile("" : "+v"(lane));
    const int mend = (nsl > 0) ? MP : M;
    for (int m = gw * 4; m < mend; m += ngw * 4) {
        const float* xrow = (m < MP) ? srcp + (size_t)m * D : srcs + (size_t)(m - MP) * D;
        f32x4 v[4][4];
#pragma unroll
        for (int r = 0; r < 4; ++r)
#pragma unroll
            for (int j = 0; j < 4; ++j) v[r][j] = ((const f32x4*)(xrow + (size_t)r * D))[lane + 64 * j];
        f32x4 ww[4];
#pragma unroll
        for (int j = 0; j < 4; ++j) ww[j] = ((const f32x4*)w)[lane + 64 * j];
#pragma unroll
        for (int r = 0; r < 4; ++r) {
            float ss = 0.f;
#pragma unroll
            for (int j = 0; j < 4; ++j) ss += (v[r][j].x * v[r][j].x + v[r][j].y * v[r][j].y) + (v[r][j].z * v[r][j].z + v[r][j].w * v[r][j].w);
            const float rstd = rsqrtf(wave_sum(ss) * (1.f / D) + EPS);
            u32x2* o8 = (u32x2*)(dst + (size_t)(m + r) * D) + lane;
#pragma unroll
            for (int j = 0; j < 4; ++j) { u32x2 o; o.x = pk2(v[r][j].x * rstd * ww[j].x, v[r][j].y * rstd * ww[j].y); o.y = pk2(v[r][j].z * rstd * ww[j].z, v[r][j].w * rstd * ww[j].w); o8[64 * j] = o; }
        }
    }
    if (nsl > 0) {
        for (int ms = ngw - 1 - gw; ms < MS; ms += ngw) {
            f32x4 v[4]; sum_sample_row(srcs, part, nsl, ms, lane, v);
            float ss = 0.f;
#pragma unroll
            for (int j = 0; j < 4; ++j) { ((f32x4*)(wb + (size_t)ms * D))[lane + 64 * j] = v[j]; ss += (v[j].x * v[j].x + v[j].y * v[j].y) + (v[j].z * v[j].z + v[j].w * v[j].w); }
            const float rstd = rsqrtf(wave_sum(ss) * (1.f / D) + EPS);
            u32x2* o8 = (u32x2*)(dst + (size_t)(MP + ms) * D) + lane;
#pragma unroll
            for (int j = 0; j < 4; ++j) { const f32x4 ww = ((const f32x4*)w)[lane + 64 * j]; u32x2 o; o.x = pk2(v[j].x * rstd * ww.x, v[j].y * rstd * ww.y); o.y = pk2(v[j].z * rstd * ww.z, v[j].w * rstd * ww.w); o8[64 * j] = o; }
        }
    }
}

__device__ __forceinline__ void unpack8(const u32x4 u, float (&f)[8]) { f[0] = bflo(u.x); f[1] = bfhi(u.x); f[2] = bflo(u.y); f[3] = bfhi(u.y); f[4] = bflo(u.z); f[5] = bfhi(u.z); f[6] = bflo(u.w); f[7] = bfhi(u.w); }
#define BF_ELEM(v, e) ((((e) & 1) ? ((v)[(e) >> 1] >> 16) : ((v)[(e) >> 1] & 0xffffu)))
__device__ __forceinline__ void conv_phase(const Params& p, int gtid, int nthreads) {
    const bf16_t* proj = (const bf16_t*)(p.ws + WS_A);
    bf16_t* BCN = (bf16_t*)(p.ws + WS_XC + XC_BCN); bf16_t* XSN = (bf16_t*)(p.ws + WS_XC + XC_XSN); bf16_t* XT = (bf16_t*)(p.ws + WS_XC + XC_XT); bf16_t* BT = (bf16_t*)(p.ws + WS_H + H_BT);
    const float* cw = p.in[22]; const float* cb = p.in[23]; const float* sconv = p.in[5];
    const int NT_P = (MP / 16) * 320, NT_S = NSB * 320;
    for (int task = gtid; task < NT_P; task += nthreads) {
        const int cgp = task % 320, rb = task / 320, c0 = cgp * 8, m0 = rb * 16;
        const bool first = (m0 % SEQ) == 0, lastblk = (m0 % SEQ) == SEQ - 16;
        u32x4 raw[19];
#pragma unroll
        for (int i = 0; i < 19; ++i) raw[i] = (i >= 3 || !first) ? *(const u32x4*)(proj + (size_t)(m0 - 3 + i) * NINP + 2048 + c0) : (u32x4){0u, 0u, 0u, 0u};
        float w0[8], w1[8], w2[8], w3[8], bs[8];
#pragma unroll
        for (int e = 0; e < 8; e += 4) { *(f32x4*)&w0[e] = *(const f32x4*)(cw + c0 + e); *(f32x4*)&w1[e] = *(const f32x4*)(cw + XBC + c0 + e); *(f32x4*)&w2[e] = *(const f32x4*)(cw + 2 * XBC + c0 + e);
            *(f32x4*)&w3[e] = *(const f32x4*)(cw + 3 * XBC + c0 + e); *(f32x4*)&bs[e] = *(const f32x4*)(cb + c0 + e); }
        float r0[8], r1[8], r2[8];
        unpack8(raw[0], r0); unpack8(raw[1], r1); unpack8(raw[2], r2);
        u32x4 ov[16];
#pragma unroll
        for (int i = 0; i < 16; ++i) {
            float cur[8]; unpack8(raw[i + 3], cur);
            float o[8];
#pragma unroll
            for (int e = 0; e < 8; ++e) { const float cv = bs[e] + w0[e] * r0[e] + w1[e] * r1[e] + w2[e] * r2[e] + w3[e] * cur[e]; o[e] = silu_f(cv); r0[e] = r1[e]; r1[e] = r2[e]; r2[e] = cur[e]; }
            ov[i].x = pk2(o[0], o[1]); ov[i].y = pk2(o[2], o[3]); ov[i].z = pk2(o[4], o[5]); ov[i].w = pk2(o[6], o[7]);
            if (i >= 13 && lastblk) { float* d = p.out + O_CONVP + ((size_t)(m0 / SEQ) * 3 + (i - 13)) * XBC + c0; *(f32x4*)d = (f32x4){cur[0], cur[1], cur[2], cur[3]}; *(f32x4*)(d + 4) = (f32x4){cur[4], cur[5], cur[6], cur[7]}; }
        }
        const int bb = m0 / SEQ, t0 = m0 % SEQ, cc = t0 >> 7, l0 = t0 & 127;
        if (c0 >= 1536) {
            const int cn = c0 - 1536;
#pragma unroll
            for (int i = 0; i < 16; ++i) *(u32x4*)(BCN + (size_t)(m0 + i) * 1024 + cn) = ov[i];
        }
        if (c0 < 2048) {
            bf16_t* tb = (c0 < 1536) ? XT + ((((size_t)(bb * 16 + cc) * NH + (c0 >> 6)) * 64 + (c0 & 63)) * 128 + l0)
                                     : BT + ((((size_t)(bb * 16 + cc) * 4 + ((c0 - 1536) >> 7)) * 128 + ((c0 - 1536) & 127)) * 128 + l0);
            const bool odd = (gtid & 1) != 0;
            bf16_t* t1 = odd ? tb - 8 * 128 + 8 : tb;
            bf16_t* t2 = odd ? tb + 8 : tb + 8 * 128;
#pragma unroll
            for (int e = 0; e < 8; ++e) {
                u32x4 q0, q1;
                q0.x = BF_ELEM(ov[0], e) | (BF_ELEM(ov[1], e) << 16); q0.y = BF_ELEM(ov[2], e) | (BF_ELEM(ov[3], e) << 16); q0.z = BF_ELEM(ov[4], e) | (BF_ELEM(ov[5], e) << 16); q0.w = BF_ELEM(ov[6], e) | (BF_ELEM(ov[7], e) << 16);
                q1.x = BF_ELEM(ov[8], e) | (BF_ELEM(ov[9], e) << 16); q1.y = BF_ELEM(ov[10], e) | (BF_ELEM(ov[11], e) << 16); q1.z = BF_ELEM(ov[12], e) | (BF_ELEM(ov[13], e) << 16); q1.w = BF_ELEM(ov[14], e) | (BF_ELEM(ov[15], e) << 16);
                const u32x4 snd = odd ? q0 : q1; u32x4 rcv;
                rcv.x = __shfl_xor(snd.x, 1); rcv.y = __shfl_xor(snd.y, 1); rcv.z = __shfl_xor(snd.z, 1); rcv.w = __shfl_xor(snd.w, 1);
                *(u32x4*)(t1 + (size_t)e * 128) = odd ? rcv : q0;
                *(u32x4*)(t2 + (size_t)e * 128) = odd ? q1 : rcv;
            }
        }
    }
    for (int task = (nthreads - 1 - gtid) ^ 1; task < NT_S; task += nthreads) {
        const int cgp = task % 320, b = task / 320, c0 = cgp * 8, m0 = MP + b * 4;
        u32x4 raw[4];
#pragma unroll
        for (int i = 0; i < 4; ++i) raw[i] = *(const u32x4*)(proj + (size_t)(m0 + i) * NINP + 2048 + c0);
        float w0[8], w1[8], w2[8], w3[8], bs[8], r0[8], r1[8], r2[8];
        const float* st = sconv + (size_t)b * 3 * XBC + c0;
#pragma unroll
        for (int e = 0; e < 8; e += 4) { *(f32x4*)&w0[e] = *(const f32x4*)(cw + c0 + e); *(f32x4*)&w1[e] = *(const f32x4*)(cw + XBC + c0 + e); *(f32x4*)&w2[e] = *(const f32x4*)(cw + 2 * XBC + c0 + e);
            *(f32x4*)&w3[e] = *(const f32x4*)(cw + 3 * XBC + c0 + e); *(f32x4*)&bs[e] = *(const f32x4*)(cb + c0 + e);
            *(f32x4*)&r0[e] = *(const f32x4*)(st + e); *(f32x4*)&r1[e] = *(const f32x4*)(st + XBC + e); *(f32x4*)&r2[e] = *(const f32x4*)(st + 2 * XBC + e); }
#pragma unroll
        for (int i = 0; i < 4; ++i) {
            float cur[8]; unpack8(raw[i], cur);
            float o[8];
#pragma unroll
            for (int e = 0; e < 8; ++e) { const float cv = bs[e] + w0[e] * r0[e] + w1[e] * r1[e] + w2[e] * r2[e] + w3[e] * cur[e]; o[e] = silu_f(cv); r0[e] = r1[e]; r1[e] = r2[e]; r2[e] = cur[e]; }
            u32x4 ov; ov.x = pk2(o[0], o[1]); ov.y = pk2(o[2], o[3]); ov.z = pk2(o[4], o[5]); ov.w = pk2(o[6], o[7]);
            if (c0 < 1536) *(u32x4*)(XSN + (size_t)(m0 + i - MP) * SSDW + c0) = ov;
            else *(u32x4*)(BCN + (size_t)(m0 + i) * 1024 + (c0 - 1536)) = ov;
            if (i >= 1) { float* d = p.out + O_CONVS + ((size_t)b * 3 + (i - 1)) * XBC + c0; *(f32x4*)d = (f32x4){cur[0], cur[1], cur[2], cur[3]}; *(f32x4*)(d + 4) = (f32x4){cur[4], cur[5], cur[6], cur[7]}; }
        }
    }
}

constexpr int LROW = 272;
constexpr int L_C = 0, L_B = 34816, L_BT = 69632, L_XT = 104448, L_XS = 121856, L_HT = 139264, L_AC = 156672, L_DT = 157184, L_G = 157696;
__device__ __forceinline__ float wave_incl_scan(float v, int lane) {
#pragma unroll
    for (int o = 1; o < 64; o <<= 1) { const float t = __shfl_up(v, o); if (lane >= o) v += t; }
    return v;
}
__device__ __forceinline__ void ssd_prompt_item(const Params& p, LAS unsigned char* lds, int b, int h) {
    int tid = threadIdx.x; asm volatile("" : "+v"(tid));
    const int lane = tid & 63, w = __builtin_amdgcn_readfirstlane(tid >> 6), fr = lane & 15, fq = lane >> 4;
    const int g = h / 6;
    const bf16_t* BCN = (const bf16_t*)(p.ws + WS_XC + XC_BCN); const bf16_t* XT = (const bf16_t*)(p.ws + WS_XC + XC_XT); const bf16_t* BT = (const bf16_t*)(p.ws + WS_H + H_BT);
    const float* dtraw = (const float*)(p.ws + WS_DTRAW); bf16_t* ys = (bf16_t*)(p.ws + WS_YS);
    const float a_h = -__expf(p.in[25][h]), dtb = p.in[24][h], Dh = p.in[26][h];
    f32x4 hacc[4];
#pragma unroll
    for (int i = 0; i < 4; ++i) hacc[i] = (f32x4){0.f, 0.f, 0.f, 0.f};
    for (int i = tid; i < 64 * 17; i += 512) *(LAS u32x4*)(lds + L_HT + i * 16) = (u32x4){0u, 0u, 0u, 0u};
    const int prow = tid >> 4, pc = tid & 15;
    u32x4 pvc[4], pvb[4], pvt[4], pvx[2]; float pdl, pdh;
#define SSD_FETCH(cc) do { const int _m0 = b * SEQ + (cc) * 128; \
        pdl = dtraw[(size_t)(_m0 + lane) * 24 + h]; pdh = dtraw[(size_t)(_m0 + 64 + lane) * 24 + h]; \
        const bf16_t* _bt = BT + (((size_t)(b * 16 + (cc)) * 4 + g) * 128) * 128; const bf16_t* _xt = XT + (((size_t)(b * 16 + (cc)) * NH + h) * 64) * 128; \
        _Pragma("unroll") for (int j = 0; j < 4; ++j) { const bf16_t* _gr = BCN + (size_t)(_m0 + prow + 32 * j) * 1024 + g * 128 + pc * 8; pvb[j] = *(const u32x4*)_gr; pvc[j] = *(const u32x4*)(_gr + 512); \
            pvt[j] = *(const u32x4*)(_bt + (size_t)(prow + 32 * j) * 128 + pc * 8); } \
        _Pragma("unroll") for (int j = 0; j < 2; ++j) pvx[j] = *(const u32x4*)(_xt + (size_t)(prow + 32 * j) * 128 + pc * 8); } while (0)
    SSD_FETCH(0);
    for (int c = 0; c < 16; ++c) {
        const int m0 = b * SEQ + c * 128;
        const float dt_lo = softplus_f(pdl + dtb), dt_hi = softplus_f(pdh + dtb);
        const float ac_lo = wave_incl_scan(dt_lo * a_h, lane); const float tot_lo = __shfl(ac_lo, 63);
        const float ac_hi = wave_incl_scan(dt_hi * a_h, lane) + tot_lo; const float alast = __shfl(ac_hi, 63);
        const float sc_lo = dt_lo * __expf(alast - ac_lo), sc_hi = dt_hi * __expf(alast - ac_hi);
        if (w == 0) { const float ae_lo = __shfl(ac_lo, (lane & 48) + 15), ae_hi = __shfl(ac_hi, (lane & 48) + 15);
            *(LAS float*)(lds + L_G + lane * 4) = dt_lo * __expf(ae_lo - ac_lo); *(LAS float*)(lds + L_G + 256 + lane * 4) = dt_hi * __expf(ae_hi - ac_hi);
            *(LAS float*)(lds + L_AC + lane * 4) = ac_lo; *(LAS float*)(lds + L_AC + 256 + lane * 4) = ac_hi; *(LAS float*)(lds + L_DT + lane * 4) = dt_lo; *(LAS float*)(lds + L_DT + 256 + lane * 4) = dt_hi; }
        float sc[8];
#pragma unroll
        for (int e = 0; e < 8; ++e) { const int src = (pc * 8 + e) & 63; const float vlo = __shfl(sc_lo, src), vhi = __shfl(sc_hi, src); sc[e] = (pc < 8) ? vlo : vhi; }
#pragma unroll
        for (int j = 0; j < 4; ++j) {
            const int r = prow + 32 * j;
            *(LAS u32x4*)(lds + L_C + r * LROW + pc * 16) = pvc[j];
            *(LAS u32x4*)(lds + L_B + r * LROW + pc * 16) = pvb[j];
            *(LAS u32x4*)(lds + L_BT + r * LROW + pc * 16) = pvt[j];
        }
#pragma unroll
        for (int j = 0; j < 2; ++j) {
            const int r = prow + 32 * j;
            float xf[8]; unpack8(pvx[j], xf);
            *(LAS u32x4*)(lds + L_XT + r * LROW + pc * 16) = pvx[j];
            u32x4 q; q.x = pk2(xf[0] * sc[0], xf[1] * sc[1]); q.y = pk2(xf[2] * sc[2], xf[3] * sc[3]); q.z = pk2(xf[4] * sc[4], xf[5] * sc[5]); q.w = pk2(xf[6] * sc[6], xf[7] * sc[7]);
            *(LAS u32x4*)(lds + L_XS + r * LROW + pc * 16) = q;
        }
        LDS_BARRIER();
        if (c < 15) SSD_FETCH(c + 1);
        const int l = 16 * w + fr;
        bf16x8 cfrag[4];
#pragma unroll
        for (int ks = 0; ks < 4; ++ks) cfrag[ks] = *(const LAS bf16x8*)(lds + L_C + l * LROW + (ks * 32 + fq * 8) * 2);
        f32x4 yacc[4];
#pragma unroll
        for (int pb = 0; pb < 4; ++pb) {
            f32x4 a = (f32x4){0.f, 0.f, 0.f, 0.f};
#pragma unroll
            for (int ks = 0; ks < 4; ++ks) { const bf16x8 hf = *(const LAS bf16x8*)(lds + L_HT + (pb * 16 + fr) * LROW + (ks * 32 + fq * 8) * 2); a = __builtin_amdgcn_mfma_f32_16x16x32_bf16(hf, cfrag[ks], a, 0, 0, 0); }
            yacc[pb] = a;
        }
        const float al = *(const LAS float*)(lds + L_AC + l * 4);
        { const float el = __expf(al);
#pragma unroll
          for (int pb = 0; pb < 4; ++pb) yacc[pb] = yacc[pb] * el; }
        f32x4 cbt[8];
#pragma unroll
        for (int sb = 0; sb < 8; ++sb) {
            cbt[sb] = (f32x4){0.f, 0.f, 0.f, 0.f};
            if (sb <= w) {
                f32x4 a = (f32x4){0.f, 0.f, 0.f, 0.f};
#pragma unroll
                for (int ks = 0; ks < 4; ++ks) { const bf16x8 bf = *(const LAS bf16x8*)(lds + L_B + (sb * 16 + fr) * LROW + (ks * 32 + fq * 8) * 2); a = __builtin_amdgcn_mfma_f32_16x16x32_bf16(bf, cfrag[ks], a, 0, 0, 0); }
                cbt[sb] = a;
            }
        }
        LDS_BARRIER();
        const int nks = (w >> 1) + 1;
#pragma unroll
        for (int sb = 0; sb < 8; ++sb) {
            if (sb < 2 * nks) {
                const int s0 = sb * 16 + 4 * fq;
                float mv[4];
                if (sb < w) {
                    const float f = __expf(al - *(const LAS float*)(lds + L_AC + (sb * 16 + 15) * 4));
                    const f32x4 gs = *(const LAS f32x4*)(lds + L_G + s0 * 4);
#pragma unroll
                    for (int e = 0; e < 4; ++e) mv[e] = cbt[sb][e] * f * gs[e];
                } else if (sb == w) {
                    const f32x4 as = *(const LAS f32x4*)(lds + L_AC + s0 * 4), ds = *(const LAS f32x4*)(lds + L_DT + s0 * 4);
#pragma unroll
                    for (int e = 0; e < 4; ++e) { const float v = cbt[sb][e] * __expf(al - as[e]) * ds[e]; mv[e] = ((s0 + e) <= l) ? v : 0.f; if (s0 + e == l) mv[e] += Dh; }
                } else {
#pragma unroll
                    for (int e = 0; e < 4; ++e) mv[e] = 0.f;
                }
                u32x2 o; o.x = pk2(mv[0], mv[1]); o.y = pk2(mv[2], mv[3]);
                *(LAS u32x2*)(lds + L_B + l * LROW + s0 * 2) = o;
            }
        }
        LDS_WAIT();
#pragma unroll
        for (int ks = 0; ks < 4; ++ks) {
            if (ks < nks) {
                const bf16x8 mf = *(const LAS bf16x8*)(lds + L_B + l * LROW + (ks * 32 + fq * 8) * 2);
#pragma unroll
                for (int pb = 0; pb < 4; ++pb) { const bf16x8 xf = *(const LAS bf16x8*)(lds + L_XT + (pb * 16 + fr) * LROW + (ks * 32 + fq * 8) * 2); yacc[pb] = __builtin_amdgcn_mfma_f32_16x16x32_bf16(xf, mf, yacc[pb], 0, 0, 0); }
            }
        }
#pragma unroll
        for (int pb = 0; pb < 4; ++pb) {
            const int pcol = h * 64 + pb * 16 + 4 * fq;
            u32x2 o; o.x = pk2(yacc[pb][0], yacc[pb][1]); o.y = pk2(yacc[pb][2], yacc[pb][3]);
            *(u32x2*)(ys + (size_t)(m0 + l) * SSDW + pcol) = o;
        }
        { const float ea = __expf(alast);
#pragma unroll
          for (int pb = 0; pb < 4; ++pb) hacc[pb] = hacc[pb] * ea; }
#pragma unroll
        for (int ks = 0; ks < 4; ++ks) {
            const bf16x8 btf = *(const LAS bf16x8*)(lds + L_BT + (16 * w + fr) * LROW + (ks * 32 + fq * 8) * 2);
#pragma unroll
            for (int pb = 0; pb < 4; ++pb) { const bf16x8 xsf = *(const LAS bf16x8*)(lds + L_XS + (pb * 16 + fr) * LROW + (ks * 32 + fq * 8) * 2); hacc[pb] = __builtin_amdgcn_mfma_f32_16x16x32_bf16(btf, xsf, hacc[pb], 0, 0, 0); }
        }
#pragma unroll
        for (int pb = 0; pb < 4; ++pb) { u32x2 o; o.x = pk2(hacc[pb][0], hacc[pb][1]); o.y = pk2(hacc[pb][2], hacc[pb][3]); *(LAS u32x2*)(lds + L_HT + (pb * 16 + fr) * LROW + (16 * w + 4 * fq) * 2) = o; }
        LDS_BARRIER();
    }
    float* so = p.out + O_SSDP + ((size_t)(b * NH + h) * 64) * 128;
#pragma unroll
    for (int pb = 0; pb < 4; ++pb) *(f32x4*)(so + (size_t)(pb * 16 + fr) * 128 + 16 * w + 4 * fq) = hacc[pb];
}

template <int MODE>
__device__ __forceinline__ void s5_wave_item(const Params& p, LAS unsigned char* wl, int g, int bidx, int seg, int m_start, int nrows, int lane_in) {
    int lane = lane_in; asm volatile("" : "+v"(lane));
    const int fr = lane & 15, fq = lane >> 4;
    const bf16_t* proj = (const bf16_t*)(p.ws + WS_A); bf16_t* vbuf = (bf16_t*)(p.ws + WS_H);
    const bf16_t* BBAR = (const bf16_t*)(p.ws + WS_BBAR); const bf16_t* CMAT = (const bf16_t*)(p.ws + WS_CMAT); const float* AB = (const float*)(p.ws + WS_S5A);
    float* S5E = (float*)(p.ws + WS_S5END);
    const bf16x8 zf = (bf16x8){0, 0, 0, 0, 0, 0, 0, 0};
    bf16x8 bfrag[8], cfrag[4];
#pragma unroll
    for (int t = 0; t < 8; ++t) bfrag[t] = (fq < 2) ? *(const bf16x8*)(BBAR + ((size_t)(g * 128 + t * 16 + fr)) * 16 + fq * 8) : zf;
    if (MODE != 1) {
#pragma unroll
        for (int ks = 0; ks < 4; ++ks) cfrag[ks] = *(const bf16x8*)(CMAT + ((size_t)(g * 16 + fr)) * 128 + ks * 32 + fq * 8);
    }
    const float ar = AB[g * 64 + lane], ai = AB[2048 + g * 64 + lane];
    const f32x4 d4 = *(const f32x4*)(p.in[19] + g * 16 + 4 * fq);
    LAS float* sBu = (LAS float*)wl; LAS bf16_t* sS = (LAS bf16_t*)(wl + 8448);
    float sr = 0.f, si = 0.f;
    if (MODE == 2 && seg > 0) {
        float pr = ar, pi = ai;
#pragma unroll
        for (int q = 0; q < 8; ++q) { const float nr = pr * pr - pi * pi, ni = 2.f * pr * pi; pr = nr; pi = ni; }
        for (int j = 0; j < seg; ++j) {
            const float* e = S5E + ((size_t)((bidx * 32 + g) * 8 + j)) * 128;
            const float er = e[lane], ei = e[64 + lane];
            const float nr = pr * sr - pi * si + er, ni = pr * si + pi * sr + ei; sr = nr; si = ni;
        }
    }
    bf16x8 uf_n; u32x2 u4_n;
    { const bf16_t* urow = proj + (size_t)(m_start + fr) * NINP + g * 16; uf_n = (fq < 2) ? *(const bf16x8*)(urow + fq * 8) : zf; u4_n = *(const u32x2*)(urow + 4 * fq); }
    for (int m0 = m_start; m0 < m_start + nrows; m0 += 16) {
        const bf16x8 uf = uf_n; const u32x2 u4 = u4_n;
        { const int mn = (m0 + 16 < m_start + nrows) ? m0 + 16 : m0; const bf16_t* urow = proj + (size_t)(mn + fr) * NINP + g * 16; uf_n = (fq < 2) ? *(const bf16x8*)(urow + fq * 8) : zf; u4_n = *(const u32x2*)(urow + 4 * fq); }
#pragma unroll
        for (int t = 0; t < 8; ++t) {
            f32x4 a = (f32x4){0.f, 0.f, 0.f, 0.f};
            a = __builtin_amdgcn_mfma_f32_16x16x32_bf16(bfrag[t], uf, a, 0, 0, 0);
            *(LAS f32x4*)(sBu + fr * 132 + t * 16 + 4 * fq) = a;
        }
        LDS_WAIT();
        {
            float br[16], bi[16]; unsigned pkv[16];
#pragma unroll
            for (int t = 0; t < 16; ++t) { br[t] = sBu[t * 132 + lane]; bi[t] = sBu[t * 132 + 64 + lane]; }
            float s0r[4], s0i[4];
            if (MODE == 0) {
#pragma unroll
                for (int q = 0; q < 4; ++q) { const int bb = ((m0 - MP) >> 2) + q; s0r[q] = p.in[2][((size_t)bb * 32 + g) * 64 + lane]; s0i[q] = p.in[3][((size_t)bb * 32 + g) * 64 + lane]; }
            }
#pragma unroll
            for (int t = 0; t < 16; ++t) {
                if (MODE == 0 && (t & 3) == 0) { sr = s0r[t >> 2]; si = s0i[t >> 2]; }
                const float nr = ar * sr - ai * si + br[t], ni = ar * si + ai * sr + bi[t];
                sr = nr; si = ni;
                if (MODE != 1) pkv[t] = pk2(sr, si);
                if (MODE == 0 && (t & 3) == 3) { const int bb = (m0 - MP + t) >> 2; p.out[O_S5RS + ((size_t)bb * 32 + g) * 64 + lane] = sr; p.out[O_S5IS + ((size_t)bb * 32 + g) * 64 + lane] = si; }
            }
            if (MODE != 1) {
#pragma unroll
                for (int t = 0; t < 16; ++t) { sS[t * 136 + lane] = (bf16_t)(pkv[t] & 0xffff); sS[t * 136 + 64 + lane] = (bf16_t)(pkv[t] >> 16); }
            }
        }
        LDS_WAIT();
        if (MODE != 1) {
            f32x4 y = (f32x4){0.f, 0.f, 0.f, 0.f};
#pragma unroll
            for (int ks = 0; ks < 4; ++ks) { const bf16x8 sf = *(const LAS bf16x8*)(sS + fr * 136 + ks * 32 + fq * 8); y = __builtin_amdgcn_mfma_f32_16x16x32_bf16(cfrag[ks], sf, y, 0, 0, 0); }
            const float y0 = y[0] + d4[0] * bflo(u4.x), y1 = y[1] + d4[1] * bfhi(u4.x), y2 = y[2] + d4[2] * bflo(u4.y), y3 = y[3] + d4[3] * bfhi(u4.y);
            u32x2 o; o.x = pk2(gelu_tanh(y0), gelu_tanh(y1)); o.y = pk2(gelu_tanh(y2), gelu_tanh(y3));
            *(u32x2*)(vbuf + (size_t)(m0 + fr) * 512 + g * 16 + 4 * fq) = o;
            LDS_WAIT();
        }
    }
    if (MODE == 1) { float* e = S5E + ((size_t)((bidx * 32 + g) * 8 + seg)) * 128; e[lane] = sr; e[64 + lane] = si; }
    if (MODE == 2 && seg == 7) { p.out[O_S5RP + ((size_t)bidx * 32 + g) * 64 + lane] = sr; p.out[O_S5IP + ((size_t)bidx * 32 + g) * 64 + lane] = si; }
}

#define SMP_LOAD(HS, BS, CS, DS, XS_, PS, pr_) do { const int _b = (pr_) / NH, _h = (pr_) % NH, _g = _h / 6; \
        PS[0] = p.in[25][_h]; PS[1] = p.in[24][_h]; PS[2] = p.in[26][_h]; \
        const float* _h0 = p.in[4] + ((size_t)(_b * NH + _h) * 64 + pp) * 128 + n0; \
        _Pragma("unroll") for (int j = 0; j < 4; ++j) HS[j] = *(const f32x4*)(_h0 + 4 * j); \
        _Pragma("unroll") for (int t = 0; t < 4; ++t) { const int _m = MP + _b * 4 + t; const bf16_t* _row = BCN + (size_t)_m * 1024 + _g * 128 + n0; \
            DS[t] = dtraw[(size_t)_m * 24 + _h]; XS_[t] = *(const unsigned*)(XSN + (size_t)(_m - MP) * SSDW + _h * 64 + (pp & ~1)); \
            BS[t][0] = *(const u32x4*)_row; BS[t][1] = *(const u32x4*)(_row + 8); CS[t][0] = *(const u32x4*)(_row + 512); CS[t][1] = *(const u32x4*)(_row + 520); } } while (0)
#define SMP_COMPUTE(HS, BS, CS, DS, XS_, PS, pr_) do { const int _b = (pr_) / NH, _h = (pr_) % NH; \
        const float a_h = -__expf(PS[0]), dtb = PS[1], Dh = PS[2]; \
        float hv[16]; \
        _Pragma("unroll") for (int j = 0; j < 4; ++j) { hv[4 * j] = HS[j][0]; hv[4 * j + 1] = HS[j][1]; hv[4 * j + 2] = HS[j][2]; hv[4 * j + 3] = HS[j][3]; } \
        _Pragma("unroll") for (int t = 0; t < 4; ++t) { const int _m = MP + _b * 4 + t; \
            const float dt = softplus_f(DS[t] + dtb), dec = __expf(dt * a_h); const float xv = (pp & 1) ? bfhi(XS_[t]) : bflo(XS_[t]), xd = xv * dt; \
            float acc = 0.f; \
            _Pragma("unroll") for (int hf = 0; hf < 2; ++hf) { float Bv[8], Cv[8]; unpack8(BS[t][hf], Bv); unpack8(CS[t][hf], Cv); \
                _Pragma("unroll") for (int j = 0; j < 8; ++j) { hv[8 * hf + j] = hv[8 * hf + j] * dec + xd * Bv[j]; acc += hv[8 * hf + j] * Cv[j]; } } \
            acc += __shfl_xor(acc, 1); acc += __shfl_xor(acc, 2); acc += __shfl_xor(acc, 4); \
            if ((tid & 7) == 0) ys[(size_t)_m * SSDW + _h * 64 + pp] = (bf16_t)(pk2(acc + Dh * xv, 0.f) & 0xffff); } \
        float* _ho = p.out + O_SSDS + ((size_t)(_b * NH + _h) * 64 + pp) * 128 + n0; \
        _Pragma("unroll") for (int j = 0; j < 16; j += 4) *(f32x4*)(_ho + j) = (f32x4){hv[j], hv[j + 1], hv[j + 2], hv[j + 3]}; } while (0)
constexpr int SMP_PAIRS = 6;
__device__ __forceinline__ void ssd_sample_item(const Params& p, int item) {
    int tid = threadIdx.x; asm volatile("" : "+v"(tid));
    const int pp = tid >> 3, n0 = (tid & 7) * 16;
    const bf16_t* BCN = (const bf16_t*)(p.ws + WS_XC + XC_BCN); const bf16_t* XSN = (const bf16_t*)(p.ws + WS_XC + XC_XSN); const float* dtraw = (const float*)(p.ws + WS_DTRAW); bf16_t* ys = (bf16_t*)(p.ws + WS_YS);
    f32x4 hA[4], hB[4]; u32x4 bA[4][2], cA[4][2], bB[4][2], cB[4][2]; float dA[4], dB[4], sA3[3], sB3[3]; unsigned xA[4], xB[4];
    const int pr0 = item * SMP_PAIRS;
    SMP_LOAD(hA, bA, cA, dA, xA, sA3, pr0);
#pragma unroll
    for (int k = 0; k < SMP_PAIRS; k += 2) {
        const int pr = pr0 + k;
        SMP_LOAD(hB, bB, cB, dB, xB, sB3, pr + 1);
        SMP_COMPUTE(hA, bA, cA, dA, xA, sA3, pr);
        if (k + 2 < SMP_PAIRS) SMP_LOAD(hA, bA, cA, dA, xA, sA3, pr + 2);
        SMP_COMPUTE(hB, bB, cB, dB, xB, sB3, pr + 1);
    }
}

__device__ __forceinline__ void gatenorm_phase(const Params& p, int gw, int ngw, int lane_in) {
    int lane = lane_in; asm volatile("" : "+v"(lane));
    const bf16_t* proj = (const bf16_t*)(p.ws + WS_A); const bf16_t* ys = (const bf16_t*)(p.ws + WS_YS); bf16_t* mix = (bf16_t*)(p.ws + WS_XC);
    const float* nw = p.in[27];
    for (int m = gw * 2; m < M; m += ngw * 2) {
        u32x4 yr[2][3], zr[2][3];
#pragma unroll
        for (int r = 0; r < 2; ++r)
#pragma unroll
            for (int j = 0; j < 3; ++j) { const int c0 = (lane + 64 * j) * 8; yr[r][j] = *(const u32x4*)(ys + (size_t)(m + r) * SSDW + c0); zr[r][j] = *(const u32x4*)(proj + (size_t)(m + r) * NINP + 512 + c0); }
#pragma unroll
        for (int r = 0; r < 2; ++r) {
            float gv[3][8]; float sg[4] = {0.f, 0.f, 0.f, 0.f};
#pragma unroll
            for (int j = 0; j < 3; ++j) {
                float yv[8], zv[8]; unpack8(yr[r][j], yv); unpack8(zr[r][j], zv);
                float ss = 0.f;
#pragma unroll
                for (int e = 0; e < 8; ++e) { gv[j][e] = yv[e] * silu_f(zv[e]); ss += gv[j][e] * gv[j][e]; }
                const int grp = (lane + 64 * j) / 48;
#pragma unroll
                for (int q = 0; q < 4; ++q) sg[q] += (grp == q) ? ss : 0.f;
            }
            float rs[4];
#pragma unroll
            for (int q = 0; q < 4; ++q) rs[q] = rsqrtf(wave_sum(sg[q]) * (1.f / 384.f) + EPS);
#pragma unroll
            for (int j = 0; j < 3; ++j) {
                const int c0 = (lane + 64 * j) * 8, grp = (lane + 64 * j) / 48;
                const float rstd = grp == 0 ? rs[0] : (grp == 1 ? rs[1] : (grp == 2 ? rs[2] : rs[3]));
                const f32x4 n0 = *(const f32x4*)(nw + c0), n1 = *(const f32x4*)(nw + c0 + 4);
                u32x4 o; o.x = pk2(gv[j][0] * rstd * n0[0], gv[j][1] * rstd * n0[1]); o.y = pk2(gv[j][2] * rstd * n0[2], gv[j][3] * rstd * n0[3]);
                o.z = pk2(gv[j][4] * rstd * n1[0], gv[j][5] * rstd * n1[1]); o.w = pk2(gv[j][6] * rstd * n1[2], gv[j][7] * rstd * n1[3]);
                *(u32x4*)(mix + (size_t)(m + r) * DMIX + 512 + c0) = o;
            }
        }
    }
}

#define XB_TMO      128
#define XB_XCNT(j)  (256  + 64 * (j))
#define XB_XSUB(j)  (1280 + 64 * (j))
#define XB_XGEN(j)  (2304 + 64 * (j))
#define XB_TOP      3328
#define XB_TOPGEN   3392
#define XCD_BAR_WORDS 3456
#define XB_SPIN_CAP (1u << 18)

__device__ __forceinline__ unsigned xb_ld(unsigned* p)              { return __hip_atomic_load(p, __ATOMIC_RELAXED, __HIP_MEMORY_SCOPE_AGENT); }
__device__ __forceinline__ unsigned xb_add(unsigned* p, unsigned v) { return __hip_atomic_fetch_add(p, v, __ATOMIC_RELAXED, __HIP_MEMORY_SCOPE_AGENT); }
__device__ __forceinline__ unsigned xb_xcc_id() { return (unsigned)__builtin_amdgcn_s_getreg((3 << 11) | 20) & 0xFu; }
#define XB_SPIN(cond, bar) do { unsigned _sp = 0; while (cond) { __builtin_amdgcn_s_sleep(1); \
    if ((++_sp & 255u) == 0u) { if (xb_ld(&(bar)[XB_TMO])) break; if (_sp > XB_SPIN_CAP) { atomicAdd(&(bar)[XB_TMO], 1u); break; } } } } while (0)

struct XcdBarrier {
    unsigned* bar; unsigned x;
    volatile LAS unsigned* st;
};

__device__ __forceinline__ XcdBarrier xcd_barrier_post(unsigned* bar, volatile LAS unsigned* st) {
    XcdBarrier b; b.bar = bar; b.x = xb_xcc_id(); b.st = st;
    if (threadIdx.x == 0) (void)xb_add(&bar[XB_XCNT(b.x)], 1u);
    return b;
}
__device__ __forceinline__ void xcd_barrier_complete(unsigned* bar, unsigned x, unsigned& nloc, unsigned& nx) {
    const unsigned G = gridDim.x * gridDim.y * gridDim.z;
    unsigned sum, cnt, mine, sp = 0u;
    for (;;) {
        sum = 0u; cnt = 0u; mine = 0u;
#pragma unroll
        for (unsigned j = 0; j < 16; ++j) { const unsigned c = xb_ld(&bar[XB_XCNT(j)]); sum += c; cnt += (c > 0u) ? 1u : 0u; mine = (j == x) ? c : mine; }
        if (sum == G) break;
        __builtin_amdgcn_s_sleep(1);
        if ((++sp & 255u) == 0u) { if (xb_ld(&bar[XB_TMO])) break; if (sp > XB_SPIN_CAP) { atomicAdd(&bar[XB_TMO], 1u); break; } }
    }
    nloc = mine > 0u ? mine : 1u; nx = cnt > 0u ? cnt : 1u;
}

__device__ __forceinline__ void xcd_barrier(const XcdBarrier& b) {
    asm volatile("s_waitcnt vmcnt(0)" ::: "memory");
    __syncthreads();
    if (threadIdx.x == 0) {
        unsigned* bar = b.bar;
        __builtin_amdgcn_s_waitcnt(0);
        unsigned nloc = b.st[0], nx = b.st[1];
        if (nloc == 0u) { xcd_barrier_complete(bar, b.x, nloc, nx); b.st[0] = nloc; b.st[1] = nx; }
        const unsigned old = xb_add(&bar[XB_XSUB(b.x)], 1u);
        const unsigned gen = old / nloc;
        if (old + 1u == (gen + 1u) * nloc) {
            __builtin_amdgcn_fence(__ATOMIC_RELEASE, "agent");
            asm volatile("s_waitcnt vmcnt(0)" ::: "memory");
            const unsigned og = xb_add(&bar[XB_TOP], 1u);
            const unsigned tg = og / nx;
            if (og + 1u == (tg + 1u) * nx) xb_add(&bar[XB_TOPGEN], 1u);
            else XB_SPIN(xb_ld(&bar[XB_TOPGEN]) == tg, bar);
            __builtin_amdgcn_fence(__ATOMIC_ACQUIRE, "agent");
            xb_add(&bar[XB_XGEN(b.x)], 1u);
            asm volatile("s_waitcnt vmcnt(0)" ::: "memory");
        } else {
            XB_SPIN(xb_ld(&bar[XB_XGEN(b.x)]) == gen, bar);
            __builtin_amdgcn_fence(__ATOMIC_ACQUIRE, "agent");
            asm volatile("s_waitcnt vmcnt(0)" ::: "memory");
        }
    }
    __syncthreads();
}

__device__ __forceinline__ void seam(const XcdBarrier& b0) { XcdBarrier b = b0; asm volatile("" : "+s"(b.bar)); asm volatile("" : "+s"(b.x)); xcd_barrier(b); }

__global__ void __launch_bounds__(512, 2) hymba_fwd(Params p) {
    extern __shared__ __attribute__((aligned(16))) unsigned char smem[];
    LAS unsigned char* lds = (LAS unsigned char*)smem;
    cg::grid_group grid = cg::this_grid();
    const int tid = threadIdx.x, lane = tid & 63, wave = __builtin_amdgcn_readfirstlane(tid >> 6);
    const int G = gridDim.x, bid = blockIdx.x;
    const int gw = bid * 8 + wave, ngw = G * 8, gtid = bid * 512 + tid, nthreads = G * 512;
    unsigned* ctl = (unsigned*)(p.ws + WS_CTL);
    volatile LAS unsigned* xst = (volatile LAS unsigned*)(lds + L_XBST);
    if (tid == 0) { xst[0] = 0u; xst[1] = 0u; }
    __syncthreads();
    const XcdBarrier xb = xcd_barrier_post((unsigned*)(p.ws + WS_BAR), xst);
    bf16_t* W1T = (bf16_t*)(p.ws + WS_W1T); bf16_t* W1D = (bf16_t*)(p.ws + WS_W1D); bf16_t* W2T = (bf16_t*)(p.ws + WS_W2T); bf16_t* W2D = (bf16_t*)(p.ws + WS_W2D);
    bf16_t* WIN = (bf16_t*)(p.ws + WS_WIN); bf16_t* WGLU = (bf16_t*)(p.ws + WS_WGLU); bf16_t* WOUT = (bf16_t*)(p.ws + WS_WOUT);
    bf16_t* HB = (bf16_t*)(p.ws + WS_H); bf16_t* AB = (bf16_t*)(p.ws + WS_A); bf16_t* XC = (bf16_t*)(p.ws + WS_XC);
    float* yout = p.out + O_Y;
    pg8::StaticOrder S;

    {
        convert_items(p, lds, CV_W1T, CV_W1D, gw, ngw, wave, lane);
        rms_phase(p.in[0], p.in[1], p.in[6], HB, gw, ngw, lane);
        for (int i = gtid; i < MS * D / 4; i += nthreads) ((f32x4*)(yout + (size_t)MP * D))[i] = ((const f32x4*)p.in[1])[i];
    }
    if (p.use_cg) grid.sync();
    seam(xb);
    for (int rep = 0; rep < REP_P1; ++rep) { S.init(M, 2 * FF, G, bid); pg8::gemm_phase<true>(lds, pg8::Gemm{HB, W1T, M, 2 * FF, D, D}, S, EpiGateUp{AB});
        { const int nfull = S.nwg % G; if (nfull > 0 && bid >= nfull) convert_items(p, lds, CV_W1D, CV_WIN, (bid - nfull) * 8 + wave, (G - nfull) * 8, wave, lane); else if (nfull == 0) convert_items(p, lds, CV_W1D, CV_WIN, gw, ngw, wave, lane); }
        if (gtid >= nthreads - 2048) {
            const int idx = gtid - (nthreads - 2048), g = idx >> 6, pp = idx & 63;
            const double lr = p.in[12][idx], li = p.in[13][idx], step = exp((double)p.in[14][g]);
            const double mag = exp(lr * step), ang = li * step;
            const double are = mag * cos(ang), aim = mag * sin(ang);
            const double den = lr * lr + li * li, nre = are - 1.0, nim = aim;
            const float cre = (float)((nre * lr + nim * li) / den), cim = (float)((nim * lr - nre * li) / den);
            float* ABf = (float*)(p.ws + WS_S5A); ABf[idx] = (float)are; ABf[2048 + idx] = (float)aim;
            bf16_t* BBAR = (bf16_t*)(p.ws + WS_BBAR); bf16_t* CMAT = (bf16_t*)(p.ws + WS_CMAT);
            const float* bre = p.in[15] + (size_t)idx * 16; const float* bim = p.in[16] + (size_t)idx * 16;
#pragma unroll
            for (int hh = 0; hh < 16; hh += 2) {
                const float r0 = cre * bre[hh] - cim * bim[hh], r1 = cre * bre[hh + 1] - cim * bim[hh + 1];
                const float i0 = cre * bim[hh] + cim * bre[hh], i1 = cre * bim[hh + 1] + cim * bre[hh + 1];
                *(unsigned*)(BBAR + ((size_t)(g * 128 + pp)) * 16 + hh) = pk2(r0, r1);
                *(unsigned*)(BBAR + ((size_t)(g * 128 + 64 + pp)) * 16 + hh) = pk2(i0, i1);
            }
#pragma unroll
            for (int hh = 0; hh < 16; ++hh) {
                const float cr = p.in[17][((size_t)g * 16 + hh) * 64 + pp], ci = p.in[18][((size_t)g * 16 + hh) * 64 + pp];
                const unsigned pk = pk2(cr, -ci);
                CMAT[((size_t)(g * 16 + hh)) * 128 + pp] = (bf16_t)(pk & 0xffff); CMAT[((size_t)(g * 16 + hh)) * 128 + 64 + pp] = (bf16_t)(pk >> 16);
            }
        }
        seam(xb); }
    { S.init(MP, D, G, bid); pg8::gemm_phase<true>(lds, pg8::Gemm{AB, W1D, MP, D, FF, FF}, S, EpiResid{p.in[0], p.in[1], yout, 0.5f});
      pg8::SplitOrder S2{8 * (FF / 256), G, bid, 256}; pg8::gemm_phase<false>(lds, pg8::Gemm{AB + (size_t)MP * FF, W1D, MS, D, 256, FF}, S2, EpiPart{(float*)(p.ws + WS_YS), 0.5f}); }
    { const int nsp = 8 * (FF / 256); if (G > nsp) { if (bid >= nsp) convert_items(p, lds, CV_WIN, CV_WGLU, (bid - nsp) * 8 + wave, (G - nsp) * 8, wave, lane); } else convert_items(p, lds, CV_WIN, CV_WGLU, gw, ngw, wave, lane); }
    seam(xb);
    rms_phase(yout, yout + (size_t)MP * D, p.in[10], HB, gw, ngw, lane, (const float*)(p.ws + WS_YS), FF / 256, yout + (size_t)MP * D);
    seam(xb);
    { S.init(M, NINP, G, bid); pg8::gemm_phase<true>(lds, pg8::Gemm{HB, WIN, M, NINP, D, D}, S, EpiProj{AB, (float*)(p.ws + WS_DTRAW)}); }
    { const int nfull = S.nwg % G; if (nfull > 0 && bid >= nfull) convert_items(p, lds, CV_WGLU, CV_W2T, (bid - nfull) * 8 + wave, (G - nfull) * 8, wave, lane); else if (nfull == 0) convert_items(p, lds, CV_WGLU, CV_W2T, gw, ngw, wave, lane); }
    seam(xb);
    for (int rep = 0; rep < REP_P5; ++rep) {
        for (int wi = gw; wi < 256 * 7; wi += ngw) { const int pair = wi / 7, sg = wi % 7; s5_wave_item<1>(p, lds + wave * 12800, pair & 31, pair >> 5, sg, (pair >> 5) * SEQ + sg * 256, 256, lane); }
        conv_phase(p, gtid, nthreads); seam(xb); }
    for (int rep = 0; rep < REP_P6; ++rep) {
        volatile LAS int* bc = (volatile LAS int*)(lds + L_BCAST);
        constexpr int N_SSDP = NB * NH, N_S5P = 256, N_S5S = 128, N_SSDS = NSB * NH / SMP_PAIRS;
        for (;;) {
            __syncthreads();
            if (tid == 0) *bc = (int)atomicAdd(&ctl[rep * 64], 1u);
            __syncthreads();
            int it = *bc;
            if (it >= N_SSDP + N_S5P + N_S5S + N_SSDS) break;
            if (it < N_SSDP) { ssd_prompt_item(p, lds, it / NH, it % NH); continue; }
            it -= N_SSDP;
            if (it < N_SSDS) { ssd_sample_item(p, it); continue; }
            it -= N_SSDS;
            if (it < N_S5P) { const int pair = it; s5_wave_item<2>(p, lds + wave * 12800, pair & 31, pair >> 5, wave, (pair >> 5) * SEQ + wave * 256, 256, lane); continue; }
            it -= N_S5P;
            { const int idx = it * 8 + wave; s5_wave_item<0>(p, lds + wave * 12800, idx & 31, 0, 0, MP + (idx >> 5) * 16, 16, lane); }
        }
        seam(xb);
    }
    { S.init(M, 512, G, bid); pg8::gemm_phase<true>(lds, pg8::Gemm{HB, WGLU, M, 512, 512, 512}, S, EpiGlu{HB, p.in[21], XC}); }
    { const int nglu = S.nwg; if (G > nglu) { if (bid >= nglu) convert_items(p, lds, CV_W2T, CV_END, (bid - nglu) * 8 + wave, (G - nglu) * 8, wave, lane); } else convert_items(p, lds, CV_W2T, CV_END, gw, ngw, wave, lane); }
    for (int rep = 0; rep < REP_P7; ++rep) { gatenorm_phase(p, ngw - 1 - gw, ngw, lane); seam(xb); }
    { S.init(MP, D, G, bid); pg8::gemm_phase<true>(lds, pg8::Gemm{XC, WOUT, MP, D, DMIX, DMIX}, S, EpiResid{yout, yout + (size_t)MP * D, yout, 1.0f});
      pg8::SplitOrder S2{8 * (DMIX / 256), G, bid, 256}; pg8::gemm_phase<false>(lds, pg8::Gemm{XC + (size_t)MP * DMIX, WOUT, MS, D, 256, DMIX}, S2, EpiPart{(float*)(p.ws + WS_YS), 1.0f}); }
    seam(xb);
    rms_phase(yout, yout + (size_t)MP * D, p.in[29], HB, gw, ngw, lane, (const float*)(p.ws + WS_YS), DMIX / 256, yout + (size_t)MP * D);
    seam(xb);
    { S.init(M, 2 * FF, G, bid); pg8::gemm_phase<true>(lds, pg8::Gemm{HB, W2T, M, 2 * FF, D, D}, S, EpiGateUp{AB}); }
    seam(xb);
    { S.init(MP, D, G, bid); pg8::gemm_phase<true>(lds, pg8::Gemm{AB, W2D, MP, D, FF, FF}, S, EpiResid{yout, yout + (size_t)MP * D, yout, 0.5f});
      pg8::SplitOrder S2{8 * (FF / 256), G, bid, 256}; pg8::gemm_phase<false>(lds, pg8::Gemm{AB + (size_t)MP * FF, W2D, MS, D, 256, FF}, S2, EpiPart{(float*)(p.ws + WS_YS), 0.5f}); }
    seam(xb);
    { int lane_f = lane; asm volatile("" : "+v"(lane_f));
    for (int m = gw * 4; m < MP; m += ngw * 4) {
        f32x4 v[4][4], ww[4];
#pragma unroll
        for (int r = 0; r < 4; ++r)
#pragma unroll
            for (int j = 0; j < 4; ++j) v[r][j] = ((const f32x4*)(yout + (size_t)(m + r) * D))[lane_f + 64 * j];
#pragma unroll
        for (int j = 0; j < 4; ++j) ww[j] = ((const f32x4*)p.in[33])[lane_f + 64 * j];
#pragma unroll
        for (int r = 0; r < 4; ++r) {
            float ss = 0.f;
#pragma unroll
            for (int j = 0; j < 4; ++j) ss += (v[r][j].x * v[r][j].x + v[r][j].y * v[r][j].y) + (v[r][j].z * v[r][j].z + v[r][j].w * v[r][j].w);
            const float rstd = rsqrtf(wave_sum(ss) * (1.f / D) + EPS);
#pragma unroll
            for (int j = 0; j < 4; ++j) ((f32x4*)(yout + (size_t)(m + r) * D))[lane_f + 64 * j] = v[r][j] * rstd * ww[j];
        }
    }
    for (int ms = ngw - 1 - gw; ms < MS; ms += ngw) {
        f32x4 v[4]; sum_sample_row(yout + (size_t)MP * D, (const float*)(p.ws + WS_YS), FF / 256, ms, lane_f, v);
        float ss = 0.f;
#pragma unroll
        for (int j = 0; j < 4; ++j) ss += (v[j].x * v[j].x + v[j].y * v[j].y) + (v[j].z * v[j].z + v[j].w * v[j].w);
        const float rstd = rsqrtf(wave_sum(ss) * (1.f / D) + EPS);
#pragma unroll
        for (int j = 0; j < 4; ++j) ((f32x4*)(yout + (size_t)(MP + ms) * D))[lane_f + 64 * j] = v[j] * rstd * ((const f32x4*)p.in[33])[lane_f + 64 * j];
    } }
}

extern "C" void kernel_launch(void* const* d_in, const int* in_sizes, int n_in, void* d_out, int out_size, void* d_ws, size_t ws_size, hipStream_t stream) {
    static int grid_blocks = 0;
    if (grid_blocks == 0) {
        if (n_in != 34 || ws_size < WS_END) { fprintf(stderr, "kernel_launch: unexpected n_in %d or ws_size %zu (< %zu)\n", n_in, ws_size, (size_t)WS_END); grid_blocks = -1; return; }
        int dev = 0, cus = 0, per_cu = 0;
        hipGetDevice(&dev);
        hipDeviceGetAttribute(&cus, hipDeviceAttributeMultiprocessorCount, dev);
        hipFuncSetAttribute((const void*)hymba_fwd, hipFuncAttributeMaxDynamicSharedMemorySize, LDS_BYTES);
        hipOccupancyMaxActiveBlocksPerMultiprocessor(&per_cu, (const void*)hymba_fwd, 512, LDS_BYTES);
        if (per_cu < 1) { fprintf(stderr, "kernel_launch: occupancy query says %d blocks/CU\n", per_cu); per_cu = 1; }
        grid_blocks = cus;
    }
    if (grid_blocks < 0) return;
    if (hipMemsetAsync((char*)d_ws + WS_CTL, 0, 16384, stream) != hipSuccess) { fprintf(stderr, "kernel_launch: memset failed\n"); return; }
    Params p{};
    for (int i = 0; i < 34; ++i) p.in[i] = (const float*)d_in[i];
    p.out = (float*)d_out; p.ws = (unsigned char*)d_ws;
    void* args[] = {&p};
    hipError_t e = hipLaunchCooperativeKernel((const void*)hymba_fwd, dim3(grid_blocks), dim3(512), args, LDS_BYTES, stream);
    if (e != hipSuccess) fprintf(stderr, "cooperative launch failed: %s (grid %d)\n", hipGetErrorString(e), grid_blocks);
}
```

```cpp
#include <hip/hip_runtime.h>
#include <hip/hip_cooperative_groups.h>
#include <cstdio>
#include <cstdint>
namespace cg = cooperative_groups;

#define LAS __attribute__((address_space(3)))
typedef unsigned short bf16_t;
typedef short bf16x8 __attribute__((ext_vector_type(8)));
typedef float f32x4 __attribute__((ext_vector_type(4)));
typedef float f32x2 __attribute__((ext_vector_type(2)));
typedef unsigned u32x4 __attribute__((ext_vector_type(4)));
typedef unsigned u32x2 __attribute__((ext_vector_type(2)));

constexpr int D = 1024, FF = 2816, NIN = 4632, NINP = 4864, DMIX = 2048;
constexpr int MP = 16384, MS = 512, M = MP + MS, SEQ = 2048, NB = 8, NSB = 128;
constexpr int XBC = 2560, SSDW = 1536, NH = 24;
constexpr float EPS = 1e-6f;
constexpr size_t O_Y = 0, O_S5RP = 17301504, O_S5IP = 17317888, O_SSDP = 17334272, O_CONVP = 18907136,
                 O_S5RS = 18968576, O_S5IS = 19230720, O_SSDS = 19492864, O_CONVS = 44658688;
constexpr size_t WS_CTL = 0, WS_BAR = 2048, WS_S5A = 16384, WS_BBAR = WS_S5A + 16384, WS_CMAT = WS_BBAR + 131072, WS_DTRAW = WS_CMAT + 131072,
                 WS_W1T = WS_DTRAW + (size_t)M * 24 * 4, WS_W1D = WS_W1T + (size_t)2 * FF * D * 2, WS_W2T = WS_W1D + (size_t)D * FF * 2,
                 WS_W2D = WS_W2T + (size_t)2 * FF * D * 2, WS_WIN = WS_W2D + (size_t)D * FF * 2, WS_WGLU = WS_WIN + (size_t)NINP * D * 2,
                 WS_WOUT = WS_WGLU + (size_t)512 * 512 * 2, WS_H = WS_WOUT + (size_t)D * DMIX * 2, WS_A = WS_H + (size_t)M * D * 2,
                 WS_XC = WS_A + (size_t)M * NINP * 2, WS_YS = WS_XC + (size_t)M * XBC * 2, WS_S5END = WS_YS + (size_t)M * SSDW * 2, WS_END = WS_S5END + (size_t)256 * 8 * 128 * 4;
constexpr size_t XC_BCN = 0, XC_XSN = (size_t)M * 1024 * 2, XC_XT = XC_XSN + (size_t)MS * SSDW * 2, H_BT = (size_t)M * 512 * 2;
constexpr int LDS_BYTES = 158720;
#define REP_P1 1
#define REP_P6 1
#define REP_P5 1
#define REP_P7 1
constexpr int L_BCAST = 158208, L_XBST = 158224;

struct Params {
    const float* in[34];
    float* out;
    unsigned char* ws;
    int use_cg; int pad;
};

__device__ __forceinline__ unsigned pk2(float lo, float hi) { unsigned r; asm("v_cvt_pk_bf16_f32 %0, %1, %2" : "=v"(r) : "v"(lo), "v"(hi)); return r; }
__device__ __forceinline__ float bflo(unsigned u) { return __uint_as_float(u << 16); }
__device__ __forceinline__ float bfhi(unsigned u) { return __uint_as_float(u & 0xffff0000u); }
__device__ __forceinline__ float bf2f(bf16_t v) { return __uint_as_float((unsigned)v << 16); }
__device__ __forceinline__ float wave_sum(float v) {
#pragma unroll
    for (int o = 1; o < 64; o <<= 1) v += __shfl_xor(v, o);
    return v;
}
__device__ __forceinline__ float silu_f(float x) { return x * __builtin_amdgcn_rcpf(1.f + __expf(-x)); }
__device__ __forceinline__ float sigmoid_f(float x) { return __builtin_amdgcn_rcpf(1.f + __expf(-x)); }
__device__ __forceinline__ float softplus_f(float x) {
    const float u = __expf(-fabsf(x));
    const float ser = u * (1.f - u * (0.5f - u * (0.33333334f - u * 0.25f)));
    const float lg = __logf(1.f + u);
    return fmaxf(x, 0.f) + (u < 0.1f ? ser : lg);
}
__device__ __forceinline__ float gelu_tanh(float y) { const float a = 0.7978845608028654f * (y + 0.044715f * y * y * y); const float t = 1.f - 2.f * __builtin_amdgcn_rcpf(1.f + __expf(2.f * a)); return 0.5f * y * (1.f + t); }
#define LDS_WAIT() asm volatile("s_waitcnt lgkmcnt(0)" ::: "memory")
#define LDS_BARRIER() do { asm volatile("s_waitcnt lgkmcnt(0)" ::: "memory"); __builtin_amdgcn_s_barrier(); asm volatile("" ::: "memory"); } while (0)

namespace pg8 {
constexpr int BM = 256, BK = 64, HALF = 128, HTB = HALF * BK * 2, STAGE_BYTES = 8 * HTB, NXCD = 8, WGM = 8;
__host__ __device__ __forceinline__ int lds_byte(int r, int c) { const int st = (r >> 4) * 2 + (c >> 5), rr = r & 15, cc = c & 31, ob = rr * 64 + cc * 2; return st * 1024 + (ob ^ (((ob >> 9) & 1) << 5)); }
__host__ __device__ __forceinline__ void stage_rc(int b, int& R, int& C) { const int st = b / 1024, sb = b % 1024, swz = sb ^ (((sb >> 9) & 1) << 5); R = (st >> 1) * 16 + swz / 64; C = (st & 1) * 32 + (swz % 64) / 2; }
struct Unit { int pm, pn, kofs; };
struct Gemm { const bf16_t* A; const bf16_t* Bt; int M, N, K, ld; };
struct StaticOrder {
    int nM, nN, nwg, G, c;
    __host__ __device__ void init(int M_, int N_, int G_, int c_) { nM = M_ / BM; nN = N_ / BM; nwg = nM * nN; G = G_; c = c_; }
    __host__ __device__ bool next(int i, Unit& u) const {
        const long L = (long)i * G + c; if (L >= nwg) return false;
        int wgid = (int)L; { const int q = nwg / NXCD, r = nwg % NXCD, xcd = wgid % NXCD, off = wgid / NXCD; wgid = (xcd < r ? xcd * (q + 1) : r * (q + 1) + (xcd - r) * q) + off; }
        const int nig = WGM * nN, gid = wgid / nig, fm = gid * WGM, gsz = (nM - fm) < WGM ? (nM - fm) : WGM;
        u.pm = fm + ((wgid % nig) % gsz); u.pn = (wgid % nig) / gsz; u.kofs = 0; return true;
    }
    __device__ __forceinline__ void a_ready(const Unit&) const {}
    __device__ __forceinline__ void done(const Unit&) const {}
};
struct SplitOrder {
    int nunits, G, c, kslice;
    __host__ __device__ bool next(int i, Unit& u) const { const int L = i * G + c; if (L >= nunits) return false; u.pm = L & 1; u.pn = (L >> 1) & 3; u.kofs = (L >> 3) * kslice; return true; }
    __device__ __forceinline__ void a_ready(const Unit&) const {}
    __device__ __forceinline__ void done(const Unit&) const {}
};

template <bool SP2, class Epi, class Sched>
__device__ __forceinline__ void gemm_phase(LAS unsigned char* lds, const Gemm g, const Sched& S, const Epi& E) {
    int tid = threadIdx.x; asm volatile("" : "+v"(tid));
    const int wid = __builtin_amdgcn_readfirstlane(tid >> 6), lane = tid & 63, wr = wid >> 2, wc = wid & 3, fr = lane & 15, fq = lane >> 4;
    const int K = g.K, nt = K / BK;
    int ldv = g.ld; asm volatile("" : "+s"(ldv));
    unsigned voffA[2], voffB[2];
#pragma unroll
    for (int i = 0; i < 2; ++i) { int R, C; stage_rc(tid * 16 + i * 8192, R, C); voffA[i] = (unsigned)(R * ldv + C) * 2u; voffB[i] = voffA[i]; }
    const size_t kstep = (size_t)(BK * 2);
    const size_t hstepA = (size_t)HALF * ldv * 2, hstepB = hstepA;
    const size_t tstepA = 2 * hstepA, tstepB = tstepA;
    const unsigned ldsw = (unsigned)wid * 1024u;
    const int aoff = lds_byte(wr * 64 + fr, fq * 8), boff = lds_byte(wc * 32 + fr, fq * 8);
#define PG8_SA(b, h) (((b) * 2 + (h)) * HTB)
#define PG8_SB(b, h) ((4 + (b) * 2 + (h)) * HTB)
#define PG8_STAGE(bufoff, gbase, voff) do { _Pragma("unroll") for (int _i = 0; _i < 2; ++_i) \
        __builtin_amdgcn_global_load_lds((const unsigned*)((const char*)(gbase) + (voff)[_i]), (LAS unsigned*)(lds + (bufoff) + ldsw + _i * 8192), 16, 0, 0); } while (0)
#define PG8_LDA(dst, b, h) do { _Pragma("unroll") for (int m = 0; m < 4; ++m) _Pragma("unroll") for (int k = 0; k < 2; ++k) dst[m][k] = *(const LAS bf16x8*)(lds + PG8_SA(b, h) + aoff + m * 2048 + k * 1024); } while (0)
#define PG8_LDB(dst, b, h) do { _Pragma("unroll") for (int n = 0; n < 2; ++n) _Pragma("unroll") for (int k = 0; k < 2; ++k) dst[n][k] = *(const LAS bf16x8*)(lds + PG8_SB(b, h) + boff + n * 2048 + k * 1024); } while (0)
#define PG8_MMA(ai, bj, At, Bt) do { __builtin_amdgcn_s_setprio(1); _Pragma("unroll") for (int m = 0; m < 4; ++m) _Pragma("unroll") for (int n = 0; n < 2; ++n) _Pragma("unroll") for (int k = 0; k < 2; ++k) \
        acc[ai][bj][m][n] = __builtin_amdgcn_mfma_f32_16x16x32_bf16(Bt[n][k], At[m][k], acc[ai][bj][m][n], 0, 0, 0); __builtin_amdgcn_s_setprio(0); } while (0)
#define PG8_WAIT_V(n) asm volatile("s_waitcnt vmcnt(" #n ")" ::: "memory")
#define PG8_WAIT_L(n) asm volatile("s_waitcnt lgkmcnt(" #n ")" ::: "memory")
#define PG8_BAR __builtin_amdgcn_s_barrier()
#define PG8_SCHED __builtin_amdgcn_sched_barrier(0)
    Unit cur, nxt; int ui = 0;
    if (!S.next(0, cur)) return;
    f32x4 acc[2][2][4][2];
#pragma unroll
    for (int a = 0; a < 2; ++a)
#pragma unroll
        for (int b = 0; b < 2; ++b)
#pragma unroll
            for (int m = 0; m < 4; ++m)
#pragma unroll
                for (int n = 0; n < 2; ++n) acc[a][b][m][n] = (f32x4){0.f, 0.f, 0.f, 0.f};
    bf16x8 At[4][2], B0[2][2], B1[2][2];
    const char* cA = (const char*)g.A + (size_t)cur.pm * tstepA + (size_t)cur.kofs * 2; const char* cB = (const char*)g.Bt + (size_t)cur.pn * tstepB + (size_t)cur.kofs * 2;
    S.a_ready(cur);
    if constexpr (SP2) {
        PG8_STAGE(PG8_SB(0, 0), cB, voffB); PG8_STAGE(PG8_SB(0, 1), cB + hstepB, voffB); PG8_STAGE(PG8_SA(0, 0), cA, voffA); PG8_STAGE(PG8_SA(0, 1), cA + hstepA, voffA);
        if (wr == 1) PG8_BAR;
        PG8_WAIT_V(2); PG8_BAR;
    } else {
        PG8_STAGE(PG8_SB(0, 0), cB, voffB); PG8_STAGE(PG8_SA(0, 0), cA, voffA); PG8_STAGE(PG8_SB(0, 1), cB + hstepB, voffB); PG8_STAGE(PG8_SA(0, 1), cA + hstepA, voffA);
        if (wr == 1) PG8_BAR;
        PG8_WAIT_V(4); PG8_BAR;
    }
    PG8_STAGE(PG8_SB(1, 0), cB + kstep, voffB); PG8_STAGE(PG8_SA(1, 0), cA + kstep, voffA); PG8_STAGE(PG8_SB(1, 1), cB + hstepB + kstep, voffB);
    PG8_WAIT_V(6); PG8_BAR;
    for (;;) {
        const bool has_next = S.next(ui + 1, nxt);
        const char* nA = has_next ? (const char*)g.A + (size_t)nxt.pm * tstepA + (size_t)nxt.kofs * 2 : cA; const char* nB = has_next ? (const char*)g.Bt + (size_t)nxt.pn * tstepB + (size_t)nxt.kofs * 2 : cB;
        for (int t = 0; t < nt; t += 2) {
            const bool last = (t == nt - 2);
            const char* a1 = cA + (size_t)(t + 1) * kstep;
            const char* a2 = last ? nA : cA + (size_t)(t + 2) * kstep; const char* b2 = last ? nB : cB + (size_t)(t + 2) * kstep;
            const char* a3 = a2 + kstep; const char* b3 = b2 + kstep;
            if (last && has_next) S.a_ready(nxt);
            if constexpr (SP2) {
            PG8_LDB(B0, 0, 0); PG8_LDB(B1, 0, 1); PG8_SCHED; PG8_LDA(At, 0, 0); PG8_STAGE(PG8_SA(1, 1), a1 + hstepA, voffA);
            PG8_WAIT_V(8); PG8_WAIT_L(0); PG8_BAR; PG8_MMA(0, 0, At, B0); PG8_MMA(0, 1, At, B1); PG8_BAR; PG8_SCHED;
            PG8_LDA(At, 0, 1); PG8_STAGE(PG8_SB(0, 0), b2, voffB); PG8_STAGE(PG8_SB(0, 1), b2 + hstepB, voffB); PG8_STAGE(PG8_SA(0, 0), a2, voffA);
            PG8_WAIT_V(8); PG8_WAIT_L(0); PG8_BAR; PG8_MMA(1, 0, At, B0); PG8_MMA(1, 1, At, B1); PG8_BAR; PG8_SCHED;
            PG8_LDB(B0, 1, 0); PG8_LDB(B1, 1, 1); PG8_SCHED; PG8_LDA(At, 1, 0); PG8_STAGE(PG8_SA(0, 1), a2 + hstepA, voffA);
            PG8_WAIT_V(8); PG8_WAIT_L(0); PG8_BAR; PG8_MMA(0, 0, At, B0); PG8_MMA(0, 1, At, B1); PG8_BAR; PG8_SCHED;
            PG8_LDA(At, 1, 1); PG8_STAGE(PG8_SB(1, 0), b3, voffB); PG8_STAGE(PG8_SB(1, 1), b3 + hstepB, voffB); PG8_STAGE(PG8_SA(1, 0), a3, voffA);
            PG8_WAIT_V(8); PG8_WAIT_L(0); PG8_BAR; PG8_MMA(1, 0, At, B0); PG8_MMA(1, 1, At, B1); PG8_BAR; PG8_SCHED;
            } else {
            PG8_LDB(B0, 0, 0); PG8_SCHED; PG8_LDA(At, 0, 0); PG8_STAGE(PG8_SA(1, 1), a1 + hstepA, voffA);
            PG8_WAIT_L(8); PG8_BAR; PG8_WAIT_L(0); PG8_MMA(0, 0, At, B0); PG8_BAR; PG8_SCHED;
            PG8_LDB(B1, 0, 1); PG8_STAGE(PG8_SB(0, 0), b2, voffB);
            PG8_BAR; PG8_WAIT_L(0); PG8_MMA(0, 1, At, B1); PG8_BAR;
            PG8_LDA(At, 0, 1); PG8_STAGE(PG8_SA(0, 0), a2, voffA);
            PG8_BAR; PG8_WAIT_L(0); PG8_MMA(1, 0, At, B0); PG8_BAR; PG8_SCHED;
            PG8_STAGE(PG8_SB(0, 1), b2 + hstepB, voffB);
            PG8_WAIT_V(6); PG8_BAR; PG8_MMA(1, 1, At, B1); PG8_BAR;
            PG8_LDB(B0, 1, 0); PG8_SCHED; PG8_LDA(At, 1, 0); PG8_STAGE(PG8_SA(0, 1), a2 + hstepA, voffA);
            PG8_WAIT_L(8); PG8_BAR; PG8_WAIT_L(0); PG8_MMA(0, 0, At, B0); PG8_BAR; PG8_SCHED;
            PG8_LDB(B1, 1, 1); PG8_STAGE(PG8_SB(1, 0), b3, voffB);
            PG8_BAR; PG8_WAIT_L(0); PG8_MMA(0, 1, At, B1); PG8_BAR;
            PG8_LDA(At, 1, 1); PG8_STAGE(PG8_SA(1, 0), a3, voffA);
            PG8_BAR; PG8_WAIT_L(0); PG8_MMA(1, 0, At, B0); PG8_BAR; PG8_SCHED;
            PG8_STAGE(PG8_SB(1, 1), b3 + hstepB, voffB);
            PG8_WAIT_V(6); PG8_BAR; PG8_MMA(1, 1, At, B1); PG8_BAR;
                    }
        }
        if constexpr (SP2) { if (wr == 0) PG8_BAR; }
        E(acc, cur, wr, wc, fr, fq); S.done(cur);
        if (!has_next) break;
#pragma unroll
        for (int a = 0; a < 2; ++a)
#pragma unroll
            for (int b = 0; b < 2; ++b)
#pragma unroll
                for (int m = 0; m < 4; ++m)
#pragma unroll
                    for (int n = 0; n < 2; ++n) acc[a][b][m][n] = (f32x4){0.f, 0.f, 0.f, 0.f};
        cur = nxt; cA = nA; cB = nB; ++ui;
        if constexpr (SP2) { if (wr == 1) PG8_BAR; }
    }
    PG8_WAIT_V(0);
    if constexpr (!SP2) { if (wr == 0) PG8_BAR; }
    PG8_BAR;
#undef PG8_SA
#undef PG8_SB
#undef PG8_STAGE
#undef PG8_LDA
#undef PG8_LDB
#undef PG8_MMA
#undef PG8_WAIT_V
#undef PG8_WAIT_L
#undef PG8_BAR
#undef PG8_SCHED
}
}
using pg8::Unit;

struct EpiGateUp {
    bf16_t* act;
    __device__ __forceinline__ void operator()(const f32x4 (&acc)[2][2][4][2], const Unit& u, int wr, int wc, int fr, int fq) const {
#pragma unroll
        for (int ai = 0; ai < 2; ++ai)
#pragma unroll
            for (int m = 0; m < 4; ++m) {
                const int r = u.pm * 256 + ai * 128 + wr * 64 + m * 16 + fr;
                const int j = u.pn * 128 + wc * 32 + 8 * fq;
                const f32x4 g0 = acc[ai][0][m][0], g1 = acc[ai][0][m][1], u0 = acc[ai][1][m][0], u1 = acc[ai][1][m][1];
                u32x4 o; o.x = pk2(silu_f(g0[0]) * u0[0], silu_f(g0[1]) * u0[1]); o.y = pk2(silu_f(g0[2]) * u0[2], silu_f(g0[3]) * u0[3]);
                o.z = pk2(silu_f(g1[0]) * u1[0], silu_f(g1[1]) * u1[1]); o.w = pk2(silu_f(g1[2]) * u1[2], silu_f(g1[3]) * u1[3]);
                *(u32x4*)(act + (size_t)r * FF + j) = o;
            }
    }
};
struct EpiResid {
    const float* rp; const float* rs; float* y; float scale;
    __device__ __forceinline__ void operator()(const f32x4 (&acc)[2][2][4][2], const Unit& u, int wr, int wc, int fr, int fq) const {
#pragma unroll
        for (int ai = 0; ai < 2; ++ai)
#pragma unroll
            for (int m = 0; m < 4; ++m) {
                const int r = u.pm * 256 + ai * 128 + wr * 64 + m * 16 + fr;
                const float* rrow = (r < MP) ? rp + (size_t)r * D : rs + (size_t)(r - MP) * D;
                float* yrow = y + (size_t)r * D;
#pragma unroll
                for (int bj = 0; bj < 2; ++bj)
#pragma unroll
                    for (int n = 0; n < 2; ++n) {
                        const int c = u.pn * 256 + bj * 128 + wc * 32 + n * 16 + 4 * fq;
                        const f32x4 rv = *(const f32x4*)(rrow + c);
                        *(f32x4*)(yrow + c) = rv + acc[ai][bj][m][n] * scale;
                    }
            }
    }
};
struct EpiPart {
    float* part; float scale;
    __device__ __forceinline__ void operator()(const f32x4 (&acc)[2][2][4][2], const Unit& u, int wr, int wc, int fr, int fq) const {
        float* pb = part + (size_t)(u.kofs >> 8) * MS * D;
#pragma unroll
        for (int ai = 0; ai < 2; ++ai)
#pragma unroll
            for (int m = 0; m < 4; ++m) {
                float* yrow = pb + (size_t)(u.pm * 256 + ai * 128 + wr * 64 + m * 16 + fr) * D;
#pragma unroll
                for (int bj = 0; bj < 2; ++bj)
#pragma unroll
                    for (int n = 0; n < 2; ++n) {
                        const int c = u.pn * 256 + bj * 128 + wc * 32 + n * 16 + 4 * fq;
                        *(f32x4*)(yrow + c) = acc[ai][bj][m][n] * scale;
                    }
            }
    }
};
struct EpiProj {
    bf16_t* proj; float* dtraw;
    __device__ __forceinline__ void operator()(const f32x4 (&acc)[2][2][4][2], const Unit& u, int wr, int wc, int fr, int fq) const {
#pragma unroll
        for (int ai = 0; ai < 2; ++ai)
#pragma unroll
            for (int m = 0; m < 4; ++m) {
                const int r = u.pm * 256 + ai * 128 + wr * 64 + m * 16 + fr;
#pragma unroll
                for (int bj = 0; bj < 2; ++bj) {
                    const int c = u.pn * 256 + bj * 128 + wc * 32 + 8 * fq;
                    const f32x4 v0 = acc[ai][bj][m][0], v1 = acc[ai][bj][m][1];
                    if (u.pn == 18) { if (c - 4608 < 24) { *(f32x4*)(dtraw + (size_t)r * 24 + (c - 4608)) = v0; *(f32x4*)(dtraw + (size_t)r * 24 + (c - 4608) + 4) = v1; } }
                    else { u32x4 o; o.x = pk2(v0[0], v0[1]); o.y = pk2(v0[2], v0[3]); o.z = pk2(v1[0], v1[1]); o.w = pk2(v1[2], v1[3]); *(u32x4*)(proj + (size_t)r * NINP + c) = o; }
                }
            }
    }
};
struct EpiGlu {
    const bf16_t* v; const float* bias; bf16_t* mix;
    __device__ __forceinline__ void operator()(const f32x4 (&acc)[2][2][4][2], const Unit& u, int wr, int wc, int fr, int fq) const {
#pragma unroll
        for (int ai = 0; ai < 2; ++ai)
#pragma unroll
            for (int m = 0; m < 4; ++m) {
                const int r = u.pm * 256 + ai * 128 + wr * 64 + m * 16 + fr;
#pragma unroll
                for (int bj = 0; bj < 2; ++bj)
#pragma unroll
                    for (int n = 0; n < 2; ++n) {
                        const int c = u.pn * 256 + bj * 128 + wc * 32 + n * 16 + 4 * fq;
                        const f32x4 a = acc[ai][bj][m][n]; const f32x4 bb = *(const f32x4*)(bias + c);
                        const u32x2 vv = *(const u32x2*)(v + (size_t)r * 512 + c);
                        u32x2 o; o.x = pk2(bflo(vv.x) * sigmoid_f(a[0] + bb[0]), bfhi(vv.x) * sigmoid_f(a[1] + bb[1]));
                        o.y = pk2(bflo(vv.y) * sigmoid_f(a[2] + bb[2]), bfhi(vv.y) * sigmoid_f(a[3] + bb[3]));
                        *(u32x2*)(mix + (size_t)r * DMIX + c) = o;
                    }
            }
    }
};

__device__ __forceinline__ void transpose_item(const float* W, int K, int N, bf16_t* WT, int mode, LAS float* scr, int item, int lane) {
    const int nblk = (N + 63) / 64, kb = item / nblk, nb = item % nblk, k0 = 64 * kb, n0 = 64 * nb;
    const int c4 = lane & 15, rr = lane >> 4, nn = n0 + 4 * c4;
    f32x4 v[16];
#pragma unroll
    for (int i = 0; i < 16; ++i) v[i] = (nn < N) ? *(const f32x4*)(W + (size_t)(k0 + 4 * i + rr) * N + nn) : (f32x4){0.f, 0.f, 0.f, 0.f};
#pragma unroll
    for (int i = 0; i < 16; ++i) { LAS float* d = scr + (4 * i + rr) * 65 + 4 * c4; d[0] = v[i][0]; d[1] = v[i][1]; d[2] = v[i][2]; d[3] = v[i][3]; }
    LDS_WAIT();
    const int c = lane & 7, nrow = lane >> 3;
#pragma unroll
    for (int j = 0; j < 8; ++j) { const int n = nrow + 8 * j; const LAS float* s = scr + (8 * c) * 65 + n;
        u32x4 o; o.x = pk2(s[0 * 65], s[1 * 65]); o.y = pk2(s[2 * 65], s[3 * 65]); o.z = pk2(s[4 * 65], s[5 * 65]); o.w = pk2(s[6 * 65], s[7 * 65]);
        const int jn = n0 + n;
        const int ip = 16 * ((jn >> 2) & 1) + 4 * ((jn >> 3) & 3) + (jn & 3);
        const int row = (mode == 0) ? jn : (mode == 3) ? ((jn & ~31) + ip) : ((jn >> 7) * 256 + ((jn & 127) & ~31) + ip + (mode == 5 ? 128 : 0));
        *(u32x4*)(WT + (size_t)row * K + k0 + 8 * c) = o; }
    LDS_WAIT();
}
constexpr int I_GU = (D / 64) * (FF / 64), I_DN = (FF / 64) * (D / 64), I_IN = (D / 64) * ((NIN + 63) / 64), I_GL = (512 / 64) * (512 / 64), I_OUT = (DMIX / 64) * (D / 64);
constexpr int CV_W1T = 0, CV_W1D = 2 * I_GU, CV_WIN = CV_W1D + I_DN, CV_WGLU = CV_WIN + I_IN, CV_WOUT = CV_WGLU + I_GL, CV_W2T = CV_WOUT + I_OUT, CV_W2D = CV_W2T + 2 * I_GU, CV_END = CV_W2D + I_DN;
__device__ __forceinline__ void convert_items(const Params& p, LAS unsigned char* lds, int lo, int hi, int gw, int ngw, int wave, int lane_in) {
    int lane = lane_in; asm volatile("" : "+v"(lane));
    LAS float* scr = (LAS float*)(lds + wave * 16640);
    for (int it = lo + gw; it < hi; it += ngw) {
        int r = it;
        if (r < CV_W1D) { if (r < I_GU) transpose_item(p.in[7], D, FF, (bf16_t*)(p.ws + WS_W1T), 4, scr, r, lane); else transpose_item(p.in[8], D, FF, (bf16_t*)(p.ws + WS_W1T), 5, scr, r - I_GU, lane); continue; }
        if (r < CV_WIN) { transpose_item(p.in[9], FF, D, (bf16_t*)(p.ws + WS_W1D), 0, scr, r - CV_W1D, lane); continue; }
        if (r < CV_WGLU) { transpose_item(p.in[11], D, NIN, (bf16_t*)(p.ws + WS_WIN), 3, scr, r - CV_WIN, lane); continue; }
        if (r < CV_WOUT) { transpose_item(p.in[20], 512, 512, (bf16_t*)(p.ws + WS_WGLU), 0, scr, r - CV_WGLU, lane); continue; }
        if (r < CV_W2T) { transpose_item(p.in[28], DMIX, D, (bf16_t*)(p.ws + WS_WOUT), 0, scr, r - CV_WOUT, lane); continue; }
        if (r < CV_W2D) { r -= CV_W2T; if (r < I_GU) transpose_item(p.in[30], D, FF, (bf16_t*)(p.ws + WS_W2T), 4, scr, r, lane); else transpose_item(p.in[31], D, FF, (bf16_t*)(p.ws + WS_W2T), 5, scr, r - I_GU, lane); continue; }
        transpose_item(p.in[32], FF, D, (bf16_t*)(p.ws + WS_W2D), 0, scr, r - CV_W2D, lane);
    }
}

__device__ __forceinline__ void sum_sample_row(const float* base, const float* part, int nsl, int ms, int lane, f32x4 (&v)[4]) {
#pragma unroll
    for (int j = 0; j < 4; ++j) v[j] = ((const f32x4*)(base + (size_t)ms * D))[lane + 64 * j];
    for (int s0 = 0; s0 < nsl; s0 += 4) {
        f32x4 t[4][4];
#pragma unroll
        for (int q = 0; q < 4; ++q) { const int sl = (s0 + q < nsl) ? s0 + q : nsl - 1;
#pragma unroll
            for (int j = 0; j < 4; ++j) t[q][j] = ((const f32x4*)(part + ((size_t)sl * MS + ms) * D))[lane + 64 * j]; }
#pragma unroll
        for (int q = 0; q < 4; ++q) { const float wq = (s0 + q < nsl) ? 1.f : 0.f;
#pragma unroll
            for (int j = 0; j < 4; ++j) v[j] += t[q][j] * wq; }
    }
}
__device__ __forceinline__ void rms_phase(const float* srcp, const float* srcs, const float* w, bf16_t* dst, int gw, int ngw, int lane_in, const float* part = nullptr, int nsl = 0, float* wb = nullptr) {
    int lane = lane_in; asm volatile("" : "+v"(lane));
    const int mend = (nsl > 0) ? MP : M;
    for (int m = gw * 4; m < mend; m += ngw * 4) {
        const float* xrow = (m < MP) ? srcp + (size_t)m * D : srcs + (size_t)(m - MP) * D;
        f32x4 v[4][4];
#pragma unroll
        for (int r = 0; r < 4; ++r)
#pragma unroll
            for (int j = 0; j < 4; ++j) v[r][j] = ((const f32x4*)(xrow + (size_t)r * D))[lane + 64 * j];
        f32x4 ww[4];
#pragma unroll
        for (int j = 0; j < 4; ++j) ww[j] = ((const f32x4*)w)[lane + 64 * j];
#pragma unroll
        for (int r = 0; r < 4; ++r) {
            float ss = 0.f;
#pragma unroll
            for (int j = 0; j < 4; ++j) ss += (v[r][j].x * v[r][j].x + v[r][j].y * v[r][j].y) + (v[r][j].z * v[r][j].z + v[r][j].w * v[r][j].w);
            const float rstd = rsqrtf(wave_sum(ss) * (1.f / D) + EPS);
            u32x2* o8 = (u32x2*)(dst + (size_t)(m + r) * D) + lane;
#pragma unroll
            for (int j = 0; j < 4; ++j) { u32x2 o; o.x = pk2(v[r][j].x * rstd * ww[j].x, v[r][j].y * rstd * ww[j].y); o.y = pk2(v[r][j].z * rstd * ww[j].z, v[r][j].w * rstd * ww[j].w); o8[64 * j] = o; }
        }
    }
    if (nsl > 0) {
        for (int ms = ngw - 1 - gw; ms < MS; ms += ngw) {
            f32x4 v[4]; sum_sample_row(srcs, part, nsl, ms, lane, v);
            float ss = 0.f;
#pragma unroll
            for (int j = 0; j < 4; ++j) { ((f32x4*)(wb + (size_t)ms * D))[lane + 64 * j] = v[j]; ss += (v[j].x * v[j].x + v[j].y * v[j].y) + (v[j].z * v[j].z + v[j].w * v[j].w); }
            const float rstd = rsqrtf(wave_sum(ss) * (1.f / D) + EPS);
            u32x2* o8 = (u32x2*)(dst + (size_t)(MP + ms) * D) + lane;
#pragma unroll
            for (int j = 0; j < 4; ++j) { const f32x4 ww = ((const f32x4*)w)[lane + 64 * j]; u32x2 o; o.x = pk2(v[j].x * rstd * ww.x, v[j].y * rstd * ww.y); o.y = pk2(v[j].z * rstd * ww.z, v[j].w * rstd * ww.w); o8[64 * j] = o; }
        }
    }
}

__device__ __forceinline__ void unpack8(const u32x4 u, float (&f)[8]) { f[0] = bflo(u.x); f[1] = bfhi(u.x); f[2] = bflo(u.y); f[3] = bfhi(u.y); f[4] = bflo(u.z); f[5] = bfhi(u.z); f[6] = bflo(u.w); f[7] = bfhi(u.w); }
#define BF_ELEM(v, e) ((((e) & 1) ? ((v)[(e) >> 1] >> 16) : ((v)[(e) >> 1] & 0xffffu)))
__device__ __forceinline__ void conv_phase(const Params& p, int gtid, int nthreads) {
    const bf16_t* proj = (const bf16_t*)(p.ws + WS_A);
    bf16_t* BCN = (bf16_t*)(p.ws + WS_XC + XC_BCN); bf16_t* XSN = (bf16_t*)(p.ws + WS_XC + XC_XSN); bf16_t* XT = (bf16_t*)(p.ws + WS_XC + XC_XT); bf16_t* BT = (bf16_t*)(p.ws + WS_H + H_BT);
    const float* cw = p.in[22]; const float* cb = p.in[23]; const float* sconv = p.in[5];
    const int NT_P = (MP / 16) * 320, NT_S = NSB * 320;
    for (int task = gtid; task < NT_P; task += nthreads) {
        const int cgp = task % 320, rb = task / 320, c0 = cgp * 8, m0 = rb * 16;
        const bool first = (m0 % SEQ) == 0, lastblk = (m0 % SEQ) == SEQ - 16;
        u32x4 raw[19];
#pragma unroll
        for (int i = 0; i < 19; ++i) raw[i] = (i >= 3 || !first) ? *(const u32x4*)(proj + (size_t)(m0 - 3 + i) * NINP + 2048 + c0) : (u32x4){0u, 0u, 0u, 0u};
        float w0[8], w1[8], w2[8], w3[8], bs[8];
#pragma unroll
        for (int e = 0; e < 8; e += 4) { *(f32x4*)&w0[e] = *(const f32x4*)(cw + c0 + e); *(f32x4*)&w1[e] = *(const f32x4*)(cw + XBC + c0 + e); *(f32x4*)&w2[e] = *(const f32x4*)(cw + 2 * XBC + c0 + e);
            *(f32x4*)&w3[e] = *(const f32x4*)(cw + 3 * XBC + c0 + e); *(f32x4*)&bs[e] = *(const f32x4*)(cb + c0 + e); }
        float r0[8], r1[8], r2[8];
        unpack8(raw[0], r0); unpack8(raw[1], r1); unpack8(raw[2], r2);
        u32x4 ov[16];
#pragma unroll
        for (int i = 0; i < 16; ++i) {
            float cur[8]; unpack8(raw[i + 3], cur);
            float o[8];
#pragma unroll
            for (int e = 0; e < 8; ++e) { const float cv = bs[e] + w0[e] * r0[e] + w1[e] * r1[e] + w2[e] * r2[e] + w3[e] * cur[e]; o[e] = silu_f(cv); r0[e] = r1[e]; r1[e] = r2[e]; r2[e] = cur[e]; }
            ov[i].x = pk2(o[0], o[1]); ov[i].y = pk2(o[2], o[3]); ov[i].z = pk2(o[4], o[5]); ov[i].w = pk2(o[6], o[7]);
            if (i >= 13 && lastblk) { float* d = p.out + O_CONVP + ((size_t)(m0 / SEQ) * 3 + (i - 13)) * XBC + c0; *(f32x4*)d = (f32x4){cur[0], cur[1], cur[2], cur[3]}; *(f32x4*)(d + 4) = (f32x4){cur[4], cur[5], cur[6], cur[7]}; }
        }
        const int bb = m0 / SEQ, t0 = m0 % SEQ, cc = t0 >> 7, l0 = t0 & 127;
        if (c0 >= 1536) {
            const int cn = c0 - 1536;
#pragma unroll
            for (int i = 0; i < 16; ++i) *(u32x4*)(BCN + (size_t)(m0 + i) * 1024 + cn) = ov[i];
        }
        if (c0 < 2048) {
            bf16_t* tb = (c0 < 1536) ? XT + ((((size_t)(bb * 16 + cc) * NH + (c0 >> 6)) * 64 + (c0 & 63)) * 128 + l0)
                                     : BT + ((((size_t)(bb * 16 + cc) * 4 + ((c0 - 1536) >> 7)) * 128 + ((c0 - 1536) & 127)) * 128 + l0);
            const bool odd = (gtid & 1) != 0;
            bf16_t* t1 = odd ? tb - 8 * 128 + 8 : tb;
            bf16_t* t2 = odd ? tb + 8 : tb + 8 * 128;
#pragma unroll
            for (int e = 0; e < 8; ++e) {
                u32x4 q0, q1;
                q0.x = BF_ELEM(ov[0], e) | (BF_ELEM(ov[1], e) << 16); q0.y = BF_ELEM(ov[2], e) | (BF_ELEM(ov[3], e) << 16); q0.z = BF_ELEM(ov[4], e) | (BF_ELEM(ov[5], e) << 16); q0.w = BF_ELEM(ov[6], e) | (BF_ELEM(ov[7], e) << 16);
                q1.x = BF_ELEM(ov[8], e) | (BF_ELEM(ov[9], e) << 16); q1.y = BF_ELEM(ov[10], e) | (BF_ELEM(ov[11], e) << 16); q1.z = BF_ELEM(ov[12], e) | (BF_ELEM(ov[13], e) << 16); q1.w = BF_ELEM(ov[14], e) | (BF_ELEM(ov[15], e) << 16);
                const u32x4 snd = odd ? q0 : q1; u32x4 rcv;
                rcv.x = __shfl_xor(snd.x, 1); rcv.y = __shfl_xor(snd.y, 1); rcv.z = __shfl_xor(snd.z, 1); rcv.w = __shfl_xor(snd.w, 1);
                *(u32x4*)(t1 + (size_t)e * 128) = odd ? rcv : q0;
                *(u32x4*)(t2 + (size_t)e * 128) = odd ? q1 : rcv;
            }
        }
    }
    for (int task = (nthreads - 1 - gtid) ^ 1; task < NT_S; task += nthreads) {
        const int cgp = task % 320, b = task / 320, c0 = cgp * 8, m0 = MP + b * 4;
        u32x4 raw[4];
#pragma unroll
        for (int i = 0; i < 4; ++i) raw[i] = *(const u32x4*)(proj + (size_t)(m0 + i) * NINP + 2048 + c0);
        float w0[8], w1[8], w2[8], w3[8], bs[8], r0[8], r1[8], r2[8];
        const float* st = sconv + (size_t)b * 3 * XBC + c0;
#pragma unroll
        for (int e = 0; e < 8; e += 4) { *(f32x4*)&w0[e] = *(const f32x4*)(cw + c0 + e); *(f32x4*)&w1[e] = *(const f32x4*)(cw + XBC + c0 + e); *(f32x4*)&w2[e] = *(const f32x4*)(cw + 2 * XBC + c0 + e);
            *(f32x4*)&w3[e] = *(const f32x4*)(cw + 3 * XBC + c0 + e); *(f32x4*)&bs[e] = *(const f32x4*)(cb + c0 + e);
            *(f32x4*)&r0[e] = *(const f32x4*)(st + e); *(f32x4*)&r1[e] = *(const f32x4*)(st + XBC + e); *(f32x4*)&r2[e] = *(const f32x4*)(st + 2 * XBC + e); }
#pragma unroll
        for (int i = 0; i < 4; ++i) {
            float cur[8]; unpack8(raw[i], cur);
            float o[8];
#pragma unroll
            for (int e = 0; e < 8; ++e) { const float cv = bs[e] + w0[e] * r0[e] + w1[e] * r1[e] + w2[e] * r2[e] + w3[e] * cur[e]; o[e] = silu_f(cv); r0[e] = r1[e]; r1[e] = r2[e]; r2[e] = cur[e]; }
            u32x4 ov; ov.x = pk2(o[0], o[1]); ov.y = pk2(o[2], o[3]); ov.z = pk2(o[4], o[5]); ov.w = pk2(o[6], o[7]);
            if (c0 < 1536) *(u32x4*)(XSN + (size_t)(m0 + i - MP) * SSDW + c0) = ov;
            else *(u32x4*)(BCN + (size_t)(m0 + i) * 1024 + (c0 - 1536)) = ov;
            if (i >= 1) { float* d = p.out + O_CONVS + ((size_t)b * 3 + (i - 1)) * XBC + c0; *(f32x4*)d = (f32x4){cur[0], cur[1], cur[2], cur[3]}; *(f32x4*)(d + 4) = (f32x4){cur[4], cur[5], cur[6], cur[7]}; }
        }
    }
}

constexpr int LROW = 272;
constexpr int L_C = 0, L_B = 34816, L_BT = 69632, L_XT = 104448, L_XS = 121856, L_HT = 139264, L_AC = 156672, L_DT = 157184, L_G = 157696;
__device__ __forceinline__ float wave_incl_scan(float v, int lane) {
#pragma unroll
    for (int o = 1; o < 64; o <<= 1) { const float t = __shfl_up(v, o); if (lane >= o) v += t; }
    return v;
}
__device__ __forceinline__ void ssd_prompt_item(const Params& p, LAS unsigned char* lds, int b, int h) {
    int tid = threadIdx.x; asm volatile("" : "+v"(tid));
    const int lane = tid & 63, w = __builtin_amdgcn_readfirstlane(tid >> 6), fr = lane & 15, fq = lane >> 4;
    const int g = h / 6;
    const bf16_t* BCN = (const bf16_t*)(p.ws + WS_XC + XC_BCN); const bf16_t* XT = (const bf16_t*)(p.ws + WS_XC + XC_XT); const bf16_t* BT = (const bf16_t*)(p.ws + WS_H + H_BT);
    const float* dtraw = (const float*)(p.ws + WS_DTRAW); bf16_t* ys = (bf16_t*)(p.ws + WS_YS);
    const float a_h = -__expf(p.in[25][h]), dtb = p.in[24][h], Dh = p.in[26][h];
    f32x4 hacc[4];
#pragma unroll
    for (int i = 0; i < 4; ++i) hacc[i] = (f32x4){0.f, 0.f, 0.f, 0.f};
    for (int i = tid; i < 64 * 17; i += 512) *(LAS u32x4*)(lds + L_HT + i * 16) = (u32x4){0u, 0u, 0u, 0u};
    const int prow = tid >> 4, pc = tid & 15;
    u32x4 pvc[4], pvb[4], pvt[4], pvx[2]; float pdl, pdh;
#define SSD_FETCH(cc) do { const int _m0 = b * SEQ + (cc) * 128; \
        pdl = dtraw[(size_t)(_m0 + lane) * 24 + h]; pdh = dtraw[(size_t)(_m0 + 64 + lane) * 24 + h]; \
        const bf16_t* _bt = BT + (((size_t)(b * 16 + (cc)) * 4 + g) * 128) * 128; const bf16_t* _xt = XT + (((size_t)(b * 16 + (cc)) * NH + h) * 64) * 128; \
        _Pragma("unroll") for (int j = 0; j < 4; ++j) { const bf16_t* _gr = BCN + (size_t)(_m0 + prow + 32 * j) * 1024 + g * 128 + pc * 8; pvb[j] = *(const u32x4*)_gr; pvc[j] = *(const u32x4*)(_gr + 512); \
            pvt[j] = *(const u32x4*)(_bt + (size_t)(prow + 32 * j) * 128 + pc * 8); } \
        _Pragma("unroll") for (int j = 0; j < 2; ++j) pvx[j] = *(const u32x4*)(_xt + (size_t)(prow + 32 * j) * 128 + pc * 8); } while (0)
    SSD_FETCH(0);
    for (int c = 0; c < 16; ++c) {
        const int m0 = b * SEQ + c * 128;
        const float dt_lo = softplus_f(pdl + dtb), dt_hi = softplus_f(pdh + dtb);
        const float ac_lo = wave_incl_scan(dt_lo * a_h, lane); const float tot_lo = __shfl(ac_lo, 63);
        const float ac_hi = wave_incl_scan(dt_hi * a_h, lane) + tot_lo; const float alast = __shfl(ac_hi, 63);
        const float sc_lo = dt_lo * __expf(alast - ac_lo), sc_hi = dt_hi * __expf(alast - ac_hi);
        if (w == 0) { const float ae_lo = __shfl(ac_lo, (lane & 48) + 15), ae_hi = __shfl(ac_hi, (lane & 48) + 15);
            *(LAS float*)(lds + L_G + lane * 4) = dt_lo * __expf(ae_lo - ac_lo); *(LAS float*)(lds + L_G + 256 + lane * 4) = dt_hi * __expf(ae_hi - ac_hi);
            *(LAS float*)(lds + L_AC + lane * 4) = ac_lo; *(LAS float*)(lds + L_AC + 256 + lane * 4) = ac_hi; *(LAS float*)(lds + L_DT + lane * 4) = dt_lo; *(LAS float*)(lds + L_DT + 256 + lane * 4) = dt_hi; }
        float sc[8];
#pragma unroll
        for (int e = 0; e < 8; ++e) { const int src = (pc * 8 + e) & 63; const float vlo = __shfl(sc_lo, src), vhi = __shfl(sc_hi, src); sc[e] = (pc < 8) ? vlo : vhi; }
#pragma unroll
        for (int j = 0; j < 4; ++j) {
            const int r = prow + 32 * j;
            *(LAS u32x4*)(lds + L_C + r * LROW + pc * 16) = pvc[j];
            *(LAS u32x4*)(lds + L_B + r * LROW + pc * 16) = pvb[j];
            *(LAS u32x4*)(lds + L_BT + r * LROW + pc * 16) = pvt[j];
        }
#pragma unroll
        for (int j = 0; j < 2; ++j) {
            const int r = prow + 32 * j;
            float xf[8]; unpack8(pvx[j], xf);
            *(LAS u32x4*)(lds + L_XT + r * LROW + pc * 16) = pvx[j];
            u32x4 q; q.x = pk2(xf[0] * sc[0], xf[1] * sc[1]); q.y = pk2(xf[2] * sc[2], xf[3] * sc[3]); q.z = pk2(xf[4] * sc[4], xf[5] * sc[5]); q.w = pk2(xf[6] * sc[6], xf[7] * sc[7]);
            *(LAS u32x4*)(lds + L_XS + r * LROW + pc * 16) = q;
        }
        LDS_BARRIER();
        if (c < 15) SSD_FETCH(c + 1);
        const int l = 16 * w + fr;
        bf16x8 cfrag[4];
#pragma unroll
        for (int ks = 0; ks < 4; ++ks) cfrag[ks] = *(const LAS bf16x8*)(lds + L_C + l * LROW + (ks * 32 + fq * 8) * 2);
        f32x4 yacc[4];
#pragma unroll
        for (int pb = 0; pb < 4; ++pb) {
            f32x4 a = (f32x4){0.f, 0.f, 0.f, 0.f};
#pragma unroll
            for (int ks = 0; ks < 4; ++ks) { const bf16x8 hf = *(const LAS bf16x8*)(lds + L_HT + (pb * 16 + fr) * LROW + (ks * 32 + fq * 8) * 2); a = __builtin_amdgcn_mfma_f32_16x16x32_bf16(hf, cfrag[ks], a, 0, 0, 0); }
            yacc[pb] = a;
        }
        const float al = *(const LAS float*)(lds + L_AC + l * 4);
        { const float el = __expf(al);
#pragma unroll
          for (int pb = 0; pb < 4; ++pb) yacc[pb] = yacc[pb] * el; }
        f32x4 cbt[8];
#pragma unroll
        for (int sb = 0; sb < 8; ++sb) {
            cbt[sb] = (f32x4){0.f, 0.f, 0.f, 0.f};
            if (sb <= w) {
                f32x4 a = (f32x4){0.f, 0.f, 0.f, 0.f};
#pragma unroll
                for (int ks = 0; ks < 4; ++ks) { const bf16x8 bf = *(const LAS bf16x8*)(lds + L_B + (sb * 16 + fr) * LROW + (ks * 32 + fq * 8) * 2); a = __builtin_amdgcn_mfma_f32_16x16x32_bf16(bf, cfrag[ks], a, 0, 0, 0); }
                cbt[sb] = a;
            }
        }
        LDS_BARRIER();
        const int nks = (w >> 1) + 1;
#pragma unroll
        for (int sb = 0; sb < 8; ++sb) {
            if (sb < 2 * nks) {
                const int s0 = sb * 16 + 4 * fq;
                float mv[4];
                if (sb < w) {
                    const float f = __expf(al - *(const LAS float*)(lds + L_AC + (sb * 16 + 15) * 4));
                    const f32x4 gs = *(const LAS f32x4*)(lds + L_G + s0 * 4);
#pragma unroll
                    for (int e = 0; e < 4; ++e) mv[e] = cbt[sb][e] * f * gs[e];
                } else if (sb == w) {
                    const f32x4 as = *(const LAS f32x4*)(lds + L_AC + s0 * 4), ds = *(const LAS f32x4*)(lds + L_DT + s0 * 4);
#pragma unroll
                    for (int e = 0; e < 4; ++e) { const float v = cbt[sb][e] * __expf(al - as[e]) * ds[e]; mv[e] = ((s0 + e) <= l) ? v : 0.f; if (s0 + e == l) mv[e] += Dh; }
                } else {
#pragma unroll
                    for (int e = 0; e < 4; ++e) mv[e] = 0.f;
                }
                u32x2 o; o.x = pk2(mv[0], mv[1]); o.y = pk2(mv[2], mv[3]);
                *(LAS u32x2*)(lds + L_B + l * LROW + s0 * 2) = o;
            }
        }
        LDS_WAIT();
#pragma unroll
        for (int ks = 0; ks < 4; ++ks) {
            if (ks < nks) {
                const bf16x8 mf = *(const LAS bf16x8*)(lds + L_B + l * LROW + (ks * 32 + fq * 8) * 2);
#pragma unroll
                for (int pb = 0; pb < 4; ++pb) { const bf16x8 xf = *(const LAS bf16x8*)(lds + L_XT + (pb * 16 + fr) * LROW + (ks * 32 + fq * 8) * 2); yacc[pb] = __builtin_amdgcn_mfma_f32_16x16x32_bf16(xf, mf, yacc[pb], 0, 0, 0); }
            }
        }
#pragma unroll
        for (int pb = 0; pb < 4; ++pb) {
            const int pcol = h * 64 + pb * 16 + 4 * fq;
            u32x2 o; o.x = pk2(yacc[pb][0], yacc[pb][1]); o.y = pk2(yacc[pb][2], yacc[pb][3]);
            *(u32x2*)(ys + (size_t)(m0 + l) * SSDW + pcol) = o;
        }
        { const float ea = __expf(alast);
#pragma unroll
          for (int pb = 0; pb < 4; ++pb) hacc[pb] = hacc[pb] * ea; }
#pragma unroll
        for (int ks = 0; ks < 4; ++ks) {
            const bf16x8 btf = *(const LAS bf16x8*)(lds + L_BT + (16 * w + fr) * LROW + (ks * 32 + fq * 8) * 2);
#pragma unroll
            for (int pb = 0; pb < 4; ++pb) { const bf16x8 xsf = *(const LAS bf16x8*)(lds + L_XS + (pb * 16 + fr) * LROW + (ks * 32 + fq * 8) * 2); hacc[pb] = __builtin_amdgcn_mfma_f32_16x16x32_bf16(btf, xsf, hacc[pb], 0, 0, 0); }
        }
#pragma unroll
        for (int pb = 0; pb < 4; ++pb) { u32x2 o; o.x = pk2(hacc[pb][0], hacc[pb][1]); o.y = pk2(hacc[pb][2], hacc[pb][3]); *(LAS u32x2*)(lds + L_HT + (pb * 16 + fr) * LROW + (16 * w + 4 * fq) * 2) = o; }
        LDS_BARRIER();
    }
    float* so = p.out + O_SSDP + ((size_t)(b * NH + h) * 64) * 128;
#pragma unroll
    for (int pb = 0; pb < 4; ++pb) *(f32x4*)(so + (size_t)(pb * 16 + fr) * 128 + 16 * w + 4 * fq) = hacc[pb];
}

template <int MODE>
__device__ __forceinline__ void s5_wave_item(const Params& p, LAS unsigned char* wl, int g, int bidx, int seg, int m_start, int nrows, int lane_in) {
    int lane = lane_in; asm volatile("" : "+v"(lane));
    const int fr = lane & 15, fq = lane >> 4;
    const bf16_t* proj = (const bf16_t*)(p.ws + WS_A); bf16_t* vbuf = (bf16_t*)(p.ws + WS_H);
    const bf16_t* BBAR = (const bf16_t*)(p.ws + WS_BBAR); const bf16_t* CMAT = (const bf16_t*)(p.ws + WS_CMAT); const float* AB = (const float*)(p.ws + WS_S5A);
    float* S5E = (float*)(p.ws + WS_S5END);
    const bf16x8 zf = (bf16x8){0, 0, 0, 0, 0, 0, 0, 0};
    bf16x8 bfrag[8], cfrag[4];
#pragma unroll
    for (int t = 0; t < 8; ++t) bfrag[t] = (fq < 2) ? *(const bf16x8*)(BBAR + ((size_t)(g * 128 + t * 16 + fr)) * 16 + fq * 8) : zf;
    if (MODE != 1) {
#pragma unroll
        for (int ks = 0; ks < 4; ++ks) cfrag[ks] = *(const bf16x8*)(CMAT + ((size_t)(g * 16 + fr)) * 128 + ks * 32 + fq * 8);
    }
    const float ar = AB[g * 64 + lane], ai = AB[2048 + g * 64 + lane];
    const f32x4 d4 = *(const f32x4*)(p.in[19] + g * 16 + 4 * fq);
    LAS float* sBu = (LAS float*)wl; LAS bf16_t* sS = (LAS bf16_t*)(wl + 8448);
    float sr = 0.f, si = 0.f;
    if (MODE == 2 && seg > 0) {
        float pr = ar, pi = ai;
#pragma unroll
        for (int q = 0; q < 8; ++q) { const float nr = pr * pr - pi * pi, ni = 2.f * pr * pi; pr = nr; pi = ni; }
        for (int j = 0; j < seg; ++j) {
            const float* e = S5E + ((size_t)((bidx * 32 + g) * 8 + j)) * 128;
            const float er = e[lane], ei = e[64 + lane];
            const float nr = pr * sr - pi * si + er, ni = pr * si + pi * sr + ei; sr = nr; si = ni;
        }
    }
    bf16x8 uf_n; u32x2 u4_n;
    { const bf16_t* urow = proj + (size_t)(m_start + fr) * NINP + g * 16; uf_n = (fq < 2) ? *(const bf16x8*)(urow + fq * 8) : zf; u4_n = *(const u32x2*)(urow + 4 * fq); }
    for (int m0 = m_start; m0 < m_start + nrows; m0 += 16) {
        const bf16x8 uf = uf_n; const u32x2 u4 = u4_n;
        { const int mn = (m0 + 16 < m_start + nrows) ? m0 + 16 : m0; const bf16_t* urow = proj + (size_t)(mn + fr) * NINP + g * 16; uf_n = (fq < 2) ? *(const bf16x8*)(urow + fq * 8) : zf; u4_n = *(const u32x2*)(urow + 4 * fq); }
#pragma unroll
        for (int t = 0; t < 8; ++t) {
            f32x4 a = (f32x4){0.f, 0.f, 0.f, 0.f};
            a = __builtin_amdgcn_mfma_f32_16x16x32_bf16(bfrag[t], uf, a, 0, 0, 0);
            *(LAS f32x4*)(sBu + fr * 132 + t * 16 + 4 * fq) = a;
        }
        LDS_WAIT();
        {
            float br[16], bi[16]; unsigned pkv[16];
#pragma unroll
            for (int t = 0; t < 16; ++t) { br[t] = sBu[t * 132 + lane]; bi[t] = sBu[t * 132 + 64 + lane]; }
            float s0r[4], s0i[4];
            if (MODE == 0) {
#pragma unroll
                for (int q = 0; q < 4; ++q) { const int bb = ((m0 - MP) >> 2) + q; s0r[q] = p.in[2][((size_t)bb * 32 + g) * 64 + lane]; s0i[q] = p.in[3][((size_t)bb * 32 + g) * 64 + lane]; }
            }
#pragma unroll
            for (int t = 0; t < 16; ++t) {
                if (MODE == 0 && (t & 3) == 0) { sr = s0r[t >> 2]; si = s0i[t >> 2]; }
                const float nr = ar * sr - ai * si + br[t], ni = ar * si + ai * sr + bi[t];
                sr = nr; si = ni;
                if (MODE != 1) pkv[t] = pk2(sr, si);
                if (MODE == 0 && (t & 3) == 3) { const int bb = (m0 - MP + t) >> 2; p.out[O_S5RS + ((size_t)bb * 32 + g) * 64 + lane] = sr; p.out[O_S5IS + ((size_t)bb * 32 + g) * 64 + lane] = si; }
            }
            if (MODE != 1) {
#pragma unroll
                for (int t = 0; t < 16; ++t) { sS[t * 136 + lane] = (bf16_t)(pkv[t] & 0xffff); sS[t * 136 + 64 + lane] = (bf16_t)(pkv[t] >> 16); }
            }
        }
        LDS_WAIT();
        if (MODE != 1) {
            f32x4 y = (f32x4){0.f, 0.f, 0.f, 0.f};
#pragma unroll
            for (int ks = 0; ks < 4; ++ks) { const bf16x8 sf = *(const LAS bf16x8*)(sS + fr * 136 + ks * 32 + fq * 8); y = __builtin_amdgcn_mfma_f32_16x16x32_bf16(cfrag[ks], sf, y, 0, 0, 0); }
            const float y0 = y[0] + d4[0] * bflo(u4.x), y1 = y[1] + d4[1] * bfhi(u4.x), y2 = y[2] + d4[2] * bflo(u4.y), y3 = y[3] + d4[3] * bfhi(u4.y);
            u32x2 o; o.x = pk2(gelu_tanh(y0), gelu_tanh(y1)); o.y = pk2(gelu_tanh(y2), gelu_tanh(y3));
            *(u32x2*)(vbuf + (size_t)(m0 + fr) * 512 + g * 16 + 4 * fq) = o;
            LDS_WAIT();
        }
    }
    if (MODE == 1) { float* e = S5E + ((size_t)((bidx * 32 + g) * 8 + seg)) * 128; e[lane] = sr; e[64 + lane] = si; }
    if (MODE == 2 && seg == 7) { p.out[O_S5RP + ((size_t)bidx * 32 + g) * 64 + lane] = sr; p.out[O_S5IP + ((size_t)bidx * 32 + g) * 64 + lane] = si; }
}

#define SMP_LOAD(HS, BS, CS, DS, XS_, PS, pr_) do { const int _b = (pr_) / NH, _h = (pr_) % NH, _g = _h / 6; \
        PS[0] = p.in[25][_h]; PS[1] = p.in[24][_h]; PS[2] = p.in[26][_h]; \
        const float* _h0 = p.in[4] + ((size_t)(_b * NH + _h) * 64 + pp) * 128 + n0; \
        _Pragma("unroll") for (int j = 0; j < 4; ++j) HS[j] = *(const f32x4*)(_h0 + 4 * j); \
        _Pragma("unroll") for (int t = 0; t < 4; ++t) { const int _m = MP + _b * 4 + t; const bf16_t* _row = BCN + (size_t)_m * 1024 + _g * 128 + n0; \
            DS[t] = dtraw[(size_t)_m * 24 + _h]; XS_[t] = *(const unsigned*)(XSN + (size_t)(_m - MP) * SSDW + _h * 64 + (pp & ~1)); \
            BS[t][0] = *(const u32x4*)_row; BS[t][1] = *(const u32x4*)(_row + 8); CS[t][0] = *(const u32x4*)(_row + 512); CS[t][1] = *(const u32x4*)(_row + 520); } } while (0)
#define SMP_COMPUTE(HS, BS, CS, DS, XS_, PS, pr_) do { const int _b = (pr_) / NH, _h = (pr_) % NH; \
        const float a_h = -__expf(PS[0]), dtb = PS[1], Dh = PS[2]; \
        float hv[16]; \
        _Pragma("unroll") for (int j = 0; j < 4; ++j) { hv[4 * j] = HS[j][0]; hv[4 * j + 1] = HS[j][1]; hv[4 * j + 2] = HS[j][2]; hv[4 * j + 3] = HS[j][3]; } \
        _Pragma("unroll") for (int t = 0; t < 4; ++t) { const int _m = MP + _b * 4 + t; \
            const float dt = softplus_f(DS[t] + dtb), dec = __expf(dt * a_h); const float xv = (pp & 1) ? bfhi(XS_[t]) : bflo(XS_[t]), xd = xv * dt; \
            float acc = 0.f; \
            _Pragma("unroll") for (int hf = 0; hf < 2; ++hf) { float Bv[8], Cv[8]; unpack8(BS[t][hf], Bv); unpack8(CS[t][hf], Cv); \
                _Pragma("unroll") for (int j = 0; j < 8; ++j) { hv[8 * hf + j] = hv[8 * hf + j] * dec + xd * Bv[j]; acc += hv[8 * hf + j] * Cv[j]; } } \
            acc += __shfl_xor(acc, 1); acc += __shfl_xor(acc, 2); acc += __shfl_xor(acc, 4); \
            if ((tid & 7) == 0) ys[(size_t)_m * SSDW + _h * 64 + pp] = (bf16_t)(pk2(acc + Dh * xv, 0.f) & 0xffff); } \
        float* _ho = p.out + O_SSDS + ((size_t)(_b * NH + _h) * 64 + pp) * 128 + n0; \
        _Pragma("unroll") for (int j = 0; j < 16; j += 4) *(f32x4*)(_ho + j) = (f32x4){hv[j], hv[j + 1], hv[j + 2], hv[j + 3]}; } while (0)
constexpr int SMP_PAIRS = 6;
__device__ __forceinline__ void ssd_sample_item(const Params& p, int item) {
    int tid = threadIdx.x; asm volatile("" : "+v"(tid));
    const int pp = tid >> 3, n0 = (tid & 7) * 16;
    const bf16_t* BCN = (const bf16_t*)(p.ws + WS_XC + XC_BCN); const bf16_t* XSN = (const bf16_t*)(p.ws + WS_XC + XC_XSN); const float* dtraw = (const float*)(p.ws + WS_DTRAW); bf16_t* ys = (bf16_t*)(p.ws + WS_YS);
    f32x4 hA[4], hB[4]; u32x4 bA[4][2], cA[4][2], bB[4][2], cB[4][2]; float dA[4], dB[4], sA3[3], sB3[3]; unsigned xA[4], xB[4];
    const int pr0 = item * SMP_PAIRS;
    SMP_LOAD(hA, bA, cA, dA, xA, sA3, pr0);
#pragma unroll
    for (int k = 0; k < SMP_PAIRS; k += 2) {
        const int pr = pr0 + k;
        SMP_LOAD(hB, bB, cB, dB, xB, sB3, pr + 1);
        SMP_COMPUTE(hA, bA, cA, dA, xA, sA3, pr);
        if (k + 2 < SMP_PAIRS) SMP_LOAD(hA, bA, cA, dA, xA, sA3, pr + 2);
        SMP_COMPUTE(hB, bB, cB, dB, xB, sB3, pr + 1);
    }
}

__device__ __forceinline__ void gatenorm_phase(const Params& p, int gw, int ngw, int lane_in) {
    int lane = lane_in; asm volatile("" : "+v"(lane));
    const bf16_t* proj = (const bf16_t*)(p.ws + WS_A); const bf16_t* ys = (const bf16_t*)(p.ws + WS_YS); bf16_t* mix = (bf16_t*)(p.ws + WS_XC);
    const float* nw = p.in[27];
    for (int m = gw * 2; m < M; m += ngw * 2) {
        u32x4 yr[2][3], zr[2][3];
#pragma unroll
        for (int r = 0; r < 2; ++r)
#pragma unroll
            for (int j = 0; j < 3; ++j) { const int c0 = (lane + 64 * j) * 8; yr[r][j] = *(const u32x4*)(ys + (size_t)(m + r) * SSDW + c0); zr[r][j] = *(const u32x4*)(proj + (size_t)(m + r) * NINP + 512 + c0); }
#pragma unroll
        for (int r = 0; r < 2; ++r) {
            float gv[3][8]; float sg[4] = {0.f, 0.f, 0.f, 0.f};
#pragma unroll
            for (int j = 0; j < 3; ++j) {
                float yv[8], zv[8]; unpack8(yr[r][j], yv); unpack8(zr[r][j], zv);
                float ss = 0.f;
#pragma unroll
                for (int e = 0; e < 8; ++e) { gv[j][e] = yv[e] * silu_f(zv[e]); ss += gv[j][e] * gv[j][e]; }
                const int grp = (lane + 64 * j) / 48;
#pragma unroll
                for (int q = 0; q < 4; ++q) sg[q] += (grp == q) ? ss : 0.f;
            }
            float rs[4];
#pragma unroll
            for (int q = 0; q < 4; ++q) rs[q] = rsqrtf(wave_sum(sg[q]) * (1.f / 384.f) + EPS);
#pragma unroll
            for (int j = 0; j < 3; ++j) {
                const int c0 = (lane + 64 * j) * 8, grp = (lane + 64 * j) / 48;
                const float rstd = grp == 0 ? rs[0] : (grp == 1 ? rs[1] : (grp == 2 ? rs[2] : rs[3]));
                const f32x4 n0 = *(const f32x4*)(nw + c0), n1 = *(const f32x4*)(nw + c0 + 4);
                u32x4 o; o.x = pk2(gv[j][0] * rstd * n0[0], gv[j][1] * rstd * n0[1]); o.y = pk2(gv[j][2] * rstd * n0[2], gv[j][3] * rstd * n0[3]);
                o.z = pk2(gv[j][4] * rstd * n1[0], gv[j][5] * rstd * n1[1]); o.w = pk2(gv[j][6] * rstd * n1[2], gv[j][7] * rstd * n1[3]);
                *(u32x4*)(mix + (size_t)(m + r) * DMIX + 512 + c0) = o;
            }
        }
    }
}

#define XB_TMO      128
#define XB_XCNT(j)  (256  + 64 * (j))
#define XB_XSUB(j)  (1280 + 64 * (j))
#define XB_XGEN(j)  (2304 + 64 * (j))
#define XB_TOP      3328
#define XB_TOPGEN   3392
#define XCD_BAR_WORDS 3456
#define XB_SPIN_CAP (1u << 18)

__device__ __forceinline__ unsigned xb_ld(unsigned* p)              { return __hip_atomic_load(p, __ATOMIC_RELAXED, __HIP_MEMORY_SCOPE_AGENT); }
__device__ __forceinline__ unsigned xb_add(unsigned* p, unsigned v) { return __hip_atomic_fetch_add(p, v, __ATOMIC_RELAXED, __HIP_MEMORY_SCOPE_AGENT); }
__device__ __forceinline__ unsigned xb_xcc_id() { return (unsigned)__builtin_amdgcn_s_getreg((3 << 11) | 20) & 0xFu; }
#define XB_SPIN(cond, bar) do { unsigned _sp = 0; while (cond) { __builtin_amdgcn_s_sleep(1); \
    if ((++_sp & 255u) == 0u) { if (xb_ld(&(bar)[XB_TMO])) break; if (_sp > XB_SPIN_CAP) { atomicAdd(&(bar)[XB_TMO], 1u); break; } } } } while (0)

struct XcdBarrier {
    unsigned* bar; unsigned x;
    volatile LAS unsigned* st;
};

__device__ __forceinline__ XcdBarrier xcd_barrier_post(unsigned* bar, volatile LAS unsigned* st) {
    XcdBarrier b; b.bar = bar; b.x = xb_xcc_id(); b.st = st;
    if (threadIdx.x == 0) (void)xb_add(&bar[XB_XCNT(b.x)], 1u);
    return b;
}
__device__ __forceinline__ void xcd_barrier_complete(unsigned* bar, unsigned x, unsigned& nloc, unsigned& nx) {
    const unsigned G = gridDim.x * gridDim.y * gridDim.z;
    unsigned sum, cnt, mine, sp = 0u;
    for (;;) {
        sum = 0u; cnt = 0u; mine = 0u;
#pragma unroll
        for (unsigned j = 0; j < 16; ++j) { const unsigned c = xb_ld(&bar[XB_XCNT(j)]); sum += c; cnt += (c > 0u) ? 1u : 0u; mine = (j == x) ? c : mine; }
        if (sum == G) break;
        __builtin_amdgcn_s_sleep(1);
        if ((++sp & 255u) == 0u) { if (xb_ld(&bar[XB_TMO])) break; if (sp > XB_SPIN_CAP) { atomicAdd(&bar[XB_TMO], 1u); break; } }
    }
    nloc = mine > 0u ? mine : 1u; nx = cnt > 0u ? cnt : 1u;
}

__device__ __forceinline__ void xcd_barrier(const XcdBarrier& b) {
    asm volatile("s_waitcnt vmcnt(0)" ::: "memory");
    __syncthreads();
    if (threadIdx.x == 0) {
        unsigned* bar = b.bar;
        __builtin_amdgcn_s_waitcnt(0);
        unsigned nloc = b.st[0], nx = b.st[1];
        if (nloc == 0u) { xcd_barrier_complete(bar, b.x, nloc, nx); b.st[0] = nloc; b.st[1] = nx; }
        const unsigned old = xb_add(&bar[XB_XSUB(b.x)], 1u);
        const unsigned gen = old / nloc;
        if (old + 1u == (gen + 1u) * nloc) {
            __builtin_amdgcn_fence(__ATOMIC_RELEASE, "agent");
            asm volatile("s_waitcnt vmcnt(0)" ::: "memory");
            const unsigned og = xb_add(&bar[XB_TOP], 1u);
            const unsigned tg = og / nx;
            if (og + 1u == (tg + 1u) * nx) xb_add(&bar[XB_TOPGEN], 1u);
            else XB_SPIN(xb_ld(&bar[XB_TOPGEN]) == tg, bar);
            __builtin_amdgcn_fence(__ATOMIC_ACQUIRE, "agent");
            xb_add(&bar[XB_XGEN(b.x)], 1u);
            asm volatile("s_waitcnt vmcnt(0)" ::: "memory");
        } else {
            XB_SPIN(xb_ld(&bar[XB_XGEN(b.x)]) == gen, bar);
            __builtin_amdgcn_fence(__ATOMIC_ACQUIRE, "agent");
            asm volatile("s_waitcnt vmcnt(0)" ::: "memory");
        }
    }
    __syncthreads();
}

__device__ __forceinline__ void seam(const XcdBarrier& b0) { XcdBarrier b = b0; asm volatile("" : "+s"(b.bar)); asm volatile("" : "+s"(b.x)); xcd_barrier(b); }

__global__ void __launch_bounds__(512, 2) hymba_fwd(Params p) {
    extern __shared__ __attribute__((aligned(16))) unsigned char smem[];
    LAS unsigned char* lds = (LAS unsigned char*)smem;
    cg::grid_group grid = cg::this_grid();
    const int tid = threadIdx.x, lane = tid & 63, wave = __builtin_amdgcn_readfirstlane(tid >> 6);
    const int G = gridDim.x, bid = blockIdx.x;
    const int gw = bid * 8 + wave, ngw = G * 8, gtid = bid * 512 + tid, nthreads = G * 512;
    unsigned* ctl = (unsigned*)(p.ws + WS_CTL);
    volatile LAS unsigned* xst = (volatile LAS unsigned*)(lds + L_XBST);
    if (tid == 0) { xst[0] = 0u; xst[1] = 0u; }
    __syncthreads();
    const XcdBarrier xb = xcd_barrier_post((unsigned*)(p.ws + WS_BAR), xst);
    bf16_t* W1T = (bf16_t*)(p.ws + WS_W1T); bf16_t* W1D = (bf16_t*)(p.ws + WS_W1D); bf16_t* W2T = (bf16_t*)(p.ws + WS_W2T); bf16_t* W2D = (bf16_t*)(p.ws + WS_W2D);
    bf16_t* WIN = (bf16_t*)(p.ws + WS_WIN); bf16_t* WGLU = (bf16_t*)(p.ws + WS_WGLU); bf16_t* WOUT = (bf16_t*)(p.ws + WS_WOUT);
    bf16_t* HB = (bf16_t*)(p.ws + WS_H); bf16_t* AB = (bf16_t*)(p.ws + WS_A); bf16_t* XC = (bf16_t*)(p.ws + WS_XC);
    float* yout = p.out + O_Y;
    pg8::StaticOrder S;

    {
        convert_items(p, lds, CV_W1T, CV_W1D, gw, ngw, wave, lane);
        rms_phase(p.in[0], p.in[1], p.in[6], HB, ngw - 1 - gw, ngw, lane);
        for (int i = gtid; i < MS * D / 4; i += nthreads) ((f32x4*)(yout + (size_t)MP * D))[i] = ((const f32x4*)p.in[1])[i];
    }
    if (p.use_cg) grid.sync();
    seam(xb);
    for (int rep = 0; rep < REP_P1; ++rep) { S.init(M, 2 * FF, G, bid); pg8::gemm_phase<true>(lds, pg8::Gemm{HB, W1T, M, 2 * FF, D, D}, S, EpiGateUp{AB});
        { const int nfull = S.nwg % G; if (nfull > 0 && bid >= nfull) convert_items(p, lds, CV_W1D, CV_WIN, (bid - nfull) * 8 + wave, (G - nfull) * 8, wave, lane); else if (nfull == 0) convert_items(p, lds, CV_W1D, CV_WIN, gw, ngw, wave, lane); }
        if (gtid >= nthreads - 2048) {
            const int idx = gtid - (nthreads - 2048), g = idx >> 6, pp = idx & 63;
            const double lr = p.in[12][idx], li = p.in[13][idx], step = exp((double)p.in[14][g]);
            const double mag = exp(lr * step), ang = li * step;
            const double are = mag * cos(ang), aim = mag * sin(ang);
            const double den = lr * lr + li * li, nre = are - 1.0, nim = aim;
            const float cre = (float)((nre * lr + nim * li) / den), cim = (float)((nim * lr - nre * li) / den);
            float* ABf = (float*)(p.ws + WS_S5A); ABf[idx] = (float)are; ABf[2048 + idx] = (float)aim;
            bf16_t* BBAR = (bf16_t*)(p.ws + WS_BBAR); bf16_t* CMAT = (bf16_t*)(p.ws + WS_CMAT);
            const float* bre = p.in[15] + (size_t)idx * 16; const float* bim = p.in[16] + (size_t)idx * 16;
#pragma unroll
            for (int hh = 0; hh < 16; hh += 2) {
                const float r0 = cre * bre[hh] - cim * bim[hh], r1 = cre * bre[hh + 1] - cim * bim[hh + 1];
                const float i0 = cre * bim[hh] + cim * bre[hh], i1 = cre * bim[hh + 1] + cim * bre[hh + 1];
                *(unsigned*)(BBAR + ((size_t)(g * 128 + pp)) * 16 + hh) = pk2(r0, r1);
                *(unsigned*)(BBAR + ((size_t)(g * 128 + 64 + pp)) * 16 + hh) = pk2(i0, i1);
            }
#pragma unroll
            for (int hh = 0; hh < 16; ++hh) {
                const float cr = p.in[17][((size_t)g * 16 + hh) * 64 + pp], ci = p.in[18][((size_t)g * 16 + hh) * 64 + pp];
                const unsigned pk = pk2(cr, -ci);
                CMAT[((size_t)(g * 16 + hh)) * 128 + pp] = (bf16_t)(pk & 0xffff); CMAT[((size_t)(g * 16 + hh)) * 128 + 64 + pp] = (bf16_t)(pk >> 16);
            }
        }
        seam(xb); }
    { S.init(MP, D, G, bid); pg8::gemm_phase<true>(lds, pg8::Gemm{AB, W1D, MP, D, FF, FF}, S, EpiResid{p.in[0], p.in[1], yout, 0.5f});
      pg8::SplitOrder S2{8 * (FF / 256), G, bid, 256}; pg8::gemm_phase<false>(lds, pg8::Gemm{AB + (size_t)MP * FF, W1D, MS, D, 256, FF}, S2, EpiPart{(float*)(p.ws + WS_YS), 0.5f}); }
    { const int nsp = 8 * (FF / 256); if (G > nsp) { if (bid >= nsp) convert_items(p, lds, CV_WIN, CV_WGLU, (bid - nsp) * 8 + wave, (G - nsp) * 8, wave, lane); } else convert_items(p, lds, CV_WIN, CV_WGLU, gw, ngw, wave, lane); }
    seam(xb);
    rms_phase(yout, yout + (size_t)MP * D, p.in[10], HB, gw, ngw, lane, (const float*)(p.ws + WS_YS), FF / 256, yout + (size_t)MP * D);
    seam(xb);
    { S.init(M, NINP, G, bid); pg8::gemm_phase<true>(lds, pg8::Gemm{HB, WIN, M, NINP, D, D}, S, EpiProj{AB, (float*)(p.ws + WS_DTRAW)}); }
    { const int nfull = S.nwg % G; if (nfull > 0 && bid >= nfull) convert_items(p, lds, CV_WGLU, CV_W2T, (bid - nfull) * 8 + wave, (G - nfull) * 8, wave, lane); else if (nfull == 0) convert_items(p, lds, CV_WGLU, CV_W2T, gw, ngw, wave, lane); }
    seam(xb);
    for (int rep = 0; rep < REP_P5; ++rep) {
        for (int wi = gw; wi < 256 * 7; wi += ngw) { const int pair = wi / 7, sg = wi % 7; s5_wave_item<1>(p, lds + wave * 12800, pair & 31, pair >> 5, sg, (pair >> 5) * SEQ + sg * 256, 256, lane); }
        conv_phase(p, gtid, nthreads); seam(xb); }
    for (int rep = 0; rep < REP_P6; ++rep) {
        volatile LAS int* bc = (volatile LAS int*)(lds + L_BCAST);
        constexpr int N_SSDP = NB * NH, N_S5P = 256, N_S5S = 128, N_SSDS = NSB * NH / SMP_PAIRS;
        for (;;) {
            __syncthreads();
            if (tid == 0) *bc = (int)atomicAdd(&ctl[rep * 64], 1u);
            __syncthreads();
            int it = *bc;
            if (it >= N_SSDP + N_S5P + N_S5S + N_SSDS) break;
            if (it < N_SSDP) { ssd_prompt_item(p, lds, it / NH, it % NH); continue; }
            it -= N_SSDP;
            if (it < N_SSDS) { ssd_sample_item(p, it); continue; }
            it -= N_SSDS;
            if (it < N_S5P) { const int pair = it; s5_wave_item<2>(p, lds + wave * 12800, pair & 31, pair >> 5, wave, (pair >> 5) * SEQ + wave * 256, 256, lane); continue; }
            it -= N_S5P;
            { const int idx = it * 8 + wave; s5_wave_item<0>(p, lds + wave * 12800, idx & 31, 0, 0, MP + (idx >> 5) * 16, 16, lane); }
        }
        seam(xb);
    }
    { S.init(M, 512, G, bid); pg8::gemm_phase<true>(lds, pg8::Gemm{HB, WGLU, M, 512, 512, 512}, S, EpiGlu{HB, p.in[21], XC}); }
    { const int nglu = S.nwg; if (G > nglu) { if (bid >= nglu) convert_items(p, lds, CV_W2T, CV_END, (bid - nglu) * 8 + wave, (G - nglu) * 8, wave, lane); } else convert_items(p, lds, CV_W2T, CV_END, gw, ngw, wave, lane); }
    for (int rep = 0; rep < REP_P7; ++rep) { gatenorm_phase(p, ngw - 1 - gw, ngw, lane); seam(xb); }
    { S.init(MP, D, G, bid); pg8::gemm_phase<true>(lds, pg8::Gemm{XC, WOUT, MP, D, DMIX, DMIX}, S, EpiResid{yout, yout + (size_t)MP * D, yout, 1.0f});
      pg8::SplitOrder S2{8 * (DMIX / 256), G, bid, 256}; pg8::gemm_phase<false>(lds, pg8::Gemm{XC + (size_t)MP * DMIX, WOUT, MS, D, 256, DMIX}, S2, EpiPart{(float*)(p.ws + WS_YS), 1.0f}); }
    seam(xb);
    rms_phase(yout, yout + (size_t)MP * D, p.in[29], HB, gw, ngw, lane, (const float*)(p.ws + WS_YS), DMIX / 256, yout + (size_t)MP * D);
    seam(xb);
    { S.init(M, 2 * FF, G, bid); pg8::gemm_phase<true>(lds, pg8::Gemm{HB, W2T, M, 2 * FF, D, D}, S, EpiGateUp{AB}); }
    seam(xb);
    { S.init(MP, D, G, bid); pg8::gemm_phase<true>(lds, pg8::Gemm{AB, W2D, MP, D, FF, FF}, S, EpiResid{yout, yout + (size_t)MP * D, yout, 0.5f});
      pg8::SplitOrder S2{8 * (FF / 256), G, bid, 256}; pg8::gemm_phase<false>(lds, pg8::Gemm{AB + (size_t)MP * FF, W2D, MS, D, 256, FF}, S2, EpiPart{(float*)(p.ws + WS_YS), 0.5f}); }
    seam(xb);
    { int lane_f = lane; asm volatile("" : "+v"(lane_f));
    for (int m = gw * 4; m < MP; m += ngw * 4) {
        f32x4 v[4][4], ww[4];
#pragma unroll
        for (int r = 0; r < 4; ++r)
#pragma unroll
            for (int j = 0; j < 4; ++j) v[r][j] = ((const f32x4*)(yout + (size_t)(m + r) * D))[lane_f + 64 * j];
#pragma unroll
        for (int j = 0; j < 4; ++j) ww[j] = ((const f32x4*)p.in[33])[lane_f + 64 * j];
#pragma unroll
        for (int r = 0; r < 4; ++r) {
            float ss = 0.f;
#pragma unroll
            for (int j = 0; j < 4; ++j) ss += (v[r][j].x * v[r][j].x + v[r][j].y * v[r][j].y) + (v[r][j].z * v[r][j].z + v[r][j].w * v[r][j].w);
            const float rstd = rsqrtf(wave_sum(ss) * (1.f / D) + EPS);
#pragma unroll
            for (int j = 0; j < 4; ++j) ((f32x4*)(yout + (size_t)(m + r) * D))[lane_f + 64 * j] = v[r][j] * rstd * ww[j];
        }
    }
    for (int ms = ngw - 1 - gw; ms < MS; ms += ngw) {
        f32x4 v[4]; sum_sample_row(yout + (size_t)MP * D, (const float*)(p.ws + WS_YS), FF / 256, ms, lane_f, v);
        float ss = 0.f;
#pragma unroll
        for (int j = 0; j < 4; ++j) ss += (v[j].x * v[j].x + v[j].y * v[j].y) + (v[j].z * v[j].z + v[j].w * v[j].w);
        const float rstd = rsqrtf(wave_sum(ss) * (1.f / D) + EPS);
#pragma unroll
        for (int j = 0; j < 4; ++j) ((f32x4*)(yout + (size_t)(MP + ms) * D))[lane_f + 64 * j] = v[j] * rstd * ((const f32x4*)p.in[33])[lane_f + 64 * j];
    } }
}

extern "C" void kernel_launch(void* const* d_in, const int* in_sizes, int n_in, void* d_out, int out_size, void* d_ws, size_t ws_size, hipStream_t stream) {
    static int grid_blocks = 0;
    if (grid_blocks == 0) {
        if (n_in != 34 || ws_size < WS_END) { fprintf(stderr, "kernel_launch: unexpected n_in %d or ws_size %zu (< %zu)\n", n_in, ws_size, (size_t)WS_END); grid_blocks = -1; return; }
        int dev = 0, cus = 0, per_cu = 0;
        hipGetDevice(&dev);
        hipDeviceGetAttribute(&cus, hipDeviceAttributeMultiprocessorCount, dev);
        hipFuncSetAttribute((const void*)hymba_fwd, hipFuncAttributeMaxDynamicSharedMemorySize, LDS_BYTES);
        hipOccupancyMaxActiveBlocksPerMultiprocessor(&per_cu, (const void*)hymba_fwd, 512, LDS_BYTES);
        if (per_cu < 1) { fprintf(stderr, "kernel_launch: occupancy query says %d blocks/CU\n", per_cu); per_cu = 1; }
        grid_blocks = cus;
    }
    if (grid_blocks < 0) return;
    if (hipMemsetAsync((char*)d_ws + WS_CTL, 0, 16384, stream) != hipSuccess) { fprintf(stderr, "kernel_launch: memset failed\n"); return; }
    Params p{};
    for (int i = 0; i < 34; ++i) p.in[i] = (const float*)d_in[i];
    p.out = (float*)d_out; p.ws = (unsigned char*)d_ws;
    void* args[] = {&p};
    hipError_t e = hipLaunchCooperativeKernel((const void*)hymba_fwd, dim3(grid_blocks), dim3(512), args, LDS_BYTES, stream);
    if (e != hipSuccess) fprintf(stderr, "cooperative launch failed: %s (grid %d)\n", hipGetErrorString(e), grid_blocks);
}
```
